# Optimizing an MI355X kernel written in HIP

```python
import jax
import jax.numpy as jnp
from jax import lax
import numpy as np

D_MODEL = 2048
BATCH = 16
SEQ = 2048
DEPTH = 4

GRID_W = 64
CTX_LEN = 256
N_MIXERS = 2
N_RWKV = (DEPTH + N_MIXERS - 1) // N_MIXERS
N_MLSTM = DEPTH // N_MIXERS
N_DIRS = 2
NORM_EPS = 1e-6

RWKV_HEAD = 64
RWKV_HEADS = D_MODEL // RWKV_HEAD
DECAY_LORA = 96
ICLR_LORA = 96
VRES_LORA = 64
GATE_LORA = 256
RWKV_GN_EPS = RWKV_HEAD * 1e-5

MLSTM_HEADS = 8
MLSTM_DV = D_MODEL // MLSTM_HEADS
MLSTM_DK = MLSTM_DV // 2
MLSTM_QK = MLSTM_HEADS * MLSTM_DK
MLSTM_V = MLSTM_HEADS * MLSTM_DV
MLSTM_PROJ = 2 * MLSTM_QK + 2 * MLSTM_V + N_DIRS * 2 * MLSTM_HEADS
CHUNK = 64
GATE_CAP = 15.0

D_FF = ((8 * D_MODEL + 767) // 768) * 256

kernel_name = 'hybrid_rwkv7_mlstm_flow_trunk'


def _rmsnorm(x, g):
    x32 = x.astype(jnp.float32)
    y = x32 * lax.rsqrt(jnp.mean(x32 * x32, axis=-1, keepdims=True) + NORM_EPS)
    return (y * g.astype(jnp.float32)).astype(x.dtype)


def _head_layernorm(y, n_heads, eps):
    shp = y.shape
    y32 = y.astype(jnp.float32).reshape(shp[:-1] + (n_heads, shp[-1] // n_heads))
    mu = jnp.mean(y32, axis=-1, keepdims=True)
    var = jnp.mean(jnp.square(y32 - mu), axis=-1, keepdims=True)
    return ((y32 - mu) * lax.rsqrt(var + eps)).reshape(shp)


def _grid_shift(h):
    b, t, d = h.shape
    rows = t // GRID_W
    q = d // 4
    g = h.reshape(b, rows, GRID_W, d)
    left = jnp.pad(g[:, :, :-1, :q], ((0, 0), (0, 0), (1, 0), (0, 0)))
    right = jnp.pad(g[:, :, 1:, q:2 * q], ((0, 0), (0, 0), (0, 1), (0, 0)))
    up = jnp.pad(g[:, :-1, :, 2 * q:3 * q], ((0, 0), (1, 0), (0, 0), (0, 0)))
    down = jnp.pad(g[:, 1:, :, 3 * q:], ((0, 0), (0, 1), (0, 0), (0, 0)))
    return jnp.concatenate([left, right, up, down], axis=-1).reshape(b, t, d)


def _seq_shift(h):
    half = h.shape[-1] // 2
    prev = jnp.pad(h[:, :-1, :half], ((0, 0), (1, 0), (0, 0)))
    nxt = jnp.pad(h[:, 1:, half:], ((0, 0), (0, 1), (0, 0)))
    return jnp.concatenate([prev, nxt], axis=-1)


def _dwconv_grid(u, w, bias):
    b, t, ch = u.shape
    rows = t // GRID_W
    y = lax.conv_general_dilated(u.reshape(b, rows, GRID_W, ch), w[:, :, None, :].astype(u.dtype),
                                 (1, 1), 'SAME', dimension_numbers=('NHWC', 'HWIO', 'NHWC'),
                                 feature_group_count=ch)
    return y.reshape(b, t, ch) + bias


def _dwconv_seq(u, w, bias):
    ch = u.shape[-1]
    y = lax.conv_general_dilated(u, w[:, None, :].astype(u.dtype), (1,), 'SAME',
                                 dimension_numbers=('NWC', 'WIO', 'NWC'), feature_group_count=ch)
    return y + bias


def _to_dirs(c_fwd, x_fwd, c_bwd, x_bwd):
    fwd = jnp.concatenate([c_fwd, x_fwd], axis=1)
    bwd = jnp.concatenate([jnp.flip(c_bwd, 1), jnp.flip(x_bwd, 1)], axis=1)
    return jnp.stack([fwd, bwd], axis=0)


def _from_dirs(y, l):
    yf, yb = y[0], y[1]
    return (yf[:, :l] + jnp.flip(yb[:, :l], 1), yf[:, l:] + jnp.flip(yb[:, l:], 1))


def _swiglu(h, w_in, w_out):
    u = h @ w_in
    return (jax.nn.silu(u[..., :D_FF]) * u[..., D_FF:]) @ w_out


def _rwkv7_scan(r, decay, k, v, z, b):
    nz, nb, tt, nh, n = r.shape
    tfirst = lambda a: jnp.moveaxis(a, 2, 0).astype(jnp.float32)

    def step(s, inp):
        r_t, w_t, k_t, v_t, z_t, b_t = inp
        sz = jnp.einsum('zbhvk,zbhk->zbhv', s, z_t)
        s = s * w_t[..., None, :] + sz[..., :, None] * b_t[..., None, :] + v_t[..., :, None] * k_t[..., None, :]
        return s, jnp.einsum('zbhvk,zbhk->zbhv', s, r_t)

    s0 = jnp.zeros((nz, nb, nh, n, n), jnp.float32)
    _, y = lax.scan(step, s0, (tfirst(r), tfirst(decay), tfirst(k), tfirst(v), tfirst(z), tfirst(b)))
    return jnp.moveaxis(y, 0, 2)


def _rwkv7_project(h, xx, p, v_first):
    xr, xw, xk, xv, xa, xg = [h + xx * p['mu'][n] for n in range(6)]
    r = xr @ p['w_r']
    k = xk @ p['w_k']
    v = xv @ p['w_v']
    if v_first is not None:
        v = v + (v_first - v) * jax.nn.sigmoid(p['v0'] + (xv @ p['v1']) @ p['v2'])
    w_pre = p['w0'][:, None, None, :] + jnp.einsum(
        'zbtr,zrd->zbtd', jnp.tanh(jnp.einsum('btd,zdr->zbtr', xw, p['w1'])), p['w2'])
    decay = jnp.exp(-jnp.exp(-jax.nn.softplus(-w_pre.astype(jnp.float32)) - 0.5))
    a = jax.nn.sigmoid(p['a0'][:, None, None, :] + jnp.einsum(
        'zbtr,zrd->zbtd', jnp.einsum('btd,zdr->zbtr', xa, p['a1']), p['a2']))
    g = jax.nn.sigmoid(xg @ p['g1']) @ p['g2']
    kk = (k * p['k_k']).astype(jnp.float32).reshape(k.shape[:-1] + (RWKV_HEADS, RWKV_HEAD))
    kk = (kk / jnp.maximum(jnp.linalg.norm(kk, axis=-1, keepdims=True), 1e-12)).reshape(k.shape).astype(k.dtype)
    k_mod = k * (1 + (a - 1) * p['k_a'])
    return r, decay, k_mod, v, -kk, kk * a, g


def _rwkv7_mixer(hx, hc, p, v_first, need_ctx):
    nb, t, d = hx.shape
    l = hc.shape[1]
    vf_c, vf_x = (None, None) if v_first is None else v_first
    rx, dx, kx, vx, zx, bx, gx = _rwkv7_project(hx, _grid_shift(hx) - hx, p, vf_x)
    rc, dc, kc, vc, zc, bc, gc = _rwkv7_project(hc, _seq_shift(hc) - hc, p, vf_c)
    heads = lambda a: a.reshape(a.shape[:-1] + (RWKV_HEADS, RWKV_HEAD))
    shared = lambda u_c, u_x: heads(_to_dirs(u_c, u_x, u_c, u_x))
    split = lambda u_c, u_x: heads(_to_dirs(u_c[0], u_x[0], u_c[1], u_x[1]))
    y = _rwkv7_scan(shared(rc, rx), split(dc, dx), split(kc, kx), shared(vc, vx), shared(zc, zx), split(bc, bx))
    y_c, y_x = _from_dirs(y.reshape(N_DIRS, nb, l + t, d), l)

    def readout(y_s, r, k_mod, v, g):
        yn = _head_layernorm(y_s, RWKV_HEADS, RWKV_GN_EPS) * p['ln_w'] + p['ln_b']
        rk = heads(r[None] * k_mod * p['r_k'].reshape(-1)).sum(-1).sum(0)
        bonus = (rk[..., None] * heads(v)).reshape(v.shape)
        return ((yn + bonus) * g).astype(hx.dtype) @ p['w_o']

    out_x = readout(y_x, rx, kx, vx, gx)
    out_c = readout(y_c, rc, kc, vc, gc) if need_ctx else None
    return out_x, out_c, (vc, vx)


def _mlstm_chunkwise(q, k, v, ig, lf):
    nz, nb, tt, nh, dk = q.shape
    dv = v.shape[-1]
    nc = tt // CHUNK

    def chunks(a):
        a = a.astype(jnp.float32).reshape((nz, nb, nc, CHUNK, nh) + a.shape[4:])
        return jnp.swapaxes(jnp.moveaxis(a, 2, 0), 3, 4)

    causal = jnp.tril(jnp.ones((CHUNK, CHUNK), dtype=bool))

    def step(carry, inp):
        c_st, n_st, m_st = carry
        qc, kc, vc, ic, fc = inp
        bcum = jnp.cumsum(fc, axis=-1)
        log_d = jnp.where(causal, bcum[..., :, None] - bcum[..., None, :] + ic[..., None, :], -jnp.inf)
        log_inter = bcum + m_st[..., None]
        m_t = jnp.maximum(log_inter, jnp.max(log_d, axis=-1))
        s = jnp.einsum('zbhtd,zbhjd->zbhtj', qc, kc) * jnp.exp(log_d - m_t[..., None])
        w_inter = jnp.exp(log_inter - m_t)
        num = w_inter[..., None] * jnp.einsum('zbhtd,zbhde->zbhte', qc, c_st) + jnp.einsum('zbhtj,zbhje->zbhte', s, vc)
        den = w_inter * jnp.einsum('zbhtd,zbhd->zbht', qc, n_st) + jnp.sum(s, axis=-1)
        h_out = num / jnp.maximum(jnp.abs(den), jnp.exp(-m_t))[..., None]
        b_end = bcum[..., -1]
        a_j = b_end[..., None] - bcum + ic
        m_new = jnp.maximum(b_end + m_st, jnp.max(a_j, axis=-1))
        wk = jnp.exp(a_j - m_new[..., None])[..., None] * kc
        dec = jnp.exp(b_end + m_st - m_new)
        c_st = dec[..., None, None] * c_st + jnp.einsum('zbhjd,zbhje->zbhde', wk, vc)
        n_st = dec[..., None] * n_st + jnp.sum(wk, axis=-2)
        return (c_st, n_st, m_new), h_out

    init = (jnp.zeros((nz, nb, nh, dk, dv), jnp.float32), jnp.zeros((nz, nb, nh, dk), jnp.float32),
            jnp.zeros((nz, nb, nh), jnp.float32))
    _, hs = lax.scan(step, init, (chunks(q), chunks(k), chunks(v), chunks(ig), chunks(lf)))
    hs = jnp.moveaxis(jnp.swapaxes(hs, 3, 4), 0, 2)
    return hs.reshape(nz, nb, tt, nh, dv).astype(v.dtype)


def _mlstm_mixer(hx, hc, p, need_ctx):
    nb, t, d = hx.shape
    l = hc.shape[1]

    def project(h, conv):
        u = h @ p['w_in']
        qk = jax.nn.silu(conv(u[..., :2 * MLSTM_QK]))
        v = u[..., 2 * MLSTM_QK:2 * MLSTM_QK + MLSTM_V]
        o = u[..., 2 * MLSTM_QK + MLSTM_V:2 * MLSTM_QK + 2 * MLSTM_V]
        gates = u[..., 2 * MLSTM_QK + 2 * MLSTM_V:].reshape(u.shape[:-1] + (N_DIRS, 2, MLSTM_HEADS)) + p['b_gate']
        gates = GATE_CAP * jnp.tanh(gates.astype(jnp.float32) / GATE_CAP)
        q = qk[..., :MLSTM_QK] * (MLSTM_DK ** -0.5)
        k = qk[..., MLSTM_QK:]
        return q, k, v, o, gates[..., 0, :], jax.nn.log_sigmoid(gates[..., 1, :])

    qx, kx, vx, ox, ix, fx = project(hx, lambda a: _dwconv_grid(a, p['conv_w'], p['conv_b']))
    qc, kc, vc, oc, ic, fc = project(hc, lambda a: _dwconv_seq(a, p['conv_w'][1], p['conv_b']))
    hd = lambda a, dh: a.reshape(a.shape[:-1] + (MLSTM_HEADS, dh))
    q = hd(_to_dirs(qc, qx, qc, qx), MLSTM_DK)
    k = hd(_to_dirs(kc, kx, kc, kx), MLSTM_DK)
    v = hd(_to_dirs(vc, vx, vc, vx), MLSTM_DV)
    ig = _to_dirs(ic[:, :, 0], ix[:, :, 0], ic[:, :, 1], ix[:, :, 1])
    lf = _to_dirs(fc[:, :, 0], fx[:, :, 0], fc[:, :, 1], fx[:, :, 1])
    h = _mlstm_chunkwise(q, k, v, ig, lf).reshape(N_DIRS, nb, l + t, MLSTM_V)
    h_c, h_x = _from_dirs(h, l)

    def readout(h_s, o):
        hn = _head_layernorm(h_s, MLSTM_HEADS, NORM_EPS) * p['norm_w']
        return (hn * jax.nn.sigmoid(o.astype(jnp.float32))).astype(hx.dtype) @ p['w_out']

    out_x = readout(h_x, ox)
    out_c = readout(h_c, oc) if need_ctx else None
    return out_x, out_c


def setup_inputs(seed: int = 0) -> dict:
    key = jax.random.key(seed)
    ks = iter(jax.random.split(key, 64))
    d = D_MODEL
    na, nbl = N_RWKV, N_MLSTM
    nrm = lambda shape, scale: jax.random.normal(next(ks), shape, jnp.float32) * scale
    uni = lambda shape, lo, hi: jax.random.uniform(next(ks), shape, jnp.float32, lo, hi)
    b_gate = jnp.stack([nrm((nbl, N_DIRS, MLSTM_HEADS), 0.1),
                        uni((nbl, N_DIRS, MLSTM_HEADS), 3.0, 6.0)], axis=2)
    return {
        'x': nrm((BATCH, SEQ, d), 1.0),
        'c': nrm((BATCH, d), 1.0),
        'ctx': nrm((BATCH, CTX_LEN, d), 1.0),
        'c_ctx': nrm((d,), 1.0),
        'mod_w': nrm((DEPTH, d, 6 * d), 0.5 * d ** -0.5),
        'mod_b': nrm((DEPTH, 6 * d), 0.02),
        'norm_g': 1.0 + nrm((DEPTH, 2, d), 0.02),
        'final_g': 1.0 + nrm((d,), 0.02),
        'rwkv_mu': uni((na, 6, d), 0.0, 1.0),
        'rwkv_w_r': nrm((na, d, d), d ** -0.5),
        'rwkv_w_k': nrm((na, d, d), d ** -0.5),
        'rwkv_w_v': nrm((na, d, d), d ** -0.5),
        'rwkv_w_o': nrm((na, d, d), d ** -0.5),
        'rwkv_w0': uni((na, N_DIRS, d), -6.0, -0.5),
        'rwkv_w1': nrm((na, N_DIRS, d, DECAY_LORA), d ** -0.5),
        'rwkv_w2': nrm((na, N_DIRS, DECAY_LORA, d), 0.5 * DECAY_LORA ** -0.5),
        'rwkv_a0': nrm((na, N_DIRS, d), 0.3),
        'rwkv_a1': nrm((na, N_DIRS, d, ICLR_LORA), d ** -0.5),
        'rwkv_a2': nrm((na, N_DIRS, ICLR_LORA, d), 0.5 * ICLR_LORA ** -0.5),
        'rwkv_g1': nrm((na, d, GATE_LORA), d ** -0.5),
        'rwkv_g2': nrm((na, GATE_LORA, d), GATE_LORA ** -0.5),
        'rwkv_k_k': 0.85 + nrm((na, d), 0.02),
        'rwkv_k_a': 1.0 + nrm((na, d), 0.02),
        'rwkv_r_k': nrm((na, RWKV_HEADS, RWKV_HEAD), 0.1),
        'rwkv_ln_w': 1.0 + nrm((na, d), 0.02),
        'rwkv_ln_b': nrm((na, d), 0.02),
        'rwkv_v0': nrm((na - 1, d), 0.3),
        'rwkv_v1': nrm((na - 1, d, VRES_LORA), d ** -0.5),
        'rwkv_v2': nrm((na - 1, VRES_LORA, d), 0.5 * VRES_LORA ** -0.5),
        'mlstm_w_in': nrm((nbl, d, MLSTM_PROJ), d ** -0.5),
        'mlstm_b_gate': b_gate,
        'mlstm_conv_w': nrm((nbl, 3, 3, 2 * MLSTM_QK), 1.0 / 3.0),
        'mlstm_conv_b': nrm((nbl, 2 * MLSTM_QK), 0.02),
        'mlstm_norm_w': 1.0 + nrm((nbl, MLSTM_V), 0.02),
        'mlstm_w_out': nrm((nbl, MLSTM_V, d), MLSTM_V ** -0.5),
        'ffn_w_in': nrm((DEPTH, d, 2 * D_FF), d ** -0.5),
        'ffn_w_out': nrm((DEPTH, D_FF, d), D_FF ** -0.5),
    }


def reference(x, c, ctx, c_ctx, mod_w, mod_b, norm_g, final_g,
              rwkv_mu, rwkv_w_r, rwkv_w_k, rwkv_w_v, rwkv_w_o, rwkv_w0, rwkv_w1, rwkv_w2,
              rwkv_a0, rwkv_a1, rwkv_a2, rwkv_g1, rwkv_g2, rwkv_k_k, rwkv_k_a, rwkv_r_k,
              rwkv_ln_w, rwkv_ln_b, rwkv_v0, rwkv_v1, rwkv_v2,
              mlstm_w_in, mlstm_b_gate, mlstm_conv_w, mlstm_conv_b, mlstm_norm_w, mlstm_w_out,
              ffn_w_in, ffn_w_out):
    v_first = None
    for i in range(DEPTH):
        last = i == DEPTH - 1
        j = i // N_MIXERS
        mod_x = jax.nn.silu(c) @ mod_w[i] + mod_b[i]
        mod_c = jax.nn.silu(c_ctx) @ mod_w[i] + mod_b[i]
        sh1, sc1, gt1, sh2, sc2, gt2 = jnp.split(mod_x[:, None, :], 6, axis=-1)
        csh1, csc1, cgt1, csh2, csc2, cgt2 = jnp.split(mod_c, 6, axis=-1)
        hx = _rmsnorm(x, norm_g[i, 0]) * (1 + sc1) + sh1
        hc = _rmsnorm(ctx, norm_g[i, 0]) * (1 + csc1) + csh1
        if i % N_MIXERS == 0:
            p = {'mu': rwkv_mu[j], 'w_r': rwkv_w_r[j], 'w_k': rwkv_w_k[j], 'w_v': rwkv_w_v[j],
                 'w_o': rwkv_w_o[j], 'w0': rwkv_w0[j], 'w1': rwkv_w1[j], 'w2': rwkv_w2[j],
                 'a0': rwkv_a0[j], 'a1': rwkv_a1[j], 'a2': rwkv_a2[j], 'g1': rwkv_g1[j], 'g2': rwkv_g2[j],
                 'k_k': rwkv_k_k[j], 'k_a': rwkv_k_a[j], 'r_k': rwkv_r_k[j],
                 'ln_w': rwkv_ln_w[j], 'ln_b': rwkv_ln_b[j]}
            if j > 0:
                p['v0'] = rwkv_v0[j - 1]
                p['v1'] = rwkv_v1[j - 1]
                p['v2'] = rwkv_v2[j - 1]
            out_x, out_c, v_pair = _rwkv7_mixer(hx, hc, p, v_first if j > 0 else None, not last)
            if j == 0:
                v_first = v_pair
        else:
            p = {'w_in': mlstm_w_in[j], 'b_gate': mlstm_b_gate[j], 'conv_w': mlstm_conv_w[j],
                 'conv_b': mlstm_conv_b[j], 'norm_w': mlstm_norm_w[j], 'w_out': mlstm_w_out[j]}
            out_x, out_c = _mlstm_mixer(hx, hc, p, not last)
        x = x + gt1 * out_x
        hx = _rmsnorm(x, norm_g[i, 1]) * (1 + sc2) + sh2
        x = x + gt2 * _swiglu(hx, ffn_w_in[i], ffn_w_out[i])
        if not last:
            ctx = ctx + cgt1 * out_c
            hc = _rmsnorm(ctx, norm_g[i, 1]) * (1 + csc2) + csh2
            ctx = ctx + cgt2 * _swiglu(hc, ffn_w_in[i], ffn_w_out[i])
    return _rmsnorm(x, final_g)
```

```cpp
#include <hip/hip_runtime.h>
#include <cstdio>
#include <cstdint>

#define LAS __attribute__((address_space(3)))
#define GAS __attribute__((address_space(1)))
typedef unsigned short bf16_t;
typedef short bf16x8 __attribute__((ext_vector_type(8)));
typedef short bf16x4 __attribute__((ext_vector_type(4)));
typedef float f32x4 __attribute__((ext_vector_type(4)));
typedef float f32x2 __attribute__((ext_vector_type(2)));
typedef unsigned u32x4 __attribute__((ext_vector_type(4)));
typedef unsigned u32x2 __attribute__((ext_vector_type(2)));
#define LDS_WAIT() asm volatile("s_waitcnt lgkmcnt(0)" ::: "memory")
#define VM_WAIT() asm volatile("s_waitcnt vmcnt(0)" ::: "memory")

constexpr int D = 2048, NB = 16, SEQ = 2048, CTXL = 256, SROW = 2304, T = NB * SROW;
constexpr int NGRP = 2, BG = 8, TG = BG * SROW;
constexpr int DFF = 5632;
constexpr int RH = 32;
constexpr int MH = 8, MDV = 256, MDK = 128, MPROJ = 6176, ULD = 6144;
constexpr int MODLD = 6 * D;
constexpr int NIN = 37;
enum { I_X = 0, I_C, I_CTX, I_CCTX, I_MODW, I_MODB, I_NORMG, I_FINALG, I_MU, I_WR, I_WK, I_WV, I_WO, I_W0, I_W1, I_W2, I_A0, I_A1, I_A2, I_G1, I_G2, I_KK, I_KA, I_RK, I_LNW, I_LNB,
       I_V0, I_V1, I_V2, I_MWIN, I_BGATE, I_CONVW, I_CONVB, I_MNORMW, I_MWOUT, I_FWIN, I_FWOUT };

constexpr size_t MiB = 1u << 20;
constexpr size_t WS_CTL = 0, CTL_ZERO_BYTES = 1 * MiB;
constexpr size_t WS_MOD = 1 * MiB;
constexpr size_t WS_XRES = 5 * MiB;
constexpr size_t WS_VF = 293 * MiB;
constexpr size_t WS_WMIX = 437 * MiB;
constexpr size_t WS_WFFN = 479 * MiB;
constexpr size_t WS_ACT = 545 * MiB;
constexpr size_t WS_END = WS_ACT + 977 * MiB;
static_assert(WS_END <= (size_t)1536 * MiB, "ws");
constexpr size_t WM_R = 0, WM_K = 8 * MiB, WM_V = 16 * MiB, WM_O = 24 * MiB, WM_W1 = 32 * MiB, WM_A1 = 33 * MiB, WM_G1 = 34 * MiB, WM_V1 = 35 * MiB,
                 WM_W2 = 36 * MiB, WM_A2 = 38 * MiB, WM_G2 = 40 * MiB, WM_V2 = 41 * MiB;
constexpr size_t WM_MIN = 0, WM_MOUT = 25 * MiB;
constexpr size_t WF_IN = 0, WF_OUT = 44 * MiB;
constexpr size_t SLOT = 72 * MiB;
constexpr size_t AR_MIX = 0;
constexpr size_t AR_H = 432 * MiB;
constexpr size_t AR_R = 432 * MiB, AR_K = 504 * MiB, AR_V = 576 * MiB;
constexpr size_t AR_LORA = 648 * MiB;
constexpr size_t AR_Y = 684 * MiB;
constexpr size_t AR_RK = 828 * MiB;
constexpr size_t AR_AO = 833 * MiB;
constexpr size_t AM_HB = 0, AM_U = 144 * MiB, AM_QK = 576 * MiB, AM_HZ1 = 720 * MiB, AM_G = 864 * MiB;
constexpr size_t AF_H2 = 0, AF_U = 144 * MiB;

constexpr int LDS_BYTES = 147456;
constexpr int LDSCTL_OFF = LDS_BYTES - 256;

__device__ __forceinline__ float bf2f(bf16_t b) { return __uint_as_float(((unsigned)b) << 16); }
typedef __bf16 bf16x2n_t __attribute__((ext_vector_type(2)));
__device__ __forceinline__ unsigned pk2(float lo, float hi) { const f32x2 v = {lo, hi}; return __builtin_bit_cast(unsigned, __builtin_convertvector(v, bf16x2n_t)); }
__device__ __forceinline__ unsigned f2bf(float f) { return pk2(f, f) & 0xffffu; }
__device__ __forceinline__ unsigned pk2a(float lo, float hi) { unsigned r; asm("v_cvt_pk_bf16_f32 %0, %1, %2" : "=v"(r) : "v"(lo), "v"(hi)); return r; }
__device__ __forceinline__ unsigned f2bfa(float f) { return pk2a(f, f) & 0xffffu; }
__device__ __forceinline__ float lo_bf(unsigned w) { return __uint_as_float(w << 16); }
__device__ __forceinline__ float hi_bf(unsigned w) { return __uint_as_float(w & 0xffff0000u); }
__device__ __forceinline__ float sigmoidf_(float x) { return __builtin_amdgcn_rcpf(1.0f + __expf(-x)); }
__device__ __forceinline__ float tanhf_(float x) { return 1.0f - 2.0f * __builtin_amdgcn_rcpf(1.0f + __expf(2.0f * x)); }
__device__ __forceinline__ float siluf_(float x) { return x * __builtin_amdgcn_rcpf(1.0f + __expf(-x)); }
template <int CTRL> __device__ __forceinline__ float dpp_(float v) { return __int_as_float(__builtin_amdgcn_update_dpp(0, __float_as_int(v), CTRL, 0xF, 0xF, true)); }
__device__ __forceinline__ float rl_(float v, int k) { return __int_as_float(__builtin_amdgcn_readlane(__float_as_int(v), k)); }
__device__ __forceinline__ float sum8_(float v) { v += dpp_<0xB1>(v); v += dpp_<0x4E>(v); v += dpp_<0x141>(v); return v; }
__device__ __forceinline__ float sum16_(float v) { v = sum8_(v); v += dpp_<0x140>(v); return v; }
__device__ __forceinline__ float wave_sum_dpp(float v) { v = sum16_(v); return (rl_(v, 0) + rl_(v, 16)) + (rl_(v, 32) + rl_(v, 48)); }
__device__ __forceinline__ float wave_sum(float v) { return wave_sum_dpp(v); }
__device__ __forceinline__ float shfl_xor_(float v, int mask, int lane) { return __int_as_float(__builtin_amdgcn_ds_bpermute((lane ^ mask) << 2, __float_as_int(v))); }

#define XB_TMO      128
#define XB_XCNT(j)  (256  + 64 * (j))
#define XB_XSUB(j)  (1280 + 64 * (j))
#define XB_XGEN(j)  (2304 + 64 * (j))
#define XB_TOP      3328
#define XB_TOPGEN   3392
#define XCD_BAR_WORDS 3456
#define XB_SPIN_CAP (1u << 24)

__device__ __forceinline__ unsigned xb_ld(unsigned* p)              { return __hip_atomic_load(p, __ATOMIC_RELAXED, __HIP_MEMORY_SCOPE_AGENT); }
__device__ __forceinline__ unsigned xb_add(unsigned* p, unsigned v) { return __hip_atomic_fetch_add(p, v, __ATOMIC_RELAXED, __HIP_MEMORY_SCOPE_AGENT); }
__device__ __forceinline__ unsigned xb_xcc_id() { return (unsigned)__builtin_amdgcn_s_getreg((3 << 11) | 20) & 0xFu; }
#define XB_SPIN(cond, bar) do { unsigned _sp = 0; while (cond) { __builtin_amdgcn_s_sleep(1); \
    if ((++_sp & 255u) == 0u) { if (xb_ld(&(bar)[XB_TMO])) break; if (_sp > XB_SPIN_CAP) { atomicAdd(&(bar)[XB_TMO], 1u); break; } } } } while (0)

struct XcdBarrier { unsigned* bar; unsigned x; volatile LAS unsigned* st; };

__device__ __forceinline__ XcdBarrier xcd_barrier_post(unsigned* bar, volatile LAS unsigned* st) {
    XcdBarrier b; b.bar = bar; b.x = xb_xcc_id(); b.st = st;
    if (threadIdx.x == 0) (void)xb_add(&bar[XB_XCNT(b.x)], 1u);
    return b;
}
__device__ __forceinline__ void xcd_barrier_complete(unsigned* bar, unsigned x, unsigned& nloc, unsigned& nx) {
    const unsigned G = gridDim.x * gridDim.y * gridDim.z;
    unsigned sum, cnt, mine, sp = 0u;
    for (;;) {
        sum = 0u; cnt = 0u; mine = 0u;
#pragma unroll
        for (unsigned j = 0; j < 16; ++j) { const unsigned c = xb_ld(&bar[XB_XCNT(j)]); sum += c; cnt += (c > 0u) ? 1u : 0u; mine = (j == x) ? c : mine; }
        if (sum == G) break;
        __builtin_amdgcn_s_sleep(1);
        if ((++sp & 255u) == 0u) { if (xb_ld(&bar[XB_TMO])) break; if (sp > XB_SPIN_CAP) { atomicAdd(&bar[XB_TMO], 1u); break; } }
    }
    nloc = mine > 0u ? mine : 1u; nx = cnt > 0u ? cnt : 1u;
}
__device__ __forceinline__ void xcd_barrier(const XcdBarrier& b) {
    asm volatile("s_waitcnt vmcnt(0)" ::: "memory");
    __syncthreads();
    if (threadIdx.x == 0) {
        unsigned* bar = b.bar;
        __builtin_amdgcn_s_waitcnt(0);
        unsigned nloc = b.st[0], nx = b.st[1];
        if (nloc == 0u) { xcd_barrier_complete(bar, b.x, nloc, nx); b.st[0] = nloc; b.st[1] = nx; }
        const unsigned old = xb_add(&bar[XB_XSUB(b.x)], 1u);
        const unsigned gen = old / nloc;
        if (old + 1u == (gen + 1u) * nloc) {
            __builtin_amdgcn_fence(__ATOMIC_RELEASE, "agent");
            asm volatile("s_waitcnt vmcnt(0)" ::: "memory");
            const unsigned og = xb_add(&bar[XB_TOP], 1u);
            const unsigned tg = og / nx;
            if (og + 1u == (tg + 1u) * nx) xb_add(&bar[XB_TOPGEN], 1u);
            else XB_SPIN(xb_ld(&bar[XB_TOPGEN]) == tg, bar);
            __builtin_amdgcn_fence(__ATOMIC_ACQUIRE, "agent");
            xb_add(&bar[XB_XGEN(b.x)], 1u);
            asm volatile("s_waitcnt vmcnt(0)" ::: "memory");
        } else {
            XB_SPIN(xb_ld(&bar[XB_XGEN(b.x)]) == gen, bar);
            __builtin_amdgcn_fence(__ATOMIC_ACQUIRE, "agent");
            asm volatile("s_waitcnt vmcnt(0)" ::: "memory");
        }
    }
    __syncthreads();
}
#ifndef GP_ALIGN
#define GP_ALIGN true
#endif
#ifndef GP_SP2
#define GP_SP2 true
#endif
namespace pg8 {
constexpr int BM = 256, BK = 64, HALF = 128, HTB = HALF * BK * 2  , STAGE_BYTES = 8 * HTB, NXCD = 8, WGM = 8;

__host__ __device__ __forceinline__ int lds_byte(int r, int c) { const int st = (r >> 4) * 2 + (c >> 5), rr = r & 15, cc = c & 31, ob = rr * 64 + cc * 2; return st * 1024 + (ob ^ (((ob >> 9) & 1) << 5)); }
__host__ __device__ __forceinline__ void stage_rc(int b, int& R, int& C) { const int st = b / 1024, sb = b % 1024, swz = sb ^ (((sb >> 9) & 1) << 5); R = (st >> 1) * 16 + swz / 64; C = (st & 1) * 32 + (swz % 64) / 2; }
__host__ __device__ __forceinline__ int perm32(int rho) { const int n = rho >> 4, i = rho & 15; return 8 * (i >> 2) + 4 * n + (i & 3); }

struct Unit { int pm, pn; };
struct Gemm { const bf16_t* A; const bf16_t* Bt; int M, N, K; };

struct StaticOrder {
    int nM, nN, nwg, G, c, skip;
    __host__ __device__ void init(int M, int N, int G_, int c_, int skip_ = 0) { nM = M / BM; nN = N / BM; nwg = nM * nN; G = G_; c = c_; skip = skip_; }
    __host__ __device__ bool next(int i, Unit& u) const {
        const long L = (long)i * G + c; if (L >= nwg) return false;
        int wgid = (int)L; { const int q = nwg / NXCD, r = nwg % NXCD, xcd = wgid % NXCD, off = wgid / NXCD; wgid = (xcd < r ? xcd * (q + 1) : r * (q + 1) + (xcd - r) * q) + off; }
        const int nig = WGM * nN, gid = wgid / nig, fm = gid * WGM, gsz = (nM - fm) < WGM ? (nM - fm) : WGM;
        u.pm = fm + ((wgid % nig) % gsz); u.pn = (wgid % nig) / gsz; if (skip) u.pm += (u.pm >> 3) + 1; return true;
    }
    __device__ __forceinline__ void a_ready(const Unit&) const {}
    __device__ __forceinline__ void done(const Unit&) const {}
};
__device__ __forceinline__ unsigned cvt_pk_bf16(float lo, float hi) { unsigned r; asm volatile("v_cvt_pk_bf16_f32 %0, %1, %2" : "=v"(r) : "v"(lo), "v"(hi)); return r; }
template <class Epi, class Sched, bool ALIGN_EPI = false, bool SP2 = false>
__device__ __forceinline__ void gemm_phase(LAS unsigned char* lds, const Gemm g, const Sched& S, const Epi& E) {
    int tid_ = threadIdx.x; asm volatile("" : "+v"(tid_));
    const int tid = tid_, wid = __builtin_amdgcn_readfirstlane(tid >> 6), lane = tid & 63, wr = wid >> 2, wc = wid & 3, fr = lane & 15, fq = lane >> 4;
    const int K = g.K, nt = K / BK;
    unsigned voffA[2], voffB[2];
#pragma unroll
    for (int i = 0; i < 2; ++i) { int R, C; stage_rc(tid * 16 + i * 8192, R, C); const int Rb = E.perm() ? ((R & ~31) + perm32(R & 31)) : R;
        voffA[i] = (unsigned)(R * K + C) * 2u; voffB[i] = (unsigned)(Rb * K + C) * 2u; }
    const size_t kstep = (size_t)(BK * 2);
    const size_t hstep = (size_t)HALF * K * 2;
    const size_t tstep = 2 * hstep;
    const unsigned ldsw = (unsigned)wid * 1024u;
    const int aoff = lds_byte(wr * 64 + fr, fq * 8), boff = lds_byte(wc * 32 + fr, fq * 8);
#define PG8_SA(b, h) (((b) * 2 + (h)) * HTB)
#define PG8_SB(b, h) ((4 + (b) * 2 + (h)) * HTB)
#define PG8_STAGE(bufoff, gbase, voff) do { _Pragma("unroll") for (int _i = 0; _i < 2; ++_i) \
        __builtin_amdgcn_global_load_lds((const unsigned*)((const char*)(gbase) + (voff)[_i]), (LAS unsigned*)(lds + (bufoff) + ldsw + _i * 8192), 16, 0, 0); } while (0)
#define PG8_LDA(dst, b, h) do { _Pragma("unroll") for (int m = 0; m < 4; ++m) _Pragma("unroll") for (int k = 0; k < 2; ++k) dst[m][k] = *(const LAS bf16x8*)(lds + PG8_SA(b, h) + aoff + m * 2048 + k * 1024); } while (0)
#define PG8_LDB(dst, b, h) do { _Pragma("unroll") for (int n = 0; n < 2; ++n) _Pragma("unroll") for (int k = 0; k < 2; ++k) dst[n][k] = *(const LAS bf16x8*)(lds + PG8_SB(b, h) + boff + n * 2048 + k * 1024); } while (0)
#define PG8_MMA(ai, bj, At, Bt) do { __builtin_amdgcn_s_setprio(1); _Pragma("unroll") for (int m = 0; m < 4; ++m) _Pragma("unroll") for (int n = 0; n < 2; ++n) _Pragma("unroll") for (int k = 0; k < 2; ++k) \
        acc[ai][bj][m][n] = __builtin_amdgcn_mfma_f32_16x16x32_bf16(Bt[n][k], At[m][k], acc[ai][bj][m][n], 0, 0, 0); __builtin_amdgcn_s_setprio(0); } while (0)
#define PG8_WAIT_V(n) asm volatile("s_waitcnt vmcnt(" #n ")" ::: "memory")
#define PG8_WAIT_L(n) asm volatile("s_waitcnt lgkmcnt(" #n ")" ::: "memory")
#define PG8_BAR __builtin_amdgcn_s_barrier()
#define PG8_SCHED __builtin_amdgcn_sched_barrier(0)
    Unit cur, nxt; int ui = 0;
    if (!S.next(0, cur)) return;
    f32x4 acc[2][2][4][2];
#pragma unroll
    for (int a = 0; a < 2; ++a)
#pragma unroll
        for (int b = 0; b < 2; ++b)
#pragma unroll
            for (int m = 0; m < 4; ++m)
#pragma unroll
                for (int n = 0; n < 2; ++n) acc[a][b][m][n] = (f32x4){0.f, 0.f, 0.f, 0.f};
    bf16x8 At[4][2], B0[2][2], B1[2][2];
    const char* cA = (const char*)g.A + (size_t)cur.pm * tstep; const char* cB = (const char*)g.Bt + (size_t)cur.pn * tstep;
    S.a_ready(cur);
    if constexpr (SP2) {
        PG8_STAGE(PG8_SB(0, 0), cB, voffB); PG8_STAGE(PG8_SB(0, 1), cB + hstep, voffB); PG8_STAGE(PG8_SA(0, 0), cA, voffA); PG8_STAGE(PG8_SA(0, 1), cA + hstep, voffA);
        if (wr == 1) PG8_BAR;
        PG8_WAIT_V(2); PG8_BAR;
        PG8_STAGE(PG8_SB(1, 0), cB + kstep, voffB); PG8_STAGE(PG8_SA(1, 0), cA + kstep, voffA); PG8_STAGE(PG8_SB(1, 1), cB + hstep + kstep, voffB);
        PG8_WAIT_V(6); PG8_BAR;
    } else {
        PG8_STAGE(PG8_SB(0, 0), cB, voffB); PG8_STAGE(PG8_SA(0, 0), cA, voffA); PG8_STAGE(PG8_SB(0, 1), cB + hstep, voffB); PG8_STAGE(PG8_SA(0, 1), cA + hstep, voffA);
        if (wr == 1) PG8_BAR;
        PG8_WAIT_V(4); PG8_BAR;
        PG8_STAGE(PG8_SB(1, 0), cB + kstep, voffB); PG8_STAGE(PG8_SA(1, 0), cA + kstep, voffA); PG8_STAGE(PG8_SB(1, 1), cB + hstep + kstep, voffB);
        PG8_WAIT_V(6); PG8_BAR;
    }
    for (;;) {
        const bool has_next = S.next(ui + 1, nxt);
        const char* nA = has_next ? (const char*)g.A + (size_t)nxt.pm * tstep : cA; const char* nB = has_next ? (const char*)g.Bt + (size_t)nxt.pn * tstep : cB;
#pragma unroll 1
        for (int t = 0; t < nt; t += 2) {
            const bool last = (t == nt - 2);
            const char* a1 = cA + (size_t)(t + 1) * kstep;
            const char* a2 = last ? nA : cA + (size_t)(t + 2) * kstep; const char* b2 = last ? nB : cB + (size_t)(t + 2) * kstep;
            const char* a3 = a2 + kstep; const char* b3 = b2 + kstep;
            if (last && has_next) S.a_ready(nxt);
            if constexpr (SP2) {
            PG8_LDB(B0, 0, 0); PG8_LDB(B1, 0, 1); PG8_SCHED; PG8_LDA(At, 0, 0); PG8_STAGE(PG8_SA(1, 1), a1 + hstep, voffA);
            PG8_WAIT_V(8); PG8_WAIT_L(0); PG8_BAR; PG8_MMA(0, 0, At, B0); PG8_MMA(0, 1, At, B1); PG8_BAR; PG8_SCHED;
            PG8_LDA(At, 0, 1); PG8_STAGE(PG8_SB(0, 0), b2, voffB); PG8_STAGE(PG8_SB(0, 1), b2 + hstep, voffB); PG8_STAGE(PG8_SA(0, 0), a2, voffA);
            PG8_WAIT_V(8); PG8_WAIT_L(0); PG8_BAR; PG8_MMA(1, 0, At, B0); PG8_MMA(1, 1, At, B1); PG8_BAR; PG8_SCHED;
            PG8_LDB(B0, 1, 0); PG8_LDB(B1, 1, 1); PG8_SCHED; PG8_LDA(At, 1, 0); PG8_STAGE(PG8_SA(0, 1), a2 + hstep, voffA);
            PG8_WAIT_V(8); PG8_WAIT_L(0); PG8_BAR; PG8_MMA(0, 0, At, B0); PG8_MMA(0, 1, At, B1); PG8_BAR; PG8_SCHED;
            PG8_LDA(At, 1, 1); PG8_STAGE(PG8_SB(1, 0), b3, voffB); PG8_STAGE(PG8_SB(1, 1), b3 + hstep, voffB); PG8_STAGE(PG8_SA(1, 0), a3, voffA);
            PG8_WAIT_V(8); PG8_WAIT_L(0); PG8_BAR; PG8_MMA(1, 0, At, B0); PG8_MMA(1, 1, At, B1); PG8_BAR; PG8_SCHED;
            } else {
            PG8_LDB(B0, 0, 0); PG8_SCHED; PG8_LDA(At, 0, 0); PG8_STAGE(PG8_SA(1, 1), a1 + hstep, voffA);
            PG8_WAIT_L(8); PG8_BAR; PG8_WAIT_L(0); PG8_MMA(0, 0, At, B0); PG8_BAR; PG8_SCHED;
            PG8_LDB(B1, 0, 1); PG8_STAGE(PG8_SB(0, 0), b2, voffB);
            PG8_BAR; PG8_WAIT_L(0); PG8_MMA(0, 1, At, B1); PG8_BAR;
            PG8_LDA(At, 0, 1); PG8_STAGE(PG8_SA(0, 0), a2, voffA);
            PG8_BAR; PG8_WAIT_L(0); PG8_MMA(1, 0, At, B0); PG8_BAR; PG8_SCHED;
            PG8_STAGE(PG8_SB(0, 1), b2 + hstep, voffB);
            PG8_WAIT_V(6); PG8_BAR; PG8_MMA(1, 1, At, B1); PG8_BAR;
            PG8_LDB(B0, 1, 0); PG8_SCHED; PG8_LDA(At, 1, 0); PG8_STAGE(PG8_SA(0, 1), a2 + hstep, voffA);
            PG8_WAIT_L(8); PG8_BAR; PG8_WAIT_L(0); PG8_MMA(0, 0, At, B0); PG8_BAR; PG8_SCHED;
            PG8_LDB(B1, 1, 1); PG8_STAGE(PG8_SB(1, 0), b3, voffB);
            PG8_BAR; PG8_WAIT_L(0); PG8_MMA(0, 1, At, B1); PG8_BAR;
            PG8_LDA(At, 1, 1); PG8_STAGE(PG8_SA(1, 0), a3, voffA);
            PG8_BAR; PG8_WAIT_L(0); PG8_MMA(1, 0, At, B0); PG8_BAR; PG8_SCHED;
            PG8_STAGE(PG8_SB(1, 1), b3 + hstep, voffB);
            PG8_WAIT_V(6); PG8_BAR; PG8_MMA(1, 1, At, B1); PG8_BAR;
            }
        }
        if constexpr (ALIGN_EPI) { if (wr == 0) PG8_BAR; }
        if constexpr (!Epi::AFTER_DRAIN) { int wr_ = wr, wc_ = wc, fr_ = fr, fq_ = fq; asm volatile("" : "+s"(wr_), "+s"(wc_), "+v"(fr_), "+v"(fq_));
            E(acc, cur, wr_, wc_, fr_, fq_); S.done(cur); }
        if (!has_next) break;
#pragma unroll
        for (int a = 0; a < 2; ++a)
#pragma unroll
            for (int b = 0; b < 2; ++b)
#pragma unroll
                for (int m = 0; m < 4; ++m)
#pragma unroll
                    for (int n = 0; n < 2; ++n) acc[a][b][m][n] = (f32x4){0.f, 0.f, 0.f, 0.f};
        cur = nxt; cA = nA; cB = nB; ++ui;
        if constexpr (ALIGN_EPI) { if (wr == 1) PG8_BAR; }
    }
    PG8_WAIT_V(0);
    if constexpr (!ALIGN_EPI) { if (wr == 0) PG8_BAR; }
    PG8_BAR;
    if constexpr (Epi::AFTER_DRAIN) { E.fused(acc, cur, wr, wc, fr, fq, lds, wid, lane); S.done(cur); }
#undef PG8_SA
#undef PG8_SB
#undef PG8_STAGE
#undef PG8_LDA
#undef PG8_LDB
#undef PG8_MMA
#undef PG8_WAIT_V
#undef PG8_WAIT_L
#undef PG8_BAR
#undef PG8_SCHED
}
}
namespace pg8 {
typedef const f32x4 (&AccRef)[2][2][4][2];

struct EpiStore {
    static constexpr bool PERM = true, AFTER_DRAIN = false; __device__ __forceinline__ bool perm() const { return true; }
    bf16_t* O; int ldc; int act; int split_cols; size_t split_stride; int gate_pn; float* G; const float* bgate;
    __device__ __forceinline__ void operator()(AccRef acc, const Unit& u, int wr, int wc, int fr, int fq) const {
        const int row0 = u.pm * BM + wr * 64 + fr;
        if (u.pn == gate_pn) {
            if (wc == 0) {
#pragma unroll
                for (int n = 0; n < 2; ++n) {
                    const int c0 = 8 * fq + 4 * n;
                    const f32x4 bg = *(const f32x4*)(bgate + c0);
                    const bool isf = (c0 & 8) != 0;
#pragma unroll
                    for (int ai = 0; ai < 2; ++ai)
#pragma unroll
                        for (int m = 0; m < 4; ++m) {
                            f32x4 v = acc[ai][0][m][n] + bg, o;
#pragma unroll
                            for (int j = 0; j < 4; ++j) { const float cpd = 15.0f * tanhf_(v[j] * (1.0f / 15.0f)); const float eu = __expf(-cpd); o[j] = isf ? -(eu < 9.765625e-4f ? eu - 0.5f * eu * eu : __logf(1.0f + eu)) : cpd; }
                            *(f32x4*)(G + (size_t)(row0 + ai * HALF + m * 16) * 32 + c0) = o;
                        }
                }
            }
            return;
        }
        int colt = u.pn * BM; bf16_t* base = O;
        if (split_cols) { const int t = colt / split_cols; base += (size_t)t * split_stride; colt -= t * split_cols; }
        const int col0 = colt + wc * 32 + 8 * fq;
#pragma unroll
        for (int ai = 0; ai < 2; ++ai)
#pragma unroll
            for (int m = 0; m < 4; ++m) { bf16_t* rowp = base + (size_t)(row0 + ai * HALF + m * 16) * ldc + col0;
#pragma unroll
                for (int bj = 0; bj < 2; ++bj) { f32x4 v0 = acc[ai][bj][m][0], v1 = acc[ai][bj][m][1];
                    if (act == 1) {
#pragma unroll
                        for (int j = 0; j < 4; ++j) { v0[j] = tanhf_(v0[j]); v1[j] = tanhf_(v1[j]); } }
                    else if (act == 2) {
#pragma unroll
                        for (int j = 0; j < 4; ++j) { v0[j] = sigmoidf_(v0[j]); v1[j] = sigmoidf_(v1[j]); } }
                    u32x4 w; w.x = cvt_pk_bf16(v0[0], v0[1]); w.y = cvt_pk_bf16(v0[2], v0[3]); w.z = cvt_pk_bf16(v1[0], v1[1]); w.w = cvt_pk_bf16(v1[2], v1[3]);
                    *(u32x4*)(rowp + bj * HALF) = w; } }
    }
};

struct EpiSigAff {
    static constexpr bool PERM = true, AFTER_DRAIN = false; __device__ __forceinline__ bool perm() const { return true; }
    bf16_t* O; size_t split_stride; const float* bias; float scale;
    __device__ __forceinline__ void operator()(AccRef acc, const Unit& u, int wr, int wc, int fr, int fq) const {
        const int row0 = u.pm * BM + wr * 64 + fr;
        int colt = u.pn * BM; const int t = colt / D; bf16_t* base = O + (size_t)t * split_stride; colt -= t * D;
        const int col0 = colt + wc * 32 + 8 * fq, bcol0 = u.pn * BM + wc * 32 + 8 * fq;
        f32x4 bv[2][2];
#pragma unroll
        for (int bj = 0; bj < 2; ++bj)
#pragma unroll
            for (int n = 0; n < 2; ++n) bv[bj][n] = *(const f32x4*)(bias + bcol0 + bj * HALF + 4 * n);
#pragma unroll
        for (int ai = 0; ai < 2; ++ai)
#pragma unroll
            for (int m = 0; m < 4; ++m) { bf16_t* rowp = base + (size_t)(row0 + ai * HALF + m * 16) * D + col0;
#pragma unroll
                for (int bj = 0; bj < 2; ++bj) { f32x4 v0 = acc[ai][bj][m][0] + bv[bj][0], v1 = acc[ai][bj][m][1] + bv[bj][1];
#pragma unroll
                    for (int j = 0; j < 4; ++j) { v0[j] = scale * sigmoidf_(v0[j]); v1[j] = scale * sigmoidf_(v1[j]); }
                    u32x4 w; w.x = cvt_pk_bf16(v0[0], v0[1]); w.y = cvt_pk_bf16(v0[2], v0[3]); w.z = cvt_pk_bf16(v1[0], v1[1]); w.w = cvt_pk_bf16(v1[2], v1[3]);
                    *(u32x4*)(rowp + bj * HALF) = w; } }
    }
};

struct EpiVmix {
    static constexpr bool PERM = true, AFTER_DRAIN = false; __device__ __forceinline__ bool perm() const { return true; }
    bf16_t* V; const bf16_t* VF; const float* v0;
    __device__ __forceinline__ void operator()(AccRef acc, const Unit& u, int wr, int wc, int fr, int fq) const {
        const int row0 = u.pm * BM + wr * 64 + fr; const int col0 = u.pn * BM + wc * 32 + 8 * fq;
        f32x4 bv[2][2];
#pragma unroll
        for (int bj = 0; bj < 2; ++bj)
#pragma unroll
            for (int n = 0; n < 2; ++n) bv[bj][n] = *(const f32x4*)(v0 + col0 + bj * HALF + 4 * n);
#pragma unroll
        for (int ai = 0; ai < 2; ++ai) {
            u32x4 vvs[4][2], ffs[4][2];
#pragma unroll
            for (int m = 0; m < 4; ++m) { const size_t off = (size_t)(row0 + ai * HALF + m * 16) * D + col0;
#pragma unroll
                for (int bj = 0; bj < 2; ++bj) { vvs[m][bj] = *(const u32x4*)(V + off + bj * HALF); ffs[m][bj] = *(const u32x4*)(VF + off + bj * HALF); } }
            asm volatile("" ::: "memory");
#pragma unroll
            for (int m = 0; m < 4; ++m) { const size_t off = (size_t)(row0 + ai * HALF + m * 16) * D + col0;
#pragma unroll
                for (int bj = 0; bj < 2; ++bj) {
                    const u32x4 vv = vvs[m][bj], ff = ffs[m][bj];
                    const f32x4 a0 = acc[ai][bj][m][0] + bv[bj][0], a1 = acc[ai][bj][m][1] + bv[bj][1];
                    float o[8];
#pragma unroll
                    for (int j = 0; j < 4; ++j) {
                        const unsigned vw = j == 0 ? vv.x : j == 1 ? vv.y : j == 2 ? vv.z : vv.w, fw = j == 0 ? ff.x : j == 1 ? ff.y : j == 2 ? ff.z : ff.w;
                        const float s0 = sigmoidf_(j < 2 ? a0[2 * j] : a1[2 * j - 4]), s1 = sigmoidf_(j < 2 ? a0[2 * j + 1] : a1[2 * j - 3]);
                        const float x0 = lo_bf(vw), x1 = hi_bf(vw), f0 = lo_bf(fw), f1 = hi_bf(fw);
                        o[2 * j] = x0 + (f0 - x0) * s0; o[2 * j + 1] = x1 + (f1 - x1) * s1; }
                    u32x4 w; w.x = cvt_pk_bf16(o[0], o[1]); w.y = cvt_pk_bf16(o[2], o[3]); w.z = cvt_pk_bf16(o[4], o[5]); w.w = cvt_pk_bf16(o[6], o[7]);
                    *(u32x4*)(V + off + bj * HALF) = w; } }
            asm volatile("" ::: "memory"); }
    }
};

struct EpiResid {
    static constexpr bool PERM = false, AFTER_DRAIN = false; __device__ __forceinline__ bool perm() const { return false; }
    float* X; const float* gate; int tile0; const float* srcx; const float* srcc;
    __device__ __forceinline__ void operator()(AccRef acc, const Unit& u, int wr, int wc, int fr, int fq) const {
        const int gpm = tile0 + u.pm; const int b = gpm / 9, tix = gpm % 9; const int idx = (tix == 0) ? 16 : b;
        const int rloc = wr * 64 + fr, col0 = u.pn * BM + wc * 32 + 4 * fq;
        const float* src = srcx ? (tix == 0 ? srcc + (size_t)b * CTXL * D : srcx + ((size_t)b * SEQ + (size_t)(tix - 1) * BM) * D) : X + (size_t)gpm * BM * D;
        float* dst = X + (size_t)gpm * BM * D;
        f32x4 gv[2][2];
#pragma unroll
        for (int bj = 0; bj < 2; ++bj)
#pragma unroll
            for (int n = 0; n < 2; ++n) gv[bj][n] = *(const f32x4*)(gate + (size_t)idx * MODLD + col0 + bj * HALF + n * 16);
        f32x4 (&ac)[2][2][4][2] = const_cast<f32x4 (&)[2][2][4][2]>(acc);
        f32x4 xa[2][2], xb[2][2];
#define RES_LD(dstv, ai_, m_) do { const size_t off_ = (size_t)(rloc + (ai_) * HALF + (m_) * 16) * D + col0; _Pragma("unroll") for (int bj = 0; bj < 2; ++bj) _Pragma("unroll") for (int n = 0; n < 2; ++n) \
            dstv[bj][n] = *(const f32x4*)(src + off_ + bj * HALF + n * 16); } while (0)
#define RES_FMA(srcv, ai_, m_) do { _Pragma("unroll") for (int bj = 0; bj < 2; ++bj) _Pragma("unroll") for (int n = 0; n < 2; ++n) ac[ai_][bj][m_][n] = srcv[bj][n] + gv[bj][n] * ac[ai_][bj][m_][n]; } while (0)
#define RES_F asm volatile("" ::: "memory")
        RES_LD(xa, 0, 0); RES_LD(xb, 0, 1); RES_F;
        RES_FMA(xa, 0, 0); RES_LD(xa, 0, 2); RES_F; RES_FMA(xb, 0, 1); RES_LD(xb, 0, 3); RES_F;
        RES_FMA(xa, 0, 2); RES_LD(xa, 1, 0); RES_F; RES_FMA(xb, 0, 3); RES_LD(xb, 1, 1); RES_F;
        RES_FMA(xa, 1, 0); RES_LD(xa, 1, 2); RES_F; RES_FMA(xb, 1, 1); RES_LD(xb, 1, 3); RES_F;
        RES_FMA(xa, 1, 2); RES_FMA(xb, 1, 3);
#undef RES_F
#undef RES_LD
#undef RES_FMA
        asm volatile("" ::: "memory");
#pragma unroll
        for (int ai = 0; ai < 2; ++ai)
#pragma unroll
            for (int m = 0; m < 4; ++m) { const size_t off = (size_t)(rloc + ai * HALF + m * 16) * D + col0;
#pragma unroll
                for (int bj = 0; bj < 2; ++bj)
#pragma unroll
                    for (int n = 0; n < 2; ++n) *(f32x4*)(dst + off + bj * HALF + n * 16) = ac[ai][bj][m][n]; }
    }
};

struct EpiSwiglu {
    static constexpr bool PERM = true, AFTER_DRAIN = false; __device__ __forceinline__ bool perm() const { return true; }
    bf16_t* O;
    __device__ __forceinline__ void operator()(AccRef acc, const Unit& u, int wr, int wc, int fr, int fq) const {
        const int row0 = u.pm * BM + wr * 64 + fr; const int col0 = u.pn * HALF + wc * 32 + 8 * fq;
#pragma unroll
        for (int ai = 0; ai < 2; ++ai)
#pragma unroll
            for (int m = 0; m < 4; ++m) { bf16_t* rowp = O + (size_t)(row0 + ai * HALF + m * 16) * DFF + col0;
                f32x4 v0, v1;
#pragma unroll
                for (int j = 0; j < 4; ++j) { v0[j] = siluf_(acc[ai][0][m][0][j]) * acc[ai][1][m][0][j]; v1[j] = siluf_(acc[ai][0][m][1][j]) * acc[ai][1][m][1][j]; }
                u32x4 w; w.x = cvt_pk_bf16(v0[0], v0[1]); w.y = cvt_pk_bf16(v0[2], v0[3]); w.z = cvt_pk_bf16(v1[0], v1[1]); w.w = cvt_pk_bf16(v1[2], v1[3]);
                *(u32x4*)rowp = w; }
    }
};
struct EpiAny {
    static constexpr bool AFTER_DRAIN = false;
    int kind;
    void* p0; const void* p1; const void* p2; const void* p3; int i0, i1, i2; size_t s0; float f0;
    __device__ __forceinline__ bool perm() const { return kind != 3; }
    __device__ __forceinline__ void operator()(AccRef acc, const Unit& u, int wr, int wc, int fr, int fq) const {
        switch (kind) {
        case 0: { EpiStore e{(bf16_t*)p0, i0, i1, 0, 0, i2, (float*)const_cast<void*>(p1), (const float*)p2}; e(acc, u, wr, wc, fr, fq); break; }
        case 1: { EpiSigAff e{(bf16_t*)p0, s0, (const float*)p1, f0}; e(acc, u, wr, wc, fr, fq); break; }
        case 2: { EpiVmix e{(bf16_t*)p0, (const bf16_t*)p1, (const float*)p2}; e(acc, u, wr, wc, fr, fq); break; }
        case 3: { EpiResid e{(float*)p0, (const float*)p1, 0, (const float*)p2, (const float*)p3}; e(acc, u, wr, wc, fr, fq); break; }
        default: { EpiSwiglu e{(bf16_t*)p0}; e(acc, u, wr, wc, fr, fq); break; }
        }
    }
};
}

template <class Epi>
__device__ __forceinline__ void run_gemm_t(LAS unsigned char* lds, const pg8::Gemm& g, const pg8::StaticOrder& S, const Epi& E) { pg8::gemm_phase<Epi, pg8::StaticOrder, GP_ALIGN, GP_SP2>(lds, g, S, E); }
__device__ __forceinline__ void run_gemm(LAS unsigned char* lds, const bf16_t* A, const bf16_t* Bt, int M, int N, int K, int skip, const pg8::EpiAny& E, int& urot) {
    pg8::Gemm g{A, Bt, M, N, K};
    const int G = (int)gridDim.x; const int Meff = skip ? (M / 9) * 8 : M; const int nwg = (Meff / 256) * (N / 256);
    const int c = ((int)blockIdx.x + G - (urot % G)) % G;
    pg8::StaticOrder S; S.init(Meff, N, G, c, skip);
    switch (E.kind) {
    case 0: { pg8::EpiStore e{(bf16_t*)E.p0, E.i0, E.i1, 0, 0, E.i2, (float*)const_cast<void*>(E.p1), (const float*)E.p2}; run_gemm_t(lds, g, S, e); break; }
    case 1: { pg8::EpiSigAff e{(bf16_t*)E.p0, E.s0, (const float*)E.p1, E.f0}; run_gemm_t(lds, g, S, e); break; }
    case 2: { pg8::EpiVmix e{(bf16_t*)E.p0, (const bf16_t*)E.p1, (const float*)E.p2}; run_gemm_t(lds, g, S, e); break; }
    case 3: { pg8::EpiResid e{(float*)E.p0, (const float*)E.p1, 0, (const float*)E.p2, (const float*)E.p3}; run_gemm_t(lds, g, S, e); break; }
    default: { pg8::EpiSwiglu e{(bf16_t*)E.p0}; run_gemm_t(lds, g, S, e); break; }
    }
    urot += nwg;
}
struct Args { const float* in[NIN]; float* out; unsigned char* ws; int ph_lo, ph_hi; };
static_assert(sizeof(Args) == NIN * 8 + 8 + 8 + 8, "Args has no padding");

typedef const __attribute__((address_space(4))) Args* CArgs;
__device__ __forceinline__ CArgs opaque_args() { CArgs p = (CArgs)__builtin_amdgcn_kernarg_segment_ptr(); asm volatile("" : "+s"(p)); return p; }
struct Tc { LAS unsigned char* lds; int tid, lane, wave, bid, G, gw, ngw; };
__device__ __forceinline__ Tc mk_tc(LAS unsigned char* lds) { Tc t; int tid = threadIdx.x; asm volatile("" : "+v"(tid)); t.lds = lds; t.tid = tid; t.lane = tid & 63; t.wave = __builtin_amdgcn_readfirstlane(tid >> 6);
    t.bid = blockIdx.x; t.G = gridDim.x; t.gw = t.bid * 8 + t.wave; t.ngw = t.G * 8; return t; }

template <class RM>
__device__ __forceinline__ void tr_item(const float* W, int ldw, bf16_t* WT, int ldk, const RM& rm, LAS float* scr, int kb, int nb, int lane) {
    const int k0 = 64 * kb, n0 = 32 * nb;
    float tmp[32];
#pragma unroll
    for (int i = 0; i < 32; ++i) { const int kk = 2 * i + (lane >> 5); tmp[i] = W[(size_t)(k0 + kk) * ldw + n0 + (lane & 31)]; }
    asm volatile("" ::: "memory");
#pragma unroll
    for (int i = 0; i < 32; ++i) { const int kk = 2 * i + (lane >> 5); scr[kk * 33 + (lane & 31)] = tmp[i]; }
    LDS_WAIT();
    const int c = lane & 7;
#pragma unroll
    for (int j = 0; j < 4; ++j) { const int n = (lane >> 3) + 8 * j; const LAS float* s = scr + (8 * c) * 33 + n;
        u32x4 o; o.x = pk2(s[0 * 33], s[1 * 33]); o.y = pk2(s[2 * 33], s[3 * 33]); o.z = pk2(s[4 * 33], s[5 * 33]); o.w = pk2(s[6 * 33], s[7 * 33]);
        *(u32x4*)(WT + (size_t)rm(n0 + n) * ldk + k0 + 8 * c) = o; }
    LDS_WAIT();
}
struct RmId { __device__ __forceinline__ int operator()(int n) const { return n; } };
struct RmSwiglu { __device__ __forceinline__ int operator()(int n) const { const int up = n >= DFF ? 1 : 0; const int m = n - up * DFF; return 256 * (m >> 7) + 128 * up + (m & 127); } };

template <class RM>
__device__ __forceinline__ void tr_matrix(const Tc& t, const float* W, int K, int N, int ldw, bf16_t* WT, int ldk, const RM& rm) {
    LAS float* scr = (LAS float*)(t.lds + t.wave * 16384);
    const int nkb = K / 64, nnb = N / 32, items = nkb * nnb;
    for (int it = t.gw; it < items; it += t.ngw) tr_item(W, ldw, WT, ldk, rm, scr, it / nnb, it % nnb, t.lane);
}
template <class SRC>
__device__ __forceinline__ void build_small(const Tc& t, bf16_t* dst, int NR, int KC, const SRC& src) {
    const int total = NR * (KC / 8);
    for (int i = t.gw * 64 + t.lane; i < total; i += t.ngw * 64) { const int n = i % NR, ko = i / NR;
        float v[8];
#pragma unroll
        for (int j = 0; j < 8; ++j) v[j] = src(n, 8 * ko + j);
        u32x4 o; o.x = pk2(v[0], v[1]); o.y = pk2(v[2], v[3]); o.z = pk2(v[4], v[5]); o.w = pk2(v[6], v[7]);
        *(u32x4*)(dst + (size_t)n * KC + 8 * ko) = o; }
}

__device__ __forceinline__ void convert_rwkv(const Tc& t, CArgs a, int jl) {
    bf16_t* wm = (bf16_t*)(a->ws + WS_WMIX);
    const size_t dd = (size_t)D * D;
    tr_matrix(t, a->in[I_WR] + jl * dd, D, D, D, (bf16_t*)((char*)wm + WM_R), D, RmId());
    tr_matrix(t, a->in[I_WK] + jl * dd, D, D, D, (bf16_t*)((char*)wm + WM_K), D, RmId());
    tr_matrix(t, a->in[I_WV] + jl * dd, D, D, D, (bf16_t*)((char*)wm + WM_V), D, RmId());
    tr_matrix(t, a->in[I_WO] + jl * dd, D, D, D, (bf16_t*)((char*)wm + WM_O), D, RmId());
    { const float* w1 = a->in[I_W1] + (size_t)jl * 2 * D * 96;
      build_small(t, (bf16_t*)((char*)wm + WM_W1), 256, D, [=](int n, int k) -> float { if (n >= 192) return 0.f; const int z = n >= 96 ? 1 : 0, r = n - 96 * z; return w1[((size_t)z * D + k) * 96 + r]; }); }
    { const float* a1 = a->in[I_A1] + (size_t)jl * 2 * D * 96;
      build_small(t, (bf16_t*)((char*)wm + WM_A1), 256, D, [=](int n, int k) -> float { if (n >= 192) return 0.f; const int z = n >= 96 ? 1 : 0, r = n - 96 * z; return a1[((size_t)z * D + k) * 96 + r]; }); }
    { const float* g1 = a->in[I_G1] + (size_t)jl * D * 256;
      build_small(t, (bf16_t*)((char*)wm + WM_G1), 256, D, [=](int n, int k) -> float { return g1[(size_t)k * 256 + n]; }); }
    if (jl > 0) { const float* v1 = a->in[I_V1] + (size_t)(jl - 1) * D * 64;
      build_small(t, (bf16_t*)((char*)wm + WM_V1), 256, D, [=](int n, int k) -> float { return n < 64 ? v1[(size_t)k * 64 + n] : 0.f; }); }
    { const float* w2 = a->in[I_W2] + (size_t)jl * 2 * 96 * D;
      build_small(t, (bf16_t*)((char*)wm + WM_W2), 2 * D, 256, [=](int n, int k) -> float { const int z = n >= D ? 1 : 0, ch = n - z * D, kk = k - 96 * z; return (kk >= 0 && kk < 96) ? w2[((size_t)z * 96 + kk) * D + ch] : 0.f; }); }
    { const float* a2 = a->in[I_A2] + (size_t)jl * 2 * 96 * D;
      build_small(t, (bf16_t*)((char*)wm + WM_A2), 2 * D, 256, [=](int n, int k) -> float { const int z = n >= D ? 1 : 0, ch = n - z * D, kk = k - 96 * z; return (kk >= 0 && kk < 96) ? a2[((size_t)z * 96 + kk) * D + ch] : 0.f; }); }
    { const float* g2 = a->in[I_G2] + (size_t)jl * 256 * D;
      build_small(t, (bf16_t*)((char*)wm + WM_G2), D, 256, [=](int n, int k) -> float { return g2[(size_t)k * D + n]; }); }
    if (jl > 0) { const float* v2 = a->in[I_V2] + (size_t)(jl - 1) * 64 * D;
      build_small(t, (bf16_t*)((char*)wm + WM_V2), D, 256, [=](int n, int k) -> float { return k < 64 ? v2[(size_t)k * D + n] : 0.f; }); }
}
__device__ __forceinline__ void convert_mlstm(const Tc& t, CArgs a, int jl) {
    bf16_t* win = (bf16_t*)(a->ws + WS_WMIX + WM_MIN); bf16_t* wout = (bf16_t*)(a->ws + WS_WMIX + WM_MOUT);
    tr_matrix(t, a->in[I_MWIN] + (size_t)jl * D * MPROJ, D, MPROJ, MPROJ, win, D, RmId());
    { u32x4* z = (u32x4*)(win + (size_t)MPROJ * D); const int total = (6400 - MPROJ) * D / 8; unsigned zz = 0u; asm volatile("" : "+v"(zz)); const u32x4 zero = {zz, zz, zz, zz};
      for (int i = t.gw * 64 + t.lane; i < total; i += t.ngw * 64) z[i] = zero; }
    tr_matrix(t, a->in[I_MWOUT] + (size_t)jl * D * D, D, D, D, wout, D, RmId());
}
__device__ __forceinline__ void convert_ffn_in(const Tc& t, CArgs a, int layer) {
    tr_matrix(t, a->in[I_FWIN] + (size_t)layer * D * 2 * DFF, D, 2 * DFF, 2 * DFF, (bf16_t*)(a->ws + WS_WFFN + WF_IN), D, RmSwiglu());
}
__device__ __forceinline__ void convert_ffn_out(const Tc& t, CArgs a, int layer) {
    tr_matrix(t, a->in[I_FWOUT] + (size_t)layer * DFF * D, DFF, D, D, (bf16_t*)(a->ws + WS_WFFN + WF_OUT), DFF, RmId());
}
__device__ __forceinline__ bool tail_crew(const Tc& t, int urot0, int nwg, Tc& ts) {
    const int G = t.G, r = nwg % G, c = (t.bid + G - (urot0 % G)) % G;
    ts = t;
    if (r == 0) return true;
    if (c < r) return false;
    ts.bid = c - r; ts.G = G - r; ts.gw = ts.bid * 8 + t.wave; ts.ngw = ts.G * 8; return true;
}

__device__ __forceinline__ void ph_prologue(const Tc& t, CArgs a) {
    LAS float* S = (LAS float*)t.lds;
    { f32x4 cv[17];
#pragma unroll
      for (int b = 0; b < 17; ++b) cv[b] = *(const f32x4*)((b < 16 ? a->in[I_C] + (size_t)b * D : a->in[I_CCTX]) + 4 * t.tid);
      const int k = 4 * t.tid;
#pragma unroll
      for (int b = 0; b < 17; ++b) { const f32x4 s = {siluf_(cv[b][0]), siluf_(cv[b][1]), siluf_(cv[b][2]), siluf_(cv[b][3])};
          *(LAS f32x4*)(S + b * 2056 + (k >> 10) * 1028 + (k & 1023)) = s; } }
    __syncthreads();
    float* mod = (float*)(a->ws + WS_MOD);
    const int col = t.lane & 31, kh = t.lane >> 5;
    for (int it = t.wave * t.G + t.bid; it < 4 * 384; it += t.ngw) { const int layer = it / 384, n0 = 32 * (it % 384);
        const auto wrs = __builtin_amdgcn_make_buffer_rsrc((void*)(a->in[I_MODW] + (size_t)layer * D * MODLD), (short)0, (int)((size_t)D * MODLD * 4), 0x00020000);
        const unsigned voff = (unsigned)(kh * 1024 * MODLD + n0 + col) * 4u;
        const LAS float* Sk = S + kh * 1028;
        f32x2 acc[17];
#pragma unroll
        for (int b = 0; b < 17; ++b) acc[b] = (f32x2){0.f, 0.f};
        float wa[8], wb[8];
#define MOD_LD(dst, k0_) do { _Pragma("unroll") for (int j = 0; j < 8; ++j) dst[j] = __builtin_bit_cast(float, __builtin_amdgcn_raw_buffer_load_b32(wrs, voff, (unsigned)(((k0_) + j) * MODLD * 4), 0)); } while (0)
#define MOD_FMA(src, k0_) do { _Pragma("unroll") for (int j4 = 0; j4 < 2; ++j4) { _Pragma("unroll") for (int b = 0; b < 17; ++b) { const f32x4 s = *(const LAS f32x4*)(Sk + b * 2056 + (k0_) + 4 * j4); \
            acc[b] = acc[b] + (f32x2){s[0], s[1]} * (f32x2){src[4 * j4], src[4 * j4 + 1]} + (f32x2){s[2], s[3]} * (f32x2){src[4 * j4 + 2], src[4 * j4 + 3]}; } asm volatile("" ::: "memory"); } } while (0)
        MOD_LD(wa, 0);
#pragma unroll 1
        for (int k0 = 0; k0 < 1024; k0 += 16) {
            MOD_LD(wb, k0 + 8);
            MOD_FMA(wa, k0);
            if (k0 + 16 < 1024) MOD_LD(wa, k0 + 16);
            MOD_FMA(wb, k0 + 8); }
#undef MOD_LD
#undef MOD_FMA
#pragma unroll
        for (int b = 0; b < 17; ++b) { float v = acc[b].x + acc[b].y; v += shfl_xor_(v, 32, t.lane);
            if (kh == 0) mod[((size_t)layer * 17 + b) * MODLD + n0 + col] = v + a->in[I_MODB][layer * MODLD + n0 + col]; } }
    __syncthreads();
}

template <bool OUT_BF16>
__device__ __forceinline__ void norm_rows(const Tc& t, CArgs a, int layer, int which, int row_begin, int nrows, void* out, bool from_inputs = false) {
    const float* xres = (const float*)(a->ws + WS_XRES);
    const float* mod = (const float*)(a->ws + WS_MOD) + (size_t)layer * 17 * MODLD;
    const int npw = (nrows + t.ngw - 1) / t.ngw;
    f32x4 gg[8], gm[8], sh[8];
    { const f32x4* gp = (const f32x4*)(a->in[I_NORMG] + (size_t)(layer * 2 + which) * D) + t.lane;
#pragma unroll
      for (int j = 0; j < 8; ++j) gg[j] = gp[64 * j]; }
    int cur_idx = -1;
    auto rowptr = [&](int r) -> const f32x4* { const int grow = row_begin + r; const int gb = grow / SROW, gs = grow % SROW;
        const float* rp = from_inputs ? (gs < CTXL ? a->in[I_CTX] + ((size_t)gb * CTXL + gs) * D : a->in[I_X] + ((size_t)gb * SEQ + (gs - CTXL)) * D) : xres + (size_t)grow * D;
        return (const f32x4*)rp + t.lane; };
    const int rfirst = t.gw * npw;
    if (rfirst >= nrows) return;
    const int nmine = (nrows - rfirst) < npw ? (nrows - rfirst) : npw;
    f32x4 xn[8];
    { const f32x4* xr = rowptr(rfirst);
#pragma unroll
      for (int j = 0; j < 8; ++j) xn[j] = xr[64 * j]; }
    for (int i = 0; i < nmine; ++i) { const int r = rfirst + i; const int grow = row_begin + r; const int idx = (grow % SROW) < CTXL ? 16 : grow / SROW;
        f32x4 v[8];
#pragma unroll
        for (int j = 0; j < 8; ++j) v[j] = xn[j];
        if (idx != cur_idx) { cur_idx = idx;
            const f32x4* shp = (const f32x4*)(mod + (size_t)idx * MODLD + (3 * which) * D) + t.lane; const f32x4* scp = (const f32x4*)(mod + (size_t)idx * MODLD + (3 * which + 1) * D) + t.lane;
#pragma unroll
            for (int j = 0; j < 8; ++j) { sh[j] = shp[64 * j]; gm[j] = gg[j] * (scp[64 * j] + 1.0f); } }
        if (i + 1 < nmine) { const f32x4* xr = rowptr(r + 1);
#pragma unroll
            for (int j = 0; j < 8; ++j) xn[j] = xr[64 * j]; }
        asm volatile("" ::: "memory");
        float ss = 0.f;
#pragma unroll
        for (int j = 0; j < 8; ++j) ss += (v[j].x * v[j].x + v[j].y * v[j].y) + (v[j].z * v[j].z + v[j].w * v[j].w);
        const float rstd = rsqrtf(wave_sum_dpp(ss) * (1.0f / D) + 1e-6f);
#pragma unroll
        for (int j = 0; j < 8; ++j) { const f32x4 o = v[j] * rstd * gm[j] + sh[j];
            if (OUT_BF16) { u32x2 w; w.x = pk2(o.x, o.y); w.y = pk2(o.z, o.w); ((u32x2*)((bf16_t*)out + (size_t)r * D))[64 * j + t.lane] = w; }
            else ((f32x4*)((float*)out + (size_t)r * D))[64 * j + t.lane] = o; }
        asm volatile("" ::: "memory");
    }
}

__device__ __forceinline__ void r2_mix(const Tc& t, CArgs a, int jl) {
    const bf16_t* H = (const bf16_t*)(a->ws + WS_ACT + AR_H);
    const int sl = t.gw & 3, c0 = 512 * sl + 8 * t.lane;
    const float* mu = a->in[I_MU] + (size_t)jl * 6 * D + c0;
    f32x4 m0[6], m1[6];
#pragma unroll
    for (int m = 0; m < 6; ++m) { m0[m] = *(const f32x4*)(mu + m * D); m1[m] = *(const f32x4*)(mu + m * D + 4); }
    const int rstep = t.ngw >> 2;
    for (int r0 = t.gw >> 2; r0 < TG; r0 += 4 * rstep) {
        u32x4 hw[4], nw[4];
#pragma unroll
        for (int k = 0; k < 4; ++k) { const int r = r0 + k * rstep; hw[k] = (u32x4){0u, 0u, 0u, 0u}; nw[k] = hw[k];
            if (r < TG) { const int s = r % SROW; int nr;
                if (s < CTXL) nr = sl < 2 ? (s > 0 ? r - 1 : -1) : (s < CTXL - 1 ? r + 1 : -1);
                else { const int i = s - CTXL, gr = i >> 6, gc = i & 63; nr = sl == 0 ? (gc > 0 ? r - 1 : -1) : sl == 1 ? (gc < 63 ? r + 1 : -1) : sl == 2 ? (gr > 0 ? r - 64 : -1) : (gr < 31 ? r + 64 : -1); }
                hw[k] = *(const u32x4*)(H + (size_t)r * D + c0);
                if (nr >= 0) nw[k] = *(const u32x4*)(H + (size_t)nr * D + c0); } }
        asm volatile("" ::: "memory");
#pragma unroll
        for (int k = 0; k < 4; ++k) { const int r = r0 + k * rstep;
            if (r < TG) {
                const f32x4 h0 = {lo_bf(hw[k].x), hi_bf(hw[k].x), lo_bf(hw[k].y), hi_bf(hw[k].y)}, h1 = {lo_bf(hw[k].z), hi_bf(hw[k].z), lo_bf(hw[k].w), hi_bf(hw[k].w)};
                const f32x4 n0 = {lo_bf(nw[k].x), hi_bf(nw[k].x), lo_bf(nw[k].y), hi_bf(nw[k].y)}, n1 = {lo_bf(nw[k].z), hi_bf(nw[k].z), lo_bf(nw[k].w), hi_bf(nw[k].w)};
                const f32x4 x0 = n0 - h0, x1 = n1 - h1;
#pragma unroll
                for (int m = 0; m < 6; ++m) { const f32x4 o0 = h0 + x0 * m0[m], o1 = h1 + x1 * m1[m];
                    u32x4 w; w.x = pk2(o0.x, o0.y); w.y = pk2(o0.z, o0.w); w.z = pk2(o1.x, o1.y); w.w = pk2(o1.z, o1.w);
                    *(u32x4*)(a->ws + WS_ACT + AR_MIX + (size_t)m * SLOT + ((size_t)r * D + c0) * 2) = w; } } }
        asm volatile("" ::: "memory");
    }
}

constexpr int R5_L = 16;
constexpr int R5_ZR = 0, R5_BK = 4608, R5_BKT = 9216, R5_V = 14336, R5_GL = 18432, R5_CH = 18688;
constexpr int R5_BUF = 2 * R5_CH;
constexpr int R5_GR = 2 * R5_BUF;
constexpr int R5_GRCH = 3072;
constexpr int R5_DS = R5_GR + 2 * R5_GRCH;
constexpr int R5_YS = R5_DS + 8 * 1024;
constexpr int R5_PW = R5_YS + 2 * 2 * 4096;
constexpr int R5_END = R5_PW + 8 * 4096;
static_assert(R5_END <= LDSCTL_OFF, "scan LDS");
__device__ __forceinline__ int r5_seq(int z, int tt) { return z == 0 ? tt : (tt < CTXL ? CTXL - 1 - tt : SROW + CTXL - 1 - tt); }

__device__ __forceinline__ void r5_scan(const Tc& t, CArgs a, int jl, int layer, int g) {
    const bf16_t* R = (const bf16_t*)(a->ws + WS_ACT + AR_R);
    const bf16_t* Kb = (const bf16_t*)(a->ws + WS_ACT + AR_K);
    const bf16_t* Vb = (layer == 0) ? (const bf16_t*)(a->ws + WS_VF) + (size_t)g * TG * D : (const bf16_t*)(a->ws + WS_ACT + AR_V);
    const int w = t.wave, lane = t.lane, c2 = w >> 2, q = w & 3, l15 = lane & 15, q4 = lane >> 4;
    for (int pair = t.bid; pair < BG * RH; pair += t.G) {
        const int z = pair / (BG * RH / 2), bl = (pair / (RH / 2)) % BG, h = 2 * (pair % (RH / 2)) + c2;
        const bf16_t* E = (const bf16_t*)(a->ws + WS_ACT + AR_MIX + (size_t)z * SLOT);
        const bf16_t* Aa = (const bf16_t*)(a->ws + WS_ACT + AR_MIX + (size_t)(2 + z) * SLOT);
        bf16_t* Y = (bf16_t*)(a->ws + WS_ACT + AR_Y + (size_t)z * SLOT);
        float* RKo = (float*)(a->ws + WS_ACT + AR_RK) + (size_t)z * TG * 32;
        const size_t colb = (size_t)h * 64 + lane;
        f32x4 ST[4];
#pragma unroll
        for (int cb = 0; cb < 4; ++cb) ST[cb] = (f32x4){0.f, 0.f, 0.f, 0.f};
        const int pst = q == 0 ? 0 : 6 * (q - 1), npass = q == 0 ? 0 : (q == 3 ? 2 : 3), plast = pst + 2 * npass;
        const int fst = q == 1 ? 0 : q == 2 ? 4 : 8, fcn = q == 0 ? 0 : (q == 3 ? 8 : 4);
        const int hf = lane >> 5, pi = lane & 31;
        unsigned pe[16], pr[3], pk[3], pv[3], pa[3];
        const int sd = z == 0 ? 1 : -1;
        const bf16_t* Eh = E + (size_t)bl * SROW * D + (size_t)h * 64; const bf16_t* Rh = R + (size_t)bl * SROW * D + (size_t)h * 64; const bf16_t* Kh = Kb + (size_t)bl * SROW * D + (size_t)h * 64;
        const bf16_t* Vh = Vb + (size_t)bl * SROW * D + (size_t)h * 64; const bf16_t* Ah = Aa + (size_t)bl * SROW * D + (size_t)h * 64;
        LAS f32x2* PW = (LAS f32x2*)(t.lds + R5_PW + w * 4096);
        f32x2 kkc2, kac2, rkc2;
        { const size_t c0 = (size_t)jl * D + (size_t)h * 64 + 2 * pi; kkc2 = *(const f32x2*)(a->in[I_KK] + c0); kac2 = *(const f32x2*)(a->in[I_KA] + c0); rkc2 = *(const f32x2*)(a->in[I_RK] + c0); }
        auto prep_load = [&](int n) {
            if (q == 0) return;
            const int s0 = r5_seq(z, n * R5_L); const unsigned rlo = (unsigned)(sd > 0 ? s0 : s0 - 15) * (unsigned)D;
#pragma unroll
            for (int i = 0; i < 16; ++i) if (i < plast) pe[i] = *(const unsigned*)(Eh + rlo + (unsigned)((sd > 0 ? i : 15 - i) * D) + 2u * (unsigned)pi);
#pragma unroll
            for (int ps = 0; ps < 3; ++ps) if (ps < npass) { const int st = pst + 2 * ps + hf; const unsigned off = rlo + (unsigned)((sd > 0 ? st : 15 - st) * D) + 2u * (unsigned)pi;
                pr[ps] = *(const unsigned*)(Rh + off); pk[ps] = *(const unsigned*)(Kh + off); pv[ps] = *(const unsigned*)(Vh + off); pa[ps] = *(const unsigned*)(Ah + off); }
        };
        auto halfsum = [&](float v) -> float { v = sum16_(v); const float h0 = rl_(v, 0) + rl_(v, 16), h1 = rl_(v, 32) + rl_(v, 48); return hf ? h1 : h0; };
        auto prep_finish = [&](int n) {
            if (q == 0) return;
            LAS unsigned char* cbuf = t.lds + (n & 1) * R5_BUF + c2 * R5_CH;
            LAS bf16_t* ZR = (LAS bf16_t*)(cbuf + R5_ZR); LAS bf16_t* BK = (LAS bf16_t*)(cbuf + R5_BK); LAS bf16_t* BKT = (LAS bf16_t*)(cbuf + R5_BKT);
            LAS float* Vs = (LAS float*)(cbuf + R5_V); LAS float* GL = (LAS float*)(cbuf + R5_GL);
            f32x2 lg = {0.f, 0.f};
#pragma unroll
            for (int i = 0; i < 16; ++i) if (i < plast) { lg = lg + (f32x2){lo_bf(pe[i]), hi_bf(pe[i])}; PW[i * 32 + pi] = lg; }
            if (q == 3 && hf == 0) *(LAS f32x2*)(GL + 2 * pi) = (f32x2){__expf(lg.x), __expf(lg.y)};
            asm volatile("s_waitcnt lgkmcnt(0)" ::: "memory");
            const int s0 = r5_seq(z, n * R5_L); float rkv[3] = {0.f, 0.f, 0.f};
#pragma unroll
            for (int ps = 0; ps < 3; ++ps) if (ps < npass) { const int st = pst + 2 * ps + hf;
                const f32x2 lgs = PW[st * 32 + pi]; f32x2 lgp = {0.f, 0.f}; if (st > 0) lgp = PW[(st - 1) * 32 + pi];
                const f32x2 r2 = {lo_bf(pr[ps]), hi_bf(pr[ps])}, k2 = {lo_bf(pk[ps]), hi_bf(pk[ps])}, v2 = {lo_bf(pv[ps]), hi_bf(pv[ps])}, a2 = {lo_bf(pa[ps]), hi_bf(pa[ps])};
                f32x2 kk2 = k2 * kkc2; const float n2 = halfsum(kk2.x * kk2.x + kk2.y * kk2.y); kk2 = kk2 * __builtin_amdgcn_rsqf(fmaxf(n2, 1e-24f));
                const f32x2 km2 = k2 * ((a2 - 1.0f) * kac2 + 1.0f);
                const f32x2 rkm = r2 * km2 * rkc2; const float rk = halfsum(rkm.x + rkm.y);
                rkv[ps] = rk;
                const f32x2 gi = {__expf(-lgs.x), __expf(-lgs.y)}, gt = {__expf(lgs.x), __expf(lgs.y)}, gp = {__expf(lgp.x), __expf(lgp.y)};
                const f32x2 zt = kk2 * gp * -1.0f, rt = r2 * gt, bt = kk2 * a2 * gi, kt = km2 * gi;
                const unsigned zw = pk2(zt.x, zt.y), rw = pk2(rt.x, rt.y), bw = pk2(bt.x, bt.y), kw = pk2(kt.x, kt.y);
                *(LAS unsigned*)(ZR + st * 72 + 2 * pi) = zw; *(LAS unsigned*)(ZR + (16 + st) * 72 + 2 * pi) = rw; *(LAS unsigned*)(BK + st * 72 + 2 * pi) = bw; *(LAS unsigned*)(BK + (16 + st) * 72 + 2 * pi) = kw;
                BKT[(2 * pi) * 40 + st] = (bf16_t)(bw & 0xffffu); BKT[(2 * pi + 1) * 40 + st] = (bf16_t)(bw >> 16);
                BKT[(2 * pi) * 40 + 16 + st] = (bf16_t)(kw & 0xffffu); BKT[(2 * pi + 1) * 40 + 16 + st] = (bf16_t)(kw >> 16);
                *(LAS f32x2*)(Vs + st * 64 + 2 * pi) = v2; }
            if (pi == 0) {
#pragma unroll
                for (int ps = 0; ps < 3; ++ps) if (ps < npass) RKo[((size_t)bl * SROW + s0 + sd * (pst + 2 * ps + hf)) * 32 + h] = rkv[ps]; }
        };
        constexpr int NCH = SROW / R5_L;
        prep_load(0); prep_finish(0); prep_load(1);
        __syncthreads();
        for (int n = 0; n < NCH; ++n) {
            LAS unsigned char* cbuf = t.lds + (n & 1) * R5_BUF + c2 * R5_CH;
            const LAS bf16_t* ZR = (const LAS bf16_t*)(cbuf + R5_ZR); const LAS bf16_t* BK = (const LAS bf16_t*)(cbuf + R5_BK); const LAS bf16_t* BKT = (const LAS bf16_t*)(cbuf + R5_BKT);
            const LAS float* Vs = (const LAS float*)(cbuf + R5_V); const LAS float* GL = (const LAS float*)(cbuf + R5_GL);
            LAS float* Nm = (LAS float*)(t.lds + R5_GR + c2 * R5_GRCH); LAS bf16_t* MKZ = (LAS bf16_t*)(t.lds + R5_GR + c2 * R5_GRCH + 1024); LAS bf16_t* MBK = (LAS bf16_t*)(t.lds + R5_GR + c2 * R5_GRCH + 1536);
            LAS bf16_t* MT = (LAS bf16_t*)(t.lds + R5_GR + c2 * R5_GRCH + 2560);
            { f32x4 gacc = (f32x4){0.f, 0.f, 0.f, 0.f};
#pragma unroll
              for (int ks = 0; ks < 2; ++ks) { const bf16x8 av = *(const LAS bf16x8*)(ZR + ((q & 2) ? 16 + l15 : l15) * 72 + 32 * ks + 8 * q4);
                  const bf16x8 bv = *(const LAS bf16x8*)(BK + ((q & 1) ? 16 + l15 : l15) * 72 + 32 * ks + 8 * q4);
                  gacc = __builtin_amdgcn_mfma_f32_16x16x32_bf16(av, bv, gacc, 0, 0, 0); }
#pragma unroll
              for (int i = 0; i < 4; ++i) { const int tt = 4 * q4 + i, j = l15; const bool keep = (q & 2) ? (j <= tt) : (j < tt); const float val = keep ? gacc[i] : 0.f;
                  if (q == 0) Nm[tt * 16 + j] = val; else if (q == 1) MKZ[tt * 16 + j] = (bf16_t)f2bf(val); else MBK[tt * 32 + (q == 3 ? 16 : 0) + j] = (bf16_t)f2bf(val); }
              if (q == 0) {
                  asm volatile("s_waitcnt lgkmcnt(0)" ::: "memory");
                  LAS float* DS = (LAS float*)(t.lds + R5_DS + w * 1024);
                  float x[4];
#pragma unroll
                  for (int i = 0; i < 4; ++i) x[i] = (4 * q4 + i == l15) ? 1.0f : 0.0f;
#pragma unroll
                  for (int bs = 0; bs < 4; ++bs) {
                      f32x4 nb[4];
#pragma unroll
                      for (int i = 0; i < 4; ++i) nb[i] = *(const LAS f32x4*)(Nm + (4 * q4 + i) * 16 + 4 * bs);
                      if (q4 == bs) { x[1] += nb[1][0] * x[0]; x[2] += nb[2][0] * x[0] + nb[2][1] * x[1]; x[3] += nb[3][0] * x[0] + nb[3][1] * x[1] + nb[3][2] * x[2];
#pragma unroll
                          for (int i = 0; i < 4; ++i) DS[(4 * bs + i) * 16 + l15] = x[i]; }
                      asm volatile("s_waitcnt lgkmcnt(0)" ::: "memory");
                      if (bs < 3 && q4 > bs) { float dj[4];
#pragma unroll
                          for (int j = 0; j < 4; ++j) dj[j] = DS[(4 * bs + j) * 16 + l15];
#pragma unroll
                          for (int i = 0; i < 4; ++i) x[i] += (nb[i][0] * dj[0] + nb[i][1] * dj[1]) + (nb[i][2] * dj[2] + nb[i][3] * dj[3]); }
                      asm volatile("" ::: "memory"); }
#pragma unroll
                  for (int i = 0; i < 4; ++i) MT[(4 * q4 + i) * 16 + l15] = (bf16_t)f2bf(x[i]); } }
            if (n + 1 < NCH) prep_finish(n + 1);
            if (n + 2 < NCH) prep_load(n + 2);
            if (n > 0) { const LAS float* ys = (const LAS float*)(t.lds + R5_YS + ((n - 1) & 1) * 8192 + c2 * 4096);
#pragma unroll
                for (int i = 0; i < 8; ++i) if (i < fcn) { const int tt = fst + i; Y[((size_t)bl * SROW + r5_seq(z, (n - 1) * R5_L) + sd * tt) * D + colb] = (bf16_t)f2bf(ys[tt * 64 + lane]); } }
            __syncthreads();
            {
              f32x4 Pz = (f32x4){0.f, 0.f, 0.f, 0.f}, Pr = Pz;
#pragma unroll
              for (int ks = 0; ks < 2; ++ks) { const f32x4 s0 = ST[2 * ks], s1 = ST[2 * ks + 1];
                  u32x4 p; p.x = pk2(s0[0], s0[1]); p.y = pk2(s0[2], s0[3]); p.z = pk2(s1[0], s1[1]); p.w = pk2(s1[2], s1[3]);
                  const bf16x8 bop = __builtin_bit_cast(bf16x8, p);
                  const LAS bf16_t* zr = ZR + l15 * 72 + 32 * ks + 4 * q4; const LAS bf16_t* rr = ZR + (16 + l15) * 72 + 32 * ks + 4 * q4;
                  const u32x2 z0 = *(const LAS u32x2*)zr, z1 = *(const LAS u32x2*)(zr + 16), r0 = *(const LAS u32x2*)rr, r1 = *(const LAS u32x2*)(rr + 16);
                  Pz = __builtin_amdgcn_mfma_f32_16x16x32_bf16(__builtin_bit_cast(bf16x8, (u32x4){z0.x, z0.y, z1.x, z1.y}), bop, Pz, 0, 0, 0);
                  Pr = __builtin_amdgcn_mfma_f32_16x16x32_bf16(__builtin_bit_cast(bf16x8, (u32x4){r0.x, r0.y, r1.x, r1.y}), bop, Pr, 0, 0, 0); }
              float vd[4];
#pragma unroll
              for (int i = 0; i < 4; ++i) vd[i] = Vs[(4 * q4 + i) * 64 + 16 * q + l15];
              const unsigned vp0 = pk2(vd[0], vd[1]), vp1 = pk2(vd[2], vd[3]);
              { const u32x2 m = *(const LAS u32x2*)(MKZ + l15 * 16 + 4 * q4);
                Pz = __builtin_amdgcn_mfma_f32_16x16x32_bf16(__builtin_bit_cast(bf16x8, (u32x4){m.x, m.y, 0u, 0u}), __builtin_bit_cast(bf16x8, (u32x4){vp0, vp1, 0u, 0u}), Pz, 0, 0, 0); }
              { float x[4];
                { const u32x2 mt = *(const LAS u32x2*)(MT + l15 * 16 + 4 * q4);
                  const f32x4 dv = __builtin_amdgcn_mfma_f32_16x16x32_bf16(__builtin_bit_cast(bf16x8, (u32x4){mt.x, mt.y, 0u, 0u}), __builtin_bit_cast(bf16x8, (u32x4){pk2(Pz[0], Pz[1]), pk2(Pz[2], Pz[3]), 0u, 0u}), (f32x4){0.f, 0.f, 0.f, 0.f}, 0, 0, 0);
                  x[0] = dv[0]; x[1] = dv[1]; x[2] = dv[2]; x[3] = dv[3]; }
                const unsigned dp0 = pk2(x[0], x[1]), dp1 = pk2(x[2], x[3]);
                const bf16x8 bdv = __builtin_bit_cast(bf16x8, (u32x4){dp0, dp1, vp0, vp1});
                { const u32x2 m0 = *(const LAS u32x2*)(MBK + l15 * 32 + 4 * q4), m1 = *(const LAS u32x2*)(MBK + l15 * 32 + 16 + 4 * q4);
                  Pr = __builtin_amdgcn_mfma_f32_16x16x32_bf16(__builtin_bit_cast(bf16x8, (u32x4){m0.x, m0.y, m1.x, m1.y}), bdv, Pr, 0, 0, 0); }
                { LAS float* ys = (LAS float*)(t.lds + R5_YS + (n & 1) * 8192 + c2 * 4096);
#pragma unroll
                  for (int i = 0; i < 4; ++i) ys[(4 * q4 + i) * 64 + 16 * q + l15] = Pr[i]; }
#pragma unroll
                for (int cb = 0; cb < 4; ++cb) { const LAS bf16_t* bt = BKT + (16 * cb + l15) * 40 + 4 * q4;
                    const u32x2 b0 = *(const LAS u32x2*)bt, k0 = *(const LAS u32x2*)(bt + 16);
                    ST[cb] = __builtin_amdgcn_mfma_f32_16x16x32_bf16(__builtin_bit_cast(bf16x8, (u32x4){b0.x, b0.y, k0.x, k0.y}), bdv, ST[cb], 0, 0, 0);
                    const f32x4 gl = *(const LAS f32x4*)(GL + 16 * cb + 4 * q4);
                    ST[cb] = ST[cb] * gl; } } }
            __syncthreads();
        }
        { const LAS float* ys = (const LAS float*)(t.lds + R5_YS + ((NCH - 1) & 1) * 8192 + c2 * 4096);
#pragma unroll
          for (int i = 0; i < 8; ++i) if (i < fcn) { const int tt = fst + i; Y[((size_t)bl * SROW + r5_seq(z, (NCH - 1) * R5_L) + sd * tt) * D + colb] = (bf16_t)f2bf(ys[tt * 64 + lane]); } }
        __syncthreads();
    }
}
__device__ __forceinline__ void r6_readout(const Tc& t, CArgs a, int jl, int layer, int g) {
    const bf16_t* Y0 = (const bf16_t*)(a->ws + WS_ACT + AR_Y), *Y1 = (const bf16_t*)(a->ws + WS_ACT + AR_Y + SLOT);
    const float* RK0 = (const float*)(a->ws + WS_ACT + AR_RK), *RK1 = RK0 + (size_t)TG * 32;
    const bf16_t* Vb = (layer == 0) ? (const bf16_t*)(a->ws + WS_VF) + (size_t)g * TG * D : (const bf16_t*)(a->ws + WS_ACT + AR_V);
    const bf16_t* Gb = (const bf16_t*)(a->ws + WS_ACT + AR_MIX + 4 * SLOT);
    bf16_t* Ao = (bf16_t*)(a->ws + WS_ACT + AR_AO) + (size_t)g * TG * D;
    const int sl = t.gw & 3, c0 = 512 * sl + 8 * t.lane, head = c0 >> 6;
    const float* lnw = a->in[I_LNW] + (size_t)jl * D + c0, *lnb = a->in[I_LNB] + (size_t)jl * D + c0;
    const f32x4 lw0 = *(const f32x4*)lnw, lw1 = *(const f32x4*)(lnw + 4), lb0 = *(const f32x4*)lnb, lb1 = *(const f32x4*)(lnb + 4);
    const float lw[8] = {lw0.x, lw0.y, lw0.z, lw0.w, lw1.x, lw1.y, lw1.z, lw1.w}, lb[8] = {lb0.x, lb0.y, lb0.z, lb0.w, lb1.x, lb1.y, lb1.z, lb1.w};
    const int rstep = t.ngw >> 2;
    for (int r0 = t.gw >> 2; r0 < TG; r0 += 2 * rstep) {
        u32x4 y0[2], y1[2], vv[2], gg[2]; float rk[2];
#pragma unroll
        for (int k = 0; k < 2; ++k) { const int r = r0 + k * rstep < TG ? r0 + k * rstep : r0; const size_t off = (size_t)r * D + c0;
            y0[k] = *(const u32x4*)(Y0 + off); y1[k] = *(const u32x4*)(Y1 + off); vv[k] = *(const u32x4*)(Vb + off); gg[k] = *(const u32x4*)(Gb + off);
            rk[k] = RK0[(size_t)r * 32 + head] + RK1[(size_t)r * 32 + head]; }
        asm volatile("" ::: "memory");
#pragma unroll
        for (int k = 0; k < 2; ++k) { const int r = r0 + k * rstep; if (r >= TG) break; const size_t off = (size_t)r * D + c0;
            const unsigned a0[4] = {y0[k].x, y0[k].y, y0[k].z, y0[k].w}, a1[4] = {y1[k].x, y1[k].y, y1[k].z, y1[k].w};
            const unsigned av[4] = {vv[k].x, vv[k].y, vv[k].z, vv[k].w}, ag[4] = {gg[k].x, gg[k].y, gg[k].z, gg[k].w};
            float y[8]; float s = 0.f;
#pragma unroll
            for (int i = 0; i < 4; ++i) { y[2 * i] = lo_bf(a0[i]) + lo_bf(a1[i]); y[2 * i + 1] = hi_bf(a0[i]) + hi_bf(a1[i]); s += y[2 * i] + y[2 * i + 1]; }
            s = sum8_(s);
            const float mean = s * (1.0f / 64.0f);
            float qq = 0.f;
#pragma unroll
            for (int i = 0; i < 8; ++i) { y[i] -= mean; qq += y[i] * y[i]; }
            qq = sum8_(qq);
            const float rstd = rsqrtf(qq * (1.0f / 64.0f) + 64e-5f);
            float o[8];
#pragma unroll
            for (int i = 0; i < 4; ++i) { o[2 * i] = (y[2 * i] * rstd * lw[2 * i] + lb[2 * i] + rk[k] * lo_bf(av[i])) * lo_bf(ag[i]);
                o[2 * i + 1] = (y[2 * i + 1] * rstd * lw[2 * i + 1] + lb[2 * i + 1] + rk[k] * hi_bf(av[i])) * hi_bf(ag[i]); }
            u32x4 w; w.x = pk2(o[0], o[1]); w.y = pk2(o[2], o[3]); w.z = pk2(o[4], o[5]); w.w = pk2(o[6], o[7]);
            *(u32x4*)(Ao + off) = w; }
        asm volatile("" ::: "memory");
    }
}

__device__ __forceinline__ void m3_conv(const Tc& t, CArgs a, int jl) {
    const bf16_t* U = (const bf16_t*)(a->ws + WS_ACT + AM_U);
    bf16_t* QK = (bf16_t*)(a->ws + WS_ACT + AM_QK);
    const int sl = t.gw & 7, c0 = 256 * sl + 4 * t.lane;
    const float* cw = a->in[I_CONVW] + (size_t)jl * 9 * D + c0;
    f32x4 wt[9];
#pragma unroll
    for (int k = 0; k < 9; ++k) wt[k] = *(const f32x4*)(cw + k * D);
    const f32x4 bias = *(const f32x4*)(a->in[I_CONVB] + (size_t)jl * D + c0);
    const float sc = c0 < 1024 ? 0.08838834764831845f : 1.0f;
    for (int row = t.gw >> 3; row < T; row += t.ngw >> 3) { const int s = row % SROW;
        f32x4 acc = bias;
        if (s < CTXL) {
#pragma unroll
            for (int dc = -1; dc <= 1; ++dc) if (s + dc >= 0 && s + dc < CTXL) { const u32x2 u = *(const u32x2*)(U + (size_t)(row + dc) * ULD + c0); const f32x4 w = wt[3 + dc + 1];
                acc.x += lo_bf(u.x) * w.x; acc.y += hi_bf(u.x) * w.y; acc.z += lo_bf(u.y) * w.z; acc.w += hi_bf(u.y) * w.w; }
        } else { const int i = s - CTXL, gr = i >> 6, gc = i & 63;
            u32x2 u[9];
#pragma unroll
            for (int dr = -1; dr <= 1; ++dr)
#pragma unroll
                for (int dc = -1; dc <= 1; ++dc) { const bool ok = (gr + dr >= 0) && (gr + dr < 32) && (gc + dc >= 0) && (gc + dc < 64);
                    u[(dr + 1) * 3 + dc + 1] = ok ? *(const u32x2*)(U + (size_t)(row + dr * 64 + dc) * ULD + c0) : (u32x2){0u, 0u}; }
#pragma unroll
            for (int k = 0; k < 9; ++k) { acc.x += lo_bf(u[k].x) * wt[k].x; acc.y += hi_bf(u[k].x) * wt[k].y; acc.z += lo_bf(u[k].y) * wt[k].z; acc.w += hi_bf(u[k].y) * wt[k].w; }
        }
        u32x2 w; w.x = pk2(siluf_(acc.x) * sc, siluf_(acc.y) * sc); w.y = pk2(siluf_(acc.z) * sc, siluf_(acc.w) * sc);
        *(u32x2*)(QK + (size_t)row * D + c0) = w;
    }
}

template <int CTRL> __device__ __forceinline__ float dppz_(float v) { return __int_as_float(__builtin_amdgcn_update_dpp(0, __float_as_int(v), CTRL, 0xF, 0xF, false)); }
template <int CTRL> __device__ __forceinline__ float dppm_(float v) { return __int_as_float(__builtin_amdgcn_update_dpp((int)0xff800000u, __float_as_int(v), CTRL, 0xF, 0xF, false)); }
constexpr int M4_QS = 136, M4_TS = 72;
constexpr int M4_SQ = 0, M4_SK = 17408, M4_SVT = 34816, M4_SWKT = 71680, M4_SP = 90112, M4_F = 99328;
__device__ __forceinline__ void m4_scan(const Tc& t, CArgs a) {
    LAS bf16_t* sQ = (LAS bf16_t*)(t.lds + M4_SQ); LAS bf16_t* sK = (LAS bf16_t*)(t.lds + M4_SK); LAS bf16_t* sVT = (LAS bf16_t*)(t.lds + M4_SVT);
    LAS bf16_t* sWKT = (LAS bf16_t*)(t.lds + M4_SWKT); LAS bf16_t* sP = (LAS bf16_t*)(t.lds + M4_SP);
    LAS float* fI = (LAS float*)(t.lds + M4_F);
    LAS float* fF = fI + 64;
    LAS float* fU = fI + 128;
    LAS float* fG = fI + 192;
    LAS float* fWI = fI + 256;
    LAS float* fEN = fI + 320;
    LAS float* fWS = fI + 384;
    LAS float* fRS = fI + 448;
    LAS float* fQN = fI + 576;
    LAS float* fN = fI + 640;
    LAS float* fSC = fI + 768;
    LAS float* fNP = fI + 832;
    const bf16_t* QK = (const bf16_t*)(a->ws + WS_ACT + AM_QK);
    const bf16_t* U = (const bf16_t*)(a->ws + WS_ACT + AM_U);
    const float* Gt = (const float*)(a->ws + WS_ACT + AM_G);
    const int tid = t.tid, lane = t.lane, w = t.wave, l15 = lane & 15, q4 = lane >> 4;
    for (int chain = t.bid; chain < 2 * NB * MH; chain += t.G) {
        const int z = chain / (NB * MH), b = (chain / MH) % NB, h = chain % MH;
        bf16_t* HZ = (bf16_t*)(a->ws + WS_ACT + (z == 0 ? AM_HB : AM_HZ1));
        f32x4 Cacc[8][2];
#pragma unroll
        for (int db = 0; db < 8; ++db)
#pragma unroll
            for (int e = 0; e < 2; ++e) Cacc[db][e] = (f32x4){0.f, 0.f, 0.f, 0.f};
        float m_old = 0.f;
        if (tid < 128) fN[tid] = 0.f;
        __syncthreads();
        const size_t rowb = (size_t)b * SROW; const int sdir = z == 0 ? 1 : -1;
        u32x4 pq[2], pkk[2], pvv[4]; float pgi = 0.f, pgf = 0.f;
#define M4_LOAD(chn) do { const int t0_ = (chn) * 64; const int sb_ = z == 0 ? t0_ : (t0_ < CTXL ? CTXL - 1 - t0_ : SROW + CTXL - 1 - t0_); \
            _Pragma("unroll") for (int rep = 0; rep < 2; ++rep) { const int cid = tid + 512 * rep, i = cid >> 4, cc = cid & 15; const size_t row = rowb + sb_ + sdir * i; \
                pq[rep] = *(const u32x4*)(QK + row * D + h * MDK + 8 * cc); pkk[rep] = *(const u32x4*)(QK + row * D + 1024 + h * MDK + 8 * cc); } \
            _Pragma("unroll") for (int rep = 0; rep < 4; ++rep) { const int cid = tid + 512 * rep, i = cid & 63, cc = cid >> 6; const size_t row = rowb + sb_ + sdir * i; \
                pvv[rep] = *(const u32x4*)(U + row * ULD + 2048 + h * MDV + 8 * cc); } \
            if (tid < 64) { const size_t row = rowb + sb_ + sdir * tid; pgi = Gt[row * 32 + z * 16 + h]; pgf = Gt[row * 32 + z * 16 + 8 + h]; } } while (0)
        M4_LOAD(0);
        for (int ch = 0; ch < SROW / 64; ++ch) {
            const int t0 = ch * 64;
            const int sbase = z == 0 ? t0 : (t0 < CTXL ? CTXL - 1 - t0 : SROW + CTXL - 1 - t0);
#pragma unroll
            for (int rep = 0; rep < 2; ++rep) { const int cid = tid + 512 * rep, i = cid >> 4, cc = cid & 15;
                *(LAS u32x4*)(sQ + i * M4_QS + 8 * cc) = pq[rep]; *(LAS u32x4*)(sK + i * M4_QS + 8 * cc) = pkk[rep]; }
#pragma unroll
            for (int rep = 0; rep < 4; ++rep) { const int cid = tid + 512 * rep, i = cid & 63, cc = cid >> 6;
                const unsigned wv[4] = {pvv[rep].x, pvv[rep].y, pvv[rep].z, pvv[rep].w};
#pragma unroll
                for (int jj = 0; jj < 4; ++jj) { sVT[(8 * cc + 2 * jj) * M4_TS + i] = (bf16_t)(wv[jj] & 0xffffu); sVT[(8 * cc + 2 * jj + 1) * M4_TS + i] = (bf16_t)(wv[jj] >> 16); } }
            if (ch > 0 && tid < 128) fN[tid] = fSC[0] * fN[tid] + ((fNP[tid] + fNP[128 + tid]) + (fNP[256 + tid] + fNP[384 + tid]));
            if (tid < 64) { fI[tid] = pgi; fF[tid] = pgf; }
            if (ch + 1 < SROW / 64) M4_LOAD(ch + 1);
            __syncthreads();
            if (w == 0) {
                const float ig = fI[lane], lf = fF[lane];
                float bc = lf;
                bc += dppz_<0x111>(bc); bc += dppz_<0x112>(bc); bc += dppz_<0x114>(bc); bc += dppz_<0x118>(bc);
                { const float t0 = rl_(bc, 15), t1 = rl_(bc, 31), t2 = rl_(bc, 47); bc += (lane >= 16 ? t0 : 0.f) + (lane >= 32 ? t1 : 0.f) + (lane >= 48 ? t2 : 0.f); }
                const float g = ig - bc;
                float pm = g;
                pm = fmaxf(pm, dppm_<0x111>(pm)); pm = fmaxf(pm, dppm_<0x112>(pm)); pm = fmaxf(pm, dppm_<0x114>(pm)); pm = fmaxf(pm, dppm_<0x118>(pm));
                { const float t0 = rl_(pm, 15), t1 = rl_(pm, 31), t2 = rl_(pm, 47); const float ninf = -__builtin_inff();
                  pm = fmaxf(pm, fmaxf(fmaxf(lane >= 16 ? t0 : ninf, lane >= 32 ? t1 : ninf), lane >= 48 ? t2 : ninf)); }
                const float b_end = rl_(bc, 63), pm_all = rl_(pm, 63);
                const float m_new = fmaxf(b_end + m_old, b_end + pm_all);
                const float mx = fmaxf(m_old, pm);
                fU[lane] = -mx; fG[lane] = g; fWI[lane] = __expf(m_old - mx); fEN[lane] = __expf(-mx - bc); fWS[lane] = __expf(b_end + g - m_new);
                if (lane == 0) { fSC[0] = __expf(b_end + m_old - m_new); fSC[1] = m_new; }
            }
            const int tb = w >> 1, jb0 = 2 * (w & 1);
            f32x4 St[2];
#pragma unroll
            for (int jj = 0; jj < 2; ++jj) { St[jj] = (f32x4){0.f, 0.f, 0.f, 0.f};
                if (jb0 + jj <= tb) {
#pragma unroll
                    for (int ks = 0; ks < 4; ++ks) { const bf16x8 av = *(const LAS bf16x8*)(sQ + (16 * tb + l15) * M4_QS + 32 * ks + 8 * q4);
                        const bf16x8 bv = *(const LAS bf16x8*)(sK + (16 * (jb0 + jj) + l15) * M4_QS + 32 * ks + 8 * q4);
                        St[jj] = __builtin_amdgcn_mfma_f32_16x16x32_bf16(av, bv, St[jj], 0, 0, 0); } } }
            __syncthreads();
            { float rs[4] = {0.f, 0.f, 0.f, 0.f};
#pragma unroll
              for (int jj = 0; jj < 2; ++jj) { const int j = 16 * (jb0 + jj) + l15; const float gj = fG[j];
#pragma unroll
                  for (int i = 0; i < 4; ++i) { const int tt = 16 * tb + 4 * q4 + i; const float val = (j <= tt) ? St[jj][i] * __expf(fU[tt] + gj) : 0.f;
                      rs[i] += val; sP[tt * M4_TS + j] = (bf16_t)f2bfa(val); } }
#pragma unroll
              for (int i = 0; i < 4; ++i) { float v = rs[i]; v = sum16_(v);
                  if (l15 == 0) fRS[(w & 1) * 64 + 16 * tb + 4 * q4 + i] = v; } }
            { const int d = tid & 127, jg = tid >> 7; unsigned pk[8]; float nn = 0.f;
#pragma unroll
              for (int jj = 0; jj < 8; ++jj) { const int j0 = 16 * jg + 2 * jj; const float w0 = fWS[j0] * bf2f(sK[j0 * M4_QS + d]), w1 = fWS[j0 + 1] * bf2f(sK[(j0 + 1) * M4_QS + d]);
                  nn += w0 + w1; pk[jj] = pk2a(w0, w1); }
              fNP[jg * 128 + d] = nn;
              *(LAS u32x4*)(sWKT + d * M4_TS + 16 * jg) = (u32x4){pk[0], pk[1], pk[2], pk[3]};
              *(LAS u32x4*)(sWKT + d * M4_TS + 16 * jg + 8) = (u32x4){pk[4], pk[5], pk[6], pk[7]}; }
            { const int tt = tid >> 3, dp = tid & 7; float s = 0.f;
#pragma unroll
              for (int dd = 0; dd < 16; ++dd) s += bf2f(sQ[tt * M4_QS + 16 * dp + dd]) * fN[16 * dp + dd];
              s = sum8_(s);
              if (dp == 0) fQN[tt] = s; }
            __syncthreads();
            asm volatile("s_waitcnt vmcnt(0)" ::: "memory");
            asm volatile("" : "+v"(pq[0]), "+v"(pq[1]), "+v"(pkk[0]), "+v"(pkk[1]));
            asm volatile("" : "+v"(pvv[0]), "+v"(pvv[1]), "+v"(pvv[2]), "+v"(pvv[3]), "+v"(pgi), "+v"(pgf));
#pragma unroll 1
            for (int x = 0; x < 4; ++x) {
                f32x4 acc[2];
                acc[0] = (f32x4){0.f, 0.f, 0.f, 0.f}; acc[1] = (f32x4){0.f, 0.f, 0.f, 0.f};
#pragma unroll
                for (int kb = 0; kb < 4; ++kb) {
                    const LAS bf16_t* qr = sQ + (16 * x + l15) * M4_QS + 32 * kb + 4 * q4;
                    const u32x2 lo = *(const LAS u32x2*)qr, hi = *(const LAS u32x2*)(qr + 16);
                    const bf16x8 aop = __builtin_bit_cast(bf16x8, (u32x4){lo.x, lo.y, hi.x, hi.y});
#pragma unroll
                    for (int e = 0; e < 2; ++e) { const f32x4 c0 = Cacc[2 * kb][e], c1 = Cacc[2 * kb + 1][e];
                        u32x4 p; p.x = pk2a(c0[0], c0[1]); p.y = pk2a(c0[2], c0[3]); p.z = pk2a(c1[0], c1[1]); p.w = pk2a(c1[2], c1[3]);
                        acc[e] = __builtin_amdgcn_mfma_f32_16x16x32_bf16(aop, __builtin_bit_cast(bf16x8, p), acc[e], 0, 0, 0); } }
                { const f32x4 wi = *(const LAS f32x4*)(fWI + 16 * x + 4 * q4); acc[0] = acc[0] * wi; acc[1] = acc[1] * wi; }
#pragma unroll
                for (int ks = 0; ks < 2; ++ks) { const bf16x8 aop = *(const LAS bf16x8*)(sP + (16 * x + l15) * M4_TS + 32 * ks + 8 * q4);
#pragma unroll
                    for (int e = 0; e < 2; ++e) { const bf16x8 bop = *(const LAS bf16x8*)(sVT + (16 * (2 * w + e) + l15) * M4_TS + 32 * ks + 8 * q4);
                        acc[e] = __builtin_amdgcn_mfma_f32_16x16x32_bf16(aop, bop, acc[e], 0, 0, 0); } }
#pragma unroll
                for (int i = 0; i < 4; ++i) { const int tt = 16 * x + 4 * q4 + i;
                    const float den = fWI[tt] * fQN[tt] + fRS[tt] + fRS[64 + tt]; const float dv = __builtin_amdgcn_rcpf(fmaxf(fabsf(den), fEN[tt]));
                    const size_t row = rowb + sbase + sdir * tt;
#pragma unroll
                    for (int e = 0; e < 2; ++e) HZ[row * D + h * MDV + 16 * (2 * w + e) + l15] = (bf16_t)f2bfa(acc[e][i] * dv); }
            }
            { const float dec = fSC[0];
#pragma unroll
              for (int db = 0; db < 8; ++db)
#pragma unroll
                  for (int e = 0; e < 2; ++e) Cacc[db][e] = Cacc[db][e] * dec;
#pragma unroll
              for (int ks = 0; ks < 2; ++ks) {
                  bf16x8 bop[2];
#pragma unroll
                  for (int e = 0; e < 2; ++e) bop[e] = *(const LAS bf16x8*)(sVT + (16 * (2 * w + e) + l15) * M4_TS + 32 * ks + 8 * q4);
#pragma unroll
                  for (int db = 0; db < 8; ++db) { const bf16x8 aop = *(const LAS bf16x8*)(sWKT + (16 * db + l15) * M4_TS + 32 * ks + 8 * q4);
#pragma unroll
                      for (int e = 0; e < 2; ++e) Cacc[db][e] = __builtin_amdgcn_mfma_f32_16x16x32_bf16(aop, bop[e], Cacc[db][e], 0, 0, 0); } }
 }
            m_old = fSC[1];
            __syncthreads();
        }
#undef M4_LOAD
    }
}

__device__ __forceinline__ void m5_readout(const Tc& t, CArgs a, int jl) {
    const bf16_t* H0 = (const bf16_t*)(a->ws + WS_ACT + AM_HB), *H1 = (const bf16_t*)(a->ws + WS_ACT + AM_HZ1);
    const bf16_t* U = (const bf16_t*)(a->ws + WS_ACT + AM_U);
    bf16_t* Ao = (bf16_t*)(a->ws + WS_ACT + AM_QK);
    const int sl = t.gw & 3, c0 = 512 * sl + 8 * t.lane;
    const float* nw = a->in[I_MNORMW] + (size_t)jl * D + c0;
    const f32x4 w0 = *(const f32x4*)nw, w1 = *(const f32x4*)(nw + 4);
    const float w8[8] = {w0.x, w0.y, w0.z, w0.w, w1.x, w1.y, w1.z, w1.w};
    const int rstep = t.ngw >> 2;
    for (int r0 = t.gw >> 2; r0 < T; r0 += 4 * rstep) {
        u32x4 h0[4], h1[4], ov[4];
#pragma unroll
        for (int k = 0; k < 4; ++k) { const int row = r0 + k * rstep < T ? r0 + k * rstep : r0; const size_t off = (size_t)row * D + c0;
            h0[k] = *(const u32x4*)(H0 + off); h1[k] = *(const u32x4*)(H1 + off); ov[k] = *(const u32x4*)(U + (size_t)row * ULD + 4096 + c0); }
        asm volatile("" ::: "memory");
#pragma unroll
        for (int k = 0; k < 4; ++k) { const int row = r0 + k * rstep; if (row >= T) break; const size_t off = (size_t)row * D + c0;
            const unsigned a0[4] = {h0[k].x, h0[k].y, h0[k].z, h0[k].w}, a1[4] = {h1[k].x, h1[k].y, h1[k].z, h1[k].w}, ao[4] = {ov[k].x, ov[k].y, ov[k].z, ov[k].w};
            float y[8]; float s = 0.f;
#pragma unroll
            for (int i = 0; i < 4; ++i) { y[2 * i] = lo_bf(a0[i]) + lo_bf(a1[i]); y[2 * i + 1] = hi_bf(a0[i]) + hi_bf(a1[i]); s += y[2 * i] + y[2 * i + 1]; }
            s = sum16_(s); s += shfl_xor_(s, 16, t.lane);
            const float mean = s * (1.0f / 256.0f);
            float qq = 0.f;
#pragma unroll
            for (int i = 0; i < 8; ++i) { y[i] -= mean; qq += y[i] * y[i]; }
            qq = sum16_(qq); qq += shfl_xor_(qq, 16, t.lane);
            const float rstd = rsqrtf(qq * (1.0f / 256.0f) + 1e-6f);
            float o[8];
#pragma unroll
            for (int i = 0; i < 4; ++i) { o[2 * i] = y[2 * i] * rstd * w8[2 * i] * sigmoidf_(lo_bf(ao[i])); o[2 * i + 1] = y[2 * i + 1] * rstd * w8[2 * i + 1] * sigmoidf_(hi_bf(ao[i])); }
            u32x4 wv; wv.x = pk2(o[0], o[1]); wv.y = pk2(o[2], o[3]); wv.z = pk2(o[4], o[5]); wv.w = pk2(o[6], o[7]);
            *(u32x4*)(Ao + off) = wv; }
        asm volatile("" ::: "memory");
    }
}

__device__ __forceinline__ void final_norm(const Tc& t, CArgs a) {
    const float* xres = (const float*)(a->ws + WS_XRES);
    f32x4 gg[8];
    { const f32x4* gp = (const f32x4*)a->in[I_FINALG] + t.lane;
#pragma unroll
      for (int j = 0; j < 8; ++j) gg[j] = gp[64 * j]; }
    for (int r0 = t.gw; r0 < NB * SEQ; r0 += 2 * t.ngw) {
        f32x4 v[2][8];
#pragma unroll
        for (int k = 0; k < 2; ++k) { const int r = r0 + k * t.ngw < NB * SEQ ? r0 + k * t.ngw : r0; const size_t row = (size_t)(r / SEQ) * SROW + CTXL + (r % SEQ);
            const f32x4* xr = (const f32x4*)(xres + row * D) + t.lane;
#pragma unroll
            for (int j = 0; j < 8; ++j) v[k][j] = xr[64 * j]; }
        asm volatile("" ::: "memory");
#pragma unroll
        for (int k = 0; k < 2; ++k) { const int r = r0 + k * t.ngw; if (r >= NB * SEQ) break;
            float ss = 0.f;
#pragma unroll
            for (int j = 0; j < 8; ++j) ss += (v[k][j].x * v[k][j].x + v[k][j].y * v[k][j].y) + (v[k][j].z * v[k][j].z + v[k][j].w * v[k][j].w);
            const float rstd = rsqrtf(wave_sum_dpp(ss) * (1.0f / D) + 1e-6f);
            f32x4* o = (f32x4*)(a->out + (size_t)r * D) + t.lane;
#pragma unroll
            for (int j = 0; j < 8; ++j) o[64 * j] = v[k][j] * rstd * gg[j]; }
        asm volatile("" ::: "memory");
    }
}
constexpr int NU_FULL = (T / 256) * (D / 256), NU_SKIP = (T / 9 * 8 / 256) * (D / 256);
constexpr int NSEG = 1 + 2 * (12 + 1 + 3) + 2 * (6 + 3) + 1;
enum { K_PRO = 0, K_RNORM, K_MIX, K_P3, K_P4, K_SCAN, K_READ, K_WO, K_MNORM, K_WIN, K_CONV, K_M4, K_M5, K_WOUT, K_FNORM, K_FIN, K_FOUT, K_FINAL };

__global__ void __launch_bounds__(512, 2) hybrid_fwd(Args args) {
    extern __shared__ __attribute__((aligned(16))) unsigned char lds_raw[];
    LAS unsigned char* const lds = (LAS unsigned char*)lds_raw;
    volatile LAS unsigned* MISC = (volatile LAS unsigned*)(lds + LDSCTL_OFF);
    if (threadIdx.x < 64) MISC[threadIdx.x] = 0u;
    __syncthreads();
    const int lo = args.ph_lo, hi = args.ph_hi;
    const bool fused = (hi - lo) > 1;
    unsigned* barw = (unsigned*)(args.ws + WS_CTL) + 4096;
    XcdBarrier bar; bar.bar = barw; bar.x = 0; bar.st = MISC + 8;
    if (fused) bar = xcd_barrier_post(barw, MISC + 8);
    int urot = 0;
#pragma unroll 1
    for (int seg = 0; seg < NSEG; ++seg) {
        int kind, layer = 0, g = 0;
        if (seg == 0) kind = K_PRO;
        else if (seg == NSEG - 1) kind = K_FINAL;
        else { const int s = seg - 1, pp = s / 25, r = s % 25;
            if (r < 16) { layer = 2 * pp; if (r < 12) { g = r / 6; kind = K_RNORM + r % 6; } else if (r == 12) kind = K_WO; else kind = K_FNORM + (r - 13); }
            else { layer = 2 * pp + 1; const int m = r - 16; kind = m < 6 ? K_MNORM + m : K_FNORM + (m - 6); } }
        const int jl = layer >> 1;
        if (seg >= lo && seg < hi) {
            const Tc t = mk_tc(lds); const CArgs a = opaque_args(); unsigned char* const act = a->ws + WS_ACT;
            int cmask = 0, crew_nu = 0, cj = 0, cl = 0;
            const bool isg = kind == K_P3 || kind == K_P4 || kind == K_WO || kind == K_WIN || kind == K_WOUT || kind == K_FIN || kind == K_FOUT;
            if (isg) {
                const int ng = kind == K_P3 ? (jl == 0 ? 6 : 7) : kind == K_P4 ? (jl == 0 ? 3 : 4) : 1;
                const unsigned char* wm = a->ws + WS_WMIX; const unsigned char* wf = a->ws + WS_WFFN;
                float* const X = (float*)(a->ws + WS_XRES); const float* const modl = (const float*)(a->ws + WS_MOD) + (size_t)layer * 17 * MODLD;
#pragma unroll 1
                for (int gi = 0; gi < ng; ++gi) {
                    const bf16_t* A; const bf16_t* Bt; int M = T, N = D, K = D, skip = 0;
                    pg8::EpiAny E; E.kind = 0; E.p0 = nullptr; E.p1 = nullptr; E.p2 = nullptr; E.p3 = nullptr; E.i0 = 0; E.i1 = 0; E.i2 = -1; E.s0 = 0; E.f0 = 0.f;
                    if (kind == K_P3) {
                        const int mi = gi == 0 ? 0 : gi == 1 ? 2 : gi == 2 ? 3 : gi == 3 ? 1 : gi == 4 ? 4 : gi == 5 ? 5 : 3;
                        const size_t wo = gi == 0 ? WM_R : gi == 1 ? WM_K : gi == 2 ? WM_V : gi == 3 ? WM_W1 : gi == 4 ? WM_A1 : gi == 5 ? WM_G1 : WM_V1;
                        bf16_t* vdst = (layer == 0) ? (bf16_t*)(a->ws + WS_VF) + (size_t)g * TG * D : (bf16_t*)(act + AR_V);
                        A = (const bf16_t*)(act + AR_MIX + (size_t)mi * SLOT); Bt = (const bf16_t*)(wm + wo); M = TG; N = gi < 3 ? D : 256;
                        E.p0 = gi == 0 ? (void*)(act + AR_R) : gi == 1 ? (void*)(act + AR_K) : gi == 2 ? (void*)vdst : (void*)(act + AR_LORA + (size_t)(gi - 3) * 9 * MiB);
                        E.i0 = N; E.i1 = gi == 3 ? 1 : gi == 5 ? 2 : 0;
                    } else if (kind == K_P4) {
                        const bf16_t* lora = (const bf16_t*)(act + AR_LORA);
                        A = lora + (size_t)gi * TG * 256; M = TG; K = 256;
                        if (gi < 2) { E.kind = 1; E.p0 = act + AR_MIX + (size_t)(2 * gi) * SLOT; E.s0 = (size_t)TG * D; E.p1 = a->in[gi == 0 ? I_W0 : I_A0] + (size_t)jl * 2 * D; E.f0 = gi == 0 ? -0.6065306597126334f : 1.0f;
                            Bt = (const bf16_t*)(wm + (gi == 0 ? WM_W2 : WM_A2)); N = 2 * D; }
                        else if (gi == 2) { E.p0 = act + AR_MIX + 4 * SLOT; E.i0 = D; Bt = (const bf16_t*)(wm + WM_G2); }
                        else { E.kind = 2; E.p0 = act + AR_V; E.p1 = (const bf16_t*)(a->ws + WS_VF) + (size_t)g * TG * D; E.p2 = a->in[I_V0] + (size_t)(jl - 1) * D; Bt = (const bf16_t*)(wm + WM_V2); }
                    } else if (kind == K_WO) {
                        E.kind = 3; E.p0 = X; E.p1 = modl + 2 * D; E.p2 = layer == 0 ? a->in[I_X] : nullptr; E.p3 = a->in[I_CTX];
                        A = (const bf16_t*)(act + AR_AO); Bt = (const bf16_t*)(wm + WM_O);
                    } else if (kind == K_WIN) {
                        E.p0 = act + AM_U; E.i0 = ULD; E.i2 = 24; E.p1 = act + AM_G; E.p2 = a->in[I_BGATE] + (size_t)jl * 32;
                        A = (const bf16_t*)(act + AM_HB); Bt = (const bf16_t*)(wm + WM_MIN); N = 6400;
                    } else if (kind == K_WOUT) {
                        E.kind = 3; E.p0 = X; E.p1 = modl + 2 * D; skip = layer == 3;
                        A = (const bf16_t*)(act + AM_QK); Bt = (const bf16_t*)(wm + WM_MOUT);
                    } else if (kind == K_FIN) {
                        E.kind = 4; E.p0 = act + AF_U; skip = layer == 3;
                        A = (const bf16_t*)(act + AF_H2); Bt = (const bf16_t*)(wf + WF_IN); N = 2 * DFF;
                    } else {
                        E.kind = 3; E.p0 = X; E.p1 = modl + 5 * D; skip = layer == 3;
                        A = (const bf16_t*)(act + AF_U); Bt = (const bf16_t*)(wf + WF_OUT); K = DFF;
                    }
                    run_gemm(t.lds, A, Bt, M, N, K, skip, E, urot);
                }
                if (kind == K_WO || kind == K_WOUT) { cmask = 8; cl = layer; crew_nu = (kind == K_WOUT && layer == 3) ? NU_SKIP : NU_FULL; }
                else if (kind == K_FOUT && layer < 3) { cmask = ((layer & 1) ? 1 : 2) | 4; cj = (layer + 1) >> 1; cl = layer + 1; crew_nu = NU_FULL; }
            } else if (kind == K_RNORM || kind == K_MNORM || kind == K_FNORM) {
                if (kind == K_RNORM && layer == 0 && g == 0) { cmask = 1 | 4; cj = 0; cl = 0; }
                const int which = kind == K_FNORM ? 1 : 0, rb = kind == K_RNORM ? g * TG : 0, nr = kind == K_RNORM ? TG : T;
                unsigned char* out = act + (kind == K_RNORM ? AR_H : kind == K_MNORM ? AM_HB : AF_H2);
                norm_rows<true>(t, a, layer, which, rb, nr, out, kind == K_RNORM && layer == 0);
            } else {
                switch (kind) {
                case K_PRO: ph_prologue(t, a); break;
                case K_MIX: r2_mix(t, a, jl); break;
                case K_SCAN: r5_scan(t, a, jl, layer, g); break;
                case K_READ: r6_readout(t, a, jl, layer, g); break;
                case K_CONV: m3_conv(t, a, jl); break;
                case K_M4: m4_scan(t, a); break;
                case K_M5: m5_readout(t, a, jl); break;
                default: final_norm(t, a); break;
                }
            }
            if (cmask) {
                const Tc t2 = mk_tc(lds); const CArgs a2 = opaque_args(); Tc ts = t2; bool in = true;
                if (crew_nu) in = tail_crew(t2, urot - crew_nu, crew_nu, ts);
                if (in) { __syncthreads();
                    if (cmask & 1) convert_rwkv(ts, a2, cj);
                    if (cmask & 2) convert_mlstm(ts, a2, cj);
                    if (cmask & 4) convert_ffn_in(ts, a2, cl);
                    if (cmask & 8) convert_ffn_out(ts, a2, cl); } }
        }
        if (fused && seg >= lo && seg + 1 < hi) xcd_barrier(bar);
    }
}

#ifndef MK_MULTI
#define MK_MULTI 0
#endif
extern "C" void kernel_launch(void* const* d_in, const int* in_sizes, int n_in, void* d_out, int out_size, void* d_ws, size_t ws_size, hipStream_t stream) {
    static int grid = 0;
    if (grid == 0) {
        if (n_in != NIN || ws_size < WS_END) { fprintf(stderr, "kernel_launch: unexpected n_in %d / ws %zu\n", n_in, ws_size); grid = -1; return; }
        int dev = 0, cus = 0, per_cu = 0;
        if (hipGetDevice(&dev) != hipSuccess || hipDeviceGetAttribute(&cus, hipDeviceAttributeMultiprocessorCount, dev) != hipSuccess) { grid = -1; return; }
        if (hipFuncSetAttribute((const void*)hybrid_fwd, hipFuncAttributeMaxDynamicSharedMemorySize, LDS_BYTES) != hipSuccess) { fprintf(stderr, "kernel_launch: hipFuncSetAttribute failed\n"); grid = -1; return; }
        if (hipOccupancyMaxActiveBlocksPerMultiprocessor(&per_cu, (const void*)hybrid_fwd, 512, LDS_BYTES) != hipSuccess || per_cu < 1)
            fprintf(stderr, "kernel_launch: occupancy query reports %d workgroups per CU\n", per_cu);
        (void)hipGetLastError();
        grid = cus;
    }
    if (grid < 0) return;
    if (hipMemsetAsync((char*)d_ws + WS_CTL, 0, CTL_ZERO_BYTES, stream) != hipSuccess) return;
    Args a{};
    for (int i = 0; i < NIN; ++i) a.in[i] = (const float*)d_in[i];
    a.out = (float*)d_out; a.ws = (unsigned char*)d_ws;
#if MK_MULTI
    for (int s = 0; s < NSEG; ++s) { a.ph_lo = s; a.ph_hi = s + 1; hipLaunchKernelGGL(hybrid_fwd, dim3(grid), dim3(512), LDS_BYTES, stream, a); }
#else
    a.ph_lo = 0; a.ph_hi = NSEG;
    hipLaunchKernelGGL(hybrid_fwd, dim3(grid), dim3(512), LDS_BYTES, stream, a);
#endif
}
```

```cpp
#include <hip/hip_runtime.h>
#include <cstdio>
#include <cstdint>

#define LAS __attribute__((address_space(3)))
#define GAS __attribute__((address_space(1)))
typedef unsigned short bf16_t;
typedef short bf16x8 __attribute__((ext_vector_type(8)));
typedef short bf16x4 __attribute__((ext_vector_type(4)));
typedef float f32x4 __attribute__((ext_vector_type(4)));
typedef float f32x2 __attribute__((ext_vector_type(2)));
typedef unsigned u32x4 __attribute__((ext_vector_type(4)));
typedef unsigned u32x2 __attribute__((ext_vector_type(2)));
#define LDS_WAIT() asm volatile("s_waitcnt lgkmcnt(0)" ::: "memory")
#define VM_WAIT() asm volatile("s_waitcnt vmcnt(0)" ::: "memory")

constexpr int D = 2048, NB = 16, SEQ = 2048, CTXL = 256, SROW = 2304, T = NB * SROW;
constexpr int NGRP = 2, BG = 8, TG = BG * SROW;
constexpr int DFF = 5632;
constexpr int RH = 32;
constexpr int MH = 8, MDV = 256, MDK = 128, MPROJ = 6176, ULD = 6144;
constexpr int MODLD = 6 * D;
constexpr int NIN = 37;
enum { I_X = 0, I_C, I_CTX, I_CCTX, I_MODW, I_MODB, I_NORMG, I_FINALG, I_MU, I_WR, I_WK, I_WV, I_WO, I_W0, I_W1, I_W2, I_A0, I_A1, I_A2, I_G1, I_G2, I_KK, I_KA, I_RK, I_LNW, I_LNB,
       I_V0, I_V1, I_V2, I_MWIN, I_BGATE, I_CONVW, I_CONVB, I_MNORMW, I_MWOUT, I_FWIN, I_FWOUT };

constexpr size_t MiB = 1u << 20;
constexpr size_t WS_CTL = 0, CTL_ZERO_BYTES = 1 * MiB;
constexpr size_t WS_MOD = 1 * MiB;
constexpr size_t WS_XRES = 5 * MiB;
constexpr size_t WS_VF = 293 * MiB;
constexpr size_t WS_WMIX = 437 * MiB;
constexpr size_t WS_WFFN = 479 * MiB;
constexpr size_t WS_ACT = 545 * MiB;
constexpr size_t WS_END = WS_ACT + 977 * MiB;
static_assert(WS_END <= (size_t)1536 * MiB, "ws");
constexpr size_t WM_R = 0, WM_K = 8 * MiB, WM_V = 16 * MiB, WM_O = 24 * MiB, WM_W1 = 32 * MiB, WM_A1 = 33 * MiB, WM_G1 = 34 * MiB, WM_V1 = 35 * MiB,
                 WM_W2 = 36 * MiB, WM_A2 = 38 * MiB, WM_G2 = 40 * MiB, WM_V2 = 41 * MiB;
constexpr size_t WM_MIN = 0, WM_MOUT = 25 * MiB;
constexpr size_t WF_IN = 0, WF_OUT = 44 * MiB;
constexpr size_t SLOT = 72 * MiB;
constexpr size_t AR_MIX = 0;
constexpr size_t AR_H = 432 * MiB;
constexpr size_t AR_R = 432 * MiB, AR_K = 504 * MiB, AR_V = 576 * MiB;
constexpr size_t AR_LORA = 648 * MiB;
constexpr size_t AR_Y = 684 * MiB;
constexpr size_t AR_RK = 828 * MiB;
constexpr size_t AR_AO = 833 * MiB;
constexpr size_t AM_HB = 0, AM_U = 144 * MiB, AM_QK = 576 * MiB, AM_HZ1 = 720 * MiB, AM_G = 864 * MiB;
constexpr size_t AF_H2 = 0, AF_U = 144 * MiB;

constexpr int LDS_BYTES = 147456;
constexpr int LDSCTL_OFF = LDS_BYTES - 256;

__device__ __forceinline__ float bf2f(bf16_t b) { return __uint_as_float(((unsigned)b) << 16); }
typedef __bf16 bf16x2n_t __attribute__((ext_vector_type(2)));
__device__ __forceinline__ unsigned pk2(float lo, float hi) { const f32x2 v = {lo, hi}; return __builtin_bit_cast(unsigned, __builtin_convertvector(v, bf16x2n_t)); }
__device__ __forceinline__ unsigned f2bf(float f) { return pk2(f, f) & 0xffffu; }
__device__ __forceinline__ unsigned pk2a(float lo, float hi) { unsigned r; asm("v_cvt_pk_bf16_f32 %0, %1, %2" : "=v"(r) : "v"(lo), "v"(hi)); return r; }
__device__ __forceinline__ unsigned f2bfa(float f) { return pk2a(f, f) & 0xffffu; }
__device__ __forceinline__ float lo_bf(unsigned w) { return __uint_as_float(w << 16); }
__device__ __forceinline__ float hi_bf(unsigned w) { return __uint_as_float(w & 0xffff0000u); }
__device__ __forceinline__ float sigmoidf_(float x) { return __builtin_amdgcn_rcpf(1.0f + __expf(-x)); }
__device__ __forceinline__ float tanhf_(float x) { return 1.0f - 2.0f * __builtin_amdgcn_rcpf(1.0f + __expf(2.0f * x)); }
__device__ __forceinline__ float siluf_(float x) { return x * __builtin_amdgcn_rcpf(1.0f + __expf(-x)); }
template <int CTRL> __device__ __forceinline__ float dpp_(float v) { return __int_as_float(__builtin_amdgcn_update_dpp(0, __float_as_int(v), CTRL, 0xF, 0xF, true)); }
__device__ __forceinline__ float rl_(float v, int k) { return __int_as_float(__builtin_amdgcn_readlane(__float_as_int(v), k)); }
__device__ __forceinline__ float sum8_(float v) { v += dpp_<0xB1>(v); v += dpp_<0x4E>(v); v += dpp_<0x141>(v); return v; }
__device__ __forceinline__ float sum16_(float v) { v = sum8_(v); v += dpp_<0x140>(v); return v; }
__device__ __forceinline__ float wave_sum_dpp(float v) { v = sum16_(v); return (rl_(v, 0) + rl_(v, 16)) + (rl_(v, 32) + rl_(v, 48)); }
__device__ __forceinline__ float wave_sum(float v) { return wave_sum_dpp(v); }
__device__ __forceinline__ float shfl_xor_(float v, int mask, int lane) { return __int_as_float(__builtin_amdgcn_ds_bpermute((lane ^ mask) << 2, __float_as_int(v))); }

#define XB_TMO      128
#define XB_XCNT(j)  (256  + 64 * (j))
#define XB_XSUB(j)  (1280 + 64 * (j))
#define XB_XGEN(j)  (2304 + 64 * (j))
#define XB_TOP      3328
#define XB_TOPGEN   3392
#define XCD_BAR_WORDS 3456
#define XB_SPIN_CAP (1u << 24)

__device__ __forceinline__ unsigned xb_ld(unsigned* p)              { return __hip_atomic_load(p, __ATOMIC_RELAXED, __HIP_MEMORY_SCOPE_AGENT); }
__device__ __forceinline__ unsigned xb_add(unsigned* p, unsigned v) { return __hip_atomic_fetch_add(p, v, __ATOMIC_RELAXED, __HIP_MEMORY_SCOPE_AGENT); }
__device__ __forceinline__ unsigned xb_xcc_id() { return (unsigned)__builtin_amdgcn_s_getreg((3 << 11) | 20) & 0xFu; }
#define XB_SPIN(cond, bar) do { unsigned _sp = 0; while (cond) { __builtin_amdgcn_s_sleep(1); \
    if ((++_sp & 255u) == 0u) { if (xb_ld(&(bar)[XB_TMO])) break; if (_sp > XB_SPIN_CAP) { atomicAdd(&(bar)[XB_TMO], 1u); break; } } } } while (0)

struct XcdBarrier { unsigned* bar; unsigned x; volatile LAS unsigned* st; };

__device__ __forceinline__ XcdBarrier xcd_barrier_post(unsigned* bar, volatile LAS unsigned* st) {
    XcdBarrier b; b.bar = bar; b.x = xb_xcc_id(); b.st = st;
    if (threadIdx.x == 0) (void)xb_add(&bar[XB_XCNT(b.x)], 1u);
    return b;
}
__device__ __forceinline__ void xcd_barrier_complete(unsigned* bar, unsigned x, unsigned& nloc, unsigned& nx) {
    const unsigned G = gridDim.x * gridDim.y * gridDim.z;
    unsigned sum, cnt, mine, sp = 0u;
    for (;;) {
        sum = 0u; cnt = 0u; mine = 0u;
#pragma unroll
        for (unsigned j = 0; j < 16; ++j) { const unsigned c = xb_ld(&bar[XB_XCNT(j)]); sum += c; cnt += (c > 0u) ? 1u : 0u; mine = (j == x) ? c : mine; }
        if (sum == G) break;
        __builtin_amdgcn_s_sleep(1);
        if ((++sp & 255u) == 0u) { if (xb_ld(&bar[XB_TMO])) break; if (sp > XB_SPIN_CAP) { atomicAdd(&bar[XB_TMO], 1u); break; } }
    }
    nloc = mine > 0u ? mine : 1u; nx = cnt > 0u ? cnt : 1u;
}
__device__ __forceinline__ void xcd_barrier(const XcdBarrier& b) {
    asm volatile("s_waitcnt vmcnt(0)" ::: "memory");
    __syncthreads();
    if (threadIdx.x == 0) {
        unsigned* bar = b.bar;
        __builtin_amdgcn_s_waitcnt(0);
        unsigned nloc = b.st[0], nx = b.st[1];
        if (nloc == 0u) { xcd_barrier_complete(bar, b.x, nloc, nx); b.st[0] = nloc; b.st[1] = nx; }
        const unsigned old = xb_add(&bar[XB_XSUB(b.x)], 1u);
        const unsigned gen = old / nloc;
        if (old + 1u == (gen + 1u) * nloc) {
            __builtin_amdgcn_fence(__ATOMIC_RELEASE, "agent");
            asm volatile("s_waitcnt vmcnt(0)" ::: "memory");
            const unsigned og = xb_add(&bar[XB_TOP], 1u);
            const unsigned tg = og / nx;
            if (og + 1u == (tg + 1u) * nx) xb_add(&bar[XB_TOPGEN], 1u);
            else XB_SPIN(xb_ld(&bar[XB_TOPGEN]) == tg, bar);
            __builtin_amdgcn_fence(__ATOMIC_ACQUIRE, "agent");
            xb_add(&bar[XB_XGEN(b.x)], 1u);
            asm volatile("s_waitcnt vmcnt(0)" ::: "memory");
        } else {
            XB_SPIN(xb_ld(&bar[XB_XGEN(b.x)]) == gen, bar);
            __builtin_amdgcn_fence(__ATOMIC_ACQUIRE, "agent");
            asm volatile("s_waitcnt vmcnt(0)" ::: "memory");
        }
    }
    __syncthreads();
}
#ifndef GP_ALIGN
#define GP_ALIGN true
#endif
#ifndef GP_SP2
#define GP_SP2 true
#endif
namespace pg8 {
constexpr int BM = 256, BK = 64, HALF = 128, HTB = HALF * BK * 2  , STAGE_BYTES = 8 * HTB, NXCD = 8, WGM = 8;

__host__ __device__ __forceinline__ int lds_byte(int r, int c) { const int st = (r >> 4) * 2 + (c >> 5), rr = r & 15, cc = c & 31, ob = rr * 64 + cc * 2; return st * 1024 + (ob ^ (((ob >> 9) & 1) << 5)); }
__host__ __device__ __forceinline__ void stage_rc(int b, int& R, int& C) { const int st = b / 1024, sb = b % 1024, swz = sb ^ (((sb >> 9) & 1) << 5); R = (st >> 1) * 16 + swz / 64; C = (st & 1) * 32 + (swz % 64) / 2; }
__host__ __device__ __forceinline__ int perm32(int rho) { const int n = rho >> 4, i = rho & 15; return 8 * (i >> 2) + 4 * n + (i & 3); }

struct Unit { int pm, pn; };
struct Gemm { const bf16_t* A; const bf16_t* Bt; int M, N, K; };

struct StaticOrder {
    int nM, nN, nwg, G, c;
    __host__ __device__ void init(int M, int N, int G_, int c_) { nM = M / BM; nN = N / BM; nwg = nM * nN; G = G_; c = c_; }
    __host__ __device__ bool next(int i, Unit& u) const {
        const long L = (long)i * G + c; if (L >= nwg) return false;
        int wgid = (int)L; { const int q = nwg / NXCD, r = nwg % NXCD, xcd = wgid % NXCD, off = wgid / NXCD; wgid = (xcd < r ? xcd * (q + 1) : r * (q + 1) + (xcd - r) * q) + off; }
        const int nig = WGM * nN, gid = wgid / nig, fm = gid * WGM, gsz = (nM - fm) < WGM ? (nM - fm) : WGM;
        u.pm = fm + ((wgid % nig) % gsz); u.pn = (wgid % nig) / gsz; return true;
    }
    __device__ __forceinline__ void a_ready(const Unit&) const {}
    __device__ __forceinline__ void done(const Unit&) const {}
};
__device__ __forceinline__ unsigned cvt_pk_bf16(float lo, float hi) { unsigned r; asm volatile("v_cvt_pk_bf16_f32 %0, %1, %2" : "=v"(r) : "v"(lo), "v"(hi)); return r; }
template <class Epi, class Sched, bool ALIGN_EPI = false, bool SP2 = false>
__device__ __forceinline__ void gemm_phase(LAS unsigned char* lds, const Gemm g, const Sched& S, const Epi& E) {
    int tid_ = threadIdx.x; asm volatile("" : "+v"(tid_));
    const int tid = tid_, wid = __builtin_amdgcn_readfirstlane(tid >> 6), lane = tid & 63, wr = wid >> 2, wc = wid & 3, fr = lane & 15, fq = lane >> 4;
    const int K = g.K, nt = K / BK;
    unsigned voffA[2], voffB[2];
#pragma unroll
    for (int i = 0; i < 2; ++i) { int R, C; stage_rc(tid * 16 + i * 8192, R, C); const int Rb = Epi::PERM ? ((R & ~31) + perm32(R & 31)) : R;
        voffA[i] = (unsigned)(R * K + C) * 2u; voffB[i] = (unsigned)(Rb * K + C) * 2u; }
    const size_t kstep = (size_t)(BK * 2);
    const size_t hstep = (size_t)HALF * K * 2;
    const size_t tstep = 2 * hstep;
    const unsigned ldsw = (unsigned)wid * 1024u;
    const int aoff = lds_byte(wr * 64 + fr, fq * 8), boff = lds_byte(wc * 32 + fr, fq * 8);
#define PG8_SA(b, h) (((b) * 2 + (h)) * HTB)
#define PG8_SB(b, h) ((4 + (b) * 2 + (h)) * HTB)
#define PG8_STAGE(bufoff, gbase, voff) do { _Pragma("unroll") for (int _i = 0; _i < 2; ++_i) \
        __builtin_amdgcn_global_load_lds((const unsigned*)((const char*)(gbase) + (voff)[_i]), (LAS unsigned*)(lds + (bufoff) + ldsw + _i * 8192), 16, 0, 0); } while (0)
#define PG8_LDA(dst, b, h) do { _Pragma("unroll") for (int m = 0; m < 4; ++m) _Pragma("unroll") for (int k = 0; k < 2; ++k) dst[m][k] = *(const LAS bf16x8*)(lds + PG8_SA(b, h) + aoff + m * 2048 + k * 1024); } while (0)
#define PG8_LDB(dst, b, h) do { _Pragma("unroll") for (int n = 0; n < 2; ++n) _Pragma("unroll") for (int k = 0; k < 2; ++k) dst[n][k] = *(const LAS bf16x8*)(lds + PG8_SB(b, h) + boff + n * 2048 + k * 1024); } while (0)
#define PG8_MMA(ai, bj, At, Bt) do { __builtin_amdgcn_s_setprio(1); _Pragma("unroll") for (int m = 0; m < 4; ++m) _Pragma("unroll") for (int n = 0; n < 2; ++n) _Pragma("unroll") for (int k = 0; k < 2; ++k) \
        acc[ai][bj][m][n] = __builtin_amdgcn_mfma_f32_16x16x32_bf16(Bt[n][k], At[m][k], acc[ai][bj][m][n], 0, 0, 0); __builtin_amdgcn_s_setprio(0); } while (0)
#define PG8_WAIT_V(n) asm volatile("s_waitcnt vmcnt(" #n ")" ::: "memory")
#define PG8_WAIT_L(n) asm volatile("s_waitcnt lgkmcnt(" #n ")" ::: "memory")
#define PG8_BAR __builtin_amdgcn_s_barrier()
#define PG8_SCHED __builtin_amdgcn_sched_barrier(0)
    Unit cur, nxt; int ui = 0;
    if (!S.next(0, cur)) return;
    f32x4 acc[2][2][4][2];
#pragma unroll
    for (int a = 0; a < 2; ++a)
#pragma unroll
        for (int b = 0; b < 2; ++b)
#pragma unroll
            for (int m = 0; m < 4; ++m)
#pragma unroll
                for (int n = 0; n < 2; ++n) acc[a][b][m][n] = (f32x4){0.f, 0.f, 0.f, 0.f};
    bf16x8 At[4][2], B0[2][2], B1[2][2];
    const char* cA = (const char*)g.A + (size_t)cur.pm * tstep; const char* cB = (const char*)g.Bt + (size_t)cur.pn * tstep;
    S.a_ready(cur);
    if constexpr (SP2) {
        PG8_STAGE(PG8_SB(0, 0), cB, voffB); PG8_STAGE(PG8_SB(0, 1), cB + hstep, voffB); PG8_STAGE(PG8_SA(0, 0), cA, voffA); PG8_STAGE(PG8_SA(0, 1), cA + hstep, voffA);
        if (wr == 1) PG8_BAR;
        PG8_WAIT_V(2); PG8_BAR;
        PG8_STAGE(PG8_SB(1, 0), cB + kstep, voffB); PG8_STAGE(PG8_SA(1, 0), cA + kstep, voffA); PG8_STAGE(PG8_SB(1, 1), cB + hstep + kstep, voffB);
        PG8_WAIT_V(6); PG8_BAR;
    } else {
        PG8_STAGE(PG8_SB(0, 0), cB, voffB); PG8_STAGE(PG8_SA(0, 0), cA, voffA); PG8_STAGE(PG8_SB(0, 1), cB + hstep, voffB); PG8_STAGE(PG8_SA(0, 1), cA + hstep, voffA);
        if (wr == 1) PG8_BAR;
        PG8_WAIT_V(4); PG8_BAR;
        PG8_STAGE(PG8_SB(1, 0), cB + kstep, voffB); PG8_STAGE(PG8_SA(1, 0), cA + kstep, voffA); PG8_STAGE(PG8_SB(1, 1), cB + hstep + kstep, voffB);
        PG8_WAIT_V(6); PG8_BAR;
    }
    for (;;) {
        const bool has_next = S.next(ui + 1, nxt);
        const char* nA = has_next ? (const char*)g.A + (size_t)nxt.pm * tstep : cA; const char* nB = has_next ? (const char*)g.Bt + (size_t)nxt.pn * tstep : cB;
#pragma unroll 1
        for (int t = 0; t < nt; t += 2) {
            const bool last = (t == nt - 2);
            const char* a1 = cA + (size_t)(t + 1) * kstep;
            const char* a2 = last ? nA : cA + (size_t)(t + 2) * kstep; const char* b2 = last ? nB : cB + (size_t)(t + 2) * kstep;
            const char* a3 = a2 + kstep; const char* b3 = b2 + kstep;
            if (last && has_next) S.a_ready(nxt);
            if constexpr (SP2) {
            PG8_LDB(B0, 0, 0); PG8_LDB(B1, 0, 1); PG8_SCHED; PG8_LDA(At, 0, 0); PG8_STAGE(PG8_SA(1, 1), a1 + hstep, voffA);
            PG8_WAIT_V(8); PG8_WAIT_L(0); PG8_BAR; PG8_MMA(0, 0, At, B0); PG8_MMA(0, 1, At, B1); PG8_BAR; PG8_SCHED;
            PG8_LDA(At, 0, 1); PG8_STAGE(PG8_SB(0, 0), b2, voffB); PG8_STAGE(PG8_SB(0, 1), b2 + hstep, voffB); PG8_STAGE(PG8_SA(0, 0), a2, voffA);
            PG8_WAIT_V(8); PG8_WAIT_L(0); PG8_BAR; PG8_MMA(1, 0, At, B0); PG8_MMA(1, 1, At, B1); PG8_BAR; PG8_SCHED;
            PG8_LDB(B0, 1, 0); PG8_LDB(B1, 1, 1); PG8_SCHED; PG8_LDA(At, 1, 0); PG8_STAGE(PG8_SA(0, 1), a2 + hstep, voffA);
            PG8_WAIT_V(8); PG8_WAIT_L(0); PG8_BAR; PG8_MMA(0, 0, At, B0); PG8_MMA(0, 1, At, B1); PG8_BAR; PG8_SCHED;
            PG8_LDA(At, 1, 1); PG8_STAGE(PG8_SB(1, 0), b3, voffB); PG8_STAGE(PG8_SB(1, 1), b3 + hstep, voffB); PG8_STAGE(PG8_SA(1, 0), a3, voffA);
            PG8_WAIT_V(8); PG8_WAIT_L(0); PG8_BAR; PG8_MMA(1, 0, At, B0); PG8_MMA(1, 1, At, B1); PG8_BAR; PG8_SCHED;
            } else {
            PG8_LDB(B0, 0, 0); PG8_SCHED; PG8_LDA(At, 0, 0); PG8_STAGE(PG8_SA(1, 1), a1 + hstep, voffA);
            PG8_WAIT_L(8); PG8_BAR; PG8_WAIT_L(0); PG8_MMA(0, 0, At, B0); PG8_BAR; PG8_SCHED;
            PG8_LDB(B1, 0, 1); PG8_STAGE(PG8_SB(0, 0), b2, voffB);
            PG8_BAR; PG8_WAIT_L(0); PG8_MMA(0, 1, At, B1); PG8_BAR;
            PG8_LDA(At, 0, 1); PG8_STAGE(PG8_SA(0, 0), a2, voffA);
            PG8_BAR; PG8_WAIT_L(0); PG8_MMA(1, 0, At, B0); PG8_BAR; PG8_SCHED;
            PG8_STAGE(PG8_SB(0, 1), b2 + hstep, voffB);
            PG8_WAIT_V(6); PG8_BAR; PG8_MMA(1, 1, At, B1); PG8_BAR;
            PG8_LDB(B0, 1, 0); PG8_SCHED; PG8_LDA(At, 1, 0); PG8_STAGE(PG8_SA(0, 1), a2 + hstep, voffA);
            PG8_WAIT_L(8); PG8_BAR; PG8_WAIT_L(0); PG8_MMA(0, 0, At, B0); PG8_BAR; PG8_SCHED;
            PG8_LDB(B1, 1, 1); PG8_STAGE(PG8_SB(1, 0), b3, voffB);
            PG8_BAR; PG8_WAIT_L(0); PG8_MMA(0, 1, At, B1); PG8_BAR;
            PG8_LDA(At, 1, 1); PG8_STAGE(PG8_SA(1, 0), a3, voffA);
            PG8_BAR; PG8_WAIT_L(0); PG8_MMA(1, 0, At, B0); PG8_BAR; PG8_SCHED;
            PG8_STAGE(PG8_SB(1, 1), b3 + hstep, voffB);
            PG8_WAIT_V(6); PG8_BAR; PG8_MMA(1, 1, At, B1); PG8_BAR;
            }
        }
        if constexpr (ALIGN_EPI) { if (wr == 0) PG8_BAR; }
        if constexpr (!Epi::AFTER_DRAIN) { E(acc, cur, wr, wc, fr, fq); S.done(cur); }
        if (!has_next) break;
#pragma unroll
        for (int a = 0; a < 2; ++a)
#pragma unroll
            for (int b = 0; b < 2; ++b)
#pragma unroll
                for (int m = 0; m < 4; ++m)
#pragma unroll
                    for (int n = 0; n < 2; ++n) acc[a][b][m][n] = (f32x4){0.f, 0.f, 0.f, 0.f};
        cur = nxt; cA = nA; cB = nB; ++ui;
        if constexpr (ALIGN_EPI) { if (wr == 1) PG8_BAR; }
    }
    PG8_WAIT_V(0);
    if constexpr (!ALIGN_EPI) { if (wr == 0) PG8_BAR; }
    PG8_BAR;
    if constexpr (Epi::AFTER_DRAIN) { E.fused(acc, cur, wr, wc, fr, fq, lds, wid, lane); S.done(cur); }
#undef PG8_SA
#undef PG8_SB
#undef PG8_STAGE
#undef PG8_LDA
#undef PG8_LDB
#undef PG8_MMA
#undef PG8_WAIT_V
#undef PG8_WAIT_L
#undef PG8_BAR
#undef PG8_SCHED
}
}
namespace pg8 {
typedef const f32x4 (&AccRef)[2][2][4][2];

struct EpiStore {
    static constexpr bool PERM = true, AFTER_DRAIN = false;
    bf16_t* O; int ldc; int act; int split_cols; size_t split_stride; int gate_pn; float* G; const float* bgate;
    __device__ __forceinline__ void operator()(AccRef acc, const Unit& u, int wr, int wc, int fr, int fq) const {
        const int row0 = u.pm * BM + wr * 64 + fr;
        if (u.pn == gate_pn) {
            if (wc == 0) {
#pragma unroll
                for (int n = 0; n < 2; ++n) {
                    const int c0 = 8 * fq + 4 * n;
                    const f32x4 bg = *(const f32x4*)(bgate + c0);
                    const bool isf = (c0 & 8) != 0;
#pragma unroll
                    for (int ai = 0; ai < 2; ++ai)
#pragma unroll
                        for (int m = 0; m < 4; ++m) {
                            f32x4 v = acc[ai][0][m][n] + bg, o;
#pragma unroll
                            for (int j = 0; j < 4; ++j) { const float cpd = 15.0f * tanhf_(v[j] * (1.0f / 15.0f)); const float eu = __expf(-cpd); o[j] = isf ? -(eu < 9.765625e-4f ? eu - 0.5f * eu * eu : __logf(1.0f + eu)) : cpd; }
                            *(f32x4*)(G + (size_t)(row0 + ai * HALF + m * 16) * 32 + c0) = o;
                        }
                }
            }
            return;
        }
        int colt = u.pn * BM; bf16_t* base = O;
        if (split_cols) { const int t = colt / split_cols; base += (size_t)t * split_stride; colt -= t * split_cols; }
        const int col0 = colt + wc * 32 + 8 * fq;
#pragma unroll
        for (int ai = 0; ai < 2; ++ai)
#pragma unroll
            for (int m = 0; m < 4; ++m) { bf16_t* rowp = base + (size_t)(row0 + ai * HALF + m * 16) * ldc + col0;
#pragma unroll
                for (int bj = 0; bj < 2; ++bj) { f32x4 v0 = acc[ai][bj][m][0], v1 = acc[ai][bj][m][1];
                    if (act == 1) {
#pragma unroll
                        for (int j = 0; j < 4; ++j) { v0[j] = tanhf_(v0[j]); v1[j] = tanhf_(v1[j]); } }
                    else if (act == 2) {
#pragma unroll
                        for (int j = 0; j < 4; ++j) { v0[j] = sigmoidf_(v0[j]); v1[j] = sigmoidf_(v1[j]); } }
                    u32x4 w; w.x = cvt_pk_bf16(v0[0], v0[1]); w.y = cvt_pk_bf16(v0[2], v0[3]); w.z = cvt_pk_bf16(v1[0], v1[1]); w.w = cvt_pk_bf16(v1[2], v1[3]);
                    *(u32x4*)(rowp + bj * HALF) = w; } }
    }
};

struct EpiSigAff {
    static constexpr bool PERM = true, AFTER_DRAIN = false;
    bf16_t* O; size_t split_stride; const float* bias; float scale;
    __device__ __forceinline__ void operator()(AccRef acc, const Unit& u, int wr, int wc, int fr, int fq) const {
        const int row0 = u.pm * BM + wr * 64 + fr;
        int colt = u.pn * BM; const int t = colt / D; bf16_t* base = O + (size_t)t * split_stride; colt -= t * D;
        const int col0 = colt + wc * 32 + 8 * fq, bcol0 = u.pn * BM + wc * 32 + 8 * fq;
        f32x4 bv[2][2];
#pragma unroll
        for (int bj = 0; bj < 2; ++bj)
#pragma unroll
            for (int n = 0; n < 2; ++n) bv[bj][n] = *(const f32x4*)(bias + bcol0 + bj * HALF + 4 * n);
#pragma unroll
        for (int ai = 0; ai < 2; ++ai)
#pragma unroll
            for (int m = 0; m < 4; ++m) { bf16_t* rowp = base + (size_t)(row0 + ai * HALF + m * 16) * D + col0;
#pragma unroll
                for (int bj = 0; bj < 2; ++bj) { f32x4 v0 = acc[ai][bj][m][0] + bv[bj][0], v1 = acc[ai][bj][m][1] + bv[bj][1];
#pragma unroll
                    for (int j = 0; j < 4; ++j) { v0[j] = scale * sigmoidf_(v0[j]); v1[j] = scale * sigmoidf_(v1[j]); }
                    u32x4 w; w.x = cvt_pk_bf16(v0[0], v0[1]); w.y = cvt_pk_bf16(v0[2], v0[3]); w.z = cvt_pk_bf16(v1[0], v1[1]); w.w = cvt_pk_bf16(v1[2], v1[3]);
                    *(u32x4*)(rowp + bj * HALF) = w; } }
    }
};

struct EpiVmix {
    static constexpr bool PERM = true, AFTER_DRAIN = false;
    bf16_t* V; const bf16_t* VF; const float* v0;
    __device__ __forceinline__ void operator()(AccRef acc, const Unit& u, int wr, int wc, int fr, int fq) const {
        const int row0 = u.pm * BM + wr * 64 + fr; const int col0 = u.pn * BM + wc * 32 + 8 * fq;
        f32x4 bv[2][2];
#pragma unroll
        for (int bj = 0; bj < 2; ++bj)
#pragma unroll
            for (int n = 0; n < 2; ++n) bv[bj][n] = *(const f32x4*)(v0 + col0 + bj * HALF + 4 * n);
#pragma unroll
        for (int ai = 0; ai < 2; ++ai) {
            u32x4 vvs[4][2], ffs[4][2];
#pragma unroll
            for (int m = 0; m < 4; ++m) { const size_t off = (size_t)(row0 + ai * HALF + m * 16) * D + col0;
#pragma unroll
                for (int bj = 0; bj < 2; ++bj) { vvs[m][bj] = *(const u32x4*)(V + off + bj * HALF); ffs[m][bj] = *(const u32x4*)(VF + off + bj * HALF); } }
            asm volatile("" ::: "memory");
#pragma unroll
            for (int m = 0; m < 4; ++m) { const size_t off = (size_t)(row0 + ai * HALF + m * 16) * D + col0;
#pragma unroll
                for (int bj = 0; bj < 2; ++bj) {
                    const u32x4 vv = vvs[m][bj], ff = ffs[m][bj];
                    const f32x4 a0 = acc[ai][bj][m][0] + bv[bj][0], a1 = acc[ai][bj][m][1] + bv[bj][1];
                    float o[8];
#pragma unroll
                    for (int j = 0; j < 4; ++j) {
                        const unsigned vw = j == 0 ? vv.x : j == 1 ? vv.y : j == 2 ? vv.z : vv.w, fw = j == 0 ? ff.x : j == 1 ? ff.y : j == 2 ? ff.z : ff.w;
                        const float s0 = sigmoidf_(j < 2 ? a0[2 * j] : a1[2 * j - 4]), s1 = sigmoidf_(j < 2 ? a0[2 * j + 1] : a1[2 * j - 3]);
                        const float x0 = lo_bf(vw), x1 = hi_bf(vw), f0 = lo_bf(fw), f1 = hi_bf(fw);
                        o[2 * j] = x0 + (f0 - x0) * s0; o[2 * j + 1] = x1 + (f1 - x1) * s1; }
                    u32x4 w; w.x = cvt_pk_bf16(o[0], o[1]); w.y = cvt_pk_bf16(o[2], o[3]); w.z = cvt_pk_bf16(o[4], o[5]); w.w = cvt_pk_bf16(o[6], o[7]);
                    *(u32x4*)(V + off + bj * HALF) = w; } }
            asm volatile("" ::: "memory"); }
    }
};

struct EpiResid {
    static constexpr bool PERM = false, AFTER_DRAIN = false;
    float* X; const float* gate; int tile0; const float* srcx; const float* srcc;
    __device__ __forceinline__ void operator()(AccRef acc, const Unit& u, int wr, int wc, int fr, int fq) const {
        const int gpm = tile0 + u.pm; const int b = gpm / 9, tix = gpm % 9; const int idx = (tix == 0) ? 16 : b;
        const int rloc = wr * 64 + fr, col0 = u.pn * BM + wc * 32 + 4 * fq;
        const float* src = srcx ? (tix == 0 ? srcc + (size_t)b * CTXL * D : srcx + ((size_t)b * SEQ + (size_t)(tix - 1) * BM) * D) : X + (size_t)gpm * BM * D;
        float* dst = X + (size_t)gpm * BM * D;
        f32x4 gv[2][2];
#pragma unroll
        for (int bj = 0; bj < 2; ++bj)
#pragma unroll
            for (int n = 0; n < 2; ++n) gv[bj][n] = *(const f32x4*)(gate + (size_t)idx * MODLD + col0 + bj * HALF + n * 16);
        f32x4 (&ac)[2][2][4][2] = const_cast<f32x4 (&)[2][2][4][2]>(acc);
        f32x4 xa[2][2], xb[2][2];
#define RES_LD(dstv, ai_, m_) do { const size_t off_ = (size_t)(rloc + (ai_) * HALF + (m_) * 16) * D + col0; _Pragma("unroll") for (int bj = 0; bj < 2; ++bj) _Pragma("unroll") for (int n = 0; n < 2; ++n) \
            dstv[bj][n] = *(const f32x4*)(src + off_ + bj * HALF + n * 16); } while (0)
#define RES_FMA(srcv, ai_, m_) do { _Pragma("unroll") for (int bj = 0; bj < 2; ++bj) _Pragma("unroll") for (int n = 0; n < 2; ++n) ac[ai_][bj][m_][n] = srcv[bj][n] + gv[bj][n] * ac[ai_][bj][m_][n]; } while (0)
        RES_LD(xa, 0, 0); RES_LD(xb, 0, 1);
        RES_FMA(xa, 0, 0); RES_LD(xa, 0, 2); RES_FMA(xb, 0, 1); RES_LD(xb, 0, 3);
        RES_FMA(xa, 0, 2); RES_LD(xa, 1, 0); RES_FMA(xb, 0, 3); RES_LD(xb, 1, 1);
        RES_FMA(xa, 1, 0); RES_LD(xa, 1, 2); RES_FMA(xb, 1, 1); RES_LD(xb, 1, 3);
        RES_FMA(xa, 1, 2); RES_FMA(xb, 1, 3);
#undef RES_LD
#undef RES_FMA
        asm volatile("" ::: "memory");
#pragma unroll
        for (int ai = 0; ai < 2; ++ai)
#pragma unroll
            for (int m = 0; m < 4; ++m) { const size_t off = (size_t)(rloc + ai * HALF + m * 16) * D + col0;
#pragma unroll
                for (int bj = 0; bj < 2; ++bj)
#pragma unroll
                    for (int n = 0; n < 2; ++n) *(f32x4*)(dst + off + bj * HALF + n * 16) = ac[ai][bj][m][n]; }
    }
};

struct EpiSwiglu {
    static constexpr bool PERM = true, AFTER_DRAIN = false;
    bf16_t* O;
    __device__ __forceinline__ void operator()(AccRef acc, const Unit& u, int wr, int wc, int fr, int fq) const {
        const int row0 = u.pm * BM + wr * 64 + fr; const int col0 = u.pn * HALF + wc * 32 + 8 * fq;
#pragma unroll
        for (int ai = 0; ai < 2; ++ai)
#pragma unroll
            for (int m = 0; m < 4; ++m) { bf16_t* rowp = O + (size_t)(row0 + ai * HALF + m * 16) * DFF + col0;
                f32x4 v0, v1;
#pragma unroll
                for (int j = 0; j < 4; ++j) { v0[j] = siluf_(acc[ai][0][m][0][j]) * acc[ai][1][m][0][j]; v1[j] = siluf_(acc[ai][0][m][1][j]) * acc[ai][1][m][1][j]; }
                u32x4 w; w.x = cvt_pk_bf16(v0[0], v0[1]); w.y = cvt_pk_bf16(v0[2], v0[3]); w.z = cvt_pk_bf16(v1[0], v1[1]); w.w = cvt_pk_bf16(v1[2], v1[3]);
                *(u32x4*)rowp = w; }
    }
};
}

namespace pg8 {
struct SkipCtxOrder : StaticOrder {
    __device__ __forceinline__ bool next(int i, Unit& u) const { if (!StaticOrder::next(i, u)) return false; u.pm = u.pm + (u.pm >> 3) + 1; return true; }
};
}
template <class Epi, bool SKIPCTX = false>
__device__ __forceinline__ void run_gemm(LAS unsigned char* lds, const bf16_t* A, const bf16_t* Bt, int M, int N, int K, const Epi& E, int& urot) {
    pg8::Gemm g{A, Bt, M, N, K};
    const int G = (int)gridDim.x; const int Meff = SKIPCTX ? (M / 9) * 8 : M; const int nwg = (Meff / 256) * (N / 256);
    const int c = ((int)blockIdx.x + G - (urot % G)) % G;
    if constexpr (SKIPCTX) { pg8::SkipCtxOrder S; S.init(Meff, N, G, c); pg8::gemm_phase<Epi, pg8::SkipCtxOrder, GP_ALIGN, GP_SP2>(lds, g, S, E); }
    else { pg8::StaticOrder S; S.init(M, N, G, c); pg8::gemm_phase<Epi, pg8::StaticOrder, GP_ALIGN, GP_SP2>(lds, g, S, E); }
    urot += nwg;
}
struct Args { const float* in[NIN]; float* out; unsigned char* ws; int ph_lo, ph_hi; };
static_assert(sizeof(Args) == NIN * 8 + 8 + 8 + 8, "Args has no padding");

typedef const __attribute__((address_space(4))) Args* CArgs;
__device__ __forceinline__ CArgs opaque_args() { CArgs p = (CArgs)__builtin_amdgcn_kernarg_segment_ptr(); asm volatile("" : "+s"(p)); return p; }
struct Tc { LAS unsigned char* lds; int tid, lane, wave, bid, G, gw, ngw; };
__device__ __forceinline__ Tc mk_tc(LAS unsigned char* lds) { Tc t; int tid = threadIdx.x; asm volatile("" : "+v"(tid)); t.lds = lds; t.tid = tid; t.lane = tid & 63; t.wave = __builtin_amdgcn_readfirstlane(tid >> 6);
    t.bid = blockIdx.x; t.G = gridDim.x; t.gw = t.bid * 8 + t.wave; t.ngw = t.G * 8; return t; }

template <class RM>
__device__ __forceinline__ void tr_item(const float* W, int ldw, bf16_t* WT, int ldk, const RM& rm, LAS float* scr, int kb, int nb, int lane) {
    const int k0 = 64 * kb, n0 = 32 * nb;
    float tmp[32];
#pragma unroll
    for (int i = 0; i < 32; ++i) { const int kk = 2 * i + (lane >> 5); tmp[i] = W[(size_t)(k0 + kk) * ldw + n0 + (lane & 31)]; }
    asm volatile("" ::: "memory");
#pragma unroll
    for (int i = 0; i < 32; ++i) { const int kk = 2 * i + (lane >> 5); scr[kk * 33 + (lane & 31)] = tmp[i]; }
    LDS_WAIT();
    const int c = lane & 7;
#pragma unroll
    for (int j = 0; j < 4; ++j) { const int n = (lane >> 3) + 8 * j; const LAS float* s = scr + (8 * c) * 33 + n;
        u32x4 o; o.x = pk2(s[0 * 33], s[1 * 33]); o.y = pk2(s[2 * 33], s[3 * 33]); o.z = pk2(s[4 * 33], s[5 * 33]); o.w = pk2(s[6 * 33], s[7 * 33]);
        *(u32x4*)(WT + (size_t)rm(n0 + n) * ldk + k0 + 8 * c) = o; }
    LDS_WAIT();
}
struct RmId { __device__ __forceinline__ int operator()(int n) const { return n; } };
struct RmSwiglu { __device__ __forceinline__ int operator()(int n) const { const int up = n >= DFF ? 1 : 0; const int m = n - up * DFF; return 256 * (m >> 7) + 128 * up + (m & 127); } };

template <class RM>
__device__ __forceinline__ void tr_matrix(const Tc& t, const float* W, int K, int N, int ldw, bf16_t* WT, int ldk, const RM& rm) {
    LAS float* scr = (LAS float*)(t.lds + t.wave * 16384);
    const int nkb = K / 64, nnb = N / 32, items = nkb * nnb;
    for (int it = t.gw; it < items; it += t.ngw) tr_item(W, ldw, WT, ldk, rm, scr, it / nnb, it % nnb, t.lane);
}
template <class SRC>
__device__ __forceinline__ void build_small(const Tc& t, bf16_t* dst, int NR, int KC, const SRC& src) {
    const int total = NR * (KC / 8);
    for (int i = t.gw * 64 + t.lane; i < total; i += t.ngw * 64) { const int n = i % NR, ko = i / NR;
        float v[8];
#pragma unroll
        for (int j = 0; j < 8; ++j) v[j] = src(n, 8 * ko + j);
        u32x4 o; o.x = pk2(v[0], v[1]); o.y = pk2(v[2], v[3]); o.z = pk2(v[4], v[5]); o.w = pk2(v[6], v[7]);
        *(u32x4*)(dst + (size_t)n * KC + 8 * ko) = o; }
}

__device__ __forceinline__ void convert_rwkv(const Tc& t, CArgs a, int jl) {
    bf16_t* wm = (bf16_t*)(a->ws + WS_WMIX);
    const size_t dd = (size_t)D * D;
    tr_matrix(t, a->in[I_WR] + jl * dd, D, D, D, (bf16_t*)((char*)wm + WM_R), D, RmId());
    tr_matrix(t, a->in[I_WK] + jl * dd, D, D, D, (bf16_t*)((char*)wm + WM_K), D, RmId());
    tr_matrix(t, a->in[I_WV] + jl * dd, D, D, D, (bf16_t*)((char*)wm + WM_V), D, RmId());
    tr_matrix(t, a->in[I_WO] + jl * dd, D, D, D, (bf16_t*)((char*)wm + WM_O), D, RmId());
    { const float* w1 = a->in[I_W1] + (size_t)jl * 2 * D * 96;
      build_small(t, (bf16_t*)((char*)wm + WM_W1), 256, D, [=](int n, int k) -> float { if (n >= 192) return 0.f; const int z = n >= 96 ? 1 : 0, r = n - 96 * z; return w1[((size_t)z * D + k) * 96 + r]; }); }
    { const float* a1 = a->in[I_A1] + (size_t)jl * 2 * D * 96;
      build_small(t, (bf16_t*)((char*)wm + WM_A1), 256, D, [=](int n, int k) -> float { if (n >= 192) return 0.f; const int z = n >= 96 ? 1 : 0, r = n - 96 * z; return a1[((size_t)z * D + k) * 96 + r]; }); }
    { const float* g1 = a->in[I_G1] + (size_t)jl * D * 256;
      build_small(t, (bf16_t*)((char*)wm + WM_G1), 256, D, [=](int n, int k) -> float { return g1[(size_t)k * 256 + n]; }); }
    if (jl > 0) { const float* v1 = a->in[I_V1] + (size_t)(jl - 1) * D * 64;
      build_small(t, (bf16_t*)((char*)wm + WM_V1), 256, D, [=](int n, int k) -> float { return n < 64 ? v1[(size_t)k * 64 + n] : 0.f; }); }
    { const float* w2 = a->in[I_W2] + (size_t)jl * 2 * 96 * D;
      build_small(t, (bf16_t*)((char*)wm + WM_W2), 2 * D, 256, [=](int n, int k) -> float { const int z = n >= D ? 1 : 0, ch = n - z * D, kk = k - 96 * z; return (kk >= 0 && kk < 96) ? w2[((size_t)z * 96 + kk) * D + ch] : 0.f; }); }
    { const float* a2 = a->in[I_A2] + (size_t)jl * 2 * 96 * D;
      build_small(t, (bf16_t*)((char*)wm + WM_A2), 2 * D, 256, [=](int n, int k) -> float { const int z = n >= D ? 1 : 0, ch = n - z * D, kk = k - 96 * z; return (kk >= 0 && kk < 96) ? a2[((size_t)z * 96 + kk) * D + ch] : 0.f; }); }
    { const float* g2 = a->in[I_G2] + (size_t)jl * 256 * D;
      build_small(t, (bf16_t*)((char*)wm + WM_G2), D, 256, [=](int n, int k) -> float { return g2[(size_t)k * D + n]; }); }
    if (jl > 0) { const float* v2 = a->in[I_V2] + (size_t)(jl - 1) * 64 * D;
      build_small(t, (bf16_t*)((char*)wm + WM_V2), D, 256, [=](int n, int k) -> float { return k < 64 ? v2[(size_t)k * D + n] : 0.f; }); }
}
__device__ __forceinline__ void convert_mlstm(const Tc& t, CArgs a, int jl) {
    bf16_t* win = (bf16_t*)(a->ws + WS_WMIX + WM_MIN); bf16_t* wout = (bf16_t*)(a->ws + WS_WMIX + WM_MOUT);
    tr_matrix(t, a->in[I_MWIN] + (size_t)jl * D * MPROJ, D, MPROJ, MPROJ, win, D, RmId());
    { u32x4* z = (u32x4*)(win + (size_t)MPROJ * D); const int total = (6400 - MPROJ) * D / 8; unsigned zz = 0u; asm volatile("" : "+v"(zz)); const u32x4 zero = {zz, zz, zz, zz};
      for (int i = t.gw * 64 + t.lane; i < total; i += t.ngw * 64) z[i] = zero; }
    tr_matrix(t, a->in[I_MWOUT] + (size_t)jl * D * D, D, D, D, wout, D, RmId());
}
__device__ __forceinline__ void convert_ffn_in(const Tc& t, CArgs a, int layer) {
    tr_matrix(t, a->in[I_FWIN] + (size_t)layer * D * 2 * DFF, D, 2 * DFF, 2 * DFF, (bf16_t*)(a->ws + WS_WFFN + WF_IN), D, RmSwiglu());
}
__device__ __forceinline__ void convert_ffn_out(const Tc& t, CArgs a, int layer) {
    tr_matrix(t, a->in[I_FWOUT] + (size_t)layer * DFF * D, DFF, D, D, (bf16_t*)(a->ws + WS_WFFN + WF_OUT), DFF, RmId());
}
__device__ __forceinline__ bool tail_crew(const Tc& t, int urot0, int nwg, Tc& ts) {
    const int G = t.G, r = nwg % G, c = (t.bid + G - (urot0 % G)) % G;
    ts = t;
    if (r == 0) return true;
    if (c < r) return false;
    ts.bid = c - r; ts.G = G - r; ts.gw = ts.bid * 8 + t.wave; ts.ngw = ts.G * 8; return true;
}

__device__ __forceinline__ void ph_prologue(const Tc& t, CArgs a) {
    LAS float* S = (LAS float*)t.lds;
    { f32x4 cv[17];
#pragma unroll
      for (int b = 0; b < 17; ++b) cv[b] = *(const f32x4*)((b < 16 ? a->in[I_C] + (size_t)b * D : a->in[I_CCTX]) + 4 * t.tid);
      const int k = 4 * t.tid;
#pragma unroll
      for (int b = 0; b < 17; ++b) { const f32x4 s = {siluf_(cv[b][0]), siluf_(cv[b][1]), siluf_(cv[b][2]), siluf_(cv[b][3])};
          *(LAS f32x4*)(S + b * 2056 + (k >> 10) * 1028 + (k & 1023)) = s; } }
    __syncthreads();
    float* mod = (float*)(a->ws + WS_MOD);
    const int col = t.lane & 31, kh = t.lane >> 5;
    for (int it = t.wave * t.G + t.bid; it < 4 * 384; it += t.ngw) { const int layer = it / 384, n0 = 32 * (it % 384);
        const auto wrs = __builtin_amdgcn_make_buffer_rsrc((void*)(a->in[I_MODW] + (size_t)layer * D * MODLD), (short)0, (int)((size_t)D * MODLD * 4), 0x00020000);
        const unsigned voff = (unsigned)(kh * 1024 * MODLD + n0 + col) * 4u;
        const LAS float* Sk = S + kh * 1028;
        f32x2 acc[17];
#pragma unroll
        for (int b = 0; b < 17; ++b) acc[b] = (f32x2){0.f, 0.f};
        float wa[8], wb[8];
#define MOD_LD(dst, k0_) do { _Pragma("unroll") for (int j = 0; j < 8; ++j) dst[j] = __builtin_bit_cast(float, __builtin_amdgcn_raw_buffer_load_b32(wrs, voff, (unsigned)(((k0_) + j) * MODLD * 4), 0)); } while (0)
#define MOD_FMA(src, k0_) do { _Pragma("unroll") for (int j4 = 0; j4 < 2; ++j4) { _Pragma("unroll") for (int b = 0; b < 17; ++b) { const f32x4 s = *(const LAS f32x4*)(Sk + b * 2056 + (k0_) + 4 * j4); \
            acc[b] = acc[b] + (f32x2){s[0], s[1]} * (f32x2){src[4 * j4], src[4 * j4 + 1]} + (f32x2){s[2], s[3]} * (f32x2){src[4 * j4 + 2], src[4 * j4 + 3]}; } asm volatile("" ::: "memory"); } } while (0)
        MOD_LD(wa, 0);
#pragma unroll 1
        for (int k0 = 0; k0 < 1024; k0 += 16) {
            MOD_LD(wb, k0 + 8);
            MOD_FMA(wa, k0);
            if (k0 + 16 < 1024) MOD_LD(wa, k0 + 16);
            MOD_FMA(wb, k0 + 8); }
#undef MOD_LD
#undef MOD_FMA
#pragma unroll
        for (int b = 0; b < 17; ++b) { float v = acc[b].x + acc[b].y; v += shfl_xor_(v, 32, t.lane);
            if (kh == 0) mod[((size_t)layer * 17 + b) * MODLD + n0 + col] = v + a->in[I_MODB][layer * MODLD + n0 + col]; } }
    __syncthreads();
}

template <bool OUT_BF16>
__device__ __forceinline__ void norm_rows(const Tc& t, CArgs a, int layer, int which, int row_begin, int nrows, void* out, bool from_inputs = false) {
    const float* xres = (const float*)(a->ws + WS_XRES);
    const float* mod = (const float*)(a->ws + WS_MOD) + (size_t)layer * 17 * MODLD;
    const int npw = (nrows + t.ngw - 1) / t.ngw;
    f32x4 gg[8], gm[8], sh[8];
    { const f32x4* gp = (const f32x4*)(a->in[I_NORMG] + (size_t)(layer * 2 + which) * D) + t.lane;
#pragma unroll
      for (int j = 0; j < 8; ++j) gg[j] = gp[64 * j]; }
    int cur_idx = -1;
    auto rowptr = [&](int r) -> const f32x4* { const int grow = row_begin + r; const int gb = grow / SROW, gs = grow % SROW;
        const float* rp = from_inputs ? (gs < CTXL ? a->in[I_CTX] + ((size_t)gb * CTXL + gs) * D : a->in[I_X] + ((size_t)gb * SEQ + (gs - CTXL)) * D) : xres + (size_t)grow * D;
        return (const f32x4*)rp + t.lane; };
    const int rfirst = t.gw * npw;
    if (rfirst >= nrows) return;
    const int nmine = (nrows - rfirst) < npw ? (nrows - rfirst) : npw;
    f32x4 xn[8];
    { const f32x4* xr = rowptr(rfirst);
#pragma unroll
      for (int j = 0; j < 8; ++j) xn[j] = xr[64 * j]; }
    for (int i = 0; i < nmine; ++i) { const int r = rfirst + i; const int grow = row_begin + r; const int idx = (grow % SROW) < CTXL ? 16 : grow / SROW;
        f32x4 v[8];
#pragma unroll
        for (int j = 0; j < 8; ++j) v[j] = xn[j];
        if (idx != cur_idx) { cur_idx = idx;
            const f32x4* shp = (const f32x4*)(mod + (size_t)idx * MODLD + (3 * which) * D) + t.lane; const f32x4* scp = (const f32x4*)(mod + (size_t)idx * MODLD + (3 * which + 1) * D) + t.lane;
#pragma unroll
            for (int j = 0; j < 8; ++j) { sh[j] = shp[64 * j]; gm[j] = gg[j] * (scp[64 * j] + 1.0f); } }
        if (i + 1 < nmine) { const f32x4* xr = rowptr(r + 1);
#pragma unroll
            for (int j = 0; j < 8; ++j) xn[j] = xr[64 * j]; }
        asm volatile("" ::: "memory");
        float ss = 0.f;
#pragma unroll
        for (int j = 0; j < 8; ++j) ss += (v[j].x * v[j].x + v[j].y * v[j].y) + (v[j].z * v[j].z + v[j].w * v[j].w);
        const float rstd = rsqrtf(wave_sum_dpp(ss) * (1.0f / D) + 1e-6f);
#pragma unroll
        for (int j = 0; j < 8; ++j) { const f32x4 o = v[j] * rstd * gm[j] + sh[j];
            if (OUT_BF16) { u32x2 w; w.x = pk2(o.x, o.y); w.y = pk2(o.z, o.w); ((u32x2*)((bf16_t*)out + (size_t)r * D))[64 * j + t.lane] = w; }
            else ((f32x4*)((float*)out + (size_t)r * D))[64 * j + t.lane] = o; }
        asm volatile("" ::: "memory");
    }
}

__device__ __forceinline__ void r2_mix(const Tc& t, CArgs a, int jl) {
    const bf16_t* H = (const bf16_t*)(a->ws + WS_ACT + AR_H);
    const int sl = t.gw & 3, c0 = 512 * sl + 8 * t.lane;
    const float* mu = a->in[I_MU] + (size_t)jl * 6 * D + c0;
    f32x4 m0[6], m1[6];
#pragma unroll
    for (int m = 0; m < 6; ++m) { m0[m] = *(const f32x4*)(mu + m * D); m1[m] = *(const f32x4*)(mu + m * D + 4); }
    const int rstep = t.ngw >> 2;
    for (int r0 = t.gw >> 2; r0 < TG; r0 += 4 * rstep) {
        u32x4 hw[4], nw[4];
#pragma unroll
        for (int k = 0; k < 4; ++k) { const int r = r0 + k * rstep; hw[k] = (u32x4){0u, 0u, 0u, 0u}; nw[k] = hw[k];
            if (r < TG) { const int s = r % SROW; int nr;
                if (s < CTXL) nr = sl < 2 ? (s > 0 ? r - 1 : -1) : (s < CTXL - 1 ? r + 1 : -1);
                else { const int i = s - CTXL, gr = i >> 6, gc = i & 63; nr = sl == 0 ? (gc > 0 ? r - 1 : -1) : sl == 1 ? (gc < 63 ? r + 1 : -1) : sl == 2 ? (gr > 0 ? r - 64 : -1) : (gr < 31 ? r + 64 : -1); }
                hw[k] = *(const u32x4*)(H + (size_t)r * D + c0);
                if (nr >= 0) nw[k] = *(const u32x4*)(H + (size_t)nr * D + c0); } }
        asm volatile("" ::: "memory");
#pragma unroll
        for (int k = 0; k < 4; ++k) { const int r = r0 + k * rstep;
            if (r < TG) {
                const f32x4 h0 = {lo_bf(hw[k].x), hi_bf(hw[k].x), lo_bf(hw[k].y), hi_bf(hw[k].y)}, h1 = {lo_bf(hw[k].z), hi_bf(hw[k].z), lo_bf(hw[k].w), hi_bf(hw[k].w)};
                const f32x4 n0 = {lo_bf(nw[k].x), hi_bf(nw[k].x), lo_bf(nw[k].y), hi_bf(nw[k].y)}, n1 = {lo_bf(nw[k].z), hi_bf(nw[k].z), lo_bf(nw[k].w), hi_bf(nw[k].w)};
                const f32x4 x0 = n0 - h0, x1 = n1 - h1;
#pragma unroll
                for (int m = 0; m < 6; ++m) { const f32x4 o0 = h0 + x0 * m0[m], o1 = h1 + x1 * m1[m];
                    u32x4 w; w.x = pk2(o0.x, o0.y); w.y = pk2(o0.z, o0.w); w.z = pk2(o1.x, o1.y); w.w = pk2(o1.z, o1.w);
                    *(u32x4*)(a->ws + WS_ACT + AR_MIX + (size_t)m * SLOT + ((size_t)r * D + c0) * 2) = w; } } }
        asm volatile("" ::: "memory");
    }
}

constexpr int R5_L = 16;
constexpr int R5_ZR = 0, R5_BK = 4608, R5_BKT = 9216, R5_V = 14336, R5_GL = 18432, R5_CH = 18688;
constexpr int R5_BUF = 2 * R5_CH;
constexpr int R5_GR = 2 * R5_BUF;
constexpr int R5_GRCH = 3072;
constexpr int R5_DS = R5_GR + 2 * R5_GRCH;
constexpr int R5_YS = R5_DS + 8 * 1024;
constexpr int R5_PW = R5_YS + 2 * 2 * 4096;
constexpr int R5_END = R5_PW + 4 * 4096;
static_assert(R5_END <= LDSCTL_OFF, "scan LDS");
__device__ __forceinline__ int r5_seq(int z, int tt) { return z == 0 ? tt : (tt < CTXL ? CTXL - 1 - tt : SROW + CTXL - 1 - tt); }

__device__ __forceinline__ void r5_scan(const Tc& t, CArgs a, int jl, int layer, int g) {
    const bf16_t* R = (const bf16_t*)(a->ws + WS_ACT + AR_R);
    const bf16_t* Kb = (const bf16_t*)(a->ws + WS_ACT + AR_K);
    const bf16_t* Vb = (layer == 0) ? (const bf16_t*)(a->ws + WS_VF) + (size_t)g * TG * D : (const bf16_t*)(a->ws + WS_ACT + AR_V);
    const int w = t.wave, lane = t.lane, c2 = w >> 2, q = w & 3, l15 = lane & 15, q4 = lane >> 4;
    for (int pair = t.bid; pair < BG * RH; pair += t.G) {
        const int z = pair / (BG * RH / 2), bl = (pair / (RH / 2)) % BG, h = 2 * (pair % (RH / 2)) + c2;
        const bf16_t* E = (const bf16_t*)(a->ws + WS_ACT + AR_MIX + (size_t)z * SLOT);
        const bf16_t* Aa = (const bf16_t*)(a->ws + WS_ACT + AR_MIX + (size_t)(2 + z) * SLOT);
        bf16_t* Y = (bf16_t*)(a->ws + WS_ACT + AR_Y + (size_t)z * SLOT);
        float* RKo = (float*)(a->ws + WS_ACT + AR_RK) + (size_t)z * TG * 32;
        const size_t colb = (size_t)h * 64 + lane;
        f32x4 ST[4];
#pragma unroll
        for (int cb = 0; cb < 4; ++cb) ST[cb] = (f32x4){0.f, 0.f, 0.f, 0.f};
        const int pst = q == 0 ? 0 : 6 * (q - 1), npass = q == 0 ? 0 : (q == 3 ? 2 : 3);
        const int hf = lane >> 5, pi = lane & 31;
        unsigned ce[8], pr[3], pk[3], pv[3], pa[3];
        const int sd = z == 0 ? 1 : -1;
        const bf16_t* Eh = E + (size_t)bl * SROW * D + (size_t)h * 64; const bf16_t* Rh = R + (size_t)bl * SROW * D + (size_t)h * 64; const bf16_t* Kh = Kb + (size_t)bl * SROW * D + (size_t)h * 64;
        const bf16_t* Vh = Vb + (size_t)bl * SROW * D + (size_t)h * 64; const bf16_t* Ah = Aa + (size_t)bl * SROW * D + (size_t)h * 64;
        f32x2 kkc2, kac2, rkc2;
        { const size_t c0 = (size_t)jl * D + (size_t)h * 64 + 2 * pi; kkc2 = *(const f32x2*)(a->in[I_KK] + c0); kac2 = *(const f32x2*)(a->in[I_KA] + c0); rkc2 = *(const f32x2*)(a->in[I_RK] + c0); }
        auto prep_load = [&](int n) {
            if (q == 0) return;
            const int s0 = r5_seq(z, n * R5_L); const unsigned rlo = (unsigned)(sd > 0 ? s0 : s0 - 15) * (unsigned)D;
#pragma unroll
            for (int ps = 0; ps < 3; ++ps) if (ps < npass) { const int st = pst + 2 * ps + hf; const unsigned off = rlo + (unsigned)((sd > 0 ? st : 15 - st) * D) + 2u * (unsigned)pi;
                pr[ps] = *(const unsigned*)(Rh + off); pk[ps] = *(const unsigned*)(Kh + off); pv[ps] = *(const unsigned*)(Vh + off); pa[ps] = *(const unsigned*)(Ah + off); }
        };
        auto halfsum = [&](float v) -> float { v = sum16_(v); const float h0 = rl_(v, 0) + rl_(v, 16), h1 = rl_(v, 32) + rl_(v, 48); return hf ? h1 : h0; };
        auto prep_finish = [&](int n) {
            if (q == 0) return;
            LAS unsigned char* cbuf = t.lds + (n & 1) * R5_BUF + c2 * R5_CH;
            LAS bf16_t* ZR = (LAS bf16_t*)(cbuf + R5_ZR); LAS bf16_t* BK = (LAS bf16_t*)(cbuf + R5_BK); LAS bf16_t* BKT = (LAS bf16_t*)(cbuf + R5_BKT);
            LAS float* Vs = (LAS float*)(cbuf + R5_V); LAS float* GL = (LAS float*)(cbuf + R5_GL);
            const LAS f32x2* PW = (const LAS f32x2*)(t.lds + R5_PW + ((n & 1) * 2 + c2) * 4096);
            if (q == 3 && hf == 0) { const f32x2 lg = PW[15 * 32 + pi]; *(LAS f32x2*)(GL + 2 * pi) = (f32x2){__expf(lg.x), __expf(lg.y)}; }
            const int s0 = r5_seq(z, n * R5_L); float rkv[3] = {0.f, 0.f, 0.f};
#pragma unroll
            for (int ps = 0; ps < 3; ++ps) if (ps < npass) { const int st = pst + 2 * ps + hf;
                const f32x2 lgs = PW[st * 32 + pi]; f32x2 lgp = {0.f, 0.f}; if (st > 0) lgp = PW[(st - 1) * 32 + pi];
                const f32x2 r2 = {lo_bf(pr[ps]), hi_bf(pr[ps])}, k2 = {lo_bf(pk[ps]), hi_bf(pk[ps])}, v2 = {lo_bf(pv[ps]), hi_bf(pv[ps])}, a2 = {lo_bf(pa[ps]), hi_bf(pa[ps])};
                f32x2 kk2 = k2 * kkc2; const float n2 = halfsum(kk2.x * kk2.x + kk2.y * kk2.y); kk2 = kk2 * __builtin_amdgcn_rsqf(fmaxf(n2, 1e-24f));
                const f32x2 km2 = k2 * ((a2 - 1.0f) * kac2 + 1.0f);
                const f32x2 rkm = r2 * km2 * rkc2; const float rk = halfsum(rkm.x + rkm.y);
                rkv[ps] = rk;
                const f32x2 gi = {__expf(-lgs.x), __expf(-lgs.y)}, gt = {__expf(lgs.x), __expf(lgs.y)}, gp = {__expf(lgp.x), __expf(lgp.y)};
                const f32x2 zt = kk2 * gp * -1.0f, rt = r2 * gt, bt = kk2 * a2 * gi, kt = km2 * gi;
                const unsigned zw = pk2(zt.x, zt.y), rw = pk2(rt.x, rt.y), bw = pk2(bt.x, bt.y), kw = pk2(kt.x, kt.y);
                *(LAS unsigned*)(ZR + st * 72 + 2 * pi) = zw; *(LAS unsigned*)(ZR + (16 + st) * 72 + 2 * pi) = rw; *(LAS unsigned*)(BK + st * 72 + 2 * pi) = bw; *(LAS unsigned*)(BK + (16 + st) * 72 + 2 * pi) = kw;
                BKT[(2 * pi) * 40 + st] = (bf16_t)(bw & 0xffffu); BKT[(2 * pi + 1) * 40 + st] = (bf16_t)(bw >> 16);
                BKT[(2 * pi) * 40 + 16 + st] = (bf16_t)(kw & 0xffffu); BKT[(2 * pi + 1) * 40 + 16 + st] = (bf16_t)(kw >> 16);
                *(LAS f32x2*)(Vs + st * 64 + 2 * pi) = v2; }
            if (pi == 0) {
#pragma unroll
                for (int ps = 0; ps < 3; ++ps) if (ps < npass) RKo[((size_t)bl * SROW + s0 + sd * (pst + 2 * ps + hf)) * 32 + h] = rkv[ps]; }
        };
        auto cum_load = [&](int m) {
            const int s0 = r5_seq(z, m * R5_L); const unsigned rlo = (unsigned)(sd > 0 ? s0 : s0 - 15) * (unsigned)D;
#pragma unroll
            for (int j = 0; j < 8; ++j) { const int i = 8 * hf + j; ce[j] = *(const unsigned*)(Eh + rlo + (unsigned)((sd > 0 ? i : 15 - i) * D) + 2u * (unsigned)pi); }
        };
        auto cum_finish = [&](int m) {
            LAS f32x2* PW = (LAS f32x2*)(t.lds + R5_PW + ((m & 1) * 2 + c2) * 4096);
            f32x2 cs[8]; f32x2 lg = {0.f, 0.f};
#pragma unroll
            for (int j = 0; j < 8; ++j) { lg = lg + (f32x2){lo_bf(ce[j]), hi_bf(ce[j])}; cs[j] = lg; }
            if (hf == 0) {
#pragma unroll
                for (int j = 0; j < 8; ++j) PW[j * 32 + pi] = cs[j]; }
            asm volatile("s_waitcnt lgkmcnt(0)" ::: "memory");
            const f32x2 base = PW[7 * 32 + pi];
            if (hf == 1) {
#pragma unroll
                for (int j = 0; j < 8; ++j) PW[(8 + j) * 32 + pi] = cs[j] + base; }
        };
        constexpr int NCH = SROW / R5_L;
        if (q == 0) { cum_load(0); cum_finish(0); cum_load(1); cum_finish(1); cum_load(2); } else prep_load(0);
        __syncthreads();
        prep_finish(0); prep_load(1);
        __syncthreads();
        for (int n = 0; n < NCH; ++n) {
            LAS unsigned char* cbuf = t.lds + (n & 1) * R5_BUF + c2 * R5_CH;
            const LAS bf16_t* ZR = (const LAS bf16_t*)(cbuf + R5_ZR); const LAS bf16_t* BK = (const LAS bf16_t*)(cbuf + R5_BK); const LAS bf16_t* BKT = (const LAS bf16_t*)(cbuf + R5_BKT);
            const LAS float* Vs = (const LAS float*)(cbuf + R5_V); const LAS float* GL = (const LAS float*)(cbuf + R5_GL);
            LAS float* Nm = (LAS float*)(t.lds + R5_GR + c2 * R5_GRCH); LAS bf16_t* MKZ = (LAS bf16_t*)(t.lds + R5_GR + c2 * R5_GRCH + 1024); LAS bf16_t* MBK = (LAS bf16_t*)(t.lds + R5_GR + c2 * R5_GRCH + 1536);
            LAS bf16_t* MT = (LAS bf16_t*)(t.lds + R5_GR + c2 * R5_GRCH + 2560);
            { f32x4 gacc = (f32x4){0.f, 0.f, 0.f, 0.f};
#pragma unroll
              for (int ks = 0; ks < 2; ++ks) { const bf16x8 av = *(const LAS bf16x8*)(ZR + ((q & 2) ? 16 + l15 : l15) * 72 + 32 * ks + 8 * q4);
                  const bf16x8 bv = *(const LAS bf16x8*)(BK + ((q & 1) ? 16 + l15 : l15) * 72 + 32 * ks + 8 * q4);
                  gacc = __builtin_amdgcn_mfma_f32_16x16x32_bf16(av, bv, gacc, 0, 0, 0); }
#pragma unroll
              for (int i = 0; i < 4; ++i) { const int tt = 4 * q4 + i, j = l15; const bool keep = (q & 2) ? (j <= tt) : (j < tt); const float val = keep ? gacc[i] : 0.f;
                  if (q == 0) Nm[tt * 16 + j] = val; else if (q == 1) MKZ[tt * 16 + j] = (bf16_t)f2bf(val); else MBK[tt * 32 + (q == 3 ? 16 : 0) + j] = (bf16_t)f2bf(val); }
              if (q == 0) {
                  asm volatile("s_waitcnt lgkmcnt(0)" ::: "memory");
                  LAS float* DS = (LAS float*)(t.lds + R5_DS + w * 1024);
                  float x[4];
#pragma unroll
                  for (int i = 0; i < 4; ++i) x[i] = (4 * q4 + i == l15) ? 1.0f : 0.0f;
#pragma unroll
                  for (int bs = 0; bs < 4; ++bs) {
                      f32x4 nb[4];
#pragma unroll
                      for (int i = 0; i < 4; ++i) nb[i] = *(const LAS f32x4*)(Nm + (4 * q4 + i) * 16 + 4 * bs);
                      if (q4 == bs) { x[1] += nb[1][0] * x[0]; x[2] += nb[2][0] * x[0] + nb[2][1] * x[1]; x[3] += nb[3][0] * x[0] + nb[3][1] * x[1] + nb[3][2] * x[2];
#pragma unroll
                          for (int i = 0; i < 4; ++i) DS[(4 * bs + i) * 16 + l15] = x[i]; }
                      asm volatile("s_waitcnt lgkmcnt(0)" ::: "memory");
                      if (bs < 3 && q4 > bs) { float dj[4];
#pragma unroll
                          for (int j = 0; j < 4; ++j) dj[j] = DS[(4 * bs + j) * 16 + l15];
#pragma unroll
                          for (int i = 0; i < 4; ++i) x[i] += (nb[i][0] * dj[0] + nb[i][1] * dj[1]) + (nb[i][2] * dj[2] + nb[i][3] * dj[3]); }
                      asm volatile("" ::: "memory"); }
#pragma unroll
                  for (int i = 0; i < 4; ++i) MT[(4 * q4 + i) * 16 + l15] = (bf16_t)f2bf(x[i]); } }
            if (n + 1 < NCH) prep_finish(n + 1);
            if (n + 2 < NCH) prep_load(n + 2);
            if (q == 0) {
                if (n + 2 < NCH) cum_finish(n + 2);
                if (n + 3 < NCH) cum_load(n + 3);
                if (n > 0) { const LAS float* ys = (const LAS float*)(t.lds + R5_YS + ((n - 1) & 1) * 8192 + c2 * 4096);
#pragma unroll
                    for (int tt = 0; tt < 16; ++tt) Y[((size_t)bl * SROW + r5_seq(z, (n - 1) * R5_L) + sd * tt) * D + colb] = (bf16_t)f2bf(ys[tt * 64 + lane]); } }
            __syncthreads();
            {
              f32x4 Pz = (f32x4){0.f, 0.f, 0.f, 0.f}, Pr = Pz;
#pragma unroll
              for (int ks = 0; ks < 2; ++ks) { const f32x4 s0 = ST[2 * ks], s1 = ST[2 * ks + 1];
                  u32x4 p; p.x = pk2(s0[0], s0[1]); p.y = pk2(s0[2], s0[3]); p.z = pk2(s1[0], s1[1]); p.w = pk2(s1[2], s1[3]);
                  const bf16x8 bop = __builtin_bit_cast(bf16x8, p);
                  const LAS bf16_t* zr = ZR + l15 * 72 + 32 * ks + 4 * q4; const LAS bf16_t* rr = ZR + (16 + l15) * 72 + 32 * ks + 4 * q4;
                  const u32x2 z0 = *(const LAS u32x2*)zr, z1 = *(const LAS u32x2*)(zr + 16), r0 = *(const LAS u32x2*)rr, r1 = *(const LAS u32x2*)(rr + 16);
                  Pz = __builtin_amdgcn_mfma_f32_16x16x32_bf16(__builtin_bit_cast(bf16x8, (u32x4){z0.x, z0.y, z1.x, z1.y}), bop, Pz, 0, 0, 0);
                  Pr = __builtin_amdgcn_mfma_f32_16x16x32_bf16(__builtin_bit_cast(bf16x8, (u32x4){r0.x, r0.y, r1.x, r1.y}), bop, Pr, 0, 0, 0); }
              float vd[4];
#pragma unroll
              for (int i = 0; i < 4; ++i) vd[i] = Vs[(4 * q4 + i) * 64 + 16 * q + l15];
              const unsigned vp0 = pk2(vd[0], vd[1]), vp1 = pk2(vd[2], vd[3]);
              { const u32x2 m = *(const LAS u32x2*)(MKZ + l15 * 16 + 4 * q4);
                Pz = __builtin_amdgcn_mfma_f32_16x16x32_bf16(__builtin_bit_cast(bf16x8, (u32x4){m.x, m.y, 0u, 0u}), __builtin_bit_cast(bf16x8, (u32x4){vp0, vp1, 0u, 0u}), Pz, 0, 0, 0); }
              { float x[4];
                { const u32x2 mt = *(const LAS u32x2*)(MT + l15 * 16 + 4 * q4);
                  const f32x4 dv = __builtin_amdgcn_mfma_f32_16x16x32_bf16(__builtin_bit_cast(bf16x8, (u32x4){mt.x, mt.y, 0u, 0u}), __builtin_bit_cast(bf16x8, (u32x4){pk2(Pz[0], Pz[1]), pk2(Pz[2], Pz[3]), 0u, 0u}), (f32x4){0.f, 0.f, 0.f, 0.f}, 0, 0, 0);
                  x[0] = dv[0]; x[1] = dv[1]; x[2] = dv[2]; x[3] = dv[3]; }
                const unsigned dp0 = pk2(x[0], x[1]), dp1 = pk2(x[2], x[3]);
                const bf16x8 bdv = __builtin_bit_cast(bf16x8, (u32x4){dp0, dp1, vp0, vp1});
                { const u32x2 m0 = *(const LAS u32x2*)(MBK + l15 * 32 + 4 * q4), m1 = *(const LAS u32x2*)(MBK + l15 * 32 + 16 + 4 * q4);
                  Pr = __builtin_amdgcn_mfma_f32_16x16x32_bf16(__builtin_bit_cast(bf16x8, (u32x4){m0.x, m0.y, m1.x, m1.y}), bdv, Pr, 0, 0, 0); }
                { LAS float* ys = (LAS float*)(t.lds + R5_YS + (n & 1) * 8192 + c2 * 4096);
#pragma unroll
                  for (int i = 0; i < 4; ++i) ys[(4 * q4 + i) * 64 + 16 * q + l15] = Pr[i]; }
#pragma unroll
                for (int cb = 0; cb < 4; ++cb) { const LAS bf16_t* bt = BKT + (16 * cb + l15) * 40 + 4 * q4;
                    const u32x2 b0 = *(const LAS u32x2*)bt, k0 = *(const LAS u32x2*)(bt + 16);
                    ST[cb] = __builtin_amdgcn_mfma_f32_16x16x32_bf16(__builtin_bit_cast(bf16x8, (u32x4){b0.x, b0.y, k0.x, k0.y}), bdv, ST[cb], 0, 0, 0);
                    const f32x4 gl = *(const LAS f32x4*)(GL + 16 * cb + 4 * q4);
                    ST[cb] = ST[cb] * gl; } } }
            __syncthreads();
        }
        if (q == 0) { const LAS float* ys = (const LAS float*)(t.lds + R5_YS + ((NCH - 1) & 1) * 8192 + c2 * 4096);
#pragma unroll
          for (int tt = 0; tt < 16; ++tt) Y[((size_t)bl * SROW + r5_seq(z, (NCH - 1) * R5_L) + sd * tt) * D + colb] = (bf16_t)f2bf(ys[tt * 64 + lane]); }
        __syncthreads();
    }
}
__device__ __forceinline__ void r6_readout(const Tc& t, CArgs a, int jl, int layer, int g) {
    const bf16_t* Y0 = (const bf16_t*)(a->ws + WS_ACT + AR_Y), *Y1 = (const bf16_t*)(a->ws + WS_ACT + AR_Y + SLOT);
    const float* RK0 = (const float*)(a->ws + WS_ACT + AR_RK), *RK1 = RK0 + (size_t)TG * 32;
    const bf16_t* Vb = (layer == 0) ? (const bf16_t*)(a->ws + WS_VF) + (size_t)g * TG * D : (const bf16_t*)(a->ws + WS_ACT + AR_V);
    const bf16_t* Gb = (const bf16_t*)(a->ws + WS_ACT + AR_MIX + 4 * SLOT);
    bf16_t* Ao = (bf16_t*)(a->ws + WS_ACT + AR_AO) + (size_t)g * TG * D;
    const int sl = t.gw & 3, c0 = 512 * sl + 8 * t.lane, head = c0 >> 6;
    const float* lnw = a->in[I_LNW] + (size_t)jl * D + c0, *lnb = a->in[I_LNB] + (size_t)jl * D + c0;
    const f32x4 lw0 = *(const f32x4*)lnw, lw1 = *(const f32x4*)(lnw + 4), lb0 = *(const f32x4*)lnb, lb1 = *(const f32x4*)(lnb + 4);
    const float lw[8] = {lw0.x, lw0.y, lw0.z, lw0.w, lw1.x, lw1.y, lw1.z, lw1.w}, lb[8] = {lb0.x, lb0.y, lb0.z, lb0.w, lb1.x, lb1.y, lb1.z, lb1.w};
    const int rstep = t.ngw >> 2;
    for (int r0 = t.gw >> 2; r0 < TG; r0 += 2 * rstep) {
        u32x4 y0[2], y1[2], vv[2], gg[2]; float rk[2];
#pragma unroll
        for (int k = 0; k < 2; ++k) { const int r = r0 + k * rstep < TG ? r0 + k * rstep : r0; const size_t off = (size_t)r * D + c0;
            y0[k] = *(const u32x4*)(Y0 + off); y1[k] = *(const u32x4*)(Y1 + off); vv[k] = *(const u32x4*)(Vb + off); gg[k] = *(const u32x4*)(Gb + off);
            rk[k] = RK0[(size_t)r * 32 + head] + RK1[(size_t)r * 32 + head]; }
        asm volatile("" ::: "memory");
#pragma unroll
        for (int k = 0; k < 2; ++k) { const int r = r0 + k * rstep; if (r >= TG) break; const size_t off = (size_t)r * D + c0;
            const unsigned a0[4] = {y0[k].x, y0[k].y, y0[k].z, y0[k].w}, a1[4] = {y1[k].x, y1[k].y, y1[k].z, y1[k].w};
            const unsigned av[4] = {vv[k].x, vv[k].y, vv[k].z, vv[k].w}, ag[4] = {gg[k].x, gg[k].y, gg[k].z, gg[k].w};
            float y[8]; float s = 0.f;
#pragma unroll
            for (int i = 0; i < 4; ++i) { y[2 * i] = lo_bf(a0[i]) + lo_bf(a1[i]); y[2 * i + 1] = hi_bf(a0[i]) + hi_bf(a1[i]); s += y[2 * i] + y[2 * i + 1]; }
            s = sum8_(s);
            const float mean = s * (1.0f / 64.0f);
            float qq = 0.f;
#pragma unroll
            for (int i = 0; i < 8; ++i) { y[i] -= mean; qq += y[i] * y[i]; }
            qq = sum8_(qq);
            const float rstd = rsqrtf(qq * (1.0f / 64.0f) + 64e-5f);
            float o[8];
#pragma unroll
            for (int i = 0; i < 4; ++i) { o[2 * i] = (y[2 * i] * rstd * lw[2 * i] + lb[2 * i] + rk[k] * lo_bf(av[i])) * lo_bf(ag[i]);
                o[2 * i + 1] = (y[2 * i + 1] * rstd * lw[2 * i + 1] + lb[2 * i + 1] + rk[k] * hi_bf(av[i])) * hi_bf(ag[i]); }
            u32x4 w; w.x = pk2(o[0], o[1]); w.y = pk2(o[2], o[3]); w.z = pk2(o[4], o[5]); w.w = pk2(o[6], o[7]);
            *(u32x4*)(Ao + off) = w; }
        asm volatile("" ::: "memory");
    }
}

__device__ __forceinline__ void m3_conv(const Tc& t, CArgs a, int jl) {
    const bf16_t* U = (const bf16_t*)(a->ws + WS_ACT + AM_U);
    bf16_t* QK = (bf16_t*)(a->ws + WS_ACT + AM_QK);
    const int sl = t.gw & 7, c0 = 256 * sl + 4 * t.lane;
    const float* cw = a->in[I_CONVW] + (size_t)jl * 9 * D + c0;
    f32x4 wt[9];
#pragma unroll
    for (int k = 0; k < 9; ++k) wt[k] = *(const f32x4*)(cw + k * D);
    const f32x4 bias = *(const f32x4*)(a->in[I_CONVB] + (size_t)jl * D + c0);
    const float sc = c0 < 1024 ? 0.08838834764831845f : 1.0f;
    for (int row = t.gw >> 3; row < T; row += t.ngw >> 3) { const int s = row % SROW;
        f32x4 acc = bias;
        if (s < CTXL) {
#pragma unroll
            for (int dc = -1; dc <= 1; ++dc) if (s + dc >= 0 && s + dc < CTXL) { const u32x2 u = *(const u32x2*)(U + (size_t)(row + dc) * ULD + c0); const f32x4 w = wt[3 + dc + 1];
                acc.x += lo_bf(u.x) * w.x; acc.y += hi_bf(u.x) * w.y; acc.z += lo_bf(u.y) * w.z; acc.w += hi_bf(u.y) * w.w; }
        } else { const int i = s - CTXL, gr = i >> 6, gc = i & 63;
            u32x2 u[9];
#pragma unroll
            for (int dr = -1; dr <= 1; ++dr)
#pragma unroll
                for (int dc = -1; dc <= 1; ++dc) { const bool ok = (gr + dr >= 0) && (gr + dr < 32) && (gc + dc >= 0) && (gc + dc < 64);
                    u[(dr + 1) * 3 + dc + 1] = ok ? *(const u32x2*)(U + (size_t)(row + dr * 64 + dc) * ULD + c0) : (u32x2){0u, 0u}; }
#pragma unroll
            for (int k = 0; k < 9; ++k) { acc.x += lo_bf(u[k].x) * wt[k].x; acc.y += hi_bf(u[k].x) * wt[k].y; acc.z += lo_bf(u[k].y) * wt[k].z; acc.w += hi_bf(u[k].y) * wt[k].w; }
        }
        u32x2 w; w.x = pk2(siluf_(acc.x) * sc, siluf_(acc.y) * sc); w.y = pk2(siluf_(acc.z) * sc, siluf_(acc.w) * sc);
        *(u32x2*)(QK + (size_t)row * D + c0) = w;
    }
}

template <int CTRL> __device__ __forceinline__ float dppz_(float v) { return __int_as_float(__builtin_amdgcn_update_dpp(0, __float_as_int(v), CTRL, 0xF, 0xF, false)); }
template <int CTRL> __device__ __forceinline__ float dppm_(float v) { return __int_as_float(__builtin_amdgcn_update_dpp((int)0xff800000u, __float_as_int(v), CTRL, 0xF, 0xF, false)); }
constexpr int M4_QS = 136, M4_TS = 72;
constexpr int M4_SQ = 0, M4_SK = 17408, M4_SVT = 34816, M4_SWKT = 71680, M4_SP = 90112, M4_F = 99328;
__device__ __forceinline__ void m4_scan(const Tc& t, CArgs a) {
    LAS bf16_t* sQ = (LAS bf16_t*)(t.lds + M4_SQ); LAS bf16_t* sK = (LAS bf16_t*)(t.lds + M4_SK); LAS bf16_t* sVT = (LAS bf16_t*)(t.lds + M4_SVT);
    LAS bf16_t* sWKT = (LAS bf16_t*)(t.lds + M4_SWKT); LAS bf16_t* sP = (LAS bf16_t*)(t.lds + M4_SP);
    LAS float* fI = (LAS float*)(t.lds + M4_F);
    LAS float* fF = fI + 64;
    LAS float* fU = fI + 128;
    LAS float* fG = fI + 192;
    LAS float* fWI = fI + 256;
    LAS float* fEN = fI + 320;
    LAS float* fWS = fI + 384;
    LAS float* fRS = fI + 448;
    LAS float* fQN = fI + 576;
    LAS float* fN = fI + 640;
    LAS float* fSC = fI + 768;
    LAS float* fNP = fI + 832;
    const bf16_t* QK = (const bf16_t*)(a->ws + WS_ACT + AM_QK);
    const bf16_t* U = (const bf16_t*)(a->ws + WS_ACT + AM_U);
    const float* Gt = (const float*)(a->ws + WS_ACT + AM_G);
    const int tid = t.tid, lane = t.lane, w = t.wave, l15 = lane & 15, q4 = lane >> 4;
    for (int chain = t.bid; chain < 2 * NB * MH; chain += t.G) {
        const int z = chain / (NB * MH), b = (chain / MH) % NB, h = chain % MH;
        bf16_t* HZ = (bf16_t*)(a->ws + WS_ACT + (z == 0 ? AM_HB : AM_HZ1));
        f32x4 Cacc[8][2];
#pragma unroll
        for (int db = 0; db < 8; ++db)
#pragma unroll
            for (int e = 0; e < 2; ++e) Cacc[db][e] = (f32x4){0.f, 0.f, 0.f, 0.f};
        float m_old = 0.f;
        if (tid < 128) fN[tid] = 0.f;
        __syncthreads();
        const size_t rowb = (size_t)b * SROW; const int sdir = z == 0 ? 1 : -1;
        u32x4 pq[2], pkk[2], pvv[4]; float pgi = 0.f, pgf = 0.f;
#define M4_LOAD(chn) do { const int t0_ = (chn) * 64; const int sb_ = z == 0 ? t0_ : (t0_ < CTXL ? CTXL - 1 - t0_ : SROW + CTXL - 1 - t0_); \
            _Pragma("unroll") for (int rep = 0; rep < 2; ++rep) { const int cid = tid + 512 * rep, i = cid >> 4, cc = cid & 15; const size_t row = rowb + sb_ + sdir * i; \
                pq[rep] = *(const u32x4*)(QK + row * D + h * MDK + 8 * cc); pkk[rep] = *(const u32x4*)(QK + row * D + 1024 + h * MDK + 8 * cc); } \
            _Pragma("unroll") for (int rep = 0; rep < 4; ++rep) { const int cid = tid + 512 * rep, i = cid & 63, cc = cid >> 6; const size_t row = rowb + sb_ + sdir * i; \
                pvv[rep] = *(const u32x4*)(U + row * ULD + 2048 + h * MDV + 8 * cc); } \
            if (tid < 64) { const size_t row = rowb + sb_ + sdir * tid; pgi = Gt[row * 32 + z * 16 + h]; pgf = Gt[row * 32 + z * 16 + 8 + h]; } } while (0)
        M4_LOAD(0);
        for (int ch = 0; ch < SROW / 64; ++ch) {
            const int t0 = ch * 64;
            const int sbase = z == 0 ? t0 : (t0 < CTXL ? CTXL - 1 - t0 : SROW + CTXL - 1 - t0);
#pragma unroll
            for (int rep = 0; rep < 2; ++rep) { const int cid = tid + 512 * rep, i = cid >> 4, cc = cid & 15;
                *(LAS u32x4*)(sQ + i * M4_QS + 8 * cc) = pq[rep]; *(LAS u32x4*)(sK + i * M4_QS + 8 * cc) = pkk[rep]; }
#pragma unroll
            for (int rep = 0; rep < 4; ++rep) { const int cid = tid + 512 * rep, i = cid & 63, cc = cid >> 6;
                const unsigned wv[4] = {pvv[rep].x, pvv[rep].y, pvv[rep].z, pvv[rep].w};
#pragma unroll
                for (int jj = 0; jj < 4; ++jj) { sVT[(8 * cc + 2 * jj) * M4_TS + i] = (bf16_t)(wv[jj] & 0xffffu); sVT[(8 * cc + 2 * jj + 1) * M4_TS + i] = (bf16_t)(wv[jj] >> 16); } }
            if (ch > 0 && tid < 128) fN[tid] = fSC[0] * fN[tid] + ((fNP[tid] + fNP[128 + tid]) + (fNP[256 + tid] + fNP[384 + tid]));
            if (tid < 64) { fI[tid] = pgi; fF[tid] = pgf; }
            if (ch + 1 < SROW / 64) M4_LOAD(ch + 1);
            __syncthreads();
            if (w == 0) {
                const float ig = fI[lane], lf = fF[lane];
                float bc = lf;
                bc += dppz_<0x111>(bc); bc += dppz_<0x112>(bc); bc += dppz_<0x114>(bc); bc += dppz_<0x118>(bc);
                { const float t0 = rl_(bc, 15), t1 = rl_(bc, 31), t2 = rl_(bc, 47); bc += (lane >= 16 ? t0 : 0.f) + (lane >= 32 ? t1 : 0.f) + (lane >= 48 ? t2 : 0.f); }
                const float g = ig - bc;
                float pm = g;
                pm = fmaxf(pm, dppm_<0x111>(pm)); pm = fmaxf(pm, dppm_<0x112>(pm)); pm = fmaxf(pm, dppm_<0x114>(pm)); pm = fmaxf(pm, dppm_<0x118>(pm));
                { const float t0 = rl_(pm, 15), t1 = rl_(pm, 31), t2 = rl_(pm, 47); const float ninf = -__builtin_inff();
                  pm = fmaxf(pm, fmaxf(fmaxf(lane >= 16 ? t0 : ninf, lane >= 32 ? t1 : ninf), lane >= 48 ? t2 : ninf)); }
                const float b_end = rl_(bc, 63), pm_all = rl_(pm, 63);
                const float m_new = fmaxf(b_end + m_old, b_end + pm_all);
                const float mx = fmaxf(m_old, pm);
                fU[lane] = -mx; fG[lane] = g; fWI[lane] = __expf(m_old - mx); fEN[lane] = __expf(-mx - bc); fWS[lane] = __expf(b_end + g - m_new);
                if (lane == 0) { fSC[0] = __expf(b_end + m_old - m_new); fSC[1] = m_new; }
            }
            const int tb = w >> 1, jb0 = 2 * (w & 1);
            f32x4 St[2];
#pragma unroll
            for (int jj = 0; jj < 2; ++jj) { St[jj] = (f32x4){0.f, 0.f, 0.f, 0.f};
                if (jb0 + jj <= tb) {
#pragma unroll
                    for (int ks = 0; ks < 4; ++ks) { const bf16x8 av = *(const LAS bf16x8*)(sQ + (16 * tb + l15) * M4_QS + 32 * ks + 8 * q4);
                        const bf16x8 bv = *(const LAS bf16x8*)(sK + (16 * (jb0 + jj) + l15) * M4_QS + 32 * ks + 8 * q4);
                        St[jj] = __builtin_amdgcn_mfma_f32_16x16x32_bf16(av, bv, St[jj], 0, 0, 0); } } }
            __syncthreads();
            { float rs[4] = {0.f, 0.f, 0.f, 0.f};
#pragma unroll
              for (int jj = 0; jj < 2; ++jj) { const int j = 16 * (jb0 + jj) + l15; const float gj = fG[j];
#pragma unroll
                  for (int i = 0; i < 4; ++i) { const int tt = 16 * tb + 4 * q4 + i; const float val = (j <= tt) ? St[jj][i] * __expf(fU[tt] + gj) : 0.f;
                      rs[i] += val; sP[tt * M4_TS + j] = (bf16_t)f2bfa(val); } }
#pragma unroll
              for (int i = 0; i < 4; ++i) { float v = rs[i]; v = sum16_(v);
                  if (l15 == 0) fRS[(w & 1) * 64 + 16 * tb + 4 * q4 + i] = v; } }
            { const int d = tid & 127, jg = tid >> 7; unsigned pk[8]; float nn = 0.f;
#pragma unroll
              for (int jj = 0; jj < 8; ++jj) { const int j0 = 16 * jg + 2 * jj; const float w0 = fWS[j0] * bf2f(sK[j0 * M4_QS + d]), w1 = fWS[j0 + 1] * bf2f(sK[(j0 + 1) * M4_QS + d]);
                  nn += w0 + w1; pk[jj] = pk2a(w0, w1); }
              fNP[jg * 128 + d] = nn;
              *(LAS u32x4*)(sWKT + d * M4_TS + 16 * jg) = (u32x4){pk[0], pk[1], pk[2], pk[3]};
              *(LAS u32x4*)(sWKT + d * M4_TS + 16 * jg + 8) = (u32x4){pk[4], pk[5], pk[6], pk[7]}; }
            { const int tt = tid >> 3, dp = tid & 7; float s = 0.f;
#pragma unroll
              for (int dd = 0; dd < 16; ++dd) s += bf2f(sQ[tt * M4_QS + 16 * dp + dd]) * fN[16 * dp + dd];
              s = sum8_(s);
              if (dp == 0) fQN[tt] = s; }
            __syncthreads();
            asm volatile("s_waitcnt vmcnt(0)" ::: "memory");
            asm volatile("" : "+v"(pq[0]), "+v"(pq[1]), "+v"(pkk[0]), "+v"(pkk[1]));
            asm volatile("" : "+v"(pvv[0]), "+v"(pvv[1]), "+v"(pvv[2]), "+v"(pvv[3]), "+v"(pgi), "+v"(pgf));
#pragma unroll 1
            for (int x = 0; x < 4; ++x) {
                f32x4 acc[2];
                acc[0] = (f32x4){0.f, 0.f, 0.f, 0.f}; acc[1] = (f32x4){0.f, 0.f, 0.f, 0.f};
#pragma unroll
                for (int kb = 0; kb < 4; ++kb) {
                    const LAS bf16_t* qr = sQ + (16 * x + l15) * M4_QS + 32 * kb + 4 * q4;
                    const u32x2 lo = *(const LAS u32x2*)qr, hi = *(const LAS u32x2*)(qr + 16);
                    const bf16x8 aop = __builtin_bit_cast(bf16x8, (u32x4){lo.x, lo.y, hi.x, hi.y});
#pragma unroll
                    for (int e = 0; e < 2; ++e) { const f32x4 c0 = Cacc[2 * kb][e], c1 = Cacc[2 * kb + 1][e];
                        u32x4 p; p.x = pk2a(c0[0], c0[1]); p.y = pk2a(c0[2], c0[3]); p.z = pk2a(c1[0], c1[1]); p.w = pk2a(c1[2], c1[3]);
                        acc[e] = __builtin_amdgcn_mfma_f32_16x16x32_bf16(aop, __builtin_bit_cast(bf16x8, p), acc[e], 0, 0, 0); } }
                { const f32x4 wi = *(const LAS f32x4*)(fWI + 16 * x + 4 * q4); acc[0] = acc[0] * wi; acc[1] = acc[1] * wi; }
#pragma unroll
                for (int ks = 0; ks < 2; ++ks) { const bf16x8 aop = *(const LAS bf16x8*)(sP + (16 * x + l15) * M4_TS + 32 * ks + 8 * q4);
#pragma unroll
                    for (int e = 0; e < 2; ++e) { const bf16x8 bop = *(const LAS bf16x8*)(sVT + (16 * (2 * w + e) + l15) * M4_TS + 32 * ks + 8 * q4);
                        acc[e] = __builtin_amdgcn_mfma_f32_16x16x32_bf16(aop, bop, acc[e], 0, 0, 0); } }
#pragma unroll
                for (int i = 0; i < 4; ++i) { const int tt = 16 * x + 4 * q4 + i;
                    const float den = fWI[tt] * fQN[tt] + fRS[tt] + fRS[64 + tt]; const float dv = __builtin_amdgcn_rcpf(fmaxf(fabsf(den), fEN[tt]));
                    const size_t row = rowb + sbase + sdir * tt;
#pragma unroll
                    for (int e = 0; e < 2; ++e) HZ[row * D + h * MDV + 16 * (2 * w + e) + l15] = (bf16_t)f2bfa(acc[e][i] * dv); }
            }
            { const float dec = fSC[0];
#pragma unroll
              for (int db = 0; db < 8; ++db)
#pragma unroll
                  for (int e = 0; e < 2; ++e) Cacc[db][e] = Cacc[db][e] * dec;
#pragma unroll
              for (int ks = 0; ks < 2; ++ks) {
                  bf16x8 bop[2];
#pragma unroll
                  for (int e = 0; e < 2; ++e) bop[e] = *(const LAS bf16x8*)(sVT + (16 * (2 * w + e) + l15) * M4_TS + 32 * ks + 8 * q4);
#pragma unroll
                  for (int db = 0; db < 8; ++db) { const bf16x8 aop = *(const LAS bf16x8*)(sWKT + (16 * db + l15) * M4_TS + 32 * ks + 8 * q4);
#pragma unroll
                      for (int e = 0; e < 2; ++e) Cacc[db][e] = __builtin_amdgcn_mfma_f32_16x16x32_bf16(aop, bop[e], Cacc[db][e], 0, 0, 0); } }
 }
            m_old = fSC[1];
            __syncthreads();
        }
#undef M4_LOAD
    }
}

__device__ __forceinline__ void m5_readout(const Tc& t, CArgs a, int jl) {
    const bf16_t* H0 = (const bf16_t*)(a->ws + WS_ACT + AM_HB), *H1 = (const bf16_t*)(a->ws + WS_ACT + AM_HZ1);
    const bf16_t* U = (const bf16_t*)(a->ws + WS_ACT + AM_U);
    bf16_t* Ao = (bf16_t*)(a->ws + WS_ACT + AM_QK);
    const int sl = t.gw & 3, c0 = 512 * sl + 8 * t.lane;
    const float* nw = a->in[I_MNORMW] + (size_t)jl * D + c0;
    const f32x4 w0 = *(const f32x4*)nw, w1 = *(const f32x4*)(nw + 4);
    const float w8[8] = {w0.x, w0.y, w0.z, w0.w, w1.x, w1.y, w1.z, w1.w};
    const int rstep = t.ngw >> 2;
    for (int r0 = t.gw >> 2; r0 < T; r0 += 4 * rstep) {
        u32x4 h0[4], h1[4], ov[4];
#pragma unroll
        for (int k = 0; k < 4; ++k) { const int row = r0 + k * rstep < T ? r0 + k * rstep : r0; const size_t off = (size_t)row * D + c0;
            h0[k] = *(const u32x4*)(H0 + off); h1[k] = *(const u32x4*)(H1 + off); ov[k] = *(const u32x4*)(U + (size_t)row * ULD + 4096 + c0); }
        asm volatile("" ::: "memory");
#pragma unroll
        for (int k = 0; k < 4; ++k) { const int row = r0 + k * rstep; if (row >= T) break; const size_t off = (size_t)row * D + c0;
            const unsigned a0[4] = {h0[k].x, h0[k].y, h0[k].z, h0[k].w}, a1[4] = {h1[k].x, h1[k].y, h1[k].z, h1[k].w}, ao[4] = {ov[k].x, ov[k].y, ov[k].z, ov[k].w};
            float y[8]; float s = 0.f;
#pragma unroll
            for (int i = 0; i < 4; ++i) { y[2 * i] = lo_bf(a0[i]) + lo_bf(a1[i]); y[2 * i + 1] = hi_bf(a0[i]) + hi_bf(a1[i]); s += y[2 * i] + y[2 * i + 1]; }
            s = sum16_(s); s += shfl_xor_(s, 16, t.lane);
            const float mean = s * (1.0f / 256.0f);
            float qq = 0.f;
#pragma unroll
            for (int i = 0; i < 8; ++i) { y[i] -= mean; qq += y[i] * y[i]; }
            qq = sum16_(qq); qq += shfl_xor_(qq, 16, t.lane);
            const float rstd = rsqrtf(qq * (1.0f / 256.0f) + 1e-6f);
            float o[8];
#pragma unroll
            for (int i = 0; i < 4; ++i) { o[2 * i] = y[2 * i] * rstd * w8[2 * i] * sigmoidf_(lo_bf(ao[i])); o[2 * i + 1] = y[2 * i + 1] * rstd * w8[2 * i + 1] * sigmoidf_(hi_bf(ao[i])); }
            u32x4 wv; wv.x = pk2(o[0], o[1]); wv.y = pk2(o[2], o[3]); wv.z = pk2(o[4], o[5]); wv.w = pk2(o[6], o[7]);
            *(u32x4*)(Ao + off) = wv; }
        asm volatile("" ::: "memory");
    }
}

__device__ __forceinline__ void final_norm(const Tc& t, CArgs a) {
    const float* xres = (const float*)(a->ws + WS_XRES);
    f32x4 gg[8];
    { const f32x4* gp = (const f32x4*)a->in[I_FINALG] + t.lane;
#pragma unroll
      for (int j = 0; j < 8; ++j) gg[j] = gp[64 * j]; }
    for (int r0 = t.gw; r0 < NB * SEQ; r0 += 2 * t.ngw) {
        f32x4 v[2][8];
#pragma unroll
        for (int k = 0; k < 2; ++k) { const int r = r0 + k * t.ngw < NB * SEQ ? r0 + k * t.ngw : r0; const size_t row = (size_t)(r / SEQ) * SROW + CTXL + (r % SEQ);
            const f32x4* xr = (const f32x4*)(xres + row * D) + t.lane;
#pragma unroll
            for (int j = 0; j < 8; ++j) v[k][j] = xr[64 * j]; }
        asm volatile("" ::: "memory");
#pragma unroll
        for (int k = 0; k < 2; ++k) { const int r = r0 + k * t.ngw; if (r >= NB * SEQ) break;
            float ss = 0.f;
#pragma unroll
            for (int j = 0; j < 8; ++j) ss += (v[k][j].x * v[k][j].x + v[k][j].y * v[k][j].y) + (v[k][j].z * v[k][j].z + v[k][j].w * v[k][j].w);
            const float rstd = rsqrtf(wave_sum_dpp(ss) * (1.0f / D) + 1e-6f);
            f32x4* o = (f32x4*)(a->out + (size_t)r * D) + t.lane;
#pragma unroll
            for (int j = 0; j < 8; ++j) o[64 * j] = v[k][j] * rstd * gg[j]; }
        asm volatile("" ::: "memory");
    }
}
constexpr int NU_FULL = (T / 256) * (D / 256), NU_SKIP = (T / 9 * 8 / 256) * (D / 256);
constexpr int NSEG = 1 + 2 * (12 + 1 + 3) + 2 * (6 + 3) + 1;

__global__ void __launch_bounds__(512, 2) hybrid_fwd(Args args) {
    extern __shared__ __attribute__((aligned(16))) unsigned char lds_raw[];
    LAS unsigned char* const lds = (LAS unsigned char*)lds_raw;
    volatile LAS unsigned* MISC = (volatile LAS unsigned*)(lds + LDSCTL_OFF);
    if (threadIdx.x < 64) MISC[threadIdx.x] = 0u;
    __syncthreads();
    const int lo = args.ph_lo, hi = args.ph_hi;
    const bool fused = (hi - lo) > 1;
    unsigned* barw = (unsigned*)(args.ws + WS_CTL) + 4096;
    XcdBarrier bar; bar.bar = barw; bar.x = 0; bar.st = MISC + 8;
    if (fused) bar = xcd_barrier_post(barw, MISC + 8);
    int seg = 0;
    int urot = 0;
#define ACTIVE (seg >= lo && seg < hi)
#define PH_BEGIN const Tc t = mk_tc(lds); const CArgs a = opaque_args(); unsigned char* const act = a->ws + WS_ACT; (void)act; (void)t;
#define SEAM() do { if (fused && seg >= lo && seg + 1 < hi) xcd_barrier(bar); ++seg; } while (0)

    if (ACTIVE) { PH_BEGIN ph_prologue(t, a); }
    SEAM();
    for (int layer = 0; layer < 4; ++layer) {
        const int jl = layer >> 1;
        if ((layer & 1) == 0) {
            for (int g = 0; g < NGRP; ++g) {
                if (ACTIVE) { PH_BEGIN if (g == 0 && layer == 0) { convert_rwkv(t, a, 0); convert_ffn_in(t, a, 0); }
                    norm_rows<true>(t, a, layer, 0, g * TG, TG, act + AR_H, layer == 0); }
                SEAM();
                if (ACTIVE) { PH_BEGIN r2_mix(t, a, jl); }
                SEAM();
                if (ACTIVE) {
                    PH_BEGIN const bf16_t* wm = (const bf16_t*)(a->ws + WS_WMIX);
                    bf16_t* vdst = (layer == 0) ? (bf16_t*)(a->ws + WS_VF) + (size_t)g * TG * D : (bf16_t*)(act + AR_V);
                    const bf16_t* mix[6];
#pragma unroll
                    for (int m = 0; m < 6; ++m) mix[m] = (const bf16_t*)(act + AR_MIX + (size_t)m * SLOT);
                    for (int q = 0; q < 7; ++q) {
                        if (q == 6 && jl == 0) break;
                        const bf16_t* A = q == 0 ? mix[0] : q == 1 ? mix[2] : q == 2 ? mix[3] : q == 3 ? mix[1] : q == 4 ? mix[4] : q == 5 ? mix[5] : mix[3];
                        const size_t wo = q == 0 ? WM_R : q == 1 ? WM_K : q == 2 ? WM_V : q == 3 ? WM_W1 : q == 4 ? WM_A1 : q == 5 ? WM_G1 : WM_V1;
                        bf16_t* O = q == 0 ? (bf16_t*)(act + AR_R) : q == 1 ? (bf16_t*)(act + AR_K) : q == 2 ? vdst : (bf16_t*)(act + AR_LORA + (size_t)(q - 3) * 9 * MiB);
                        const int N = q < 3 ? D : 256; const int actf = q == 3 ? 1 : q == 5 ? 2 : 0;
                        pg8::EpiStore E{O, N, actf, 0, 0, -1, nullptr, nullptr};
                        run_gemm(t.lds, A, (const bf16_t*)((const char*)wm + wo), TG, N, D, E, urot);
                    }
                }
                SEAM();
                if (ACTIVE) {
                    PH_BEGIN const bf16_t* wm = (const bf16_t*)(a->ws + WS_WMIX);
                    const bf16_t* lora = (const bf16_t*)(act + AR_LORA);
                    for (int q = 0; q < 2; ++q) {
                        pg8::EpiSigAff E{(bf16_t*)(act + AR_MIX + (size_t)(2 * q) * SLOT), (size_t)TG * D, a->in[q == 0 ? I_W0 : I_A0] + (size_t)jl * 2 * D, q == 0 ? -0.6065306597126334f : 1.0f};
                        run_gemm(t.lds, lora + (size_t)q * TG * 256, (const bf16_t*)((const char*)wm + (q == 0 ? WM_W2 : WM_A2)), TG, 2 * D, 256, E, urot);
                    }
                    { pg8::EpiStore E{(bf16_t*)(act + AR_MIX + 4 * SLOT), D, 0, 0, 0, -1, nullptr, nullptr};
                      run_gemm(t.lds, lora + (size_t)2 * TG * 256, (const bf16_t*)((const char*)wm + WM_G2), TG, D, 256, E, urot); }
                    if (jl > 0) { pg8::EpiVmix E{(bf16_t*)(act + AR_V), (const bf16_t*)(a->ws + WS_VF) + (size_t)g * TG * D, a->in[I_V0] + (size_t)(jl - 1) * D};
                      run_gemm(t.lds, lora + (size_t)3 * TG * 256, (const bf16_t*)((const char*)wm + WM_V2), TG, D, 256, E, urot); }
                }
                SEAM();
                if (ACTIVE) { PH_BEGIN r5_scan(t, a, jl, layer, g); }
                SEAM();
                if (ACTIVE) { PH_BEGIN r6_readout(t, a, jl, layer, g); }
                SEAM();
            }
            if (ACTIVE) { PH_BEGIN pg8::EpiResid E{(float*)(a->ws + WS_XRES), (const float*)(a->ws + WS_MOD) + (size_t)layer * 17 * MODLD + 2 * D, 0, layer == 0 ? a->in[I_X] : nullptr, a->in[I_CTX]};
                run_gemm(t.lds, (const bf16_t*)(act + AR_AO), (const bf16_t*)(a->ws + WS_WMIX + WM_O), T, D, D, E, urot);
                { const Tc t2 = mk_tc(lds); const CArgs a2 = opaque_args(); Tc ts; if (tail_crew(t2, urot - NU_FULL, NU_FULL, ts)) { __syncthreads(); convert_ffn_out(ts, a2, layer); } } }
            SEAM();
        } else {
            if (ACTIVE) { PH_BEGIN norm_rows<true>(t, a, layer, 0, 0, T, act + AM_HB); }
            SEAM();
            if (ACTIVE) { PH_BEGIN pg8::EpiStore E{(bf16_t*)(act + AM_U), ULD, 0, 0, 0, 24, (float*)(act + AM_G), a->in[I_BGATE] + (size_t)jl * 32};
                run_gemm(t.lds, (const bf16_t*)(act + AM_HB), (const bf16_t*)(a->ws + WS_WMIX + WM_MIN), T, 6400, D, E, urot); }
            SEAM();
            if (ACTIVE) { PH_BEGIN m3_conv(t, a, jl); }
            SEAM();
            if (ACTIVE) { PH_BEGIN m4_scan(t, a); }
            SEAM();
            if (ACTIVE) { PH_BEGIN m5_readout(t, a, jl); }
            SEAM();
            if (ACTIVE) { PH_BEGIN pg8::EpiResid E{(float*)(a->ws + WS_XRES), (const float*)(a->ws + WS_MOD) + (size_t)layer * 17 * MODLD + 2 * D, 0, nullptr, nullptr};
                if (layer == 3) run_gemm<pg8::EpiResid, true>(t.lds, (const bf16_t*)(act + AM_QK), (const bf16_t*)(a->ws + WS_WMIX + WM_MOUT), T, D, D, E, urot);
                else run_gemm(t.lds, (const bf16_t*)(act + AM_QK), (const bf16_t*)(a->ws + WS_WMIX + WM_MOUT), T, D, D, E, urot);
                { const Tc t2 = mk_tc(lds); const CArgs a2 = opaque_args(); Tc ts; const int nu = layer == 3 ? NU_SKIP : NU_FULL; if (tail_crew(t2, urot - nu, nu, ts)) { __syncthreads(); convert_ffn_out(ts, a2, layer); } } }
            SEAM();
        }
        if (ACTIVE) { PH_BEGIN norm_rows<true>(t, a, layer, 1, 0, T, act + AF_H2); }
        SEAM();
        if (ACTIVE) { PH_BEGIN pg8::EpiSwiglu E{(bf16_t*)(act + AF_U)};
            if (layer == 3) run_gemm<pg8::EpiSwiglu, true>(t.lds, (const bf16_t*)(act + AF_H2), (const bf16_t*)(a->ws + WS_WFFN + WF_IN), T, 2 * DFF, D, E, urot);
            else run_gemm(t.lds, (const bf16_t*)(act + AF_H2), (const bf16_t*)(a->ws + WS_WFFN + WF_IN), T, 2 * DFF, D, E, urot); }
        SEAM();
        if (ACTIVE) { PH_BEGIN pg8::EpiResid E{(float*)(a->ws + WS_XRES), (const float*)(a->ws + WS_MOD) + (size_t)layer * 17 * MODLD + 5 * D, 0, nullptr, nullptr};
            if (layer == 3) run_gemm<pg8::EpiResid, true>(t.lds, (const bf16_t*)(act + AF_U), (const bf16_t*)(a->ws + WS_WFFN + WF_OUT), T, D, DFF, E, urot);
            else run_gemm(t.lds, (const bf16_t*)(act + AF_U), (const bf16_t*)(a->ws + WS_WFFN + WF_OUT), T, D, DFF, E, urot);
            if (layer < 3) { const Tc t2 = mk_tc(lds); const CArgs a2 = opaque_args(); Tc ts; if (tail_crew(t2, urot - NU_FULL, NU_FULL, ts)) { __syncthreads();
                if (layer & 1) convert_rwkv(ts, a2, (layer + 1) >> 1); else convert_mlstm(ts, a2, (layer + 1) >> 1);
                convert_ffn_in(ts, a2, layer + 1); } } }
        SEAM();
    }
    if (ACTIVE) { PH_BEGIN final_norm(t, a); }
#undef ACTIVE
#undef SEAM
#undef PH_BEGIN
}

#ifndef MK_MULTI
#define MK_MULTI 0
#endif
extern "C" void kernel_launch(void* const* d_in, const int* in_sizes, int n_in, void* d_out, int out_size, void* d_ws, size_t ws_size, hipStream_t stream) {
    static int grid = 0;
    if (grid == 0) {
        if (n_in != NIN || ws_size < WS_END) { fprintf(stderr, "kernel_launch: unexpected n_in %d / ws %zu\n", n_in, ws_size); grid = -1; return; }
        int dev = 0, cus = 0, per_cu = 0;
        if (hipGetDevice(&dev) != hipSuccess || hipDeviceGetAttribute(&cus, hipDeviceAttributeMultiprocessorCount, dev) != hipSuccess) { grid = -1; return; }
        if (hipFuncSetAttribute((const void*)hybrid_fwd, hipFuncAttributeMaxDynamicSharedMemorySize, LDS_BYTES) != hipSuccess) { fprintf(stderr, "kernel_launch: hipFuncSetAttribute failed\n"); grid = -1; return; }
        if (hipOccupancyMaxActiveBlocksPerMultiprocessor(&per_cu, (const void*)hybrid_fwd, 512, LDS_BYTES) != hipSuccess || per_cu < 1)
            fprintf(stderr, "kernel_launch: occupancy query reports %d workgroups per CU\n", per_cu);
        (void)hipGetLastError();
        grid = cus;
    }
    if (grid < 0) return;
    if (hipMemsetAsync((char*)d_ws + WS_CTL, 0, CTL_ZERO_BYTES, stream) != hipSuccess) return;
    Args a{};
    for (int i = 0; i < NIN; ++i) a.in[i] = (const float*)d_in[i];
    a.out = (float*)d_out; a.ws = (unsigned char*)d_ws;
#if MK_MULTI
    for (int s = 0; s < NSEG; ++s) { a.ph_lo = s; a.ph_hi = s + 1; hipLaunchKernelGGL(hybrid_fwd, dim3(grid), dim3(512), LDS_BYTES, stream, a); }
#else
    a.ph_lo = 0; a.ph_hi = NSEG;
    hipLaunchKernelGGL(hybrid_fwd, dim3(grid), dim3(512), LDS_BYTES, stream, a);
#endif
}
```

```cpp
#include <hip/hip_runtime.h>
#include <cstdio>
#include <cstdint>

#define LAS __attribute__((address_space(3)))
#define GAS __attribute__((address_space(1)))
typedef unsigned short bf16_t;
typedef short bf16x8 __attribute__((ext_vector_type(8)));
typedef short bf16x4 __attribute__((ext_vector_type(4)));
typedef float f32x4 __attribute__((ext_vector_type(4)));
typedef float f32x2 __attribute__((ext_vector_type(2)));
typedef unsigned u32x4 __attribute__((ext_vector_type(4)));
typedef unsigned u32x2 __attribute__((ext_vector_type(2)));
#define LDS_WAIT() asm volatile("s_waitcnt lgkmcnt(0)" ::: "memory")
#define VM_WAIT() asm volatile("s_waitcnt vmcnt(0)" ::: "memory")

constexpr int D = 2048, NB = 16, SEQ = 2048, CTXL = 256, SROW = 2304, T = NB * SROW;
constexpr int NGRP = 2, BG = 8, TG = BG * SROW;
constexpr int DFF = 5632;
constexpr int RH = 32;
constexpr int MH = 8, MDV = 256, MDK = 128, MPROJ = 6176, ULD = 6144;
constexpr int MODLD = 6 * D;
constexpr int NIN = 37;
enum { I_X = 0, I_C, I_CTX, I_CCTX, I_MODW, I_MODB, I_NORMG, I_FINALG, I_MU, I_WR, I_WK, I_WV, I_WO, I_W0, I_W1, I_W2, I_A0, I_A1, I_A2, I_G1, I_G2, I_KK, I_KA, I_RK, I_LNW, I_LNB,
       I_V0, I_V1, I_V2, I_MWIN, I_BGATE, I_CONVW, I_CONVB, I_MNORMW, I_MWOUT, I_FWIN, I_FWOUT };

constexpr size_t MiB = 1u << 20;
constexpr size_t WS_CTL = 0, CTL_ZERO_BYTES = 1 * MiB;
constexpr size_t WS_MOD = 1 * MiB;
constexpr size_t WS_XRES = 5 * MiB;
constexpr size_t WS_VF = 293 * MiB;
constexpr size_t WS_WMIX = 437 * MiB;
constexpr size_t WS_WFFN = 479 * MiB;
constexpr size_t WS_ACT = 545 * MiB;
constexpr size_t WS_END = WS_ACT + 977 * MiB;
static_assert(WS_END <= (size_t)1536 * MiB, "ws");
constexpr size_t WM_R = 0, WM_K = 8 * MiB, WM_V = 16 * MiB, WM_O = 24 * MiB, WM_W1 = 32 * MiB, WM_A1 = 33 * MiB, WM_G1 = 34 * MiB, WM_V1 = 35 * MiB,
                 WM_W2 = 36 * MiB, WM_A2 = 38 * MiB, WM_G2 = 40 * MiB, WM_V2 = 41 * MiB;
constexpr size_t WM_MIN = 0, WM_MOUT = 25 * MiB;
constexpr size_t WF_IN = 0, WF_OUT = 44 * MiB;
constexpr size_t SLOT = 72 * MiB;
constexpr size_t AR_MIX = 0;
constexpr size_t AR_H = 432 * MiB;
constexpr size_t AR_R = 432 * MiB, AR_K = 504 * MiB, AR_V = 576 * MiB;
constexpr size_t AR_LORA = 648 * MiB;
constexpr size_t AR_Y = 684 * MiB;
constexpr size_t AR_RK = 828 * MiB;
constexpr size_t AR_AO = 833 * MiB;
constexpr size_t AM_HB = 0, AM_U = 144 * MiB, AM_QK = 576 * MiB, AM_HZ1 = 720 * MiB, AM_G = 864 * MiB;
constexpr size_t AF_H2 = 0, AF_U = 144 * MiB;

constexpr int LDS_BYTES = 147456;
constexpr int LDSCTL_OFF = LDS_BYTES - 256;

__device__ __forceinline__ float bf2f(bf16_t b) { return __uint_as_float(((unsigned)b) << 16); }
typedef __bf16 bf16x2n_t __attribute__((ext_vector_type(2)));
__device__ __forceinline__ unsigned pk2(float lo, float hi) { const f32x2 v = {lo, hi}; return __builtin_bit_cast(unsigned, __builtin_convertvector(v, bf16x2n_t)); }
__device__ __forceinline__ unsigned f2bf(float f) { return pk2(f, f) & 0xffffu; }
__device__ __forceinline__ unsigned pk2a(float lo, float hi) { unsigned r; asm("v_cvt_pk_bf16_f32 %0, %1, %2" : "=v"(r) : "v"(lo), "v"(hi)); return r; }
__device__ __forceinline__ unsigned f2bfa(float f) { return pk2a(f, f) & 0xffffu; }
__device__ __forceinline__ float lo_bf(unsigned w) { return __uint_as_float(w << 16); }
__device__ __forceinline__ float hi_bf(unsigned w) { return __uint_as_float(w & 0xffff0000u); }
__device__ __forceinline__ float sigmoidf_(float x) { return __builtin_amdgcn_rcpf(1.0f + __expf(-x)); }
__device__ __forceinline__ float tanhf_(float x) { return 1.0f - 2.0f * __builtin_amdgcn_rcpf(1.0f + __expf(2.0f * x)); }
__device__ __forceinline__ float siluf_(float x) { return x * __builtin_amdgcn_rcpf(1.0f + __expf(-x)); }
template <int CTRL> __device__ __forceinline__ float dpp_(float v) { return __int_as_float(__builtin_amdgcn_update_dpp(0, __float_as_int(v), CTRL, 0xF, 0xF, true)); }
__device__ __forceinline__ float rl_(float v, int k) { return __int_as_float(__builtin_amdgcn_readlane(__float_as_int(v), k)); }
__device__ __forceinline__ float sum8_(float v) { v += dpp_<0xB1>(v); v += dpp_<0x4E>(v); v += dpp_<0x141>(v); return v; }
__device__ __forceinline__ float sum16_(float v) { v = sum8_(v); v += dpp_<0x140>(v); return v; }
__device__ __forceinline__ float wave_sum_dpp(float v) { v = sum16_(v); return (rl_(v, 0) + rl_(v, 16)) + (rl_(v, 32) + rl_(v, 48)); }
__device__ __forceinline__ float wave_sum(float v) { return wave_sum_dpp(v); }
__device__ __forceinline__ float shfl_xor_(float v, int mask, int lane) { return __int_as_float(__builtin_amdgcn_ds_bpermute((lane ^ mask) << 2, __float_as_int(v))); }

#define XB_TMO      128
#define XB_XCNT(j)  (256  + 64 * (j))
#define XB_XSUB(j)  (1280 + 64 * (j))
#define XB_XGEN(j)  (2304 + 64 * (j))
#define XB_TOP      3328
#define XB_TOPGEN   3392
#define XCD_BAR_WORDS 3456
#define XB_SPIN_CAP (1u << 24)

__device__ __forceinline__ unsigned xb_ld(unsigned* p)              { return __hip_atomic_load(p, __ATOMIC_RELAXED, __HIP_MEMORY_SCOPE_AGENT); }
__device__ __forceinline__ unsigned xb_add(unsigned* p, unsigned v) { return __hip_atomic_fetch_add(p, v, __ATOMIC_RELAXED, __HIP_MEMORY_SCOPE_AGENT); }
__device__ __forceinline__ unsigned xb_xcc_id() { return (unsigned)__builtin_amdgcn_s_getreg((3 << 11) | 20) & 0xFu; }
#define XB_SPIN(cond, bar) do { unsigned _sp = 0; while (cond) { __builtin_amdgcn_s_sleep(1); \
    if ((++_sp & 255u) == 0u) { if (xb_ld(&(bar)[XB_TMO])) break; if (_sp > XB_SPIN_CAP) { atomicAdd(&(bar)[XB_TMO], 1u); break; } } } } while (0)

struct XcdBarrier { unsigned* bar; unsigned x; volatile LAS unsigned* st; };

__device__ __forceinline__ XcdBarrier xcd_barrier_post(unsigned* bar, volatile LAS unsigned* st) {
    XcdBarrier b; b.bar = bar; b.x = xb_xcc_id(); b.st = st;
    if (threadIdx.x == 0) (void)xb_add(&bar[XB_XCNT(b.x)], 1u);
    return b;
}
__device__ __forceinline__ void xcd_barrier_complete(unsigned* bar, unsigned x, unsigned& nloc, unsigned& nx) {
    const unsigned G = gridDim.x * gridDim.y * gridDim.z;
    unsigned sum, cnt, mine, sp = 0u;
    for (;;) {
        sum = 0u; cnt = 0u; mine = 0u;
#pragma unroll
        for (unsigned j = 0; j < 16; ++j) { const unsigned c = xb_ld(&bar[XB_XCNT(j)]); sum += c; cnt += (c > 0u) ? 1u : 0u; mine = (j == x) ? c : mine; }
        if (sum == G) break;
        __builtin_amdgcn_s_sleep(1);
        if ((++sp & 255u) == 0u) { if (xb_ld(&bar[XB_TMO])) break; if (sp > XB_SPIN_CAP) { atomicAdd(&bar[XB_TMO], 1u); break; } }
    }
    nloc = mine > 0u ? mine : 1u; nx = cnt > 0u ? cnt : 1u;
}
__device__ __forceinline__ void xcd_barrier(const XcdBarrier& b) {
    asm volatile("s_waitcnt vmcnt(0)" ::: "memory");
    __syncthreads();
    if (threadIdx.x == 0) {
        unsigned* bar = b.bar;
        __builtin_amdgcn_s_waitcnt(0);
        unsigned nloc = b.st[0], nx = b.st[1];
        if (nloc == 0u) { xcd_barrier_complete(bar, b.x, nloc, nx); b.st[0] = nloc; b.st[1] = nx; }
        const unsigned old = xb_add(&bar[XB_XSUB(b.x)], 1u);
        const unsigned gen = old / nloc;
        if (old + 1u == (gen + 1u) * nloc) {
            __builtin_amdgcn_fence(__ATOMIC_RELEASE, "agent");
            asm volatile("s_waitcnt vmcnt(0)" ::: "memory");
            const unsigned og = xb_add(&bar[XB_TOP], 1u);
            const unsigned tg = og / nx;
            if (og + 1u == (tg + 1u) * nx) xb_add(&bar[XB_TOPGEN], 1u);
            else XB_SPIN(xb_ld(&bar[XB_TOPGEN]) == tg, bar);
            __builtin_amdgcn_fence(__ATOMIC_ACQUIRE, "agent");
            xb_add(&bar[XB_XGEN(b.x)], 1u);
            asm volatile("s_waitcnt vmcnt(0)" ::: "memory");
        } else {
            XB_SPIN(xb_ld(&bar[XB_XGEN(b.x)]) == gen, bar);
            __builtin_amdgcn_fence(__ATOMIC_ACQUIRE, "agent");
            asm volatile("s_waitcnt vmcnt(0)" ::: "memory");
        }
    }
    __syncthreads();
}
#ifndef GP_ALIGN
#define GP_ALIGN true
#endif
#ifndef GP_SP2
#define GP_SP2 true
#endif
namespace pg8 {
constexpr int BM = 256, BK = 64, HALF = 128, HTB = HALF * BK * 2  , STAGE_BYTES = 8 * HTB, NXCD = 8, WGM = 8;

__host__ __device__ __forceinline__ int lds_byte(int r, int c) { const int st = (r >> 4) * 2 + (c >> 5), rr = r & 15, cc = c & 31, ob = rr * 64 + cc * 2; return st * 1024 + (ob ^ (((ob >> 9) & 1) << 5)); }
__host__ __device__ __forceinline__ void stage_rc(int b, int& R, int& C) { const int st = b / 1024, sb = b % 1024, swz = sb ^ (((sb >> 9) & 1) << 5); R = (st >> 1) * 16 + swz / 64; C = (st & 1) * 32 + (swz % 64) / 2; }
__host__ __device__ __forceinline__ int perm32(int rho) { const int n = rho >> 4, i = rho & 15; return 8 * (i >> 2) + 4 * n + (i & 3); }

struct Unit { int pm, pn; };
struct Gemm { const bf16_t* A; const bf16_t* Bt; int M, N, K; };

struct StaticOrder {
    int nM, nN, nwg, G, c;
    __host__ __device__ void init(int M, int N, int G_, int c_) { nM = M / BM; nN = N / BM; nwg = nM * nN; G = G_; c = c_; }
    __host__ __device__ bool next(int i, Unit& u) const {
        const long L = (long)i * G + c; if (L >= nwg) return false;
        int wgid = (int)L; { const int q = nwg / NXCD, r = nwg % NXCD, xcd = wgid % NXCD, off = wgid / NXCD; wgid = (xcd < r ? xcd * (q + 1) : r * (q + 1) + (xcd - r) * q) + off; }
        const int nig = WGM * nN, gid = wgid / nig, fm = gid * WGM, gsz = (nM - fm) < WGM ? (nM - fm) : WGM;
        u.pm = fm + ((wgid % nig) % gsz); u.pn = (wgid % nig) / gsz; return true;
    }
    __device__ __forceinline__ void a_ready(const Unit&) const {}
    __device__ __forceinline__ void done(const Unit&) const {}
};
__device__ __forceinline__ unsigned cvt_pk_bf16(float lo, float hi) { unsigned r; asm volatile("v_cvt_pk_bf16_f32 %0, %1, %2" : "=v"(r) : "v"(lo), "v"(hi)); return r; }
template <class Epi, class Sched, bool ALIGN_EPI = false, bool SP2 = false>
__device__ __forceinline__ void gemm_phase(LAS unsigned char* lds, const Gemm g, const Sched& S, const Epi& E) {
    int tid_ = threadIdx.x; asm volatile("" : "+v"(tid_));
    const int tid = tid_, wid = __builtin_amdgcn_readfirstlane(tid >> 6), lane = tid & 63, wr = wid >> 2, wc = wid & 3, fr = lane & 15, fq = lane >> 4;
    const int K = g.K, nt = K / BK;
    unsigned voffA[2], voffB[2];
#pragma unroll
    for (int i = 0; i < 2; ++i) { int R, C; stage_rc(tid * 16 + i * 8192, R, C); const int Rb = Epi::PERM ? ((R & ~31) + perm32(R & 31)) : R;
        voffA[i] = (unsigned)(R * K + C) * 2u; voffB[i] = (unsigned)(Rb * K + C) * 2u; }
    const size_t kstep = (size_t)(BK * 2);
    const size_t hstep = (size_t)HALF * K * 2;
    const size_t tstep = 2 * hstep;
    const unsigned ldsw = (unsigned)wid * 1024u;
    const int aoff = lds_byte(wr * 64 + fr, fq * 8), boff = lds_byte(wc * 32 + fr, fq * 8);
#define PG8_SA(b, h) (((b) * 2 + (h)) * HTB)
#define PG8_SB(b, h) ((4 + (b) * 2 + (h)) * HTB)
#define PG8_STAGE(bufoff, gbase, voff) do { _Pragma("unroll") for (int _i = 0; _i < 2; ++_i) \
        __builtin_amdgcn_global_load_lds((const unsigned*)((const char*)(gbase) + (voff)[_i]), (LAS unsigned*)(lds + (bufoff) + ldsw + _i * 8192), 16, 0, 0); } while (0)
#define PG8_LDA(dst, b, h) do { _Pragma("unroll") for (int m = 0; m < 4; ++m) _Pragma("unroll") for (int k = 0; k < 2; ++k) dst[m][k] = *(const LAS bf16x8*)(lds + PG8_SA(b, h) + aoff + m * 2048 + k * 1024); } while (0)
#define PG8_LDB(dst, b, h) do { _Pragma("unroll") for (int n = 0; n < 2; ++n) _Pragma("unroll") for (int k = 0; k < 2; ++k) dst[n][k] = *(const LAS bf16x8*)(lds + PG8_SB(b, h) + boff + n * 2048 + k * 1024); } while (0)
#define PG8_MMA(ai, bj, At, Bt) do { __builtin_amdgcn_s_setprio(1); _Pragma("unroll") for (int m = 0; m < 4; ++m) _Pragma("unroll") for (int n = 0; n < 2; ++n) _Pragma("unroll") for (int k = 0; k < 2; ++k) \
        acc[ai][bj][m][n] = __builtin_amdgcn_mfma_f32_16x16x32_bf16(Bt[n][k], At[m][k], acc[ai][bj][m][n], 0, 0, 0); __builtin_amdgcn_s_setprio(0); } while (0)
#define PG8_WAIT_V(n) asm volatile("s_waitcnt vmcnt(" #n ")" ::: "memory")
#define PG8_WAIT_L(n) asm volatile("s_waitcnt lgkmcnt(" #n ")" ::: "memory")
#define PG8_BAR __builtin_amdgcn_s_barrier()
#define PG8_SCHED __builtin_amdgcn_sched_barrier(0)
    Unit cur, nxt; int ui = 0;
    if (!S.next(0, cur)) return;
    f32x4 acc[2][2][4][2];
#pragma unroll
    for (int a = 0; a < 2; ++a)
#pragma unroll
        for (int b = 0; b < 2; ++b)
#pragma unroll
            for (int m = 0; m < 4; ++m)
#pragma unroll
                for (int n = 0; n < 2; ++n) acc[a][b][m][n] = (f32x4){0.f, 0.f, 0.f, 0.f};
    bf16x8 At[4][2], B0[2][2], B1[2][2];
    const char* cA = (const char*)g.A + (size_t)cur.pm * tstep; const char* cB = (const char*)g.Bt + (size_t)cur.pn * tstep;
    S.a_ready(cur);
    if constexpr (SP2) {
        PG8_STAGE(PG8_SB(0, 0), cB, voffB); PG8_STAGE(PG8_SB(0, 1), cB + hstep, voffB); PG8_STAGE(PG8_SA(0, 0), cA, voffA); PG8_STAGE(PG8_SA(0, 1), cA + hstep, voffA);
        if (wr == 1) PG8_BAR;
        PG8_WAIT_V(2); PG8_BAR;
        PG8_STAGE(PG8_SB(1, 0), cB + kstep, voffB); PG8_STAGE(PG8_SA(1, 0), cA + kstep, voffA); PG8_STAGE(PG8_SB(1, 1), cB + hstep + kstep, voffB);
        PG8_WAIT_V(6); PG8_BAR;
    } else {
        PG8_STAGE(PG8_SB(0, 0), cB, voffB); PG8_STAGE(PG8_SA(0, 0), cA, voffA); PG8_STAGE(PG8_SB(0, 1), cB + hstep, voffB); PG8_STAGE(PG8_SA(0, 1), cA + hstep, voffA);
        if (wr == 1) PG8_BAR;
        PG8_WAIT_V(4); PG8_BAR;
        PG8_STAGE(PG8_SB(1, 0), cB + kstep, voffB); PG8_STAGE(PG8_SA(1, 0), cA + kstep, voffA); PG8_STAGE(PG8_SB(1, 1), cB + hstep + kstep, voffB);
        PG8_WAIT_V(6); PG8_BAR;
    }
    for (;;) {
        const bool has_next = S.next(ui + 1, nxt);
        const char* nA = has_next ? (const char*)g.A + (size_t)nxt.pm * tstep : cA; const char* nB = has_next ? (const char*)g.Bt + (size_t)nxt.pn * tstep : cB;
#pragma unroll 1
        for (int t = 0; t < nt; t += 2) {
            const bool last = (t == nt - 2);
            const char* a1 = cA + (size_t)(t + 1) * kstep;
            const char* a2 = last ? nA : cA + (size_t)(t + 2) * kstep; const char* b2 = last ? nB : cB + (size_t)(t + 2) * kstep;
            const char* a3 = a2 + kstep; const char* b3 = b2 + kstep;
            if (last && has_next) S.a_ready(nxt);
            if constexpr (SP2) {
            PG8_LDB(B0, 0, 0); PG8_LDB(B1, 0, 1); PG8_SCHED; PG8_LDA(At, 0, 0); PG8_STAGE(PG8_SA(1, 1), a1 + hstep, voffA);
            PG8_WAIT_V(8); PG8_WAIT_L(0); PG8_BAR; PG8_MMA(0, 0, At, B0); PG8_MMA(0, 1, At, B1); PG8_BAR; PG8_SCHED;
            PG8_LDA(At, 0, 1); PG8_STAGE(PG8_SB(0, 0), b2, voffB); PG8_STAGE(PG8_SB(0, 1), b2 + hstep, voffB); PG8_STAGE(PG8_SA(0, 0), a2, voffA);
            PG8_WAIT_V(8); PG8_WAIT_L(0); PG8_BAR; PG8_MMA(1, 0, At, B0); PG8_MMA(1, 1, At, B1); PG8_BAR; PG8_SCHED;
            PG8_LDB(B0, 1, 0); PG8_LDB(B1, 1, 1); PG8_SCHED; PG8_LDA(At, 1, 0); PG8_STAGE(PG8_SA(0, 1), a2 + hstep, voffA);
            PG8_WAIT_V(8); PG8_WAIT_L(0); PG8_BAR; PG8_MMA(0, 0, At, B0); PG8_MMA(0, 1, At, B1); PG8_BAR; PG8_SCHED;
            PG8_LDA(At, 1, 1); PG8_STAGE(PG8_SB(1, 0), b3, voffB); PG8_STAGE(PG8_SB(1, 1), b3 + hstep, voffB); PG8_STAGE(PG8_SA(1, 0), a3, voffA);
            PG8_WAIT_V(8); PG8_WAIT_L(0); PG8_BAR; PG8_MMA(1, 0, At, B0); PG8_MMA(1, 1, At, B1); PG8_BAR; PG8_SCHED;
            } else {
            PG8_LDB(B0, 0, 0); PG8_SCHED; PG8_LDA(At, 0, 0); PG8_STAGE(PG8_SA(1, 1), a1 + hstep, voffA);
            PG8_WAIT_L(8); PG8_BAR; PG8_WAIT_L(0); PG8_MMA(0, 0, At, B0); PG8_BAR; PG8_SCHED;
            PG8_LDB(B1, 0, 1); PG8_STAGE(PG8_SB(0, 0), b2, voffB);
            PG8_BAR; PG8_WAIT_L(0); PG8_MMA(0, 1, At, B1); PG8_BAR;
            PG8_LDA(At, 0, 1); PG8_STAGE(PG8_SA(0, 0), a2, voffA);
            PG8_BAR; PG8_WAIT_L(0); PG8_MMA(1, 0, At, B0); PG8_BAR; PG8_SCHED;
            PG8_STAGE(PG8_SB(0, 1), b2 + hstep, voffB);
            PG8_WAIT_V(6); PG8_BAR; PG8_MMA(1, 1, At, B1); PG8_BAR;
            PG8_LDB(B0, 1, 0); PG8_SCHED; PG8_LDA(At, 1, 0); PG8_STAGE(PG8_SA(0, 1), a2 + hstep, voffA);
            PG8_WAIT_L(8); PG8_BAR; PG8_WAIT_L(0); PG8_MMA(0, 0, At, B0); PG8_BAR; PG8_SCHED;
            PG8_LDB(B1, 1, 1); PG8_STAGE(PG8_SB(1, 0), b3, voffB);
            PG8_BAR; PG8_WAIT_L(0); PG8_MMA(0, 1, At, B1); PG8_BAR;
            PG8_LDA(At, 1, 1); PG8_STAGE(PG8_SA(1, 0), a3, voffA);
            PG8_BAR; PG8_WAIT_L(0); PG8_MMA(1, 0, At, B0); PG8_BAR; PG8_SCHED;
            PG8_STAGE(PG8_SB(1, 1), b3 + hstep, voffB);
            PG8_WAIT_V(6); PG8_BAR; PG8_MMA(1, 1, At, B1); PG8_BAR;
            }
        }
        if constexpr (ALIGN_EPI) { if (wr == 0) PG8_BAR; }
        if constexpr (!Epi::AFTER_DRAIN) { E(acc, cur, wr, wc, fr, fq); S.done(cur); }
        if (!has_next) break;
#pragma unroll
        for (int a = 0; a < 2; ++a)
#pragma unroll
            for (int b = 0; b < 2; ++b)
#pragma unroll
                for (int m = 0; m < 4; ++m)
#pragma unroll
                    for (int n = 0; n < 2; ++n) acc[a][b][m][n] = (f32x4){0.f, 0.f, 0.f, 0.f};
        cur = nxt; cA = nA; cB = nB; ++ui;
        if constexpr (ALIGN_EPI) { if (wr == 1) PG8_BAR; }
    }
    PG8_WAIT_V(0);
    if constexpr (!ALIGN_EPI) { if (wr == 0) PG8_BAR; }
    PG8_BAR;
    if constexpr (Epi::AFTER_DRAIN) { E.fused(acc, cur, wr, wc, fr, fq, lds, wid, lane); S.done(cur); }
#undef PG8_SA
#undef PG8_SB
#undef PG8_STAGE
#undef PG8_LDA
#undef PG8_LDB
#undef PG8_MMA
#undef PG8_WAIT_V
#undef PG8_WAIT_L
#undef PG8_BAR
#undef PG8_SCHED
}
}
namespace pg8 {
typedef const f32x4 (&AccRef)[2][2][4][2];

struct EpiStore {
    static constexpr bool PERM = true, AFTER_DRAIN = false;
    bf16_t* O; int ldc; int act; int split_cols; size_t split_stride; int gate_pn; float* G; const float* bgate;
    __device__ __forceinline__ void operator()(AccRef acc, const Unit& u, int wr, int wc, int fr, int fq) const {
        const int row0 = u.pm * BM + wr * 64 + fr;
        if (u.pn == gate_pn) {
            if (wc == 0) {
#pragma unroll
                for (int n = 0; n < 2; ++n) {
                    const int c0 = 8 * fq + 4 * n;
                    const f32x4 bg = *(const f32x4*)(bgate + c0);
                    const bool isf = (c0 & 8) != 0;
#pragma unroll
                    for (int ai = 0; ai < 2; ++ai)
#pragma unroll
                        for (int m = 0; m < 4; ++m) {
                            f32x4 v = acc[ai][0][m][n] + bg, o;
#pragma unroll
                            for (int j = 0; j < 4; ++j) { const float cpd = 15.0f * tanhf_(v[j] * (1.0f / 15.0f)); const float eu = __expf(-cpd); o[j] = isf ? -(eu < 9.765625e-4f ? eu - 0.5f * eu * eu : __logf(1.0f + eu)) : cpd; }
                            *(f32x4*)(G + (size_t)(row0 + ai * HALF + m * 16) * 32 + c0) = o;
                        }
                }
            }
            return;
        }
        int colt = u.pn * BM; bf16_t* base = O;
        if (split_cols) { const int t = colt / split_cols; base += (size_t)t * split_stride; colt -= t * split_cols; }
        const int col0 = colt + wc * 32 + 8 * fq;
#pragma unroll
        for (int ai = 0; ai < 2; ++ai)
#pragma unroll
            for (int m = 0; m < 4; ++m) { bf16_t* rowp = base + (size_t)(row0 + ai * HALF + m * 16) * ldc + col0;
#pragma unroll
                for (int bj = 0; bj < 2; ++bj) { f32x4 v0 = acc[ai][bj][m][0], v1 = acc[ai][bj][m][1];
                    if (act == 1) {
#pragma unroll
                        for (int j = 0; j < 4; ++j) { v0[j] = tanhf_(v0[j]); v1[j] = tanhf_(v1[j]); } }
                    else if (act == 2) {
#pragma unroll
                        for (int j = 0; j < 4; ++j) { v0[j] = sigmoidf_(v0[j]); v1[j] = sigmoidf_(v1[j]); } }
                    u32x4 w; w.x = cvt_pk_bf16(v0[0], v0[1]); w.y = cvt_pk_bf16(v0[2], v0[3]); w.z = cvt_pk_bf16(v1[0], v1[1]); w.w = cvt_pk_bf16(v1[2], v1[3]);
                    *(u32x4*)(rowp + bj * HALF) = w; } }
    }
};

struct EpiSigAff {
    static constexpr bool PERM = true, AFTER_DRAIN = false;
    bf16_t* O; size_t split_stride; const float* bias; float scale;
    __device__ __forceinline__ void operator()(AccRef acc, const Unit& u, int wr, int wc, int fr, int fq) const {
        const int row0 = u.pm * BM + wr * 64 + fr;
        int colt = u.pn * BM; const int t = colt / D; bf16_t* base = O + (size_t)t * split_stride; colt -= t * D;
        const int col0 = colt + wc * 32 + 8 * fq, bcol0 = u.pn * BM + wc * 32 + 8 * fq;
        f32x4 bv[2][2];
#pragma unroll
        for (int bj = 0; bj < 2; ++bj)
#pragma unroll
            for (int n = 0; n < 2; ++n) bv[bj][n] = *(const f32x4*)(bias + bcol0 + bj * HALF + 4 * n);
#pragma unroll
        for (int ai = 0; ai < 2; ++ai)
#pragma unroll
            for (int m = 0; m < 4; ++m) { bf16_t* rowp = base + (size_t)(row0 + ai * HALF + m * 16) * D + col0;
#pragma unroll
                for (int bj = 0; bj < 2; ++bj) { f32x4 v0 = acc[ai][bj][m][0] + bv[bj][0], v1 = acc[ai][bj][m][1] + bv[bj][1];
#pragma unroll
                    for (int j = 0; j < 4; ++j) { v0[j] = scale * sigmoidf_(v0[j]); v1[j] = scale * sigmoidf_(v1[j]); }
                    u32x4 w; w.x = cvt_pk_bf16(v0[0], v0[1]); w.y = cvt_pk_bf16(v0[2], v0[3]); w.z = cvt_pk_bf16(v1[0], v1[1]); w.w = cvt_pk_bf16(v1[2], v1[3]);
                    *(u32x4*)(rowp + bj * HALF) = w; } }
    }
};

struct EpiVmix {
    static constexpr bool PERM = true, AFTER_DRAIN = false;
    bf16_t* V; const bf16_t* VF; const float* v0;
    __device__ __forceinline__ void operator()(AccRef acc, const Unit& u, int wr, int wc, int fr, int fq) const {
        const int row0 = u.pm * BM + wr * 64 + fr; const int col0 = u.pn * BM + wc * 32 + 8 * fq;
        f32x4 bv[2][2];
#pragma unroll
        for (int bj = 0; bj < 2; ++bj)
#pragma unroll
            for (int n = 0; n < 2; ++n) bv[bj][n] = *(const f32x4*)(v0 + col0 + bj * HALF + 4 * n);
#pragma unroll
        for (int ai = 0; ai < 2; ++ai) {
            u32x4 vvs[4][2], ffs[4][2];
#pragma unroll
            for (int m = 0; m < 4; ++m) { const size_t off = (size_t)(row0 + ai * HALF + m * 16) * D + col0;
#pragma unroll
                for (int bj = 0; bj < 2; ++bj) { vvs[m][bj] = *(const u32x4*)(V + off + bj * HALF); ffs[m][bj] = *(const u32x4*)(VF + off + bj * HALF); } }
            asm volatile("" ::: "memory");
#pragma unroll
            for (int m = 0; m < 4; ++m) { const size_t off = (size_t)(row0 + ai * HALF + m * 16) * D + col0;
#pragma unroll
                for (int bj = 0; bj < 2; ++bj) {
                    const u32x4 vv = vvs[m][bj], ff = ffs[m][bj];
                    const f32x4 a0 = acc[ai][bj][m][0] + bv[bj][0], a1 = acc[ai][bj][m][1] + bv[bj][1];
                    float o[8];
#pragma unroll
                    for (int j = 0; j < 4; ++j) {
                        const unsigned vw = j == 0 ? vv.x : j == 1 ? vv.y : j == 2 ? vv.z : vv.w, fw = j == 0 ? ff.x : j == 1 ? ff.y : j == 2 ? ff.z : ff.w;
                        const float s0 = sigmoidf_(j < 2 ? a0[2 * j] : a1[2 * j - 4]), s1 = sigmoidf_(j < 2 ? a0[2 * j + 1] : a1[2 * j - 3]);
                        const float x0 = lo_bf(vw), x1 = hi_bf(vw), f0 = lo_bf(fw), f1 = hi_bf(fw);
                        o[2 * j] = x0 + (f0 - x0) * s0; o[2 * j + 1] = x1 + (f1 - x1) * s1; }
                    u32x4 w; w.x = cvt_pk_bf16(o[0], o[1]); w.y = cvt_pk_bf16(o[2], o[3]); w.z = cvt_pk_bf16(o[4], o[5]); w.w = cvt_pk_bf16(o[6], o[7]);
                    *(u32x4*)(V + off + bj * HALF) = w; } }
            asm volatile("" ::: "memory"); }
    }
};

struct EpiResid {
    static constexpr bool PERM = false, AFTER_DRAIN = false;
    float* X; const float* gate; int tile0; const float* srcx; const float* srcc;
    __device__ __forceinline__ void operator()(AccRef acc, const Unit& u, int wr, int wc, int fr, int fq) const {
        const int gpm = tile0 + u.pm; const int b = gpm / 9, tix = gpm % 9; const int idx = (tix == 0) ? 16 : b;
        const int rloc = wr * 64 + fr, col0 = u.pn * BM + wc * 32 + 4 * fq;
        const float* src = srcx ? (tix == 0 ? srcc + (size_t)b * CTXL * D : srcx + ((size_t)b * SEQ + (size_t)(tix - 1) * BM) * D) : X + (size_t)gpm * BM * D;
        float* dst = X + (size_t)gpm * BM * D;
        f32x4 gv[2][2];
#pragma unroll
        for (int bj = 0; bj < 2; ++bj)
#pragma unroll
            for (int n = 0; n < 2; ++n) gv[bj][n] = *(const f32x4*)(gate + (size_t)idx * MODLD + col0 + bj * HALF + n * 16);
        f32x4 (&ac)[2][2][4][2] = const_cast<f32x4 (&)[2][2][4][2]>(acc);
        f32x4 xa[2][2], xb[2][2];
#define RES_LD(dstv, ai_, m_) do { const size_t off_ = (size_t)(rloc + (ai_) * HALF + (m_) * 16) * D + col0; _Pragma("unroll") for (int bj = 0; bj < 2; ++bj) _Pragma("unroll") for (int n = 0; n < 2; ++n) \
            dstv[bj][n] = *(const f32x4*)(src + off_ + bj * HALF + n * 16); } while (0)
#define RES_FMA(srcv, ai_, m_) do { _Pragma("unroll") for (int bj = 0; bj < 2; ++bj) _Pragma("unroll") for (int n = 0; n < 2; ++n) ac[ai_][bj][m_][n] = srcv[bj][n] + gv[bj][n] * ac[ai_][bj][m_][n]; } while (0)
        RES_LD(xa, 0, 0); RES_LD(xb, 0, 1);
        RES_FMA(xa, 0, 0); RES_LD(xa, 0, 2); RES_FMA(xb, 0, 1); RES_LD(xb, 0, 3);
        RES_FMA(xa, 0, 2); RES_LD(xa, 1, 0); RES_FMA(xb, 0, 3); RES_LD(xb, 1, 1);
        RES_FMA(xa, 1, 0); RES_LD(xa, 1, 2); RES_FMA(xb, 1, 1); RES_LD(xb, 1, 3);
        RES_FMA(xa, 1, 2); RES_FMA(xb, 1, 3);
#undef RES_LD
#undef RES_FMA
        asm volatile("" ::: "memory");
#pragma unroll
        for (int ai = 0; ai < 2; ++ai)
#pragma unroll
            for (int m = 0; m < 4; ++m) { const size_t off = (size_t)(rloc + ai * HALF + m * 16) * D + col0;
#pragma unroll
                for (int bj = 0; bj < 2; ++bj)
#pragma unroll
                    for (int n = 0; n < 2; ++n) *(f32x4*)(dst + off + bj * HALF + n * 16) = ac[ai][bj][m][n]; }
    }
};

struct EpiSwiglu {
    static constexpr bool PERM = true, AFTER_DRAIN = false;
    bf16_t* O;
    __device__ __forceinline__ void operator()(AccRef acc, const Unit& u, int wr, int wc, int fr, int fq) const {
        const int row0 = u.pm * BM + wr * 64 + fr; const int col0 = u.pn * HALF + wc * 32 + 8 * fq;
#pragma unroll
        for (int ai = 0; ai < 2; ++ai)
#pragma unroll
            for (int m = 0; m < 4; ++m) { bf16_t* rowp = O + (size_t)(row0 + ai * HALF + m * 16) * DFF + col0;
                f32x4 v0, v1;
#pragma unroll
                for (int j = 0; j < 4; ++j) { v0[j] = siluf_(acc[ai][0][m][0][j]) * acc[ai][1][m][0][j]; v1[j] = siluf_(acc[ai][0][m][1][j]) * acc[ai][1][m][1][j]; }
                u32x4 w; w.x = cvt_pk_bf16(v0[0], v0[1]); w.y = cvt_pk_bf16(v0[2], v0[3]); w.z = cvt_pk_bf16(v1[0], v1[1]); w.w = cvt_pk_bf16(v1[2], v1[3]);
                *(u32x4*)rowp = w; }
    }
};
}

namespace pg8 {
struct SkipCtxOrder : StaticOrder {
    __device__ __forceinline__ bool next(int i, Unit& u) const { if (!StaticOrder::next(i, u)) return false; u.pm = u.pm + (u.pm >> 3) + 1; return true; }
};
}
template <class Epi, bool SKIPCTX = false>
__device__ __forceinline__ void run_gemm(LAS unsigned char* lds, const bf16_t* A, const bf16_t* Bt, int M, int N, int K, const Epi& E, int& urot) {
    pg8::Gemm g{A, Bt, M, N, K};
    const int G = (int)gridDim.x; const int Meff = SKIPCTX ? (M / 9) * 8 : M; const int nwg = (Meff / 256) * (N / 256);
    const int c = ((int)blockIdx.x + G - (urot % G)) % G;
    if constexpr (SKIPCTX) { pg8::SkipCtxOrder S; S.init(Meff, N, G, c); pg8::gemm_phase<Epi, pg8::SkipCtxOrder, GP_ALIGN, GP_SP2>(lds, g, S, E); }
    else { pg8::StaticOrder S; S.init(M, N, G, c); pg8::gemm_phase<Epi, pg8::StaticOrder, GP_ALIGN, GP_SP2>(lds, g, S, E); }
    urot += nwg;
}
struct Args { const float* in[NIN]; float* out; unsigned char* ws; int ph_lo, ph_hi; };
static_assert(sizeof(Args) == NIN * 8 + 8 + 8 + 8, "Args has no padding");

typedef const __attribute__((address_space(4))) Args* CArgs;
__device__ __forceinline__ CArgs opaque_args() { CArgs p = (CArgs)__builtin_amdgcn_kernarg_segment_ptr(); asm volatile("" : "+s"(p)); return p; }
struct Tc { LAS unsigned char* lds; int tid, lane, wave, bid, G, gw, ngw; };
__device__ __forceinline__ Tc mk_tc(LAS unsigned char* lds) { Tc t; int tid = threadIdx.x; asm volatile("" : "+v"(tid)); t.lds = lds; t.tid = tid; t.lane = tid & 63; t.wave = __builtin_amdgcn_readfirstlane(tid >> 6);
    t.bid = blockIdx.x; t.G = gridDim.x; t.gw = t.bid * 8 + t.wave; t.ngw = t.G * 8; return t; }

template <class RM>
__device__ __forceinline__ void tr_item(const float* W, int ldw, bf16_t* WT, int ldk, const RM& rm, LAS float* scr, int kb, int nb, int lane) {
    const int k0 = 64 * kb, n0 = 32 * nb;
    float tmp[32];
#pragma unroll
    for (int i = 0; i < 32; ++i) { const int kk = 2 * i + (lane >> 5); tmp[i] = W[(size_t)(k0 + kk) * ldw + n0 + (lane & 31)]; }
    asm volatile("" ::: "memory");
#pragma unroll
    for (int i = 0; i < 32; ++i) { const int kk = 2 * i + (lane >> 5); scr[kk * 33 + (lane & 31)] = tmp[i]; }
    LDS_WAIT();
    const int c = lane & 7;
#pragma unroll
    for (int j = 0; j < 4; ++j) { const int n = (lane >> 3) + 8 * j; const LAS float* s = scr + (8 * c) * 33 + n;
        u32x4 o; o.x = pk2(s[0 * 33], s[1 * 33]); o.y = pk2(s[2 * 33], s[3 * 33]); o.z = pk2(s[4 * 33], s[5 * 33]); o.w = pk2(s[6 * 33], s[7 * 33]);
        *(u32x4*)(WT + (size_t)rm(n0 + n) * ldk + k0 + 8 * c) = o; }
    LDS_WAIT();
}
struct RmId { __device__ __forceinline__ int operator()(int n) const { return n; } };
struct RmSwiglu { __device__ __forceinline__ int operator()(int n) const { const int up = n >= DFF ? 1 : 0; const int m = n - up * DFF; return 256 * (m >> 7) + 128 * up + (m & 127); } };

template <class RM>
__device__ __forceinline__ void tr_matrix(const Tc& t, const float* W, int K, int N, int ldw, bf16_t* WT, int ldk, const RM& rm) {
    LAS float* scr = (LAS float*)(t.lds + t.wave * 16384);
    const int nkb = K / 64, nnb = N / 32, items = nkb * nnb;
    for (int it = t.gw; it < items; it += t.ngw) tr_item(W, ldw, WT, ldk, rm, scr, it / nnb, it % nnb, t.lane);
}
template <class SRC>
__device__ __forceinline__ void build_small(const Tc& t, bf16_t* dst, int NR, int KC, const SRC& src) {
    const int total = NR * (KC / 8);
    for (int i = t.gw * 64 + t.lane; i < total; i += t.ngw * 64) { const int n = i % NR, ko = i / NR;
        float v[8];
#pragma unroll
        for (int j = 0; j < 8; ++j) v[j] = src(n, 8 * ko + j);
        u32x4 o; o.x = pk2(v[0], v[1]); o.y = pk2(v[2], v[3]); o.z = pk2(v[4], v[5]); o.w = pk2(v[6], v[7]);
        *(u32x4*)(dst + (size_t)n * KC + 8 * ko) = o; }
}

__device__ __forceinline__ void convert_rwkv(const Tc& t, CArgs a, int jl) {
    bf16_t* wm = (bf16_t*)(a->ws + WS_WMIX);
    const size_t dd = (size_t)D * D;
    tr_matrix(t, a->in[I_WR] + jl * dd, D, D, D, (bf16_t*)((char*)wm + WM_R), D, RmId());
    tr_matrix(t, a->in[I_WK] + jl * dd, D, D, D, (bf16_t*)((char*)wm + WM_K), D, RmId());
    tr_matrix(t, a->in[I_WV] + jl * dd, D, D, D, (bf16_t*)((char*)wm + WM_V), D, RmId());
    tr_matrix(t, a->in[I_WO] + jl * dd, D, D, D, (bf16_t*)((char*)wm + WM_O), D, RmId());
    { const float* w1 = a->in[I_W1] + (size_t)jl * 2 * D * 96;
      build_small(t, (bf16_t*)((char*)wm + WM_W1), 256, D, [=](int n, int k) -> float { if (n >= 192) return 0.f; const int z = n >= 96 ? 1 : 0, r = n - 96 * z; return w1[((size_t)z * D + k) * 96 + r]; }); }
    { const float* a1 = a->in[I_A1] + (size_t)jl * 2 * D * 96;
      build_small(t, (bf16_t*)((char*)wm + WM_A1), 256, D, [=](int n, int k) -> float { if (n >= 192) return 0.f; const int z = n >= 96 ? 1 : 0, r = n - 96 * z; return a1[((size_t)z * D + k) * 96 + r]; }); }
    { const float* g1 = a->in[I_G1] + (size_t)jl * D * 256;
      build_small(t, (bf16_t*)((char*)wm + WM_G1), 256, D, [=](int n, int k) -> float { return g1[(size_t)k * 256 + n]; }); }
    if (jl > 0) { const float* v1 = a->in[I_V1] + (size_t)(jl - 1) * D * 64;
      build_small(t, (bf16_t*)((char*)wm + WM_V1), 256, D, [=](int n, int k) -> float { return n < 64 ? v1[(size_t)k * 64 + n] : 0.f; }); }
    { const float* w2 = a->in[I_W2] + (size_t)jl * 2 * 96 * D;
      build_small(t, (bf16_t*)((char*)wm + WM_W2), 2 * D, 256, [=](int n, int k) -> float { const int z = n >= D ? 1 : 0, ch = n - z * D, kk = k - 96 * z; return (kk >= 0 && kk < 96) ? w2[((size_t)z * 96 + kk) * D + ch] : 0.f; }); }
    { const float* a2 = a->in[I_A2] + (size_t)jl * 2 * 96 * D;
      build_small(t, (bf16_t*)((char*)wm + WM_A2), 2 * D, 256, [=](int n, int k) -> float { const int z = n >= D ? 1 : 0, ch = n - z * D, kk = k - 96 * z; return (kk >= 0 && kk < 96) ? a2[((size_t)z * 96 + kk) * D + ch] : 0.f; }); }
    { const float* g2 = a->in[I_G2] + (size_t)jl * 256 * D;
      build_small(t, (bf16_t*)((char*)wm + WM_G2), D, 256, [=](int n, int k) -> float { return g2[(size_t)k * D + n]; }); }
    if (jl > 0) { const float* v2 = a->in[I_V2] + (size_t)(jl - 1) * 64 * D;
      build_small(t, (bf16_t*)((char*)wm + WM_V2), D, 256, [=](int n, int k) -> float { return k < 64 ? v2[(size_t)k * D + n] : 0.f; }); }
}
__device__ __forceinline__ void convert_mlstm(const Tc& t, CArgs a, int jl) {
    bf16_t* win = (bf16_t*)(a->ws + WS_WMIX + WM_MIN); bf16_t* wout = (bf16_t*)(a->ws + WS_WMIX + WM_MOUT);
    tr_matrix(t, a->in[I_MWIN] + (size_t)jl * D * MPROJ, D, MPROJ, MPROJ, win, D, RmId());
    { u32x4* z = (u32x4*)(win + (size_t)MPROJ * D); const int total = (6400 - MPROJ) * D / 8; unsigned zz = 0u; asm volatile("" : "+v"(zz)); const u32x4 zero = {zz, zz, zz, zz};
      for (int i = t.gw * 64 + t.lane; i < total; i += t.ngw * 64) z[i] = zero; }
    tr_matrix(t, a->in[I_MWOUT] + (size_t)jl * D * D, D, D, D, wout, D, RmId());
}
__device__ __forceinline__ void convert_ffn_in(const Tc& t, CArgs a, int layer) {
    tr_matrix(t, a->in[I_FWIN] + (size_t)layer * D * 2 * DFF, D, 2 * DFF, 2 * DFF, (bf16_t*)(a->ws + WS_WFFN + WF_IN), D, RmSwiglu());
}
__device__ __forceinline__ void convert_ffn_out(const Tc& t, CArgs a, int layer) {
    tr_matrix(t, a->in[I_FWOUT] + (size_t)layer * DFF * D, DFF, D, D, (bf16_t*)(a->ws + WS_WFFN + WF_OUT), DFF, RmId());
}
__device__ __forceinline__ bool tail_crew(const Tc& t, int urot0, int nwg, Tc& ts) {
    const int G = t.G, r = nwg % G, c = (t.bid + G - (urot0 % G)) % G;
    ts = t;
    if (r == 0) return true;
    if (c < r) return false;
    ts.bid = c - r; ts.G = G - r; ts.gw = ts.bid * 8 + t.wave; ts.ngw = ts.G * 8; return true;
}

__device__ __forceinline__ void ph_prologue(const Tc& t, CArgs a) {
    LAS float* S = (LAS float*)t.lds;
    { f32x4 cv[17];
#pragma unroll
      for (int b = 0; b < 17; ++b) cv[b] = *(const f32x4*)((b < 16 ? a->in[I_C] + (size_t)b * D : a->in[I_CCTX]) + 4 * t.tid);
      const int k = 4 * t.tid;
#pragma unroll
      for (int b = 0; b < 17; ++b) { const f32x4 s = {siluf_(cv[b][0]), siluf_(cv[b][1]), siluf_(cv[b][2]), siluf_(cv[b][3])};
          *(LAS f32x4*)(S + b * 2056 + (k >> 10) * 1028 + (k & 1023)) = s; } }
    __syncthreads();
    float* mod = (float*)(a->ws + WS_MOD);
    const int col = t.lane & 31, kh = t.lane >> 5;
    for (int it = t.wave * t.G + t.bid; it < 4 * 384; it += t.ngw) { const int layer = it / 384, n0 = 32 * (it % 384);
        const auto wrs = __builtin_amdgcn_make_buffer_rsrc((void*)(a->in[I_MODW] + (size_t)layer * D * MODLD), (short)0, (int)((size_t)D * MODLD * 4), 0x00020000);
        const unsigned voff = (unsigned)(kh * 1024 * MODLD + n0 + col) * 4u;
        const LAS float* Sk = S + kh * 1028;
        f32x2 acc[17];
#pragma unroll
        for (int b = 0; b < 17; ++b) acc[b] = (f32x2){0.f, 0.f};
        float wa[8], wb[8];
#define MOD_LD(dst, k0_) do { _Pragma("unroll") for (int j = 0; j < 8; ++j) dst[j] = __builtin_bit_cast(float, __builtin_amdgcn_raw_buffer_load_b32(wrs, voff, (unsigned)(((k0_) + j) * MODLD * 4), 0)); } while (0)
#define MOD_FMA(src, k0_) do { _Pragma("unroll") for (int j4 = 0; j4 < 2; ++j4) { _Pragma("unroll") for (int b = 0; b < 17; ++b) { const f32x4 s = *(const LAS f32x4*)(Sk + b * 2056 + (k0_) + 4 * j4); \
            acc[b] = acc[b] + (f32x2){s[0], s[1]} * (f32x2){src[4 * j4], src[4 * j4 + 1]} + (f32x2){s[2], s[3]} * (f32x2){src[4 * j4 + 2], src[4 * j4 + 3]}; } asm volatile("" ::: "memory"); } } while (0)
        MOD_LD(wa, 0);
#pragma unroll 1
        for (int k0 = 0; k0 < 1024; k0 += 16) {
            MOD_LD(wb, k0 + 8);
            MOD_FMA(wa, k0);
            if (k0 + 16 < 1024) MOD_LD(wa, k0 + 16);
            MOD_FMA(wb, k0 + 8); }
#undef MOD_LD
#undef MOD_FMA
#pragma unroll
        for (int b = 0; b < 17; ++b) { float v = acc[b].x + acc[b].y; v += shfl_xor_(v, 32, t.lane);
            if (kh == 0) mod[((size_t)layer * 17 + b) * MODLD + n0 + col] = v + a->in[I_MODB][layer * MODLD + n0 + col]; } }
    __syncthreads();
}

template <bool OUT_BF16>
__device__ __forceinline__ void norm_rows(const Tc& t, CArgs a, int layer, int which, int row_begin, int nrows, void* out, bool from_inputs = false) {
    const float* xres = (const float*)(a->ws + WS_XRES);
    const float* mod = (const float*)(a->ws + WS_MOD) + (size_t)layer * 17 * MODLD;
    const int npw = (nrows + t.ngw - 1) / t.ngw;
    f32x4 gg[8], gm[8], sh[8];
    { const f32x4* gp = (const f32x4*)(a->in[I_NORMG] + (size_t)(layer * 2 + which) * D) + t.lane;
#pragma unroll
      for (int j = 0; j < 8; ++j) gg[j] = gp[64 * j]; }
    int cur_idx = -1;
    auto rowptr = [&](int r) -> const f32x4* { const int grow = row_begin + r; const int gb = grow / SROW, gs = grow % SROW;
        const float* rp = from_inputs ? (gs < CTXL ? a->in[I_CTX] + ((size_t)gb * CTXL + gs) * D : a->in[I_X] + ((size_t)gb * SEQ + (gs - CTXL)) * D) : xres + (size_t)grow * D;
        return (const f32x4*)rp + t.lane; };
    const int rfirst = t.gw * npw;
    if (rfirst >= nrows) return;
    const int nmine = (nrows - rfirst) < npw ? (nrows - rfirst) : npw;
    f32x4 xn[8];
    { const f32x4* xr = rowptr(rfirst);
#pragma unroll
      for (int j = 0; j < 8; ++j) xn[j] = xr[64 * j]; }
    for (int i = 0; i < nmine; ++i) { const int r = rfirst + i; const int grow = row_begin + r; const int idx = (grow % SROW) < CTXL ? 16 : grow / SROW;
        f32x4 v[8];
#pragma unroll
        for (int j = 0; j < 8; ++j) v[j] = xn[j];
        if (idx != cur_idx) { cur_idx = idx;
            const f32x4* shp = (const f32x4*)(mod + (size_t)idx * MODLD + (3 * which) * D) + t.lane; const f32x4* scp = (const f32x4*)(mod + (size_t)idx * MODLD + (3 * which + 1) * D) + t.lane;
#pragma unroll
            for (int j = 0; j < 8; ++j) { sh[j] = shp[64 * j]; gm[j] = gg[j] * (scp[64 * j] + 1.0f); } }
        if (i + 1 < nmine) { const f32x4* xr = rowptr(r + 1);
#pragma unroll
            for (int j = 0; j < 8; ++j) xn[j] = xr[64 * j]; }
        asm volatile("" ::: "memory");
        float ss = 0.f;
#pragma unroll
        for (int j = 0; j < 8; ++j) ss += (v[j].x * v[j].x + v[j].y * v[j].y) + (v[j].z * v[j].z + v[j].w * v[j].w);
        const float rstd = rsqrtf(wave_sum_dpp(ss) * (1.0f / D) + 1e-6f);
#pragma unroll
        for (int j = 0; j < 8; ++j) { const f32x4 o = v[j] * rstd * gm[j] + sh[j];
            if (OUT_BF16) { u32x2 w; w.x = pk2(o.x, o.y); w.y = pk2(o.z, o.w); ((u32x2*)((bf16_t*)out + (size_t)r * D))[64 * j + t.lane] = w; }
            else ((f32x4*)((float*)out + (size_t)r * D))[64 * j + t.lane] = o; }
        asm volatile("" ::: "memory");
    }
}

__device__ __forceinline__ void r2_mix(const Tc& t, CArgs a, int jl) {
    const bf16_t* H = (const bf16_t*)(a->ws + WS_ACT + AR_H);
    const int sl = t.gw & 3, c0 = 512 * sl + 8 * t.lane;
    const float* mu = a->in[I_MU] + (size_t)jl * 6 * D + c0;
    f32x4 m0[6], m1[6];
#pragma unroll
    for (int m = 0; m < 6; ++m) { m0[m] = *(const f32x4*)(mu + m * D); m1[m] = *(const f32x4*)(mu + m * D + 4); }
    const int rstep = t.ngw >> 2;
    for (int r0 = t.gw >> 2; r0 < TG; r0 += 4 * rstep) {
        u32x4 hw[4], nw[4];
#pragma unroll
        for (int k = 0; k < 4; ++k) { const int r = r0 + k * rstep; hw[k] = (u32x4){0u, 0u, 0u, 0u}; nw[k] = hw[k];
            if (r < TG) { const int s = r % SROW; int nr;
                if (s < CTXL) nr = sl < 2 ? (s > 0 ? r - 1 : -1) : (s < CTXL - 1 ? r + 1 : -1);
                else { const int i = s - CTXL, gr = i >> 6, gc = i & 63; nr = sl == 0 ? (gc > 0 ? r - 1 : -1) : sl == 1 ? (gc < 63 ? r + 1 : -1) : sl == 2 ? (gr > 0 ? r - 64 : -1) : (gr < 31 ? r + 64 : -1); }
                hw[k] = *(const u32x4*)(H + (size_t)r * D + c0);
                if (nr >= 0) nw[k] = *(const u32x4*)(H + (size_t)nr * D + c0); } }
        asm volatile("" ::: "memory");
#pragma unroll
        for (int k = 0; k < 4; ++k) { const int r = r0 + k * rstep;
            if (r < TG) {
                const f32x4 h0 = {lo_bf(hw[k].x), hi_bf(hw[k].x), lo_bf(hw[k].y), hi_bf(hw[k].y)}, h1 = {lo_bf(hw[k].z), hi_bf(hw[k].z), lo_bf(hw[k].w), hi_bf(hw[k].w)};
                const f32x4 n0 = {lo_bf(nw[k].x), hi_bf(nw[k].x), lo_bf(nw[k].y), hi_bf(nw[k].y)}, n1 = {lo_bf(nw[k].z), hi_bf(nw[k].z), lo_bf(nw[k].w), hi_bf(nw[k].w)};
                const f32x4 x0 = n0 - h0, x1 = n1 - h1;
#pragma unroll
                for (int m = 0; m < 6; ++m) { const f32x4 o0 = h0 + x0 * m0[m], o1 = h1 + x1 * m1[m];
                    u32x4 w; w.x = pk2(o0.x, o0.y); w.y = pk2(o0.z, o0.w); w.z = pk2(o1.x, o1.y); w.w = pk2(o1.z, o1.w);
                    *(u32x4*)(a->ws + WS_ACT + AR_MIX + (size_t)m * SLOT + ((size_t)r * D + c0) * 2) = w; } } }
        asm volatile("" ::: "memory");
    }
}

constexpr int R5_L = 16;
constexpr int R5_ZR = 0, R5_BK = 4608, R5_BKT = 9216, R5_V = 14336, R5_GL = 18432, R5_CH = 18688;
constexpr int R5_BUF = 2 * R5_CH;
constexpr int R5_GR = 2 * R5_BUF;
constexpr int R5_GRCH = 3072;
constexpr int R5_DS = R5_GR + 2 * R5_GRCH;
constexpr int R5_YS = R5_DS + 8 * 1024;
constexpr int R5_PW = R5_YS + 2 * 2 * 4096;
constexpr int R5_END = R5_PW + 4 * 8192 + 512;
static_assert(R5_END <= LDSCTL_OFF, "scan LDS");
__device__ __forceinline__ int r5_seq(int z, int tt) { return z == 0 ? tt : (tt < CTXL ? CTXL - 1 - tt : SROW + CTXL - 1 - tt); }

__device__ __forceinline__ void r5_scan(const Tc& t, CArgs a, int jl, int layer, int g) {
    const bf16_t* R = (const bf16_t*)(a->ws + WS_ACT + AR_R);
    const bf16_t* Kb = (const bf16_t*)(a->ws + WS_ACT + AR_K);
    const bf16_t* Vb = (layer == 0) ? (const bf16_t*)(a->ws + WS_VF) + (size_t)g * TG * D : (const bf16_t*)(a->ws + WS_ACT + AR_V);
    const int w = t.wave, lane = t.lane, c2 = w >> 2, q = w & 3, l15 = lane & 15, q4 = lane >> 4;
    for (int pair = t.bid; pair < BG * RH; pair += t.G) {
        const int z = pair / (BG * RH / 2), bl = (pair / (RH / 2)) % BG, h = 2 * (pair % (RH / 2)) + c2;
        const bf16_t* E = (const bf16_t*)(a->ws + WS_ACT + AR_MIX + (size_t)z * SLOT);
        const bf16_t* Aa = (const bf16_t*)(a->ws + WS_ACT + AR_MIX + (size_t)(2 + z) * SLOT);
        bf16_t* Y = (bf16_t*)(a->ws + WS_ACT + AR_Y + (size_t)z * SLOT);
        float* RKo = (float*)(a->ws + WS_ACT + AR_RK) + (size_t)z * TG * 32;
        const size_t colb = (size_t)h * 64 + lane;
        f32x4 ST[4];
#pragma unroll
        for (int cb = 0; cb < 4; ++cb) ST[cb] = (f32x4){0.f, 0.f, 0.f, 0.f};
        const int pst = q == 0 ? 0 : 6 * (q - 1), npass = q == 0 ? 0 : (q == 3 ? 2 : 3);
        const int hf = lane >> 5, pi = lane & 31;
        unsigned ce[8], pr[3], pk[3], pv[3], pa[3];
        const int sd = z == 0 ? 1 : -1;
        const bf16_t* Eh = E + (size_t)bl * SROW * D + (size_t)h * 64; const bf16_t* Rh = R + (size_t)bl * SROW * D + (size_t)h * 64; const bf16_t* Kh = Kb + (size_t)bl * SROW * D + (size_t)h * 64;
        const bf16_t* Vh = Vb + (size_t)bl * SROW * D + (size_t)h * 64; const bf16_t* Ah = Aa + (size_t)bl * SROW * D + (size_t)h * 64;
        f32x2 kkc2, kac2, rkc2;
        { const size_t c0 = (size_t)jl * D + (size_t)h * 64 + 2 * pi; kkc2 = *(const f32x2*)(a->in[I_KK] + c0); kac2 = *(const f32x2*)(a->in[I_KA] + c0); rkc2 = *(const f32x2*)(a->in[I_RK] + c0); }
        auto prep_load = [&](int n) {
            if (q == 0) return;
            const int s0 = r5_seq(z, n * R5_L); const unsigned rlo = (unsigned)(sd > 0 ? s0 : s0 - 15) * (unsigned)D;
#pragma unroll
            for (int ps = 0; ps < 3; ++ps) if (ps < npass) { const int st = pst + 2 * ps + hf; const unsigned off = rlo + (unsigned)((sd > 0 ? st : 15 - st) * D) + 2u * (unsigned)pi;
                pr[ps] = *(const unsigned*)(Rh + off); pk[ps] = *(const unsigned*)(Kh + off); pv[ps] = *(const unsigned*)(Vh + off); pa[ps] = *(const unsigned*)(Ah + off); }
        };
        auto halfsum = [&](float v) -> float { v = sum16_(v); const float h0 = rl_(v, 0) + rl_(v, 16), h1 = rl_(v, 32) + rl_(v, 48); return hf ? h1 : h0; };
        auto prep_finish = [&](int n) {
            if (q == 0) return;
            LAS unsigned char* cbuf = t.lds + (n & 1) * R5_BUF + c2 * R5_CH;
            LAS bf16_t* ZR = (LAS bf16_t*)(cbuf + R5_ZR); LAS bf16_t* BK = (LAS bf16_t*)(cbuf + R5_BK); LAS bf16_t* BKT = (LAS bf16_t*)(cbuf + R5_BKT);
            LAS float* Vs = (LAS float*)(cbuf + R5_V); LAS float* GL = (LAS float*)(cbuf + R5_GL);
            const LAS f32x2* GT = (const LAS f32x2*)(t.lds + R5_PW + ((n & 1) * 2 + c2) * 8192);
            const LAS f32x2* GI = GT + 512;
            if (q == 3 && hf == 0) *(LAS f32x2*)(GL + 2 * pi) = GT[15 * 32 + pi];
            const int s0 = r5_seq(z, n * R5_L); float rkv[3] = {0.f, 0.f, 0.f};
#pragma unroll
            for (int ps = 0; ps < 3; ++ps) if (ps < npass) { const int st = pst + 2 * ps + hf;
                const f32x2 gt = GT[st * 32 + pi], gi = GI[st * 32 + pi]; f32x2 gp = {1.f, 1.f}; if (st > 0) gp = GT[(st - 1) * 32 + pi];
                const f32x2 r2 = {lo_bf(pr[ps]), hi_bf(pr[ps])}, k2 = {lo_bf(pk[ps]), hi_bf(pk[ps])}, v2 = {lo_bf(pv[ps]), hi_bf(pv[ps])}, a2 = {lo_bf(pa[ps]), hi_bf(pa[ps])};
                f32x2 kk2 = k2 * kkc2; const float n2 = halfsum(kk2.x * kk2.x + kk2.y * kk2.y); kk2 = kk2 * __builtin_amdgcn_rsqf(fmaxf(n2, 1e-24f));
                const f32x2 km2 = k2 * ((a2 - 1.0f) * kac2 + 1.0f);
                const f32x2 rkm = r2 * km2 * rkc2; const float rk = halfsum(rkm.x + rkm.y);
                rkv[ps] = rk;
                const f32x2 zt = kk2 * gp * -1.0f, rt = r2 * gt, bt = kk2 * a2 * gi, kt = km2 * gi;
                const unsigned zw = pk2(zt.x, zt.y), rw = pk2(rt.x, rt.y), bw = pk2(bt.x, bt.y), kw = pk2(kt.x, kt.y);
                *(LAS unsigned*)(ZR + st * 72 + 2 * pi) = zw; *(LAS unsigned*)(ZR + (16 + st) * 72 + 2 * pi) = rw; *(LAS unsigned*)(BK + st * 72 + 2 * pi) = bw; *(LAS unsigned*)(BK + (16 + st) * 72 + 2 * pi) = kw;
                BKT[(2 * pi) * 40 + st] = (bf16_t)(bw & 0xffffu); BKT[(2 * pi + 1) * 40 + st] = (bf16_t)(bw >> 16);
                BKT[(2 * pi) * 40 + 16 + st] = (bf16_t)(kw & 0xffffu); BKT[(2 * pi + 1) * 40 + 16 + st] = (bf16_t)(kw >> 16);
                *(LAS f32x2*)(Vs + st * 64 + 2 * pi) = v2; }
            if (pi == 0) {
#pragma unroll
                for (int ps = 0; ps < 3; ++ps) if (ps < npass) RKo[((size_t)bl * SROW + s0 + sd * (pst + 2 * ps + hf)) * 32 + h] = rkv[ps]; }
        };
        auto cum_load = [&](int m) {
            const int s0 = r5_seq(z, m * R5_L); const unsigned rlo = (unsigned)(sd > 0 ? s0 : s0 - 15) * (unsigned)D;
#pragma unroll
            for (int j = 0; j < 8; ++j) { const int i = 8 * hf + j; ce[j] = *(const unsigned*)(Eh + rlo + (unsigned)((sd > 0 ? i : 15 - i) * D) + 2u * (unsigned)pi); }
        };
        auto cum_finish = [&](int m) {
            LAS f32x2* GT = (LAS f32x2*)(t.lds + R5_PW + ((m & 1) * 2 + c2) * 8192); LAS f32x2* GI = GT + 512;
            LAS f32x2* HB = (LAS f32x2*)(t.lds + R5_PW + 4 * 8192 + c2 * 256);
            f32x2 cs[8]; f32x2 lg = {0.f, 0.f};
#pragma unroll
            for (int j = 0; j < 8; ++j) { lg = lg + (f32x2){lo_bf(ce[j]), hi_bf(ce[j])}; cs[j] = lg; }
            if (hf == 0) HB[pi] = lg;
            asm volatile("s_waitcnt lgkmcnt(0)" ::: "memory");
            f32x2 base = HB[pi]; if (hf == 0) base = (f32x2){0.f, 0.f};
#pragma unroll
            for (int j = 0; j < 8; ++j) { const f32x2 c = cs[j] + base;
                GT[(8 * hf + j) * 32 + pi] = (f32x2){__expf(c.x), __expf(c.y)}; GI[(8 * hf + j) * 32 + pi] = (f32x2){__expf(-c.x), __expf(-c.y)}; }
        };
        constexpr int NCH = SROW / R5_L;
        if (q == 0) { cum_load(0); cum_finish(0); cum_load(1); cum_finish(1); cum_load(2); } else prep_load(0);
        __syncthreads();
        prep_finish(0); prep_load(1);
        __syncthreads();
        for (int n = 0; n < NCH; ++n) {
            LAS unsigned char* cbuf = t.lds + (n & 1) * R5_BUF + c2 * R5_CH;
            const LAS bf16_t* ZR = (const LAS bf16_t*)(cbuf + R5_ZR); const LAS bf16_t* BK = (const LAS bf16_t*)(cbuf + R5_BK); const LAS bf16_t* BKT = (const LAS bf16_t*)(cbuf + R5_BKT);
            const LAS float* Vs = (const LAS float*)(cbuf + R5_V); const LAS float* GL = (const LAS float*)(cbuf + R5_GL);
            LAS float* Nm = (LAS float*)(t.lds + R5_GR + c2 * R5_GRCH); LAS bf16_t* MKZ = (LAS bf16_t*)(t.lds + R5_GR + c2 * R5_GRCH + 1024); LAS bf16_t* MBK = (LAS bf16_t*)(t.lds + R5_GR + c2 * R5_GRCH + 1536);
            LAS bf16_t* MT = (LAS bf16_t*)(t.lds + R5_GR + c2 * R5_GRCH + 2560);
            { f32x4 gacc = (f32x4){0.f, 0.f, 0.f, 0.f};
#pragma unroll
              for (int ks = 0; ks < 2; ++ks) { const bf16x8 av = *(const LAS bf16x8*)(ZR + ((q & 2) ? 16 + l15 : l15) * 72 + 32 * ks + 8 * q4);
                  const bf16x8 bv = *(const LAS bf16x8*)(BK + ((q & 1) ? 16 + l15 : l15) * 72 + 32 * ks + 8 * q4);
                  gacc = __builtin_amdgcn_mfma_f32_16x16x32_bf16(av, bv, gacc, 0, 0, 0); }
#pragma unroll
              for (int i = 0; i < 4; ++i) { const int tt = 4 * q4 + i, j = l15; const bool keep = (q & 2) ? (j <= tt) : (j < tt); const float val = keep ? gacc[i] : 0.f;
                  if (q == 0) Nm[tt * 16 + j] = val; else if (q == 1) MKZ[tt * 16 + j] = (bf16_t)f2bf(val); else MBK[tt * 32 + (q == 3 ? 16 : 0) + j] = (bf16_t)f2bf(val); }
              if (q == 0) {
                  asm volatile("s_waitcnt lgkmcnt(0)" ::: "memory");
                  LAS float* DS = (LAS float*)(t.lds + R5_DS + w * 1024);
                  float x[4];
#pragma unroll
                  for (int i = 0; i < 4; ++i) x[i] = (4 * q4 + i == l15) ? 1.0f : 0.0f;
                  f32x4 nall[4][4];
#pragma unroll
                  for (int bs = 0; bs < 4; ++bs)
#pragma unroll
                      for (int i = 0; i < 4; ++i) nall[bs][i] = *(const LAS f32x4*)(Nm + (4 * q4 + i) * 16 + 4 * bs);
#pragma unroll
                  for (int bs = 0; bs < 4; ++bs) {
                      f32x4 nb[4];
#pragma unroll
                      for (int i = 0; i < 4; ++i) nb[i] = nall[bs][i];
                      if (q4 == bs) { x[1] += nb[1][0] * x[0]; x[2] += nb[2][0] * x[0] + nb[2][1] * x[1]; x[3] += nb[3][0] * x[0] + nb[3][1] * x[1] + nb[3][2] * x[2];
#pragma unroll
                          for (int i = 0; i < 4; ++i) DS[(4 * bs + i) * 16 + l15] = x[i]; }
                      asm volatile("s_waitcnt lgkmcnt(0)" ::: "memory");
                      if (bs < 3 && q4 > bs) { float dj[4];
#pragma unroll
                          for (int j = 0; j < 4; ++j) dj[j] = DS[(4 * bs + j) * 16 + l15];
#pragma unroll
                          for (int i = 0; i < 4; ++i) x[i] += (nb[i][0] * dj[0] + nb[i][1] * dj[1]) + (nb[i][2] * dj[2] + nb[i][3] * dj[3]); }
                      asm volatile("" ::: "memory"); }
#pragma unroll
                  for (int i = 0; i < 4; ++i) MT[(4 * q4 + i) * 16 + l15] = (bf16_t)f2bf(x[i]); } }
            if (n + 1 < NCH) prep_finish(n + 1);
            if (n + 2 < NCH) prep_load(n + 2);
            if (q == 0) {
                if (n + 2 < NCH) cum_finish(n + 2);
                if (n + 3 < NCH) cum_load(n + 3); }
            if (q == 3) {
                if (n > 0) { const LAS float* ys = (const LAS float*)(t.lds + R5_YS + ((n - 1) & 1) * 8192 + c2 * 4096);
#pragma unroll
                    for (int tt = 0; tt < 16; ++tt) Y[((size_t)bl * SROW + r5_seq(z, (n - 1) * R5_L) + sd * tt) * D + colb] = (bf16_t)f2bf(ys[tt * 64 + lane]); } }
            __syncthreads();
            {
              f32x4 Pz = (f32x4){0.f, 0.f, 0.f, 0.f}, Pr = Pz;
#pragma unroll
              for (int ks = 0; ks < 2; ++ks) { const f32x4 s0 = ST[2 * ks], s1 = ST[2 * ks + 1];
                  u32x4 p; p.x = pk2(s0[0], s0[1]); p.y = pk2(s0[2], s0[3]); p.z = pk2(s1[0], s1[1]); p.w = pk2(s1[2], s1[3]);
                  const bf16x8 bop = __builtin_bit_cast(bf16x8, p);
                  const LAS bf16_t* zr = ZR + l15 * 72 + 32 * ks + 4 * q4; const LAS bf16_t* rr = ZR + (16 + l15) * 72 + 32 * ks + 4 * q4;
                  const u32x2 z0 = *(const LAS u32x2*)zr, z1 = *(const LAS u32x2*)(zr + 16), r0 = *(const LAS u32x2*)rr, r1 = *(const LAS u32x2*)(rr + 16);
                  Pz = __builtin_amdgcn_mfma_f32_16x16x32_bf16(__builtin_bit_cast(bf16x8, (u32x4){z0.x, z0.y, z1.x, z1.y}), bop, Pz, 0, 0, 0);
                  Pr = __builtin_amdgcn_mfma_f32_16x16x32_bf16(__builtin_bit_cast(bf16x8, (u32x4){r0.x, r0.y, r1.x, r1.y}), bop, Pr, 0, 0, 0); }
              float vd[4];
#pragma unroll
              for (int i = 0; i < 4; ++i) vd[i] = Vs[(4 * q4 + i) * 64 + 16 * q + l15];
              const unsigned vp0 = pk2(vd[0], vd[1]), vp1 = pk2(vd[2], vd[3]);
              { const u32x2 m = *(const LAS u32x2*)(MKZ + l15 * 16 + 4 * q4);
                Pz = __builtin_amdgcn_mfma_f32_16x16x32_bf16(__builtin_bit_cast(bf16x8, (u32x4){m.x, m.y, 0u, 0u}), __builtin_bit_cast(bf16x8, (u32x4){vp0, vp1, 0u, 0u}), Pz, 0, 0, 0); }
              { float x[4];
                { const u32x2 mt = *(const LAS u32x2*)(MT + l15 * 16 + 4 * q4);
                  const f32x4 dv = __builtin_amdgcn_mfma_f32_16x16x32_bf16(__builtin_bit_cast(bf16x8, (u32x4){mt.x, mt.y, 0u, 0u}), __builtin_bit_cast(bf16x8, (u32x4){pk2(Pz[0], Pz[1]), pk2(Pz[2], Pz[3]), 0u, 0u}), (f32x4){0.f, 0.f, 0.f, 0.f}, 0, 0, 0);
                  x[0] = dv[0]; x[1] = dv[1]; x[2] = dv[2]; x[3] = dv[3]; }
                const unsigned dp0 = pk2(x[0], x[1]), dp1 = pk2(x[2], x[3]);
                const bf16x8 bdv = __builtin_bit_cast(bf16x8, (u32x4){dp0, dp1, vp0, vp1});
                { const u32x2 m0 = *(const LAS u32x2*)(MBK + l15 * 32 + 4 * q4), m1 = *(const LAS u32x2*)(MBK + l15 * 32 + 16 + 4 * q4);
                  Pr = __builtin_amdgcn_mfma_f32_16x16x32_bf16(__builtin_bit_cast(bf16x8, (u32x4){m0.x, m0.y, m1.x, m1.y}), bdv, Pr, 0, 0, 0); }
                { LAS float* ys = (LAS float*)(t.lds + R5_YS + (n & 1) * 8192 + c2 * 4096);
#pragma unroll
                  for (int i = 0; i < 4; ++i) ys[(4 * q4 + i) * 64 + 16 * q + l15] = Pr[i]; }
#pragma unroll
                for (int cb = 0; cb < 4; ++cb) { const LAS bf16_t* bt = BKT + (16 * cb + l15) * 40 + 4 * q4;
                    const u32x2 b0 = *(const LAS u32x2*)bt, k0 = *(const LAS u32x2*)(bt + 16);
                    ST[cb] = __builtin_amdgcn_mfma_f32_16x16x32_bf16(__builtin_bit_cast(bf16x8, (u32x4){b0.x, b0.y, k0.x, k0.y}), bdv, ST[cb], 0, 0, 0);
                    const f32x4 gl = *(const LAS f32x4*)(GL + 16 * cb + 4 * q4);
                    ST[cb] = ST[cb] * gl; } } }
            __syncthreads();
        }
        if (q == 3) { const LAS float* ys = (const LAS float*)(t.lds + R5_YS + ((NCH - 1) & 1) * 8192 + c2 * 4096);
#pragma unroll
          for (int tt = 0; tt < 16; ++tt) Y[((size_t)bl * SROW + r5_seq(z, (NCH - 1) * R5_L) + sd * tt) * D + colb] = (bf16_t)f2bf(ys[tt * 64 + lane]); }
        __syncthreads();
    }
}
__device__ __forceinline__ void r6_readout(const Tc& t, CArgs a, int jl, int layer, int g) {
    const bf16_t* Y0 = (const bf16_t*)(a->ws + WS_ACT + AR_Y), *Y1 = (const bf16_t*)(a->ws + WS_ACT + AR_Y + SLOT);
    const float* RK0 = (const float*)(a->ws + WS_ACT + AR_RK), *RK1 = RK0 + (size_t)TG * 32;
    const bf16_t* Vb = (layer == 0) ? (const bf16_t*)(a->ws + WS_VF) + (size_t)g * TG * D : (const bf16_t*)(a->ws + WS_ACT + AR_V);
    const bf16_t* Gb = (const bf16_t*)(a->ws + WS_ACT + AR_MIX + 4 * SLOT);
    bf16_t* Ao = (bf16_t*)(a->ws + WS_ACT + AR_AO) + (size_t)g * TG * D;
    const int sl = t.gw & 3, c0 = 512 * sl + 8 * t.lane, head = c0 >> 6;
    const float* lnw = a->in[I_LNW] + (size_t)jl * D + c0, *lnb = a->in[I_LNB] + (size_t)jl * D + c0;
    const f32x4 lw0 = *(const f32x4*)lnw, lw1 = *(const f32x4*)(lnw + 4), lb0 = *(const f32x4*)lnb, lb1 = *(const f32x4*)(lnb + 4);
    const float lw[8] = {lw0.x, lw0.y, lw0.z, lw0.w, lw1.x, lw1.y, lw1.z, lw1.w}, lb[8] = {lb0.x, lb0.y, lb0.z, lb0.w, lb1.x, lb1.y, lb1.z, lb1.w};
    const int rstep = t.ngw >> 2;
    for (int r0 = t.gw >> 2; r0 < TG; r0 += 2 * rstep) {
        u32x4 y0[2], y1[2], vv[2], gg[2]; float rk[2];
#pragma unroll
        for (int k = 0; k < 2; ++k) { const int r = r0 + k * rstep < TG ? r0 + k * rstep : r0; const size_t off = (size_t)r * D + c0;
            y0[k] = *(const u32x4*)(Y0 + off); y1[k] = *(const u32x4*)(Y1 + off); vv[k] = *(const u32x4*)(Vb + off); gg[k] = *(const u32x4*)(Gb + off);
            rk[k] = RK0[(size_t)r * 32 + head] + RK1[(size_t)r * 32 + head]; }
        asm volatile("" ::: "memory");
#pragma unroll
        for (int k = 0; k < 2; ++k) { const int r = r0 + k * rstep; if (r >= TG) break; const size_t off = (size_t)r * D + c0;
            const unsigned a0[4] = {y0[k].x, y0[k].y, y0[k].z, y0[k].w}, a1[4] = {y1[k].x, y1[k].y, y1[k].z, y1[k].w};
            const unsigned av[4] = {vv[k].x, vv[k].y, vv[k].z, vv[k].w}, ag[4] = {gg[k].x, gg[k].y, gg[k].z, gg[k].w};
            float y[8]; float s = 0.f;
#pragma unroll
            for (int i = 0; i < 4; ++i) { y[2 * i] = lo_bf(a0[i]) + lo_bf(a1[i]); y[2 * i + 1] = hi_bf(a0[i]) + hi_bf(a1[i]); s += y[2 * i] + y[2 * i + 1]; }
            s = sum8_(s);
            const float mean = s * (1.0f / 64.0f);
            float qq = 0.f;
#pragma unroll
            for (int i = 0; i < 8; ++i) { y[i] -= mean; qq += y[i] * y[i]; }
            qq = sum8_(qq);
            const float rstd = rsqrtf(qq * (1.0f / 64.0f) + 64e-5f);
            float o[8];
#pragma unroll
            for (int i = 0; i < 4; ++i) { o[2 * i] = (y[2 * i] * rstd * lw[2 * i] + lb[2 * i] + rk[k] * lo_bf(av[i])) * lo_bf(ag[i]);
                o[2 * i + 1] = (y[2 * i + 1] * rstd * lw[2 * i + 1] + lb[2 * i + 1] + rk[k] * hi_bf(av[i])) * hi_bf(ag[i]); }
            u32x4 w; w.x = pk2(o[0], o[1]); w.y = pk2(o[2], o[3]); w.z = pk2(o[4], o[5]); w.w = pk2(o[6], o[7]);
            *(u32x4*)(Ao + off) = w; }
        asm volatile("" ::: "memory");
    }
}

__device__ __forceinline__ void m3_conv(const Tc& t, CArgs a, int jl) {
    const bf16_t* U = (const bf16_t*)(a->ws + WS_ACT + AM_U);
    bf16_t* QK = (bf16_t*)(a->ws + WS_ACT + AM_QK);
    const int sl = t.gw & 7, c0 = 256 * sl + 4 * t.lane;
    const float* cw = a->in[I_CONVW] + (size_t)jl * 9 * D + c0;
    f32x4 wt[9];
#pragma unroll
    for (int k = 0; k < 9; ++k) wt[k] = *(const f32x4*)(cw + k * D);
    const f32x4 bias = *(const f32x4*)(a->in[I_CONVB] + (size_t)jl * D + c0);
    const float sc = c0 < 1024 ? 0.08838834764831845f : 1.0f;
    for (int row = t.gw >> 3; row < T; row += t.ngw >> 3) { const int s = row % SROW;
        f32x4 acc = bias;
        if (s < CTXL) {
#pragma unroll
            for (int dc = -1; dc <= 1; ++dc) if (s + dc >= 0 && s + dc < CTXL) { const u32x2 u = *(const u32x2*)(U + (size_t)(row + dc) * ULD + c0); const f32x4 w = wt[3 + dc + 1];
                acc.x += lo_bf(u.x) * w.x; acc.y += hi_bf(u.x) * w.y; acc.z += lo_bf(u.y) * w.z; acc.w += hi_bf(u.y) * w.w; }
        } else { const int i = s - CTXL, gr = i >> 6, gc = i & 63;
            u32x2 u[9];
#pragma unroll
            for (int dr = -1; dr <= 1; ++dr)
#pragma unroll
                for (int dc = -1; dc <= 1; ++dc) { const bool ok = (gr + dr >= 0) && (gr + dr < 32) && (gc + dc >= 0) && (gc + dc < 64);
                    u[(dr + 1) * 3 + dc + 1] = ok ? *(const u32x2*)(U + (size_t)(row + dr * 64 + dc) * ULD + c0) : (u32x2){0u, 0u}; }
#pragma unroll
            for (int k = 0; k < 9; ++k) { acc.x += lo_bf(u[k].x) * wt[k].x; acc.y += hi_bf(u[k].x) * wt[k].y; acc.z += lo_bf(u[k].y) * wt[k].z; acc.w += hi_bf(u[k].y) * wt[k].w; }
        }
        u32x2 w; w.x = pk2(siluf_(acc.x) * sc, siluf_(acc.y) * sc); w.y = pk2(siluf_(acc.z) * sc, siluf_(acc.w) * sc);
        *(u32x2*)(QK + (size_t)row * D + c0) = w;
    }
}

template <int CTRL> __device__ __forceinline__ float dppz_(float v) { return __int_as_float(__builtin_amdgcn_update_dpp(0, __float_as_int(v), CTRL, 0xF, 0xF, false)); }
template <int CTRL> __device__ __forceinline__ float dppm_(float v) { return __int_as_float(__builtin_amdgcn_update_dpp((int)0xff800000u, __float_as_int(v), CTRL, 0xF, 0xF, false)); }
constexpr int M4_QS = 136, M4_TS = 72;
constexpr int M4_SQ = 0, M4_SK = 17408, M4_SVT = 34816, M4_SWKT = 71680, M4_SP = 90112, M4_F = 99328;
__device__ __forceinline__ void m4_scan(const Tc& t, CArgs a) {
    LAS bf16_t* sQ = (LAS bf16_t*)(t.lds + M4_SQ); LAS bf16_t* sK = (LAS bf16_t*)(t.lds + M4_SK); LAS bf16_t* sVT = (LAS bf16_t*)(t.lds + M4_SVT);
    LAS bf16_t* sWKT = (LAS bf16_t*)(t.lds + M4_SWKT); LAS bf16_t* sP = (LAS bf16_t*)(t.lds + M4_SP);
    LAS float* fI = (LAS float*)(t.lds + M4_F);
    LAS float* fF = fI + 64;
    LAS float* fU = fI + 128;
    LAS float* fG = fI + 192;
    LAS float* fWI = fI + 256;
    LAS float* fEN = fI + 320;
    LAS float* fWS = fI + 384;
    LAS float* fRS = fI + 448;
    LAS float* fQN = fI + 576;
    LAS float* fN = fI + 640;
    LAS float* fSC = fI + 768;
    LAS float* fNP = fI + 832;
    const bf16_t* QK = (const bf16_t*)(a->ws + WS_ACT + AM_QK);
    const bf16_t* U = (const bf16_t*)(a->ws + WS_ACT + AM_U);
    const float* Gt = (const float*)(a->ws + WS_ACT + AM_G);
    const int tid = t.tid, lane = t.lane, w = t.wave, l15 = lane & 15, q4 = lane >> 4;
    for (int chain = t.bid; chain < 2 * NB * MH; chain += t.G) {
        const int z = chain / (NB * MH), b = (chain / MH) % NB, h = chain % MH;
        bf16_t* HZ = (bf16_t*)(a->ws + WS_ACT + (z == 0 ? AM_HB : AM_HZ1));
        f32x4 Cacc[8][2];
#pragma unroll
        for (int db = 0; db < 8; ++db)
#pragma unroll
            for (int e = 0; e < 2; ++e) Cacc[db][e] = (f32x4){0.f, 0.f, 0.f, 0.f};
        float m_old = 0.f;
        if (tid < 128) fN[tid] = 0.f;
        __syncthreads();
        const size_t rowb = (size_t)b * SROW; const int sdir = z == 0 ? 1 : -1;
        u32x4 pq[2], pkk[2], pvv[4]; float pgi = 0.f, pgf = 0.f;
#define M4_LOAD(chn) do { const int t0_ = (chn) * 64; const int sb_ = z == 0 ? t0_ : (t0_ < CTXL ? CTXL - 1 - t0_ : SROW + CTXL - 1 - t0_); \
            _Pragma("unroll") for (int rep = 0; rep < 2; ++rep) { const int cid = tid + 512 * rep, i = cid >> 4, cc = cid & 15; const size_t row = rowb + sb_ + sdir * i; \
                pq[rep] = *(const u32x4*)(QK + row * D + h * MDK + 8 * cc); pkk[rep] = *(const u32x4*)(QK + row * D + 1024 + h * MDK + 8 * cc); } \
            _Pragma("unroll") for (int rep = 0; rep < 4; ++rep) { const int cid = tid + 512 * rep, i = cid & 63, cc = cid >> 6; const size_t row = rowb + sb_ + sdir * i; \
                pvv[rep] = *(const u32x4*)(U + row * ULD + 2048 + h * MDV + 8 * cc); } \
            if (tid < 64) { const size_t row = rowb + sb_ + sdir * tid; pgi = Gt[row * 32 + z * 16 + h]; pgf = Gt[row * 32 + z * 16 + 8 + h]; } } while (0)
        M4_LOAD(0);
        for (int ch = 0; ch < SROW / 64; ++ch) {
            const int t0 = ch * 64;
            const int sbase = z == 0 ? t0 : (t0 < CTXL ? CTXL - 1 - t0 : SROW + CTXL - 1 - t0);
#pragma unroll
            for (int rep = 0; rep < 2; ++rep) { const int cid = tid + 512 * rep, i = cid >> 4, cc = cid & 15;
                *(LAS u32x4*)(sQ + i * M4_QS + 8 * cc) = pq[rep]; *(LAS u32x4*)(sK + i * M4_QS + 8 * cc) = pkk[rep]; }
#pragma unroll
            for (int rep = 0; rep < 4; ++rep) { const int cid = tid + 512 * rep, i = cid & 63, cc = cid >> 6;
                const unsigned wv[4] = {pvv[rep].x, pvv[rep].y, pvv[rep].z, pvv[rep].w};
#pragma unroll
                for (int jj = 0; jj < 4; ++jj) { sVT[(8 * cc + 2 * jj) * M4_TS + i] = (bf16_t)(wv[jj] & 0xffffu); sVT[(8 * cc + 2 * jj + 1) * M4_TS + i] = (bf16_t)(wv[jj] >> 16); } }
            if (ch > 0 && tid < 128) fN[tid] = fSC[0] * fN[tid] + ((fNP[tid] + fNP[128 + tid]) + (fNP[256 + tid] + fNP[384 + tid]));
            if (tid < 64) { fI[tid] = pgi; fF[tid] = pgf; }
            if (ch + 1 < SROW / 64) M4_LOAD(ch + 1);
            __syncthreads();
            if (w == 0) {
                const float ig = fI[lane], lf = fF[lane];
                float bc = lf;
                bc += dppz_<0x111>(bc); bc += dppz_<0x112>(bc); bc += dppz_<0x114>(bc); bc += dppz_<0x118>(bc);
                { const float t0 = rl_(bc, 15), t1 = rl_(bc, 31), t2 = rl_(bc, 47); bc += (lane >= 16 ? t0 : 0.f) + (lane >= 32 ? t1 : 0.f) + (lane >= 48 ? t2 : 0.f); }
                const float g = ig - bc;
                float pm = g;
                pm = fmaxf(pm, dppm_<0x111>(pm)); pm = fmaxf(pm, dppm_<0x112>(pm)); pm = fmaxf(pm, dppm_<0x114>(pm)); pm = fmaxf(pm, dppm_<0x118>(pm));
                { const float t0 = rl_(pm, 15), t1 = rl_(pm, 31), t2 = rl_(pm, 47); const float ninf = -__builtin_inff();
                  pm = fmaxf(pm, fmaxf(fmaxf(lane >= 16 ? t0 : ninf, lane >= 32 ? t1 : ninf), lane >= 48 ? t2 : ninf)); }
                const float b_end = rl_(bc, 63), pm_all = rl_(pm, 63);
                const float m_new = fmaxf(b_end + m_old, b_end + pm_all);
                const float mx = fmaxf(m_old, pm);
                fU[lane] = -mx; fG[lane] = g; fWI[lane] = __expf(m_old - mx); fEN[lane] = __expf(-mx - bc); fWS[lane] = __expf(b_end + g - m_new);
                if (lane == 0) { fSC[0] = __expf(b_end + m_old - m_new); fSC[1] = m_new; }
            }
            const int tb = w >> 1, jb0 = 2 * (w & 1);
            f32x4 St[2];
#pragma unroll
            for (int jj = 0; jj < 2; ++jj) { St[jj] = (f32x4){0.f, 0.f, 0.f, 0.f};
                if (jb0 + jj <= tb) {
#pragma unroll
                    for (int ks = 0; ks < 4; ++ks) { const bf16x8 av = *(const LAS bf16x8*)(sQ + (16 * tb + l15) * M4_QS + 32 * ks + 8 * q4);
                        const bf16x8 bv = *(const LAS bf16x8*)(sK + (16 * (jb0 + jj) + l15) * M4_QS + 32 * ks + 8 * q4);
                        St[jj] = __builtin_amdgcn_mfma_f32_16x16x32_bf16(av, bv, St[jj], 0, 0, 0); } } }
            __syncthreads();
            { float rs[4] = {0.f, 0.f, 0.f, 0.f};
#pragma unroll
              for (int jj = 0; jj < 2; ++jj) { const int j = 16 * (jb0 + jj) + l15; const float gj = fG[j];
#pragma unroll
                  for (int i = 0; i < 4; ++i) { const int tt = 16 * tb + 4 * q4 + i; const float val = (j <= tt) ? St[jj][i] * __expf(fU[tt] + gj) : 0.f;
                      rs[i] += val; sP[tt * M4_TS + j] = (bf16_t)f2bfa(val); } }
#pragma unroll
              for (int i = 0; i < 4; ++i) { float v = rs[i]; v = sum16_(v);
                  if (l15 == 0) fRS[(w & 1) * 64 + 16 * tb + 4 * q4 + i] = v; } }
            { const int d = tid & 127, jg = tid >> 7; unsigned pk[8]; float nn = 0.f;
#pragma unroll
              for (int jj = 0; jj < 8; ++jj) { const int j0 = 16 * jg + 2 * jj; const float w0 = fWS[j0] * bf2f(sK[j0 * M4_QS + d]), w1 = fWS[j0 + 1] * bf2f(sK[(j0 + 1) * M4_QS + d]);
                  nn += w0 + w1; pk[jj] = pk2a(w0, w1); }
              fNP[jg * 128 + d] = nn;
              *(LAS u32x4*)(sWKT + d * M4_TS + 16 * jg) = (u32x4){pk[0], pk[1], pk[2], pk[3]};
              *(LAS u32x4*)(sWKT + d * M4_TS + 16 * jg + 8) = (u32x4){pk[4], pk[5], pk[6], pk[7]}; }
            { const int tt = tid >> 3, dp = tid & 7; float s = 0.f;
#pragma unroll
              for (int dd = 0; dd < 16; ++dd) s += bf2f(sQ[tt * M4_QS + 16 * dp + dd]) * fN[16 * dp + dd];
              s = sum8_(s);
              if (dp == 0) fQN[tt] = s; }
            __syncthreads();
            asm volatile("s_waitcnt vmcnt(0)" ::: "memory");
            asm volatile("" : "+v"(pq[0]), "+v"(pq[1]), "+v"(pkk[0]), "+v"(pkk[1]));
            asm volatile("" : "+v"(pvv[0]), "+v"(pvv[1]), "+v"(pvv[2]), "+v"(pvv[3]), "+v"(pgi), "+v"(pgf));
#pragma unroll 1
            for (int x = 0; x < 4; ++x) {
                f32x4 acc[2];
                acc[0] = (f32x4){0.f, 0.f, 0.f, 0.f}; acc[1] = (f32x4){0.f, 0.f, 0.f, 0.f};
#pragma unroll
                for (int kb = 0; kb < 4; ++kb) {
                    const LAS bf16_t* qr = sQ + (16 * x + l15) * M4_QS + 32 * kb + 4 * q4;
                    const u32x2 lo = *(const LAS u32x2*)qr, hi = *(const LAS u32x2*)(qr + 16);
                    const bf16x8 aop = __builtin_bit_cast(bf16x8, (u32x4){lo.x, lo.y, hi.x, hi.y});
#pragma unroll
                    for (int e = 0; e < 2; ++e) { const f32x4 c0 = Cacc[2 * kb][e], c1 = Cacc[2 * kb + 1][e];
                        u32x4 p; p.x = pk2a(c0[0], c0[1]); p.y = pk2a(c0[2], c0[3]); p.z = pk2a(c1[0], c1[1]); p.w = pk2a(c1[2], c1[3]);
                        acc[e] = __builtin_amdgcn_mfma_f32_16x16x32_bf16(aop, __builtin_bit_cast(bf16x8, p), acc[e], 0, 0, 0); } }
                { const f32x4 wi = *(const LAS f32x4*)(fWI + 16 * x + 4 * q4); acc[0] = acc[0] * wi; acc[1] = acc[1] * wi; }
#pragma unroll
                for (int ks = 0; ks < 2; ++ks) { const bf16x8 aop = *(const LAS bf16x8*)(sP + (16 * x + l15) * M4_TS + 32 * ks + 8 * q4);
#pragma unroll
                    for (int e = 0; e < 2; ++e) { const bf16x8 bop = *(const LAS bf16x8*)(sVT + (16 * (2 * w + e) + l15) * M4_TS + 32 * ks + 8 * q4);
                        acc[e] = __builtin_amdgcn_mfma_f32_16x16x32_bf16(aop, bop, acc[e], 0, 0, 0); } }
#pragma unroll
                for (int i = 0; i < 4; ++i) { const int tt = 16 * x + 4 * q4 + i;
                    const float den = fWI[tt] * fQN[tt] + fRS[tt] + fRS[64 + tt]; const float dv = __builtin_amdgcn_rcpf(fmaxf(fabsf(den), fEN[tt]));
                    const size_t row = rowb + sbase + sdir * tt;
#pragma unroll
                    for (int e = 0; e < 2; ++e) HZ[row * D + h * MDV + 16 * (2 * w + e) + l15] = (bf16_t)f2bfa(acc[e][i] * dv); }
            }
            { const float dec = fSC[0];
#pragma unroll
              for (int db = 0; db < 8; ++db)
#pragma unroll
                  for (int e = 0; e < 2; ++e) Cacc[db][e] = Cacc[db][e] * dec;
#pragma unroll
              for (int ks = 0; ks < 2; ++ks) {
                  bf16x8 bop[2];
#pragma unroll
                  for (int e = 0; e < 2; ++e) bop[e] = *(const LAS bf16x8*)(sVT + (16 * (2 * w + e) + l15) * M4_TS + 32 * ks + 8 * q4);
#pragma unroll
                  for (int db = 0; db < 8; ++db) { const bf16x8 aop = *(const LAS bf16x8*)(sWKT + (16 * db + l15) * M4_TS + 32 * ks + 8 * q4);
#pragma unroll
                      for (int e = 0; e < 2; ++e) Cacc[db][e] = __builtin_amdgcn_mfma_f32_16x16x32_bf16(aop, bop[e], Cacc[db][e], 0, 0, 0); } }
 }
            m_old = fSC[1];
            __syncthreads();
        }
#undef M4_LOAD
    }
}

__device__ __forceinline__ void m5_readout(const Tc& t, CArgs a, int jl) {
    const bf16_t* H0 = (const bf16_t*)(a->ws + WS_ACT + AM_HB), *H1 = (const bf16_t*)(a->ws + WS_ACT + AM_HZ1);
    const bf16_t* U = (const bf16_t*)(a->ws + WS_ACT + AM_U);
    bf16_t* Ao = (bf16_t*)(a->ws + WS_ACT + AM_QK);
    const int sl = t.gw & 3, c0 = 512 * sl + 8 * t.lane;
    const float* nw = a->in[I_MNORMW] + (size_t)jl * D + c0;
    const f32x4 w0 = *(const f32x4*)nw, w1 = *(const f32x4*)(nw + 4);
    const float w8[8] = {w0.x, w0.y, w0.z, w0.w, w1.x, w1.y, w1.z, w1.w};
    const int rstep = t.ngw >> 2;
    for (int r0 = t.gw >> 2; r0 < T; r0 += 4 * rstep) {
        u32x4 h0[4], h1[4], ov[4];
#pragma unroll
        for (int k = 0; k < 4; ++k) { const int row = r0 + k * rstep < T ? r0 + k * rstep : r0; const size_t off = (size_t)row * D + c0;
            h0[k] = *(const u32x4*)(H0 + off); h1[k] = *(const u32x4*)(H1 + off); ov[k] = *(const u32x4*)(U + (size_t)row * ULD + 4096 + c0); }
        asm volatile("" ::: "memory");
#pragma unroll
        for (int k = 0; k < 4; ++k) { const int row = r0 + k * rstep; if (row >= T) break; const size_t off = (size_t)row * D + c0;
            const unsigned a0[4] = {h0[k].x, h0[k].y, h0[k].z, h0[k].w}, a1[4] = {h1[k].x, h1[k].y, h1[k].z, h1[k].w}, ao[4] = {ov[k].x, ov[k].y, ov[k].z, ov[k].w};
            float y[8]; float s = 0.f;
#pragma unroll
            for (int i = 0; i < 4; ++i) { y[2 * i] = lo_bf(a0[i]) + lo_bf(a1[i]); y[2 * i + 1] = hi_bf(a0[i]) + hi_bf(a1[i]); s += y[2 * i] + y[2 * i + 1]; }
            s = sum16_(s); s += shfl_xor_(s, 16, t.lane);
            const float mean = s * (1.0f / 256.0f);
            float qq = 0.f;
#pragma unroll
            for (int i = 0; i < 8; ++i) { y[i] -= mean; qq += y[i] * y[i]; }
            qq = sum16_(qq); qq += shfl_xor_(qq, 16, t.lane);
            const float rstd = rsqrtf(qq * (1.0f / 256.0f) + 1e-6f);
            float o[8];
#pragma unroll
            for (int i = 0; i < 4; ++i) { o[2 * i] = y[2 * i] * rstd * w8[2 * i] * sigmoidf_(lo_bf(ao[i])); o[2 * i + 1] = y[2 * i + 1] * rstd * w8[2 * i + 1] * sigmoidf_(hi_bf(ao[i])); }
            u32x4 wv; wv.x = pk2(o[0], o[1]); wv.y = pk2(o[2], o[3]); wv.z = pk2(o[4], o[5]); wv.w = pk2(o[6], o[7]);
            *(u32x4*)(Ao + off) = wv; }
        asm volatile("" ::: "memory");
    }
}

__device__ __forceinline__ void final_norm(const Tc& t, CArgs a) {
    const float* xres = (const float*)(a->ws + WS_XRES);
    f32x4 gg[8];
    { const f32x4* gp = (const f32x4*)a->in[I_FINALG] + t.lane;
#pragma unroll
      for (int j = 0; j < 8; ++j) gg[j] = gp[64 * j]; }
    for (int r0 = t.gw; r0 < NB * SEQ; r0 += 2 * t.ngw) {
        f32x4 v[2][8];
#pragma unroll
        for (int k = 0; k < 2; ++k) { const int r = r0 + k * t.ngw < NB * SEQ ? r0 + k * t.ngw : r0; const size_t row = (size_t)(r / SEQ) * SROW + CTXL + (r % SEQ);
            const f32x4* xr = (const f32x4*)(xres + row * D) + t.lane;
#pragma unroll
            for (int j = 0; j < 8; ++j) v[k][j] = xr[64 * j]; }
        asm volatile("" ::: "memory");
#pragma unroll
        for (int k = 0; k < 2; ++k) { const int r = r0 + k * t.ngw; if (r >= NB * SEQ) break;
            float ss = 0.f;
#pragma unroll
            for (int j = 0; j < 8; ++j) ss += (v[k][j].x * v[k][j].x + v[k][j].y * v[k][j].y) + (v[k][j].z * v[k][j].z + v[k][j].w * v[k][j].w);
            const float rstd = rsqrtf(wave_sum_dpp(ss) * (1.0f / D) + 1e-6f);
            f32x4* o = (f32x4*)(a->out + (size_t)r * D) + t.lane;
#pragma unroll
            for (int j = 0; j < 8; ++j) o[64 * j] = v[k][j] * rstd * gg[j]; }
        asm volatile("" ::: "memory");
    }
}
constexpr int NU_FULL = (T / 256) * (D / 256), NU_SKIP = (T / 9 * 8 / 256) * (D / 256);
constexpr int NSEG = 1 + 2 * (12 + 1 + 3) + 2 * (6 + 3) + 1;

__global__ void __launch_bounds__(512, 2) hybrid_fwd(Args args) {
    extern __shared__ __attribute__((aligned(16))) unsigned char lds_raw[];
    LAS unsigned char* const lds = (LAS unsigned char*)lds_raw;
    volatile LAS unsigned* MISC = (volatile LAS unsigned*)(lds + LDSCTL_OFF);
    if (threadIdx.x < 64) MISC[threadIdx.x] = 0u;
    __syncthreads();
    const int lo = args.ph_lo, hi = args.ph_hi;
    const bool fused = (hi - lo) > 1;
    unsigned* barw = (unsigned*)(args.ws + WS_CTL) + 4096;
    XcdBarrier bar; bar.bar = barw; bar.x = 0; bar.st = MISC + 8;
    if (fused) bar = xcd_barrier_post(barw, MISC + 8);
    int seg = 0;
    int urot = 0;
#define ACTIVE (seg >= lo && seg < hi)
#define PH_BEGIN const Tc t = mk_tc(lds); const CArgs a = opaque_args(); unsigned char* const act = a->ws + WS_ACT; (void)act; (void)t;
#define SEAM() do { if (fused && seg >= lo && seg + 1 < hi) xcd_barrier(bar); ++seg; } while (0)

    if (ACTIVE) { PH_BEGIN ph_prologue(t, a); }
    SEAM();
    for (int layer = 0; layer < 4; ++layer) {
        const int jl = layer >> 1;
        if ((layer & 1) == 0) {
            for (int g = 0; g < NGRP; ++g) {
                if (ACTIVE) { PH_BEGIN if (g == 0 && layer == 0) { convert_rwkv(t, a, 0); convert_ffn_in(t, a, 0); }
                    norm_rows<true>(t, a, layer, 0, g * TG, TG, act + AR_H, layer == 0); }
                SEAM();
                if (ACTIVE) { PH_BEGIN r2_mix(t, a, jl); }
                SEAM();
                if (ACTIVE) {
                    PH_BEGIN const bf16_t* wm = (const bf16_t*)(a->ws + WS_WMIX);
                    bf16_t* vdst = (layer == 0) ? (bf16_t*)(a->ws + WS_VF) + (size_t)g * TG * D : (bf16_t*)(act + AR_V);
                    const bf16_t* mix[6];
#pragma unroll
                    for (int m = 0; m < 6; ++m) mix[m] = (const bf16_t*)(act + AR_MIX + (size_t)m * SLOT);
                    for (int q = 0; q < 7; ++q) {
                        if (q == 6 && jl == 0) break;
                        const bf16_t* A = q == 0 ? mix[0] : q == 1 ? mix[2] : q == 2 ? mix[3] : q == 3 ? mix[1] : q == 4 ? mix[4] : q == 5 ? mix[5] : mix[3];
                        const size_t wo = q == 0 ? WM_R : q == 1 ? WM_K : q == 2 ? WM_V : q == 3 ? WM_W1 : q == 4 ? WM_A1 : q == 5 ? WM_G1 : WM_V1;
                        bf16_t* O = q == 0 ? (bf16_t*)(act + AR_R) : q == 1 ? (bf16_t*)(act + AR_K) : q == 2 ? vdst : (bf16_t*)(act + AR_LORA + (size_t)(q - 3) * 9 * MiB);
                        const int N = q < 3 ? D : 256; const int actf = q == 3 ? 1 : q == 5 ? 2 : 0;
                        pg8::EpiStore E{O, N, actf, 0, 0, -1, nullptr, nullptr};
                        run_gemm(t.lds, A, (const bf16_t*)((const char*)wm + wo), TG, N, D, E, urot);
                    }
                }
                SEAM();
                if (ACTIVE) {
                    PH_BEGIN const bf16_t* wm = (const bf16_t*)(a->ws + WS_WMIX);
                    const bf16_t* lora = (const bf16_t*)(act + AR_LORA);
                    for (int q = 0; q < 2; ++q) {
                        pg8::EpiSigAff E{(bf16_t*)(act + AR_MIX + (size_t)(2 * q) * SLOT), (size_t)TG * D, a->in[q == 0 ? I_W0 : I_A0] + (size_t)jl * 2 * D, q == 0 ? -0.6065306597126334f : 1.0f};
                        run_gemm(t.lds, lora + (size_t)q * TG * 256, (const bf16_t*)((const char*)wm + (q == 0 ? WM_W2 : WM_A2)), TG, 2 * D, 256, E, urot);
                    }
                    { pg8::EpiStore E{(bf16_t*)(act + AR_MIX + 4 * SLOT), D, 0, 0, 0, -1, nullptr, nullptr};
                      run_gemm(t.lds, lora + (size_t)2 * TG * 256, (const bf16_t*)((const char*)wm + WM_G2), TG, D, 256, E, urot); }
                    if (jl > 0) { pg8::EpiVmix E{(bf16_t*)(act + AR_V), (const bf16_t*)(a->ws + WS_VF) + (size_t)g * TG * D, a->in[I_V0] + (size_t)(jl - 1) * D};
                      run_gemm(t.lds, lora + (size_t)3 * TG * 256, (const bf16_t*)((const char*)wm + WM_V2), TG, D, 256, E, urot); }
                }
                SEAM();
                if (ACTIVE) { PH_BEGIN r5_scan(t, a, jl, layer, g); }
                SEAM();
                if (ACTIVE) { PH_BEGIN r6_readout(t, a, jl, layer, g); }
                SEAM();
            }
            if (ACTIVE) { PH_BEGIN pg8::EpiResid E{(float*)(a->ws + WS_XRES), (const float*)(a->ws + WS_MOD) + (size_t)layer * 17 * MODLD + 2 * D, 0, layer == 0 ? a->in[I_X] : nullptr, a->in[I_CTX]};
                run_gemm(t.lds, (const bf16_t*)(act + AR_AO), (const bf16_t*)(a->ws + WS_WMIX + WM_O), T, D, D, E, urot);
                { const Tc t2 = mk_tc(lds); const CArgs a2 = opaque_args(); Tc ts; if (tail_crew(t2, urot - NU_FULL, NU_FULL, ts)) { __syncthreads(); convert_ffn_out(ts, a2, layer); } } }
            SEAM();
        } else {
            if (ACTIVE) { PH_BEGIN norm_rows<true>(t, a, layer, 0, 0, T, act + AM_HB); }
            SEAM();
            if (ACTIVE) { PH_BEGIN pg8::EpiStore E{(bf16_t*)(act + AM_U), ULD, 0, 0, 0, 24, (float*)(act + AM_G), a->in[I_BGATE] + (size_t)jl * 32};
                run_gemm(t.lds, (const bf16_t*)(act + AM_HB), (const bf16_t*)(a->ws + WS_WMIX + WM_MIN), T, 6400, D, E, urot); }
            SEAM();
            if (ACTIVE) { PH_BEGIN m3_conv(t, a, jl); }
            SEAM();
            if (ACTIVE) { PH_BEGIN m4_scan(t, a); }
            SEAM();
            if (ACTIVE) { PH_BEGIN m5_readout(t, a, jl); }
            SEAM();
            if (ACTIVE) { PH_BEGIN pg8::EpiResid E{(float*)(a->ws + WS_XRES), (const float*)(a->ws + WS_MOD) + (size_t)layer * 17 * MODLD + 2 * D, 0, nullptr, nullptr};
                if (layer == 3) run_gemm<pg8::EpiResid, true>(t.lds, (const bf16_t*)(act + AM_QK), (const bf16_t*)(a->ws + WS_WMIX + WM_MOUT), T, D, D, E, urot);
                else run_gemm(t.lds, (const bf16_t*)(act + AM_QK), (const bf16_t*)(a->ws + WS_WMIX + WM_MOUT), T, D, D, E, urot);
                { const Tc t2 = mk_tc(lds); const CArgs a2 = opaque_args(); Tc ts; const int nu = layer == 3 ? NU_SKIP : NU_FULL; if (tail_crew(t2, urot - nu, nu, ts)) { __syncthreads(); convert_ffn_out(ts, a2, layer); } } }
            SEAM();
        }
        if (ACTIVE) { PH_BEGIN norm_rows<true>(t, a, layer, 1, 0, T, act + AF_H2); }
        SEAM();
        if (ACTIVE) { PH_BEGIN pg8::EpiSwiglu E{(bf16_t*)(act + AF_U)};
            if (layer == 3) run_gemm<pg8::EpiSwiglu, true>(t.lds, (const bf16_t*)(act + AF_H2), (const bf16_t*)(a->ws + WS_WFFN + WF_IN), T, 2 * DFF, D, E, urot);
            else run_gemm(t.lds, (const bf16_t*)(act + AF_H2), (const bf16_t*)(a->ws + WS_WFFN + WF_IN), T, 2 * DFF, D, E, urot); }
        SEAM();
        if (ACTIVE) { PH_BEGIN pg8::EpiResid E{(float*)(a->ws + WS_XRES), (const float*)(a->ws + WS_MOD) + (size_t)layer * 17 * MODLD + 5 * D, 0, nullptr, nullptr};
            if (layer == 3) run_gemm<pg8::EpiResid, true>(t.lds, (const bf16_t*)(act + AF_U), (const bf16_t*)(a->ws + WS_WFFN + WF_OUT), T, D, DFF, E, urot);
            else run_gemm(t.lds, (const bf16_t*)(act + AF_U), (const bf16_t*)(a->ws + WS_WFFN + WF_OUT), T, D, DFF, E, urot);
            if (layer < 3) { const Tc t2 = mk_tc(lds); const CArgs a2 = opaque_args(); Tc ts; if (tail_crew(t2, urot - NU_FULL, NU_FULL, ts)) { __syncthreads();
                if (layer & 1) convert_rwkv(ts, a2, (layer + 1) >> 1); else convert_mlstm(ts, a2, (layer + 1) >> 1);
                convert_ffn_in(ts, a2, layer + 1); } } }
        SEAM();
    }
    if (ACTIVE) { PH_BEGIN final_norm(t, a); }
#undef ACTIVE
#undef SEAM
#undef PH_BEGIN
}

#ifndef MK_MULTI
#define MK_MULTI 0
#endif
extern "C" void kernel_launch(void* const* d_in, const int* in_sizes, int n_in, void* d_out, int out_size, void* d_ws, size_t ws_size, hipStream_t stream) {
    static int grid = 0;
    if (grid == 0) {
        if (n_in != NIN || ws_size < WS_END) { fprintf(stderr, "kernel_launch: unexpected n_in %d / ws %zu\n", n_in, ws_size); grid = -1; return; }
        int dev = 0, cus = 0, per_cu = 0;
        if (hipGetDevice(&dev) != hipSuccess || hipDeviceGetAttribute(&cus, hipDeviceAttributeMultiprocessorCount, dev) != hipSuccess) { grid = -1; return; }
        if (hipFuncSetAttribute((const void*)hybrid_fwd, hipFuncAttributeMaxDynamicSharedMemorySize, LDS_BYTES) != hipSuccess) { fprintf(stderr, "kernel_launch: hipFuncSetAttribute failed\n"); grid = -1; return; }
        if (hipOccupancyMaxActiveBlocksPerMultiprocessor(&per_cu, (const void*)hybrid_fwd, 512, LDS_BYTES) != hipSuccess || per_cu < 1)
            fprintf(stderr, "kernel_launch: occupancy query reports %d workgroups per CU\n", per_cu);
        (void)hipGetLastError();
        grid = cus;
    }
    if (grid < 0) return;
    if (hipMemsetAsync((char*)d_ws + WS_CTL, 0, CTL_ZERO_BYTES, stream) != hipSuccess) return;
    Args a{};
    for (int i = 0; i < NIN; ++i) a.in[i] = (const float*)d_in[i];
    a.out = (float*)d_out; a.ws = (unsigned char*)d_ws;
#if MK_MULTI
    for (int s = 0; s < NSEG; ++s) { a.ph_lo = s; a.ph_hi = s + 1; hipLaunchKernelGGL(hybrid_fwd, dim3(grid), dim3(512), LDS_BYTES, stream, a); }
#else
    a.ph_lo = 0; a.ph_hi = NSEG;
    hipLaunchKernelGGL(hybrid_fwd, dim3(grid), dim3(512), LDS_BYTES, stream, a);
#endif
}
```

```cpp
#include <hip/hip_runtime.h>
#include <cstdio>
#include <cstdint>

#define LAS __attribute__((address_space(3)))
#define GAS __attribute__((address_space(1)))
typedef unsigned short bf16_t;
typedef short bf16x8 __attribute__((ext_vector_type(8)));
typedef short bf16x4 __attribute__((ext_vector_type(4)));
typedef float f32x4 __attribute__((ext_vector_type(4)));
typedef float f32x2 __attribute__((ext_vector_type(2)));
typedef unsigned u32x4 __attribute__((ext_vector_type(4)));
typedef unsigned u32x2 __attribute__((ext_vector_type(2)));
#define LDS_WAIT() asm volatile("s_waitcnt lgkmcnt(0)" ::: "memory")
#define VM_WAIT() asm volatile("s_waitcnt vmcnt(0)" ::: "memory")

constexpr int D = 2048, NB = 16, SEQ = 2048, CTXL = 256, SROW = 2304, T = NB * SROW;
constexpr int NGRP = 2, BG = 8, TG = BG * SROW;
constexpr int DFF = 5632;
constexpr int RH = 32;
constexpr int MH = 8, MDV = 256, MDK = 128, MPROJ = 6176, ULD = 6144;
constexpr int MODLD = 6 * D;
constexpr int NIN = 37;
enum { I_X = 0, I_C, I_CTX, I_CCTX, I_MODW, I_MODB, I_NORMG, I_FINALG, I_MU, I_WR, I_WK, I_WV, I_WO, I_W0, I_W1, I_W2, I_A0, I_A1, I_A2, I_G1, I_G2, I_KK, I_KA, I_RK, I_LNW, I_LNB,
       I_V0, I_V1, I_V2, I_MWIN, I_BGATE, I_CONVW, I_CONVB, I_MNORMW, I_MWOUT, I_FWIN, I_FWOUT };

constexpr size_t MiB = 1u << 20;
constexpr size_t WS_CTL = 0, CTL_ZERO_BYTES = 1 * MiB;
constexpr size_t WS_MOD = 1 * MiB;
constexpr size_t WS_XRES = 5 * MiB;
constexpr size_t WS_VF = 293 * MiB;
constexpr size_t WS_WMIX = 437 * MiB;
constexpr size_t WS_WFFN = 479 * MiB;
constexpr size_t WS_ACT = 545 * MiB;
constexpr size_t WS_END = WS_ACT + 977 * MiB;
static_assert(WS_END <= (size_t)1536 * MiB, "ws");
constexpr size_t WM_R = 0, WM_K = 8 * MiB, WM_V = 16 * MiB, WM_O = 24 * MiB, WM_W1 = 32 * MiB, WM_A1 = 33 * MiB, WM_G1 = 34 * MiB, WM_V1 = 35 * MiB,
                 WM_W2 = 36 * MiB, WM_A2 = 38 * MiB, WM_G2 = 40 * MiB, WM_V2 = 41 * MiB;
constexpr size_t WM_MIN = 0, WM_MOUT = 25 * MiB;
constexpr size_t WF_IN = 0, WF_OUT = 44 * MiB;
constexpr size_t SLOT = 72 * MiB;
constexpr size_t AR_MIX = 0;
constexpr size_t AR_H = 432 * MiB;
constexpr size_t AR_R = 432 * MiB, AR_K = 504 * MiB, AR_V = 576 * MiB;
constexpr size_t AR_LORA = 648 * MiB;
constexpr size_t AR_Y = 684 * MiB;
constexpr size_t AR_RK = 828 * MiB;
constexpr size_t AR_AO = 833 * MiB;
constexpr size_t AM_HB = 0, AM_U = 144 * MiB, AM_QK = 576 * MiB, AM_HZ1 = 720 * MiB, AM_G = 864 * MiB;
constexpr size_t AF_H2 = 0, AF_U = 144 * MiB;

constexpr int LDS_BYTES = 147456;
constexpr int LDSCTL_OFF = LDS_BYTES - 256;

__device__ __forceinline__ float bf2f(bf16_t b) { return __uint_as_float(((unsigned)b) << 16); }
typedef __bf16 bf16x2n_t __attribute__((ext_vector_type(2)));
__device__ __forceinline__ unsigned pk2(float lo, float hi) { const f32x2 v = {lo, hi}; return __builtin_bit_cast(unsigned, __builtin_convertvector(v, bf16x2n_t)); }
__device__ __forceinline__ unsigned f2bf(float f) { return pk2(f, f) & 0xffffu; }
__device__ __forceinline__ unsigned pk2a(float lo, float hi) { unsigned r; asm("v_cvt_pk_bf16_f32 %0, %1, %2" : "=v"(r) : "v"(lo), "v"(hi)); return r; }
__device__ __forceinline__ unsigned f2bfa(float f) { return pk2a(f, f) & 0xffffu; }
__device__ __forceinline__ float lo_bf(unsigned w) { return __uint_as_float(w << 16); }
__device__ __forceinline__ float hi_bf(unsigned w) { return __uint_as_float(w & 0xffff0000u); }
__device__ __forceinline__ float sigmoidf_(float x) { return __builtin_amdgcn_rcpf(1.0f + __expf(-x)); }
__device__ __forceinline__ float tanhf_(float x) { return 1.0f - 2.0f * __builtin_amdgcn_rcpf(1.0f + __expf(2.0f * x)); }
__device__ __forceinline__ float siluf_(float x) { return x * __builtin_amdgcn_rcpf(1.0f + __expf(-x)); }
template <int CTRL> __device__ __forceinline__ float dpp_(float v) { return __int_as_float(__builtin_amdgcn_update_dpp(0, __float_as_int(v), CTRL, 0xF, 0xF, true)); }
__device__ __forceinline__ float rl_(float v, int k) { return __int_as_float(__builtin_amdgcn_readlane(__float_as_int(v), k)); }
__device__ __forceinline__ float sum8_(float v) { v += dpp_<0xB1>(v); v += dpp_<0x4E>(v); v += dpp_<0x141>(v); return v; }
__device__ __forceinline__ float sum16_(float v) { v = sum8_(v); v += dpp_<0x140>(v); return v; }
__device__ __forceinline__ float wave_sum_dpp(float v) { v = sum16_(v); return (rl_(v, 0) + rl_(v, 16)) + (rl_(v, 32) + rl_(v, 48)); }
__device__ __forceinline__ float wave_sum(float v) { return wave_sum_dpp(v); }
__device__ __forceinline__ float shfl_xor_(float v, int mask, int lane) { return __int_as_float(__builtin_amdgcn_ds_bpermute((lane ^ mask) << 2, __float_as_int(v))); }

#define XB_TMO      128
#define XB_XCNT(j)  (256  + 64 * (j))
#define XB_XSUB(j)  (1280 + 64 * (j))
#define XB_XGEN(j)  (2304 + 64 * (j))
#define XB_TOP      3328
#define XB_TOPGEN   3392
#define XCD_BAR_WORDS 3456
#define XB_SPIN_CAP (1u << 24)

__device__ __forceinline__ unsigned xb_ld(unsigned* p)              { return __hip_atomic_load(p, __ATOMIC_RELAXED, __HIP_MEMORY_SCOPE_AGENT); }
__device__ __forceinline__ unsigned xb_add(unsigned* p, unsigned v) { return __hip_atomic_fetch_add(p, v, __ATOMIC_RELAXED, __HIP_MEMORY_SCOPE_AGENT); }
__device__ __forceinline__ unsigned xb_xcc_id() { return (unsigned)__builtin_amdgcn_s_getreg((3 << 11) | 20) & 0xFu; }
#define XB_SPIN(cond, bar) do { unsigned _sp = 0; while (cond) { __builtin_amdgcn_s_sleep(1); \
    if ((++_sp & 255u) == 0u) { if (xb_ld(&(bar)[XB_TMO])) break; if (_sp > XB_SPIN_CAP) { atomicAdd(&(bar)[XB_TMO], 1u); break; } } } } while (0)

struct XcdBarrier { unsigned* bar; unsigned x; volatile LAS unsigned* st; };

__device__ __forceinline__ XcdBarrier xcd_barrier_post(unsigned* bar, volatile LAS unsigned* st) {
    XcdBarrier b; b.bar = bar; b.x = xb_xcc_id(); b.st = st;
    if (threadIdx.x == 0) (void)xb_add(&bar[XB_XCNT(b.x)], 1u);
    return b;
}
__device__ __forceinline__ void xcd_barrier_complete(unsigned* bar, unsigned x, unsigned& nloc, unsigned& nx) {
    const unsigned G = gridDim.x * gridDim.y * gridDim.z;
    unsigned sum, cnt, mine, sp = 0u;
    for (;;) {
        sum = 0u; cnt = 0u; mine = 0u;
#pragma unroll
        for (unsigned j = 0; j < 16; ++j) { const unsigned c = xb_ld(&bar[XB_XCNT(j)]); sum += c; cnt += (c > 0u) ? 1u : 0u; mine = (j == x) ? c : mine; }
        if (sum == G) break;
        __builtin_amdgcn_s_sleep(1);
        if ((++sp & 255u) == 0u) { if (xb_ld(&bar[XB_TMO])) break; if (sp > XB_SPIN_CAP) { atomicAdd(&bar[XB_TMO], 1u); break; } }
    }
    nloc = mine > 0u ? mine : 1u; nx = cnt > 0u ? cnt : 1u;
}
__device__ __forceinline__ void xcd_barrier(const XcdBarrier& b) {
    asm volatile("s_waitcnt vmcnt(0)" ::: "memory");
    __syncthreads();
    if (threadIdx.x == 0) {
        unsigned* bar = b.bar;
        __builtin_amdgcn_s_waitcnt(0);
        unsigned nloc = b.st[0], nx = b.st[1];
        if (nloc == 0u) { xcd_barrier_complete(bar, b.x, nloc, nx); b.st[0] = nloc; b.st[1] = nx; }
        const unsigned old = xb_add(&bar[XB_XSUB(b.x)], 1u);
        const unsigned gen = old / nloc;
        if (old + 1u == (gen + 1u) * nloc) {
            __builtin_amdgcn_fence(__ATOMIC_RELEASE, "agent");
            asm volatile("s_waitcnt vmcnt(0)" ::: "memory");
            const unsigned og = xb_add(&bar[XB_TOP], 1u);
            const unsigned tg = og / nx;
            if (og + 1u == (tg + 1u) * nx) xb_add(&bar[XB_TOPGEN], 1u);
            else XB_SPIN(xb_ld(&bar[XB_TOPGEN]) == tg, bar);
            __builtin_amdgcn_fence(__ATOMIC_ACQUIRE, "agent");
            xb_add(&bar[XB_XGEN(b.x)], 1u);
            asm volatile("s_waitcnt vmcnt(0)" ::: "memory");
        } else {
            XB_SPIN(xb_ld(&bar[XB_XGEN(b.x)]) == gen, bar);
            __builtin_amdgcn_fence(__ATOMIC_ACQUIRE, "agent");
            asm volatile("s_waitcnt vmcnt(0)" ::: "memory");
        }
    }
    __syncthreads();
}
#ifndef GP_ALIGN
#define GP_ALIGN true
#endif
#ifndef GP_SP2
#define GP_SP2 true
#endif
namespace pg8 {
constexpr int BM = 256, BK = 64, HALF = 128, HTB = HALF * BK * 2  , STAGE_BYTES = 8 * HTB, NXCD = 8, WGM = 8;

__host__ __device__ __forceinline__ int lds_byte(int r, int c) { const int st = (r >> 4) * 2 + (c >> 5), rr = r & 15, cc = c & 31, ob = rr * 64 + cc * 2; return st * 1024 + (ob ^ (((ob >> 9) & 1) << 5)); }
__host__ __device__ __forceinline__ void stage_rc(int b, int& R, int& C) { const int st = b / 1024, sb = b % 1024, swz = sb ^ (((sb >> 9) & 1) << 5); R = (st >> 1) * 16 + swz / 64; C = (st & 1) * 32 + (swz % 64) / 2; }
__host__ __device__ __forceinline__ int perm32(int rho) { const int n = rho >> 4, i = rho & 15; return 8 * (i >> 2) + 4 * n + (i & 3); }

struct Unit { int pm, pn; };
struct Gemm { const bf16_t* A; const bf16_t* Bt; int M, N, K; };

struct StaticOrder {
    int nM, nN, nwg, G, c;
    __host__ __device__ void init(int M, int N, int G_, int c_) { nM = M / BM; nN = N / BM; nwg = nM * nN; G = G_; c = c_; }
    __host__ __device__ bool next(int i, Unit& u) const {
        const long L = (long)i * G + c; if (L >= nwg) return false;
        int wgid = (int)L; { const int q = nwg / NXCD, r = nwg % NXCD, xcd = wgid % NXCD, off = wgid / NXCD; wgid = (xcd < r ? xcd * (q + 1) : r * (q + 1) + (xcd - r) * q) + off; }
        const int nig = WGM * nN, gid = wgid / nig, fm = gid * WGM, gsz = (nM - fm) < WGM ? (nM - fm) : WGM;
        u.pm = fm + ((wgid % nig) % gsz); u.pn = (wgid % nig) / gsz; return true;
    }
    __device__ __forceinline__ void a_ready(const Unit&) const {}
    __device__ __forceinline__ void done(const Unit&) const {}
};
__device__ __forceinline__ unsigned cvt_pk_bf16(float lo, float hi) { unsigned r; asm volatile("v_cvt_pk_bf16_f32 %0, %1, %2" : "=v"(r) : "v"(lo), "v"(hi)); return r; }
template <class Epi, class Sched, bool ALIGN_EPI = false, bool SP2 = false>
__device__ __forceinline__ void gemm_phase(LAS unsigned char* lds, const Gemm g, const Sched& S, const Epi& E) {
    int tid_ = threadIdx.x; asm volatile("" : "+v"(tid_));
    const int tid = tid_, wid = __builtin_amdgcn_readfirstlane(tid >> 6), lane = tid & 63, wr = wid >> 2, wc = wid & 3, fr = lane & 15, fq = lane >> 4;
    const int K = g.K, nt = K / BK;
    unsigned voffA[2], voffB[2];
#pragma unroll
    for (int i = 0; i < 2; ++i) { int R, C; stage_rc(tid * 16 + i * 8192, R, C); const int Rb = Epi::PERM ? ((R & ~31) + perm32(R & 31)) : R;
        voffA[i] = (unsigned)(R * K + C) * 2u; voffB[i] = (unsigned)(Rb * K + C) * 2u; }
    const size_t kstep = (size_t)(BK * 2);
    const size_t hstep = (size_t)HALF * K * 2;
    const size_t tstep = 2 * hstep;
    const unsigned ldsw = (unsigned)wid * 1024u;
    const int aoff = lds_byte(wr * 64 + fr, fq * 8), boff = lds_byte(wc * 32 + fr, fq * 8);
#define PG8_SA(b, h) (((b) * 2 + (h)) * HTB)
#define PG8_SB(b, h) ((4 + (b) * 2 + (h)) * HTB)
#define PG8_STAGE(bufoff, gbase, voff) do { _Pragma("unroll") for (int _i = 0; _i < 2; ++_i) \
        __builtin_amdgcn_global_load_lds((const unsigned*)((const char*)(gbase) + (voff)[_i]), (LAS unsigned*)(lds + (bufoff) + ldsw + _i * 8192), 16, 0, 0); } while (0)
#define PG8_LDA(dst, b, h) do { _Pragma("unroll") for (int m = 0; m < 4; ++m) _Pragma("unroll") for (int k = 0; k < 2; ++k) dst[m][k] = *(const LAS bf16x8*)(lds + PG8_SA(b, h) + aoff + m * 2048 + k * 1024); } while (0)
#define PG8_LDB(dst, b, h) do { _Pragma("unroll") for (int n = 0; n < 2; ++n) _Pragma("unroll") for (int k = 0; k < 2; ++k) dst[n][k] = *(const LAS bf16x8*)(lds + PG8_SB(b, h) + boff + n * 2048 + k * 1024); } while (0)
#define PG8_MMA(ai, bj, At, Bt) do { __builtin_amdgcn_s_setprio(1); _Pragma("unroll") for (int m = 0; m < 4; ++m) _Pragma("unroll") for (int n = 0; n < 2; ++n) _Pragma("unroll") for (int k = 0; k < 2; ++k) \
        acc[ai][bj][m][n] = __builtin_amdgcn_mfma_f32_16x16x32_bf16(Bt[n][k], At[m][k], acc[ai][bj][m][n], 0, 0, 0); __builtin_amdgcn_s_setprio(0); } while (0)
#define PG8_WAIT_V(n) asm volatile("s_waitcnt vmcnt(" #n ")" ::: "memory")
#define PG8_WAIT_L(n) asm volatile("s_waitcnt lgkmcnt(" #n ")" ::: "memory")
#define PG8_BAR __builtin_amdgcn_s_barrier()
#define PG8_SCHED __builtin_amdgcn_sched_barrier(0)
    Unit cur, nxt; int ui = 0;
    if (!S.next(0, cur)) return;
    f32x4 acc[2][2][4][2];
#pragma unroll
    for (int a = 0; a < 2; ++a)
#pragma unroll
        for (int b = 0; b < 2; ++b)
#pragma unroll
            for (int m = 0; m < 4; ++m)
#pragma unroll
                for (int n = 0; n < 2; ++n) acc[a][b][m][n] = (f32x4){0.f, 0.f, 0.f, 0.f};
    bf16x8 At[4][2], B0[2][2], B1[2][2];
    const char* cA = (const char*)g.A + (size_t)cur.pm * tstep; const char* cB = (const char*)g.Bt + (size_t)cur.pn * tstep;
    S.a_ready(cur);
    if constexpr (SP2) {
        PG8_STAGE(PG8_SB(0, 0), cB, voffB); PG8_STAGE(PG8_SB(0, 1), cB + hstep, voffB); PG8_STAGE(PG8_SA(0, 0), cA, voffA); PG8_STAGE(PG8_SA(0, 1), cA + hstep, voffA);
        if (wr == 1) PG8_BAR;
        PG8_WAIT_V(2); PG8_BAR;
        PG8_STAGE(PG8_SB(1, 0), cB + kstep, voffB); PG8_STAGE(PG8_SA(1, 0), cA + kstep, voffA); PG8_STAGE(PG8_SB(1, 1), cB + hstep + kstep, voffB);
        PG8_WAIT_V(6); PG8_BAR;
    } else {
        PG8_STAGE(PG8_SB(0, 0), cB, voffB); PG8_STAGE(PG8_SA(0, 0), cA, voffA); PG8_STAGE(PG8_SB(0, 1), cB + hstep, voffB); PG8_STAGE(PG8_SA(0, 1), cA + hstep, voffA);
        if (wr == 1) PG8_BAR;
        PG8_WAIT_V(4); PG8_BAR;
        PG8_STAGE(PG8_SB(1, 0), cB + kstep, voffB); PG8_STAGE(PG8_SA(1, 0), cA + kstep, voffA); PG8_STAGE(PG8_SB(1, 1), cB + hstep + kstep, voffB);
        PG8_WAIT_V(6); PG8_BAR;
    }
    for (;;) {
        const bool has_next = S.next(ui + 1, nxt);
        const char* nA = has_next ? (const char*)g.A + (size_t)nxt.pm * tstep : cA; const char* nB = has_next ? (const char*)g.Bt + (size_t)nxt.pn * tstep : cB;
#pragma unroll 1
        for (int t = 0; t < nt; t += 2) {
            const bool last = (t == nt - 2);
            const char* a1 = cA + (size_t)(t + 1) * kstep;
            const char* a2 = last ? nA : cA + (size_t)(t + 2) * kstep; const char* b2 = last ? nB : cB + (size_t)(t + 2) * kstep;
            const char* a3 = a2 + kstep; const char* b3 = b2 + kstep;
            if (last && has_next) S.a_ready(nxt);
            if constexpr (SP2) {
            PG8_LDB(B0, 0, 0); PG8_LDB(B1, 0, 1); PG8_SCHED; PG8_LDA(At, 0, 0); PG8_STAGE(PG8_SA(1, 1), a1 + hstep, voffA);
            PG8_WAIT_V(8); PG8_WAIT_L(0); PG8_BAR; PG8_MMA(0, 0, At, B0); PG8_MMA(0, 1, At, B1); PG8_BAR; PG8_SCHED;
            PG8_LDA(At, 0, 1); PG8_STAGE(PG8_SB(0, 0), b2, voffB); PG8_STAGE(PG8_SB(0, 1), b2 + hstep, voffB); PG8_STAGE(PG8_SA(0, 0), a2, voffA);
            PG8_WAIT_V(8); PG8_WAIT_L(0); PG8_BAR; PG8_MMA(1, 0, At, B0); PG8_MMA(1, 1, At, B1); PG8_BAR; PG8_SCHED;
            PG8_LDB(B0, 1, 0); PG8_LDB(B1, 1, 1); PG8_SCHED; PG8_LDA(At, 1, 0); PG8_STAGE(PG8_SA(0, 1), a2 + hstep, voffA);
            PG8_WAIT_V(8); PG8_WAIT_L(0); PG8_BAR; PG8_MMA(0, 0, At, B0); PG8_MMA(0, 1, At, B1); PG8_BAR; PG8_SCHED;
            PG8_LDA(At, 1, 1); PG8_STAGE(PG8_SB(1, 0), b3, voffB); PG8_STAGE(PG8_SB(1, 1), b3 + hstep, voffB); PG8_STAGE(PG8_SA(1, 0), a3, voffA);
            PG8_WAIT_V(8); PG8_WAIT_L(0); PG8_BAR; PG8_MMA(1, 0, At, B0); PG8_MMA(1, 1, At, B1); PG8_BAR; PG8_SCHED;
            } else {
            PG8_LDB(B0, 0, 0); PG8_SCHED; PG8_LDA(At, 0, 0); PG8_STAGE(PG8_SA(1, 1), a1 + hstep, voffA);
            PG8_WAIT_L(8); PG8_BAR; PG8_WAIT_L(0); PG8_MMA(0, 0, At, B0); PG8_BAR; PG8_SCHED;
            PG8_LDB(B1, 0, 1); PG8_STAGE(PG8_SB(0, 0), b2, voffB);
            PG8_BAR; PG8_WAIT_L(0); PG8_MMA(0, 1, At, B1); PG8_BAR;
            PG8_LDA(At, 0, 1); PG8_STAGE(PG8_SA(0, 0), a2, voffA);
            PG8_BAR; PG8_WAIT_L(0); PG8_MMA(1, 0, At, B0); PG8_BAR; PG8_SCHED;
            PG8_STAGE(PG8_SB(0, 1), b2 + hstep, voffB);
            PG8_WAIT_V(6); PG8_BAR; PG8_MMA(1, 1, At, B1); PG8_BAR;
            PG8_LDB(B0, 1, 0); PG8_SCHED; PG8_LDA(At, 1, 0); PG8_STAGE(PG8_SA(0, 1), a2 + hstep, voffA);
            PG8_WAIT_L(8); PG8_BAR; PG8_WAIT_L(0); PG8_MMA(0, 0, At, B0); PG8_BAR; PG8_SCHED;
            PG8_LDB(B1, 1, 1); PG8_STAGE(PG8_SB(1, 0), b3, voffB);
            PG8_BAR; PG8_WAIT_L(0); PG8_MMA(0, 1, At, B1); PG8_BAR;
            PG8_LDA(At, 1, 1); PG8_STAGE(PG8_SA(1, 0), a3, voffA);
            PG8_BAR; PG8_WAIT_L(0); PG8_MMA(1, 0, At, B0); PG8_BAR; PG8_SCHED;
            PG8_STAGE(PG8_SB(1, 1), b3 + hstep, voffB);
            PG8_WAIT_V(6); PG8_BAR; PG8_MMA(1, 1, At, B1); PG8_BAR;
            }
        }
        if constexpr (ALIGN_EPI) { if (wr == 0) PG8_BAR; }
        if constexpr (!Epi::AFTER_DRAIN) { E(acc, cur, wr, wc, fr, fq); S.done(cur); }
        if (!has_next) break;
#pragma unroll
        for (int a = 0; a < 2; ++a)
#pragma unroll
            for (int b = 0; b < 2; ++b)
#pragma unroll
                for (int m = 0; m < 4; ++m)
#pragma unroll
                    for (int n = 0; n < 2; ++n) acc[a][b][m][n] = (f32x4){0.f, 0.f, 0.f, 0.f};
        cur = nxt; cA = nA; cB = nB; ++ui;
        if constexpr (ALIGN_EPI) { if (wr == 1) PG8_BAR; }
    }
    PG8_WAIT_V(0);
    if constexpr (!ALIGN_EPI) { if (wr == 0) PG8_BAR; }
    PG8_BAR;
    if constexpr (Epi::AFTER_DRAIN) { E.fused(acc, cur, wr, wc, fr, fq, lds, wid, lane); S.done(cur); }
#undef PG8_SA
#undef PG8_SB
#undef PG8_STAGE
#undef PG8_LDA
#undef PG8_LDB
#undef PG8_MMA
#undef PG8_WAIT_V
#undef PG8_WAIT_L
#undef PG8_BAR
#undef PG8_SCHED
}
}
namespace pg8 {
typedef const f32x4 (&AccRef)[2][2][4][2];

struct EpiStore {
    static constexpr bool PERM = true, AFTER_DRAIN = false;
    bf16_t* O; int ldc; int act; int split_cols; size_t split_stride; int gate_pn; float* G; const float* bgate;
    __device__ __forceinline__ void operator()(AccRef acc, const Unit& u, int wr, int wc, int fr, int fq) const {
        const int row0 = u.pm * BM + wr * 64 + fr;
        if (u.pn == gate_pn) {
            if (wc == 0) {
#pragma unroll
                for (int n = 0; n < 2; ++n) {
                    const int c0 = 8 * fq + 4 * n;
                    const f32x4 bg = *(const f32x4*)(bgate + c0);
                    const bool isf = (c0 & 8) != 0;
#pragma unroll
                    for (int ai = 0; ai < 2; ++ai)
#pragma unroll
                        for (int m = 0; m < 4; ++m) {
                            f32x4 v = acc[ai][0][m][n] + bg, o;
#pragma unroll
                            for (int j = 0; j < 4; ++j) { const float cpd = 15.0f * tanhf_(v[j] * (1.0f / 15.0f)); const float eu = __expf(-cpd); o[j] = isf ? -(eu < 9.765625e-4f ? eu - 0.5f * eu * eu : __logf(1.0f + eu)) : cpd; }
                            *(f32x4*)(G + (size_t)(row0 + ai * HALF + m * 16) * 32 + c0) = o;
                        }
                }
            }
            return;
        }
        int colt = u.pn * BM; bf16_t* base = O;
        if (split_cols) { const int t = colt / split_cols; base += (size_t)t * split_stride; colt -= t * split_cols; }
        const int col0 = colt + wc * 32 + 8 * fq;
#pragma unroll
        for (int ai = 0; ai < 2; ++ai)
#pragma unroll
            for (int m = 0; m < 4; ++m) { bf16_t* rowp = base + (size_t)(row0 + ai * HALF + m * 16) * ldc + col0;
#pragma unroll
                for (int bj = 0; bj < 2; ++bj) { f32x4 v0 = acc[ai][bj][m][0], v1 = acc[ai][bj][m][1];
                    if (act == 1) {
#pragma unroll
                        for (int j = 0; j < 4; ++j) { v0[j] = tanhf_(v0[j]); v1[j] = tanhf_(v1[j]); } }
                    else if (act == 2) {
#pragma unroll
                        for (int j = 0; j < 4; ++j) { v0[j] = sigmoidf_(v0[j]); v1[j] = sigmoidf_(v1[j]); } }
                    u32x4 w; w.x = cvt_pk_bf16(v0[0], v0[1]); w.y = cvt_pk_bf16(v0[2], v0[3]); w.z = cvt_pk_bf16(v1[0], v1[1]); w.w = cvt_pk_bf16(v1[2], v1[3]);
                    *(u32x4*)(rowp + bj * HALF) = w; } }
    }
};

struct EpiSigAff {
    static constexpr bool PERM = true, AFTER_DRAIN = false;
    bf16_t* O; size_t split_stride; const float* bias; float scale;
    __device__ __forceinline__ void operator()(AccRef acc, const Unit& u, int wr, int wc, int fr, int fq) const {
        const int row0 = u.pm * BM + wr * 64 + fr;
        int colt = u.pn * BM; const int t = colt / D; bf16_t* base = O + (size_t)t * split_stride; colt -= t * D;
        const int col0 = colt + wc * 32 + 8 * fq, bcol0 = u.pn * BM + wc * 32 + 8 * fq;
        f32x4 bv[2][2];
#pragma unroll
        for (int bj = 0; bj < 2; ++bj)
#pragma unroll
            for (int n = 0; n < 2; ++n) bv[bj][n] = *(const f32x4*)(bias + bcol0 + bj * HALF + 4 * n);
#pragma unroll
        for (int ai = 0; ai < 2; ++ai)
#pragma unroll
            for (int m = 0; m < 4; ++m) { bf16_t* rowp = base + (size_t)(row0 + ai * HALF + m * 16) * D + col0;
#pragma unroll
                for (int bj = 0; bj < 2; ++bj) { f32x4 v0 = acc[ai][bj][m][0] + bv[bj][0], v1 = acc[ai][bj][m][1] + bv[bj][1];
#pragma unroll
                    for (int j = 0; j < 4; ++j) { v0[j] = scale * sigmoidf_(v0[j]); v1[j] = scale * sigmoidf_(v1[j]); }
                    u32x4 w; w.x = cvt_pk_bf16(v0[0], v0[1]); w.y = cvt_pk_bf16(v0[2], v0[3]); w.z = cvt_pk_bf16(v1[0], v1[1]); w.w = cvt_pk_bf16(v1[2], v1[3]);
                    *(u32x4*)(rowp + bj * HALF) = w; } }
    }
};

struct EpiVmix {
    static constexpr bool PERM = true, AFTER_DRAIN = false;
    bf16_t* V; const bf16_t* VF; const float* v0;
    __device__ __forceinline__ void operator()(AccRef acc, const Unit& u, int wr, int wc, int fr, int fq) const {
        const int row0 = u.pm * BM + wr * 64 + fr; const int col0 = u.pn * BM + wc * 32 + 8 * fq;
        f32x4 bv[2][2];
#pragma unroll
        for (int bj = 0; bj < 2; ++bj)
#pragma unroll
            for (int n = 0; n < 2; ++n) bv[bj][n] = *(const f32x4*)(v0 + col0 + bj * HALF + 4 * n);
#pragma unroll
        for (int ai = 0; ai < 2; ++ai) {
            u32x4 vvs[4][2], ffs[4][2];
#pragma unroll
            for (int m = 0; m < 4; ++m) { const size_t off = (size_t)(row0 + ai * HALF + m * 16) * D + col0;
#pragma unroll
                for (int bj = 0; bj < 2; ++bj) { vvs[m][bj] = *(const u32x4*)(V + off + bj * HALF); ffs[m][bj] = *(const u32x4*)(VF + off + bj * HALF); } }
            asm volatile("" ::: "memory");
#pragma unroll
            for (int m = 0; m < 4; ++m) { const size_t off = (size_t)(row0 + ai * HALF + m * 16) * D + col0;
#pragma unroll
                for (int bj = 0; bj < 2; ++bj) {
                    const u32x4 vv = vvs[m][bj], ff = ffs[m][bj];
                    const f32x4 a0 = acc[ai][bj][m][0] + bv[bj][0], a1 = acc[ai][bj][m][1] + bv[bj][1];
                    float o[8];
#pragma unroll
                    for (int j = 0; j < 4; ++j) {
                        const unsigned vw = j == 0 ? vv.x : j == 1 ? vv.y : j == 2 ? vv.z : vv.w, fw = j == 0 ? ff.x : j == 1 ? ff.y : j == 2 ? ff.z : ff.w;
                        const float s0 = sigmoidf_(j < 2 ? a0[2 * j] : a1[2 * j - 4]), s1 = sigmoidf_(j < 2 ? a0[2 * j + 1] : a1[2 * j - 3]);
                        const float x0 = lo_bf(vw), x1 = hi_bf(vw), f0 = lo_bf(fw), f1 = hi_bf(fw);
                        o[2 * j] = x0 + (f0 - x0) * s0; o[2 * j + 1] = x1 + (f1 - x1) * s1; }
                    u32x4 w; w.x = cvt_pk_bf16(o[0], o[1]); w.y = cvt_pk_bf16(o[2], o[3]); w.z = cvt_pk_bf16(o[4], o[5]); w.w = cvt_pk_bf16(o[6], o[7]);
                    *(u32x4*)(V + off + bj * HALF) = w; } }
            asm volatile("" ::: "memory"); }
    }
};

struct EpiResid {
    static constexpr bool PERM = false, AFTER_DRAIN = false;
    float* X; const float* gate; int tile0; const float* srcx; const float* srcc;
    __device__ __forceinline__ void operator()(AccRef acc, const Unit& u, int wr, int wc, int fr, int fq) const {
        const int gpm = tile0 + u.pm; const int b = gpm / 9, tix = gpm % 9; const int idx = (tix == 0) ? 16 : b;
        const int rloc = wr * 64 + fr, col0 = u.pn * BM + wc * 32 + 4 * fq;
        const float* src = srcx ? (tix == 0 ? srcc + (size_t)b * CTXL * D : srcx + ((size_t)b * SEQ + (size_t)(tix - 1) * BM) * D) : X + (size_t)gpm * BM * D;
        float* dst = X + (size_t)gpm * BM * D;
        f32x4 gv[2][2];
#pragma unroll
        for (int bj = 0; bj < 2; ++bj)
#pragma unroll
            for (int n = 0; n < 2; ++n) gv[bj][n] = *(const f32x4*)(gate + (size_t)idx * MODLD + col0 + bj * HALF + n * 16);
        f32x4 (&ac)[2][2][4][2] = const_cast<f32x4 (&)[2][2][4][2]>(acc);
        f32x4 xa[2][2], xb[2][2];
#define RES_LD(dstv, ai_, m_) do { const size_t off_ = (size_t)(rloc + (ai_) * HALF + (m_) * 16) * D + col0; _Pragma("unroll") for (int bj = 0; bj < 2; ++bj) _Pragma("unroll") for (int n = 0; n < 2; ++n) \
            dstv[bj][n] = *(const f32x4*)(src + off_ + bj * HALF + n * 16); } while (0)
#define RES_FMA(srcv, ai_, m_) do { _Pragma("unroll") for (int bj = 0; bj < 2; ++bj) _Pragma("unroll") for (int n = 0; n < 2; ++n) ac[ai_][bj][m_][n] = srcv[bj][n] + gv[bj][n] * ac[ai_][bj][m_][n]; } while (0)
        RES_LD(xa, 0, 0); RES_LD(xb, 0, 1);
        RES_FMA(xa, 0, 0); RES_LD(xa, 0, 2); RES_FMA(xb, 0, 1); RES_LD(xb, 0, 3);
        RES_FMA(xa, 0, 2); RES_LD(xa, 1, 0); RES_FMA(xb, 0, 3); RES_LD(xb, 1, 1);
        RES_FMA(xa, 1, 0); RES_LD(xa, 1, 2); RES_FMA(xb, 1, 1); RES_LD(xb, 1, 3);
        RES_FMA(xa, 1, 2); RES_FMA(xb, 1, 3);
#undef RES_LD
#undef RES_FMA
        asm volatile("" ::: "memory");
#pragma unroll
        for (int ai = 0; ai < 2; ++ai)
#pragma unroll
            for (int m = 0; m < 4; ++m) { const size_t off = (size_t)(rloc + ai * HALF + m * 16) * D + col0;
#pragma unroll
                for (int bj = 0; bj < 2; ++bj)
#pragma unroll
                    for (int n = 0; n < 2; ++n) *(f32x4*)(dst + off + bj * HALF + n * 16) = ac[ai][bj][m][n]; }
    }
};

struct EpiSwiglu {
    static constexpr bool PERM = true, AFTER_DRAIN = false;
    bf16_t* O;
    __device__ __forceinline__ void operator()(AccRef acc, const Unit& u, int wr, int wc, int fr, int fq) const {
        const int row0 = u.pm * BM + wr * 64 + fr; const int col0 = u.pn * HALF + wc * 32 + 8 * fq;
#pragma unroll
        for (int ai = 0; ai < 2; ++ai)
#pragma unroll
            for (int m = 0; m < 4; ++m) { bf16_t* rowp = O + (size_t)(row0 + ai * HALF + m * 16) * DFF + col0;
                f32x4 v0, v1;
#pragma unroll
                for (int j = 0; j < 4; ++j) { v0[j] = siluf_(acc[ai][0][m][0][j]) * acc[ai][1][m][0][j]; v1[j] = siluf_(acc[ai][0][m][1][j]) * acc[ai][1][m][1][j]; }
                u32x4 w; w.x = cvt_pk_bf16(v0[0], v0[1]); w.y = cvt_pk_bf16(v0[2], v0[3]); w.z = cvt_pk_bf16(v1[0], v1[1]); w.w = cvt_pk_bf16(v1[2], v1[3]);
                *(u32x4*)rowp = w; }
    }
};
}

namespace pg8 {
struct SkipCtxOrder : StaticOrder {
    __device__ __forceinline__ bool next(int i, Unit& u) const { if (!StaticOrder::next(i, u)) return false; u.pm = u.pm + (u.pm >> 3) + 1; return true; }
};
}
template <class Epi, bool SKIPCTX = false>
__device__ __forceinline__ void run_gemm(LAS unsigned char* lds, const bf16_t* A, const bf16_t* Bt, int M, int N, int K, const Epi& E, int& urot) {
    pg8::Gemm g{A, Bt, M, N, K};
    const int G = (int)gridDim.x; const int Meff = SKIPCTX ? (M / 9) * 8 : M; const int nwg = (Meff / 256) * (N / 256);
    const int c = ((int)blockIdx.x + G - (urot % G)) % G;
    if constexpr (SKIPCTX) { pg8::SkipCtxOrder S; S.init(Meff, N, G, c); pg8::gemm_phase<Epi, pg8::SkipCtxOrder, GP_ALIGN, GP_SP2>(lds, g, S, E); }
    else { pg8::StaticOrder S; S.init(M, N, G, c); pg8::gemm_phase<Epi, pg8::StaticOrder, GP_ALIGN, GP_SP2>(lds, g, S, E); }
    urot += nwg;
}
struct Args { const float* in[NIN]; float* out; unsigned char* ws; int ph_lo, ph_hi; };
static_assert(sizeof(Args) == NIN * 8 + 8 + 8 + 8, "Args has no padding");

typedef const __attribute__((address_space(4))) Args* CArgs;
__device__ __forceinline__ CArgs opaque_args() { CArgs p = (CArgs)__builtin_amdgcn_kernarg_segment_ptr(); asm volatile("" : "+s"(p)); return p; }
struct Tc { LAS unsigned char* lds; int tid, lane, wave, bid, G, gw, ngw; };
__device__ __forceinline__ Tc mk_tc(LAS unsigned char* lds) { Tc t; int tid = threadIdx.x; asm volatile("" : "+v"(tid)); t.lds = lds; t.tid = tid; t.lane = tid & 63; t.wave = __builtin_amdgcn_readfirstlane(tid >> 6);
    t.bid = blockIdx.x; t.G = gridDim.x; t.gw = t.bid * 8 + t.wave; t.ngw = t.G * 8; return t; }

template <class RM>
__device__ __forceinline__ void tr_item(const float* W, int ldw, bf16_t* WT, int ldk, const RM& rm, LAS float* scr, int kb, int nb, int lane) {
    const int k0 = 64 * kb, n0 = 32 * nb;
    float tmp[32];
#pragma unroll
    for (int i = 0; i < 32; ++i) { const int kk = 2 * i + (lane >> 5); tmp[i] = W[(size_t)(k0 + kk) * ldw + n0 + (lane & 31)]; }
    asm volatile("" ::: "memory");
#pragma unroll
    for (int i = 0; i < 32; ++i) { const int kk = 2 * i + (lane >> 5); scr[kk * 33 + (lane & 31)] = tmp[i]; }
    LDS_WAIT();
    const int c = lane & 7;
#pragma unroll
    for (int j = 0; j < 4; ++j) { const int n = (lane >> 3) + 8 * j; const LAS float* s = scr + (8 * c) * 33 + n;
        u32x4 o; o.x = pk2(s[0 * 33], s[1 * 33]); o.y = pk2(s[2 * 33], s[3 * 33]); o.z = pk2(s[4 * 33], s[5 * 33]); o.w = pk2(s[6 * 33], s[7 * 33]);
        *(u32x4*)(WT + (size_t)rm(n0 + n) * ldk + k0 + 8 * c) = o; }
    LDS_WAIT();
}
struct RmId { __device__ __forceinline__ int operator()(int n) const { return n; } };
struct RmSwiglu { __device__ __forceinline__ int operator()(int n) const { const int up = n >= DFF ? 1 : 0; const int m = n - up * DFF; return 256 * (m >> 7) + 128 * up + (m & 127); } };

template <class RM>
__device__ __forceinline__ void tr_matrix(const Tc& t, const float* W, int K, int N, int ldw, bf16_t* WT, int ldk, const RM& rm) {
    LAS float* scr = (LAS float*)(t.lds + t.wave * 16384);
    const int nkb = K / 64, nnb = N / 32, items = nkb * nnb;
    for (int it = t.gw; it < items; it += t.ngw) tr_item(W, ldw, WT, ldk, rm, scr, it / nnb, it % nnb, t.lane);
}
template <class SRC>
__device__ __forceinline__ void build_small(const Tc& t, bf16_t* dst, int NR, int KC, const SRC& src) {
    const int total = NR * (KC / 8);
    for (int i = t.gw * 64 + t.lane; i < total; i += t.ngw * 64) { const int n = i % NR, ko = i / NR;
        float v[8];
#pragma unroll
        for (int j = 0; j < 8; ++j) v[j] = src(n, 8 * ko + j);
        u32x4 o; o.x = pk2(v[0], v[1]); o.y = pk2(v[2], v[3]); o.z = pk2(v[4], v[5]); o.w = pk2(v[6], v[7]);
        *(u32x4*)(dst + (size_t)n * KC + 8 * ko) = o; }
}

__device__ __forceinline__ void convert_rwkv(const Tc& t, CArgs a, int jl) {
    bf16_t* wm = (bf16_t*)(a->ws + WS_WMIX);
    const size_t dd = (size_t)D * D;
    tr_matrix(t, a->in[I_WR] + jl * dd, D, D, D, (bf16_t*)((char*)wm + WM_R), D, RmId());
    tr_matrix(t, a->in[I_WK] + jl * dd, D, D, D, (bf16_t*)((char*)wm + WM_K), D, RmId());
    tr_matrix(t, a->in[I_WV] + jl * dd, D, D, D, (bf16_t*)((char*)wm + WM_V), D, RmId());
    tr_matrix(t, a->in[I_WO] + jl * dd, D, D, D, (bf16_t*)((char*)wm + WM_O), D, RmId());
    { const float* w1 = a->in[I_W1] + (size_t)jl * 2 * D * 96;
      build_small(t, (bf16_t*)((char*)wm + WM_W1), 256, D, [=](int n, int k) -> float { if (n >= 192) return 0.f; const int z = n >= 96 ? 1 : 0, r = n - 96 * z; return w1[((size_t)z * D + k) * 96 + r]; }); }
    { const float* a1 = a->in[I_A1] + (size_t)jl * 2 * D * 96;
      build_small(t, (bf16_t*)((char*)wm + WM_A1), 256, D, [=](int n, int k) -> float { if (n >= 192) return 0.f; const int z = n >= 96 ? 1 : 0, r = n - 96 * z; return a1[((size_t)z * D + k) * 96 + r]; }); }
    { const float* g1 = a->in[I_G1] + (size_t)jl * D * 256;
      build_small(t, (bf16_t*)((char*)wm + WM_G1), 256, D, [=](int n, int k) -> float { return g1[(size_t)k * 256 + n]; }); }
    if (jl > 0) { const float* v1 = a->in[I_V1] + (size_t)(jl - 1) * D * 64;
      build_small(t, (bf16_t*)((char*)wm + WM_V1), 256, D, [=](int n, int k) -> float { return n < 64 ? v1[(size_t)k * 64 + n] : 0.f; }); }
    { const float* w2 = a->in[I_W2] + (size_t)jl * 2 * 96 * D;
      build_small(t, (bf16_t*)((char*)wm + WM_W2), 2 * D, 256, [=](int n, int k) -> float { const int z = n >= D ? 1 : 0, ch = n - z * D, kk = k - 96 * z; return (kk >= 0 && kk < 96) ? w2[((size_t)z * 96 + kk) * D + ch] : 0.f; }); }
    { const float* a2 = a->in[I_A2] + (size_t)jl * 2 * 96 * D;
      build_small(t, (bf16_t*)((char*)wm + WM_A2), 2 * D, 256, [=](int n, int k) -> float { const int z = n >= D ? 1 : 0, ch = n - z * D, kk = k - 96 * z; return (kk >= 0 && kk < 96) ? a2[((size_t)z * 96 + kk) * D + ch] : 0.f; }); }
    { const float* g2 = a->in[I_G2] + (size_t)jl * 256 * D;
      build_small(t, (bf16_t*)((char*)wm + WM_G2), D, 256, [=](int n, int k) -> float { return g2[(size_t)k * D + n]; }); }
    if (jl > 0) { const float* v2 = a->in[I_V2] + (size_t)(jl - 1) * 64 * D;
      build_small(t, (bf16_t*)((char*)wm + WM_V2), D, 256, [=](int n, int k) -> float { return k < 64 ? v2[(size_t)k * D + n] : 0.f; }); }
}
__device__ __forceinline__ void convert_mlstm(const Tc& t, CArgs a, int jl) {
    bf16_t* win = (bf16_t*)(a->ws + WS_WMIX + WM_MIN); bf16_t* wout = (bf16_t*)(a->ws + WS_WMIX + WM_MOUT);
    tr_matrix(t, a->in[I_MWIN] + (size_t)jl * D * MPROJ, D, MPROJ, MPROJ, win, D, RmId());
    { u32x4* z = (u32x4*)(win + (size_t)MPROJ * D); const int total = (6400 - MPROJ) * D / 8; unsigned zz = 0u; asm volatile("" : "+v"(zz)); const u32x4 zero = {zz, zz, zz, zz};
      for (int i = t.gw * 64 + t.lane; i < total; i += t.ngw * 64) z[i] = zero; }
    tr_matrix(t, a->in[I_MWOUT] + (size_t)jl * D * D, D, D, D, wout, D, RmId());
}
__device__ __forceinline__ void convert_ffn_in(const Tc& t, CArgs a, int layer) {
    tr_matrix(t, a->in[I_FWIN] + (size_t)layer * D * 2 * DFF, D, 2 * DFF, 2 * DFF, (bf16_t*)(a->ws + WS_WFFN + WF_IN), D, RmSwiglu());
}
__device__ __forceinline__ void convert_ffn_out(const Tc& t, CArgs a, int layer) {
    tr_matrix(t, a->in[I_FWOUT] + (size_t)layer * DFF * D, DFF, D, D, (bf16_t*)(a->ws + WS_WFFN + WF_OUT), DFF, RmId());
}
__device__ __forceinline__ bool tail_crew(const Tc& t, int urot0, int nwg, Tc& ts) {
    const int G = t.G, r = nwg % G, c = (t.bid + G - (urot0 % G)) % G;
    ts = t;
    if (r == 0) return true;
    if (c < r) return false;
    ts.bid = c - r; ts.G = G - r; ts.gw = ts.bid * 8 + t.wave; ts.ngw = ts.G * 8; return true;
}

__device__ __forceinline__ void ph_prologue(const Tc& t, CArgs a) {
    LAS float* S = (LAS float*)t.lds;
    { f32x4 cv[17];
#pragma unroll
      for (int b = 0; b < 17; ++b) cv[b] = *(const f32x4*)((b < 16 ? a->in[I_C] + (size_t)b * D : a->in[I_CCTX]) + 4 * t.tid);
      const int k = 4 * t.tid;
#pragma unroll
      for (int b = 0; b < 17; ++b) { const f32x4 s = {siluf_(cv[b][0]), siluf_(cv[b][1]), siluf_(cv[b][2]), siluf_(cv[b][3])};
          *(LAS f32x4*)(S + b * 2056 + (k >> 10) * 1028 + (k & 1023)) = s; } }
    __syncthreads();
    float* mod = (float*)(a->ws + WS_MOD);
    const int col = t.lane & 31, kh = t.lane >> 5;
    for (int it = t.wave * t.G + t.bid; it < 4 * 384; it += t.ngw) { const int layer = it / 384, n0 = 32 * (it % 384);
        const auto wrs = __builtin_amdgcn_make_buffer_rsrc((void*)(a->in[I_MODW] + (size_t)layer * D * MODLD), (short)0, (int)((size_t)D * MODLD * 4), 0x00020000);
        const unsigned voff = (unsigned)(kh * 1024 * MODLD + n0 + col) * 4u;
        const LAS float* Sk = S + kh * 1028;
        f32x2 acc[17];
#pragma unroll
        for (int b = 0; b < 17; ++b) acc[b] = (f32x2){0.f, 0.f};
        float wa[8], wb[8];
#define MOD_LD(dst, k0_) do { _Pragma("unroll") for (int j = 0; j < 8; ++j) dst[j] = __builtin_bit_cast(float, __builtin_amdgcn_raw_buffer_load_b32(wrs, voff, (unsigned)(((k0_) + j) * MODLD * 4), 0)); } while (0)
#define MOD_FMA(src, k0_) do { _Pragma("unroll") for (int j4 = 0; j4 < 2; ++j4) { _Pragma("unroll") for (int b = 0; b < 17; ++b) { const f32x4 s = *(const LAS f32x4*)(Sk + b * 2056 + (k0_) + 4 * j4); \
            acc[b] = acc[b] + (f32x2){s[0], s[1]} * (f32x2){src[4 * j4], src[4 * j4 + 1]} + (f32x2){s[2], s[3]} * (f32x2){src[4 * j4 + 2], src[4 * j4 + 3]}; } asm volatile("" ::: "memory"); } } while (0)
        MOD_LD(wa, 0);
#pragma unroll 1
        for (int k0 = 0; k0 < 1024; k0 += 16) {
            MOD_LD(wb, k0 + 8);
            MOD_FMA(wa, k0);
            if (k0 + 16 < 1024) MOD_LD(wa, k0 + 16);
            MOD_FMA(wb, k0 + 8); }
#undef MOD_LD
#undef MOD_FMA
#pragma unroll
        for (int b = 0; b < 17; ++b) { float v = acc[b].x + acc[b].y; v += shfl_xor_(v, 32, t.lane);
            if (kh == 0) mod[((size_t)layer * 17 + b) * MODLD + n0 + col] = v + a->in[I_MODB][layer * MODLD + n0 + col]; } }
    __syncthreads();
}

template <bool OUT_BF16>
__device__ __forceinline__ void norm_rows(const Tc& t, CArgs a, int layer, int which, int row_begin, int nrows, void* out, bool from_inputs = false) {
    const float* xres = (const float*)(a->ws + WS_XRES);
    const float* mod = (const float*)(a->ws + WS_MOD) + (size_t)layer * 17 * MODLD;
    const int npw = (nrows + t.ngw - 1) / t.ngw;
    f32x4 gg[8], gm[8], sh[8];
    { const f32x4* gp = (const f32x4*)(a->in[I_NORMG] + (size_t)(layer * 2 + which) * D) + t.lane;
#pragma unroll
      for (int j = 0; j < 8; ++j) gg[j] = gp[64 * j]; }
    int cur_idx = -1;
    auto rowptr = [&](int r) -> const f32x4* { const int grow = row_begin + r; const int gb = grow / SROW, gs = grow % SROW;
        const float* rp = from_inputs ? (gs < CTXL ? a->in[I_CTX] + ((size_t)gb * CTXL + gs) * D : a->in[I_X] + ((size_t)gb * SEQ + (gs - CTXL)) * D) : xres + (size_t)grow * D;
        return (const f32x4*)rp + t.lane; };
    const int rfirst = t.gw * npw;
    if (rfirst >= nrows) return;
    const int nmine = (nrows - rfirst) < npw ? (nrows - rfirst) : npw;
    f32x4 xn[8];
    { const f32x4* xr = rowptr(rfirst);
#pragma unroll
      for (int j = 0; j < 8; ++j) xn[j] = xr[64 * j]; }
    for (int i = 0; i < nmine; ++i) { const int r = rfirst + i; const int grow = row_begin + r; const int idx = (grow % SROW) < CTXL ? 16 : grow / SROW;
        f32x4 v[8];
#pragma unroll
        for (int j = 0; j < 8; ++j) v[j] = xn[j];
        if (idx != cur_idx) { cur_idx = idx;
            const f32x4* shp = (const f32x4*)(mod + (size_t)idx * MODLD + (3 * which) * D) + t.lane; const f32x4* scp = (const f32x4*)(mod + (size_t)idx * MODLD + (3 * which + 1) * D) + t.lane;
#pragma unroll
            for (int j = 0; j < 8; ++j) { sh[j] = shp[64 * j]; gm[j] = gg[j] * (scp[64 * j] + 1.0f); } }
        if (i + 1 < nmine) { const f32x4* xr = rowptr(r + 1);
#pragma unroll
            for (int j = 0; j < 8; ++j) xn[j] = xr[64 * j]; }
        asm volatile("" ::: "memory");
        float ss = 0.f;
#pragma unroll
        for (int j = 0; j < 8; ++j) ss += (v[j].x * v[j].x + v[j].y * v[j].y) + (v[j].z * v[j].z + v[j].w * v[j].w);
        const float rstd = rsqrtf(wave_sum_dpp(ss) * (1.0f / D) + 1e-6f);
#pragma unroll
        for (int j = 0; j < 8; ++j) { const f32x4 o = v[j] * rstd * gm[j] + sh[j];
            if (OUT_BF16) { u32x2 w; w.x = pk2(o.x, o.y); w.y = pk2(o.z, o.w); ((u32x2*)((bf16_t*)out + (size_t)r * D))[64 * j + t.lane] = w; }
            else ((f32x4*)((float*)out + (size_t)r * D))[64 * j + t.lane] = o; }
        asm volatile("" ::: "memory");
    }
}

__device__ __forceinline__ void r2_mix(const Tc& t, CArgs a, int jl) {
    const bf16_t* H = (const bf16_t*)(a->ws + WS_ACT + AR_H);
    const int sl = t.gw & 3, c0 = 512 * sl + 8 * t.lane;
    const float* mu = a->in[I_MU] + (size_t)jl * 6 * D + c0;
    f32x4 m0[6], m1[6];
#pragma unroll
    for (int m = 0; m < 6; ++m) { m0[m] = *(const f32x4*)(mu + m * D); m1[m] = *(const f32x4*)(mu + m * D + 4); }
    const int rstep = t.ngw >> 2;
    for (int r0 = t.gw >> 2; r0 < TG; r0 += 4 * rstep) {
        u32x4 hw[4], nw[4];
#pragma unroll
        for (int k = 0; k < 4; ++k) { const int r = r0 + k * rstep; hw[k] = (u32x4){0u, 0u, 0u, 0u}; nw[k] = hw[k];
            if (r < TG) { const int s = r % SROW; int nr;
                if (s < CTXL) nr = sl < 2 ? (s > 0 ? r - 1 : -1) : (s < CTXL - 1 ? r + 1 : -1);
                else { const int i = s - CTXL, gr = i >> 6, gc = i & 63; nr = sl == 0 ? (gc > 0 ? r - 1 : -1) : sl == 1 ? (gc < 63 ? r + 1 : -1) : sl == 2 ? (gr > 0 ? r - 64 : -1) : (gr < 31 ? r + 64 : -1); }
                hw[k] = *(const u32x4*)(H + (size_t)r * D + c0);
                if (nr >= 0) nw[k] = *(const u32x4*)(H + (size_t)nr * D + c0); } }
        asm volatile("" ::: "memory");
#pragma unroll
        for (int k = 0; k < 4; ++k) { const int r = r0 + k * rstep;
            if (r < TG) {
                const f32x4 h0 = {lo_bf(hw[k].x), hi_bf(hw[k].x), lo_bf(hw[k].y), hi_bf(hw[k].y)}, h1 = {lo_bf(hw[k].z), hi_bf(hw[k].z), lo_bf(hw[k].w), hi_bf(hw[k].w)};
                const f32x4 n0 = {lo_bf(nw[k].x), hi_bf(nw[k].x), lo_bf(nw[k].y), hi_bf(nw[k].y)}, n1 = {lo_bf(nw[k].z), hi_bf(nw[k].z), lo_bf(nw[k].w), hi_bf(nw[k].w)};
                const f32x4 x0 = n0 - h0, x1 = n1 - h1;
#pragma unroll
                for (int m = 0; m < 6; ++m) { const f32x4 o0 = h0 + x0 * m0[m], o1 = h1 + x1 * m1[m];
                    u32x4 w; w.x = pk2(o0.x, o0.y); w.y = pk2(o0.z, o0.w); w.z = pk2(o1.x, o1.y); w.w = pk2(o1.z, o1.w);
                    *(u32x4*)(a->ws + WS_ACT + AR_MIX + (size_t)m * SLOT + ((size_t)r * D + c0) * 2) = w; } } }
        asm volatile("" ::: "memory");
    }
}

constexpr int R5_L = 16;
constexpr int R5_ZR = 0, R5_BK = 4608, R5_BKT = 9216, R5_V = 14336, R5_GL = 18432, R5_CH = 18688;
constexpr int R5_BUF = 2 * R5_CH;
constexpr int R5_GR = 2 * R5_BUF;
constexpr int R5_GRCH = 3072;
constexpr int R5_DS = R5_GR + 2 * R5_GRCH;
constexpr int R5_YS = R5_DS + 8 * 1024;
constexpr int R5_PW = R5_YS + 2 * 2 * 4096;
constexpr int R5_END = R5_PW + 4 * 8192 + 512;
static_assert(R5_END <= LDSCTL_OFF, "scan LDS");
__device__ __forceinline__ int r5_seq(int z, int tt) { return z == 0 ? tt : (tt < CTXL ? CTXL - 1 - tt : SROW + CTXL - 1 - tt); }

__device__ __forceinline__ void r5_scan(const Tc& t, CArgs a, int jl, int layer, int g) {
    const bf16_t* R = (const bf16_t*)(a->ws + WS_ACT + AR_R);
    const bf16_t* Kb = (const bf16_t*)(a->ws + WS_ACT + AR_K);
    const bf16_t* Vb = (layer == 0) ? (const bf16_t*)(a->ws + WS_VF) + (size_t)g * TG * D : (const bf16_t*)(a->ws + WS_ACT + AR_V);
    const int w = t.wave, lane = t.lane, c2 = w >> 2, q = w & 3, l15 = lane & 15, q4 = lane >> 4;
    for (int pair = t.bid; pair < BG * RH; pair += t.G) {
        const int z = pair / (BG * RH / 2), bl = (pair / (RH / 2)) % BG, h = 2 * (pair % (RH / 2)) + c2;
        const bf16_t* E = (const bf16_t*)(a->ws + WS_ACT + AR_MIX + (size_t)z * SLOT);
        const bf16_t* Aa = (const bf16_t*)(a->ws + WS_ACT + AR_MIX + (size_t)(2 + z) * SLOT);
        bf16_t* Y = (bf16_t*)(a->ws + WS_ACT + AR_Y + (size_t)z * SLOT);
        float* RKo = (float*)(a->ws + WS_ACT + AR_RK) + (size_t)z * TG * 32;
        const size_t colb = (size_t)h * 64 + lane;
        f32x4 ST[4];
#pragma unroll
        for (int cb = 0; cb < 4; ++cb) ST[cb] = (f32x4){0.f, 0.f, 0.f, 0.f};
        const int pst = q == 0 ? 0 : 6 * (q - 1), npass = q == 0 ? 0 : (q == 3 ? 2 : 3);
        const int hf = lane >> 5, pi = lane & 31;
        unsigned ce[8], pr[3], pk[3], pv[3], pa[3];
        const int sd = z == 0 ? 1 : -1;
        const bf16_t* Eh = E + (size_t)bl * SROW * D + (size_t)h * 64; const bf16_t* Rh = R + (size_t)bl * SROW * D + (size_t)h * 64; const bf16_t* Kh = Kb + (size_t)bl * SROW * D + (size_t)h * 64;
        const bf16_t* Vh = Vb + (size_t)bl * SROW * D + (size_t)h * 64; const bf16_t* Ah = Aa + (size_t)bl * SROW * D + (size_t)h * 64;
        f32x2 kkc2, kac2, rkc2;
        { const size_t c0 = (size_t)jl * D + (size_t)h * 64 + 2 * pi; kkc2 = *(const f32x2*)(a->in[I_KK] + c0); kac2 = *(const f32x2*)(a->in[I_KA] + c0); rkc2 = *(const f32x2*)(a->in[I_RK] + c0); }
        auto prep_load = [&](int n) {
            if (q == 0) return;
            const int s0 = r5_seq(z, n * R5_L); const unsigned rlo = (unsigned)(sd > 0 ? s0 : s0 - 15) * (unsigned)D;
#pragma unroll
            for (int ps = 0; ps < 3; ++ps) if (ps < npass) { const int st = pst + 2 * ps + hf; const unsigned off = rlo + (unsigned)((sd > 0 ? st : 15 - st) * D) + 2u * (unsigned)pi;
                pr[ps] = *(const unsigned*)(Rh + off); pk[ps] = *(const unsigned*)(Kh + off); pv[ps] = *(const unsigned*)(Vh + off); pa[ps] = *(const unsigned*)(Ah + off); }
        };
        auto halfsum = [&](float v) -> float { v = sum16_(v); const float h0 = rl_(v, 0) + rl_(v, 16), h1 = rl_(v, 32) + rl_(v, 48); return hf ? h1 : h0; };
        auto prep_finish = [&](int n) {
            if (q == 0) return;
            LAS unsigned char* cbuf = t.lds + (n & 1) * R5_BUF + c2 * R5_CH;
            LAS bf16_t* ZR = (LAS bf16_t*)(cbuf + R5_ZR); LAS bf16_t* BK = (LAS bf16_t*)(cbuf + R5_BK); LAS bf16_t* BKT = (LAS bf16_t*)(cbuf + R5_BKT);
            LAS float* Vs = (LAS float*)(cbuf + R5_V); LAS float* GL = (LAS float*)(cbuf + R5_GL);
            const LAS f32x2* GT = (const LAS f32x2*)(t.lds + R5_PW + ((n & 1) * 2 + c2) * 8192);
            const LAS f32x2* GI = GT + 512;
            if (q == 3 && hf == 0) *(LAS f32x2*)(GL + 2 * pi) = GT[15 * 32 + pi];
            const int s0 = r5_seq(z, n * R5_L); float rkv[3] = {0.f, 0.f, 0.f};
#pragma unroll
            for (int ps = 0; ps < 3; ++ps) if (ps < npass) { const int st = pst + 2 * ps + hf;
                const f32x2 gt = GT[st * 32 + pi]; const f32x2 gi = {__builtin_amdgcn_rcpf(gt.x), __builtin_amdgcn_rcpf(gt.y)}; f32x2 gp = {1.f, 1.f}; if (st > 0) gp = GT[(st - 1) * 32 + pi];
                const f32x2 r2 = {lo_bf(pr[ps]), hi_bf(pr[ps])}, k2 = {lo_bf(pk[ps]), hi_bf(pk[ps])}, v2 = {lo_bf(pv[ps]), hi_bf(pv[ps])}, a2 = {lo_bf(pa[ps]), hi_bf(pa[ps])};
                f32x2 kk2 = k2 * kkc2; const float n2 = halfsum(kk2.x * kk2.x + kk2.y * kk2.y); kk2 = kk2 * __builtin_amdgcn_rsqf(fmaxf(n2, 1e-24f));
                const f32x2 km2 = k2 * ((a2 - 1.0f) * kac2 + 1.0f);
                const f32x2 rkm = r2 * km2 * rkc2; const float rk = halfsum(rkm.x + rkm.y);
                rkv[ps] = rk;
                const f32x2 zt = kk2 * gp * -1.0f, rt = r2 * gt, bt = kk2 * a2 * gi, kt = km2 * gi;
                const unsigned zw = pk2(zt.x, zt.y), rw = pk2(rt.x, rt.y), bw = pk2(bt.x, bt.y), kw = pk2(kt.x, kt.y);
                *(LAS unsigned*)(ZR + st * 72 + 2 * pi) = zw; *(LAS unsigned*)(ZR + (16 + st) * 72 + 2 * pi) = rw; *(LAS unsigned*)(BK + st * 72 + 2 * pi) = bw; *(LAS unsigned*)(BK + (16 + st) * 72 + 2 * pi) = kw;
                BKT[(2 * pi) * 40 + st] = (bf16_t)(bw & 0xffffu); BKT[(2 * pi + 1) * 40 + st] = (bf16_t)(bw >> 16);
                BKT[(2 * pi) * 40 + 16 + st] = (bf16_t)(kw & 0xffffu); BKT[(2 * pi + 1) * 40 + 16 + st] = (bf16_t)(kw >> 16);
                *(LAS f32x2*)(Vs + st * 64 + 2 * pi) = v2; }
            if (pi == 0) {
#pragma unroll
                for (int ps = 0; ps < 3; ++ps) if (ps < npass) RKo[((size_t)bl * SROW + s0 + sd * (pst + 2 * ps + hf)) * 32 + h] = rkv[ps]; }
        };
        auto cum_load = [&](int m) {
            const int s0 = r5_seq(z, m * R5_L); const unsigned rlo = (unsigned)(sd > 0 ? s0 : s0 - 15) * (unsigned)D;
#pragma unroll
            for (int j = 0; j < 8; ++j) { const int i = 8 * hf + j; ce[j] = *(const unsigned*)(Eh + rlo + (unsigned)((sd > 0 ? i : 15 - i) * D) + 2u * (unsigned)pi); }
        };
        auto cum_finish = [&](int m) {
            LAS f32x2* GT = (LAS f32x2*)(t.lds + R5_PW + ((m & 1) * 2 + c2) * 8192); LAS f32x2* GI = GT + 512;
            LAS f32x2* HB = (LAS f32x2*)(t.lds + R5_PW + 4 * 8192 + c2 * 256);
            f32x2 cs[8]; f32x2 lg = {0.f, 0.f};
#pragma unroll
            for (int j = 0; j < 8; ++j) { lg = lg + (f32x2){lo_bf(ce[j]), hi_bf(ce[j])}; cs[j] = lg; }
            if (hf == 0) HB[pi] = lg;
            asm volatile("s_waitcnt lgkmcnt(0)" ::: "memory");
            f32x2 base = HB[pi]; if (hf == 0) base = (f32x2){0.f, 0.f};
#pragma unroll
            for (int j = 0; j < 8; ++j) { const f32x2 c = cs[j] + base;
                GT[(8 * hf + j) * 32 + pi] = (f32x2){__expf(c.x), __expf(c.y)}; }
        };
        constexpr int NCH = SROW / R5_L;
        if (q == 0) { cum_load(0); cum_finish(0); cum_load(1); cum_finish(1); cum_load(2); } else prep_load(0);
        __syncthreads();
        prep_finish(0); prep_load(1);
        __syncthreads();
        for (int n = 0; n < NCH; ++n) {
            LAS unsigned char* cbuf = t.lds + (n & 1) * R5_BUF + c2 * R5_CH;
            const LAS bf16_t* ZR = (const LAS bf16_t*)(cbuf + R5_ZR); const LAS bf16_t* BK = (const LAS bf16_t*)(cbuf + R5_BK); const LAS bf16_t* BKT = (const LAS bf16_t*)(cbuf + R5_BKT);
            const LAS float* Vs = (const LAS float*)(cbuf + R5_V); const LAS float* GL = (const LAS float*)(cbuf + R5_GL);
            LAS float* Nm = (LAS float*)(t.lds + R5_GR + c2 * R5_GRCH); LAS bf16_t* MKZ = (LAS bf16_t*)(t.lds + R5_GR + c2 * R5_GRCH + 1024); LAS bf16_t* MBK = (LAS bf16_t*)(t.lds + R5_GR + c2 * R5_GRCH + 1536);
            LAS bf16_t* MT = (LAS bf16_t*)(t.lds + R5_GR + c2 * R5_GRCH + 2560);
            { f32x4 gacc = (f32x4){0.f, 0.f, 0.f, 0.f};
#pragma unroll
              for (int ks = 0; ks < 2; ++ks) { const bf16x8 av = *(const LAS bf16x8*)(ZR + ((q & 2) ? 16 + l15 : l15) * 72 + 32 * ks + 8 * q4);
                  const bf16x8 bv = *(const LAS bf16x8*)(BK + ((q & 1) ? 16 + l15 : l15) * 72 + 32 * ks + 8 * q4);
                  gacc = __builtin_amdgcn_mfma_f32_16x16x32_bf16(av, bv, gacc, 0, 0, 0); }
#pragma unroll
              for (int i = 0; i < 4; ++i) { const int tt = 4 * q4 + i, j = l15; const bool keep = (q & 2) ? (j <= tt) : (j < tt); const float val = keep ? gacc[i] : 0.f;
                  if (q == 0) Nm[tt * 16 + j] = val; else if (q == 1) MKZ[tt * 16 + j] = (bf16_t)f2bf(val); else MBK[tt * 32 + (q == 3 ? 16 : 0) + j] = (bf16_t)f2bf(val); }
              if (q == 0) {
                  asm volatile("s_waitcnt lgkmcnt(0)" ::: "memory");
                  float tc[16];
                  tc[0] = (l15 == 0) ? 1.0f : 0.0f;
                  f32x4 nA[12], nB[12];
#define R5_SLOT_A(i, jb) ((i) <= 4 ? (i) - 1 : 4 + 2 * ((i) - 5) + (jb))
#pragma unroll
                  for (int i = 1; i <= 8; ++i)
#pragma unroll
                      for (int jb = 0; 4 * jb < i; ++jb) nA[R5_SLOT_A(i, jb)] = *(const LAS f32x4*)(Nm + i * 16 + 4 * jb);
#pragma unroll
                  for (int i = 9; i <= 12; ++i)
#pragma unroll
                      for (int jb = 0; jb < 3; ++jb) nB[(i - 9) * 3 + jb] = *(const LAS f32x4*)(Nm + i * 16 + 4 * jb);
                  asm volatile("" ::: "memory");
#pragma unroll
                  for (int i = 1; i <= 8; ++i) { float s = (l15 == i) ? 1.0f : 0.0f;
#pragma unroll
                      for (int jb = 0; 4 * jb < i; ++jb) { const f32x4 nv = nA[R5_SLOT_A(i, jb)];
#pragma unroll
                          for (int j = 0; j < 4; ++j) if (4 * jb + j < i) s += nv[j] * tc[4 * jb + j]; }
                      tc[i] = s; }
#pragma unroll
                  for (int i = 13; i <= 15; ++i)
#pragma unroll
                      for (int jb = 0; jb < 4; ++jb) nA[(i - 13) * 4 + jb] = *(const LAS f32x4*)(Nm + i * 16 + 4 * jb);
                  asm volatile("" ::: "memory");
#pragma unroll
                  for (int i = 9; i <= 12; ++i) { float s = (l15 == i) ? 1.0f : 0.0f;
#pragma unroll
                      for (int jb = 0; jb < 3; ++jb) { const f32x4 nv = nB[(i - 9) * 3 + jb];
#pragma unroll
                          for (int j = 0; j < 4; ++j) if (4 * jb + j < i) s += nv[j] * tc[4 * jb + j]; }
                      tc[i] = s; }
#pragma unroll
                  for (int i = 13; i <= 15; ++i) { float s = (l15 == i) ? 1.0f : 0.0f;
#pragma unroll
                      for (int jb = 0; jb < 4; ++jb) { const f32x4 nv = nA[(i - 13) * 4 + jb];
#pragma unroll
                          for (int j = 0; j < 4; ++j) if (4 * jb + j < i) s += nv[j] * tc[4 * jb + j]; }
                      tc[i] = s; }
#undef R5_SLOT_A
#pragma unroll
                  for (int i = 0; i < 4; ++i) { const float v = q4 == 0 ? tc[i] : q4 == 1 ? tc[4 + i] : q4 == 2 ? tc[8 + i] : tc[12 + i];
                      MT[(4 * q4 + i) * 16 + l15] = (bf16_t)f2bf(v); } } }
            if (n + 1 < NCH) prep_finish(n + 1);
            if (n + 2 < NCH) prep_load(n + 2);
            if (q == 0) {
                if (n + 2 < NCH) cum_finish(n + 2);
                if (n + 3 < NCH) cum_load(n + 3); }
            if (q == 3) {
                if (n > 0) { const LAS float* ys = (const LAS float*)(t.lds + R5_YS + ((n - 1) & 1) * 8192 + c2 * 4096);
#pragma unroll
                    for (int tt = 0; tt < 16; ++tt) Y[((size_t)bl * SROW + r5_seq(z, (n - 1) * R5_L) + sd * tt) * D + colb] = (bf16_t)f2bf(ys[tt * 64 + lane]); } }
            __syncthreads();
            {
              f32x4 Pz = (f32x4){0.f, 0.f, 0.f, 0.f}, Pr = Pz;
#pragma unroll
              for (int ks = 0; ks < 2; ++ks) { const f32x4 s0 = ST[2 * ks], s1 = ST[2 * ks + 1];
                  u32x4 p; p.x = pk2(s0[0], s0[1]); p.y = pk2(s0[2], s0[3]); p.z = pk2(s1[0], s1[1]); p.w = pk2(s1[2], s1[3]);
                  const bf16x8 bop = __builtin_bit_cast(bf16x8, p);
                  const LAS bf16_t* zr = ZR + l15 * 72 + 32 * ks + 4 * q4; const LAS bf16_t* rr = ZR + (16 + l15) * 72 + 32 * ks + 4 * q4;
                  const u32x2 z0 = *(const LAS u32x2*)zr, z1 = *(const LAS u32x2*)(zr + 16), r0 = *(const LAS u32x2*)rr, r1 = *(const LAS u32x2*)(rr + 16);
                  Pz = __builtin_amdgcn_mfma_f32_16x16x32_bf16(__builtin_bit_cast(bf16x8, (u32x4){z0.x, z0.y, z1.x, z1.y}), bop, Pz, 0, 0, 0);
                  Pr = __builtin_amdgcn_mfma_f32_16x16x32_bf16(__builtin_bit_cast(bf16x8, (u32x4){r0.x, r0.y, r1.x, r1.y}), bop, Pr, 0, 0, 0); }
              float vd[4];
#pragma unroll
              for (int i = 0; i < 4; ++i) vd[i] = Vs[(4 * q4 + i) * 64 + 16 * q + l15];
              const unsigned vp0 = pk2(vd[0], vd[1]), vp1 = pk2(vd[2], vd[3]);
              { const u32x2 m = *(const LAS u32x2*)(MKZ + l15 * 16 + 4 * q4);
                Pz = __builtin_amdgcn_mfma_f32_16x16x32_bf16(__builtin_bit_cast(bf16x8, (u32x4){m.x, m.y, 0u, 0u}), __builtin_bit_cast(bf16x8, (u32x4){vp0, vp1, 0u, 0u}), Pz, 0, 0, 0); }
              { float x[4];
                { const u32x2 mt = *(const LAS u32x2*)(MT + l15 * 16 + 4 * q4);
                  const f32x4 dv = __builtin_amdgcn_mfma_f32_16x16x32_bf16(__builtin_bit_cast(bf16x8, (u32x4){mt.x, mt.y, 0u, 0u}), __builtin_bit_cast(bf16x8, (u32x4){pk2(Pz[0], Pz[1]), pk2(Pz[2], Pz[3]), 0u, 0u}), (f32x4){0.f, 0.f, 0.f, 0.f}, 0, 0, 0);
                  x[0] = dv[0]; x[1] = dv[1]; x[2] = dv[2]; x[3] = dv[3]; }
                const unsigned dp0 = pk2(x[0], x[1]), dp1 = pk2(x[2], x[3]);
                const bf16x8 bdv = __builtin_bit_cast(bf16x8, (u32x4){dp0, dp1, vp0, vp1});
                { const u32x2 m0 = *(const LAS u32x2*)(MBK + l15 * 32 + 4 * q4), m1 = *(const LAS u32x2*)(MBK + l15 * 32 + 16 + 4 * q4);
                  Pr = __builtin_amdgcn_mfma_f32_16x16x32_bf16(__builtin_bit_cast(bf16x8, (u32x4){m0.x, m0.y, m1.x, m1.y}), bdv, Pr, 0, 0, 0); }
                { LAS float* ys = (LAS float*)(t.lds + R5_YS + (n & 1) * 8192 + c2 * 4096);
#pragma unroll
                  for (int i = 0; i < 4; ++i) ys[(4 * q4 + i) * 64 + 16 * q + l15] = Pr[i]; }
#pragma unroll
                for (int cb = 0; cb < 4; ++cb) { const LAS bf16_t* bt = BKT + (16 * cb + l15) * 40 + 4 * q4;
                    const u32x2 b0 = *(const LAS u32x2*)bt, k0 = *(const LAS u32x2*)(bt + 16);
                    ST[cb] = __builtin_amdgcn_mfma_f32_16x16x32_bf16(__builtin_bit_cast(bf16x8, (u32x4){b0.x, b0.y, k0.x, k0.y}), bdv, ST[cb], 0, 0, 0);
                    const f32x4 gl = *(const LAS f32x4*)(GL + 16 * cb + 4 * q4);
                    ST[cb] = ST[cb] * gl; } } }
            __syncthreads();
        }
        if (q == 3) { const LAS float* ys = (const LAS float*)(t.lds + R5_YS + ((NCH - 1) & 1) * 8192 + c2 * 4096);
#pragma unroll
          for (int tt = 0; tt < 16; ++tt) Y[((size_t)bl * SROW + r5_seq(z, (NCH - 1) * R5_L) + sd * tt) * D + colb] = (bf16_t)f2bf(ys[tt * 64 + lane]); }
        __syncthreads();
    }
}
__device__ __forceinline__ void r6_readout(const Tc& t, CArgs a, int jl, int layer, int g) {
    const bf16_t* Y0 = (const bf16_t*)(a->ws + WS_ACT + AR_Y), *Y1 = (const bf16_t*)(a->ws + WS_ACT + AR_Y + SLOT);
    const float* RK0 = (const float*)(a->ws + WS_ACT + AR_RK), *RK1 = RK0 + (size_t)TG * 32;
    const bf16_t* Vb = (layer == 0) ? (const bf16_t*)(a->ws + WS_VF) + (size_t)g * TG * D : (const bf16_t*)(a->ws + WS_ACT + AR_V);
    const bf16_t* Gb = (const bf16_t*)(a->ws + WS_ACT + AR_MIX + 4 * SLOT);
    bf16_t* Ao = (bf16_t*)(a->ws + WS_ACT + AR_AO) + (size_t)g * TG * D;
    const int sl = t.gw & 3, c0 = 512 * sl + 8 * t.lane, head = c0 >> 6;
    const float* lnw = a->in[I_LNW] + (size_t)jl * D + c0, *lnb = a->in[I_LNB] + (size_t)jl * D + c0;
    const f32x4 lw0 = *(const f32x4*)lnw, lw1 = *(const f32x4*)(lnw + 4), lb0 = *(const f32x4*)lnb, lb1 = *(const f32x4*)(lnb + 4);
    const float lw[8] = {lw0.x, lw0.y, lw0.z, lw0.w, lw1.x, lw1.y, lw1.z, lw1.w}, lb[8] = {lb0.x, lb0.y, lb0.z, lb0.w, lb1.x, lb1.y, lb1.z, lb1.w};
    const int rstep = t.ngw >> 2;
    for (int r0 = t.gw >> 2; r0 < TG; r0 += 2 * rstep) {
        u32x4 y0[2], y1[2], vv[2], gg[2]; float rk[2];
#pragma unroll
        for (int k = 0; k < 2; ++k) { const int r = r0 + k * rstep < TG ? r0 + k * rstep : r0; const size_t off = (size_t)r * D + c0;
            y0[k] = *(const u32x4*)(Y0 + off); y1[k] = *(const u32x4*)(Y1 + off); vv[k] = *(const u32x4*)(Vb + off); gg[k] = *(const u32x4*)(Gb + off);
            rk[k] = RK0[(size_t)r * 32 + head] + RK1[(size_t)r * 32 + head]; }
        asm volatile("" ::: "memory");
#pragma unroll
        for (int k = 0; k < 2; ++k) { const int r = r0 + k * rstep; if (r >= TG) break; const size_t off = (size_t)r * D + c0;
            const unsigned a0[4] = {y0[k].x, y0[k].y, y0[k].z, y0[k].w}, a1[4] = {y1[k].x, y1[k].y, y1[k].z, y1[k].w};
            const unsigned av[4] = {vv[k].x, vv[k].y, vv[k].z, vv[k].w}, ag[4] = {gg[k].x, gg[k].y, gg[k].z, gg[k].w};
            float y[8]; float s = 0.f;
#pragma unroll
            for (int i = 0; i < 4; ++i) { y[2 * i] = lo_bf(a0[i]) + lo_bf(a1[i]); y[2 * i + 1] = hi_bf(a0[i]) + hi_bf(a1[i]); s += y[2 * i] + y[2 * i + 1]; }
            s = sum8_(s);
            const float mean = s * (1.0f / 64.0f);
            float qq = 0.f;
#pragma unroll
            for (int i = 0; i < 8; ++i) { y[i] -= mean; qq += y[i] * y[i]; }
            qq = sum8_(qq);
            const float rstd = rsqrtf(qq * (1.0f / 64.0f) + 64e-5f);
            float o[8];
#pragma unroll
            for (int i = 0; i < 4; ++i) { o[2 * i] = (y[2 * i] * rstd * lw[2 * i] + lb[2 * i] + rk[k] * lo_bf(av[i])) * lo_bf(ag[i]);
                o[2 * i + 1] = (y[2 * i + 1] * rstd * lw[2 * i + 1] + lb[2 * i + 1] + rk[k] * hi_bf(av[i])) * hi_bf(ag[i]); }
            u32x4 w; w.x = pk2(o[0], o[1]); w.y = pk2(o[2], o[3]); w.z = pk2(o[4], o[5]); w.w = pk2(o[6], o[7]);
            *(u32x4*)(Ao + off) = w; }
        asm volatile("" ::: "memory");
    }
}

__device__ __forceinline__ void m3_conv(const Tc& t, CArgs a, int jl) {
    const bf16_t* U = (const bf16_t*)(a->ws + WS_ACT + AM_U);
    bf16_t* QK = (bf16_t*)(a->ws + WS_ACT + AM_QK);
    const int sl = t.gw & 7, c0 = 256 * sl + 4 * t.lane;
    const float* cw = a->in[I_CONVW] + (size_t)jl * 9 * D + c0;
    f32x4 wt[9];
#pragma unroll
    for (int k = 0; k < 9; ++k) wt[k] = *(const f32x4*)(cw + k * D);
    const f32x4 bias = *(const f32x4*)(a->in[I_CONVB] + (size_t)jl * D + c0);
    const float sc = c0 < 1024 ? 0.08838834764831845f : 1.0f;
    for (int row = t.gw >> 3; row < T; row += t.ngw >> 3) { const int s = row % SROW;
        f32x4 acc = bias;
        if (s < CTXL) {
#pragma unroll
            for (int dc = -1; dc <= 1; ++dc) if (s + dc >= 0 && s + dc < CTXL) { const u32x2 u = *(const u32x2*)(U + (size_t)(row + dc) * ULD + c0); const f32x4 w = wt[3 + dc + 1];
                acc.x += lo_bf(u.x) * w.x; acc.y += hi_bf(u.x) * w.y; acc.z += lo_bf(u.y) * w.z; acc.w += hi_bf(u.y) * w.w; }
        } else { const int i = s - CTXL, gr = i >> 6, gc = i & 63;
            u32x2 u[9];
#pragma unroll
            for (int dr = -1; dr <= 1; ++dr)
#pragma unroll
                for (int dc = -1; dc <= 1; ++dc) { const bool ok = (gr + dr >= 0) && (gr + dr < 32) && (gc + dc >= 0) && (gc + dc < 64);
                    u[(dr + 1) * 3 + dc + 1] = ok ? *(const u32x2*)(U + (size_t)(row + dr * 64 + dc) * ULD + c0) : (u32x2){0u, 0u}; }
#pragma unroll
            for (int k = 0; k < 9; ++k) { acc.x += lo_bf(u[k].x) * wt[k].x; acc.y += hi_bf(u[k].x) * wt[k].y; acc.z += lo_bf(u[k].y) * wt[k].z; acc.w += hi_bf(u[k].y) * wt[k].w; }
        }
        u32x2 w; w.x = pk2(siluf_(acc.x) * sc, siluf_(acc.y) * sc); w.y = pk2(siluf_(acc.z) * sc, siluf_(acc.w) * sc);
        *(u32x2*)(QK + (size_t)row * D + c0) = w;
    }
}

template <int CTRL> __device__ __forceinline__ float dppz_(float v) { return __int_as_float(__builtin_amdgcn_update_dpp(0, __float_as_int(v), CTRL, 0xF, 0xF, false)); }
template <int CTRL> __device__ __forceinline__ float dppm_(float v) { return __int_as_float(__builtin_amdgcn_update_dpp((int)0xff800000u, __float_as_int(v), CTRL, 0xF, 0xF, false)); }
constexpr int M4_QS = 136, M4_TS = 72;
constexpr int M4_SQ = 0, M4_SK = 17408, M4_SVT = 34816, M4_SWKT = 71680, M4_SP = 90112, M4_F = 99328;
__device__ __forceinline__ void m4_scan(const Tc& t, CArgs a) {
    LAS bf16_t* sQ = (LAS bf16_t*)(t.lds + M4_SQ); LAS bf16_t* sK = (LAS bf16_t*)(t.lds + M4_SK); LAS bf16_t* sVT = (LAS bf16_t*)(t.lds + M4_SVT);
    LAS bf16_t* sWKT = (LAS bf16_t*)(t.lds + M4_SWKT); LAS bf16_t* sP = (LAS bf16_t*)(t.lds + M4_SP);
    LAS float* fI = (LAS float*)(t.lds + M4_F);
    LAS float* fF = fI + 64;
    LAS float* fU = fI + 128;
    LAS float* fG = fI + 192;
    LAS float* fWI = fI + 256;
    LAS float* fEN = fI + 320;
    LAS float* fWS = fI + 384;
    LAS float* fRS = fI + 448;
    LAS float* fQN = fI + 576;
    LAS float* fN = fI + 640;
    LAS float* fSC = fI + 768;
    LAS float* fNP = fI + 832;
    const bf16_t* QK = (const bf16_t*)(a->ws + WS_ACT + AM_QK);
    const bf16_t* U = (const bf16_t*)(a->ws + WS_ACT + AM_U);
    const float* Gt = (const float*)(a->ws + WS_ACT + AM_G);
    const int tid = t.tid, lane = t.lane, w = t.wave, l15 = lane & 15, q4 = lane >> 4;
    for (int chain = t.bid; chain < 2 * NB * MH; chain += t.G) {
        const int z = chain / (NB * MH), b = (chain / MH) % NB, h = chain % MH;
        bf16_t* HZ = (bf16_t*)(a->ws + WS_ACT + (z == 0 ? AM_HB : AM_HZ1));
        f32x4 Cacc[8][2];
#pragma unroll
        for (int db = 0; db < 8; ++db)
#pragma unroll
            for (int e = 0; e < 2; ++e) Cacc[db][e] = (f32x4){0.f, 0.f, 0.f, 0.f};
        float m_old = 0.f;
        if (tid < 128) fN[tid] = 0.f;
        __syncthreads();
        const size_t rowb = (size_t)b * SROW; const int sdir = z == 0 ? 1 : -1;
        u32x4 pq[2], pkk[2], pvv[4]; float pgi = 0.f, pgf = 0.f;
#define M4_LOAD(chn) do { const int t0_ = (chn) * 64; const int sb_ = z == 0 ? t0_ : (t0_ < CTXL ? CTXL - 1 - t0_ : SROW + CTXL - 1 - t0_); \
            _Pragma("unroll") for (int rep = 0; rep < 2; ++rep) { const int cid = tid + 512 * rep, i = cid >> 4, cc = cid & 15; const size_t row = rowb + sb_ + sdir * i; \
                pq[rep] = *(const u32x4*)(QK + row * D + h * MDK + 8 * cc); pkk[rep] = *(const u32x4*)(QK + row * D + 1024 + h * MDK + 8 * cc); } \
            _Pragma("unroll") for (int rep = 0; rep < 4; ++rep) { const int cid = tid + 512 * rep, i = cid & 63, cc = cid >> 6; const size_t row = rowb + sb_ + sdir * i; \
                pvv[rep] = *(const u32x4*)(U + row * ULD + 2048 + h * MDV + 8 * cc); } \
            if (tid < 64) { const size_t row = rowb + sb_ + sdir * tid; pgi = Gt[row * 32 + z * 16 + h]; pgf = Gt[row * 32 + z * 16 + 8 + h]; } } while (0)
        M4_LOAD(0);
        for (int ch = 0; ch < SROW / 64; ++ch) {
            const int t0 = ch * 64;
            const int sbase = z == 0 ? t0 : (t0 < CTXL ? CTXL - 1 - t0 : SROW + CTXL - 1 - t0);
#pragma unroll
            for (int rep = 0; rep < 2; ++rep) { const int cid = tid + 512 * rep, i = cid >> 4, cc = cid & 15;
                *(LAS u32x4*)(sQ + i * M4_QS + 8 * cc) = pq[rep]; *(LAS u32x4*)(sK + i * M4_QS + 8 * cc) = pkk[rep]; }
#pragma unroll
            for (int rep = 0; rep < 4; ++rep) { const int cid = tid + 512 * rep, i = cid & 63, cc = cid >> 6;
                const unsigned wv[4] = {pvv[rep].x, pvv[rep].y, pvv[rep].z, pvv[rep].w};
#pragma unroll
                for (int jj = 0; jj < 4; ++jj) { sVT[(8 * cc + 2 * jj) * M4_TS + i] = (bf16_t)(wv[jj] & 0xffffu); sVT[(8 * cc + 2 * jj + 1) * M4_TS + i] = (bf16_t)(wv[jj] >> 16); } }
            if (ch > 0 && tid < 128) fN[tid] = fSC[0] * fN[tid] + ((fNP[tid] + fNP[128 + tid]) + (fNP[256 + tid] + fNP[384 + tid]));
            if (tid < 64) { fI[tid] = pgi; fF[tid] = pgf; }
            if (ch + 1 < SROW / 64) M4_LOAD(ch + 1);
            __syncthreads();
            if (w == 0) {
                const float ig = fI[lane], lf = fF[lane];
                float bc = lf;
                bc += dppz_<0x111>(bc); bc += dppz_<0x112>(bc); bc += dppz_<0x114>(bc); bc += dppz_<0x118>(bc);
                { const float t0 = rl_(bc, 15), t1 = rl_(bc, 31), t2 = rl_(bc, 47); bc += (lane >= 16 ? t0 : 0.f) + (lane >= 32 ? t1 : 0.f) + (lane >= 48 ? t2 : 0.f); }
                const float g = ig - bc;
                float pm = g;
                pm = fmaxf(pm, dppm_<0x111>(pm)); pm = fmaxf(pm, dppm_<0x112>(pm)); pm = fmaxf(pm, dppm_<0x114>(pm)); pm = fmaxf(pm, dppm_<0x118>(pm));
                { const float t0 = rl_(pm, 15), t1 = rl_(pm, 31), t2 = rl_(pm, 47); const float ninf = -__builtin_inff();
                  pm = fmaxf(pm, fmaxf(fmaxf(lane >= 16 ? t0 : ninf, lane >= 32 ? t1 : ninf), lane >= 48 ? t2 : ninf)); }
                const float b_end = rl_(bc, 63), pm_all = rl_(pm, 63);
                const float m_new = fmaxf(b_end + m_old, b_end + pm_all);
                const float mx = fmaxf(m_old, pm);
                fU[lane] = -mx; fG[lane] = g; fWI[lane] = __expf(m_old - mx); fEN[lane] = __expf(-mx - bc); fWS[lane] = __expf(b_end + g - m_new);
                if (lane == 0) { fSC[0] = __expf(b_end + m_old - m_new); fSC[1] = m_new; }
            }
            const int tb = w >> 1, jb0 = 2 * (w & 1);
            f32x4 St[2];
#pragma unroll
            for (int jj = 0; jj < 2; ++jj) { St[jj] = (f32x4){0.f, 0.f, 0.f, 0.f};
                if (jb0 + jj <= tb) {
#pragma unroll
                    for (int ks = 0; ks < 4; ++ks) { const bf16x8 av = *(const LAS bf16x8*)(sQ + (16 * tb + l15) * M4_QS + 32 * ks + 8 * q4);
                        const bf16x8 bv = *(const LAS bf16x8*)(sK + (16 * (jb0 + jj) + l15) * M4_QS + 32 * ks + 8 * q4);
                        St[jj] = __builtin_amdgcn_mfma_f32_16x16x32_bf16(av, bv, St[jj], 0, 0, 0); } } }
            __syncthreads();
            { float rs[4] = {0.f, 0.f, 0.f, 0.f};
#pragma unroll
              for (int jj = 0; jj < 2; ++jj) { const int j = 16 * (jb0 + jj) + l15; const float gj = fG[j];
#pragma unroll
                  for (int i = 0; i < 4; ++i) { const int tt = 16 * tb + 4 * q4 + i; const float val = (j <= tt) ? St[jj][i] * __expf(fU[tt] + gj) : 0.f;
                      rs[i] += val; sP[tt * M4_TS + j] = (bf16_t)f2bfa(val); } }
#pragma unroll
              for (int i = 0; i < 4; ++i) { float v = rs[i]; v = sum16_(v);
                  if (l15 == 0) fRS[(w & 1) * 64 + 16 * tb + 4 * q4 + i] = v; } }
            { const int d = tid & 127, jg = tid >> 7; unsigned pk[8]; float nn = 0.f;
#pragma unroll
              for (int jj = 0; jj < 8; ++jj) { const int j0 = 16 * jg + 2 * jj; const float w0 = fWS[j0] * bf2f(sK[j0 * M4_QS + d]), w1 = fWS[j0 + 1] * bf2f(sK[(j0 + 1) * M4_QS + d]);
                  nn += w0 + w1; pk[jj] = pk2a(w0, w1); }
              fNP[jg * 128 + d] = nn;
              *(LAS u32x4*)(sWKT + d * M4_TS + 16 * jg) = (u32x4){pk[0], pk[1], pk[2], pk[3]};
              *(LAS u32x4*)(sWKT + d * M4_TS + 16 * jg + 8) = (u32x4){pk[4], pk[5], pk[6], pk[7]}; }
            { const int tt = tid >> 3, dp = tid & 7; float s = 0.f;
#pragma unroll
              for (int dd = 0; dd < 16; ++dd) s += bf2f(sQ[tt * M4_QS + 16 * dp + dd]) * fN[16 * dp + dd];
              s = sum8_(s);
              if (dp == 0) fQN[tt] = s; }
            __syncthreads();
            asm volatile("s_waitcnt vmcnt(0)" ::: "memory");
            asm volatile("" : "+v"(pq[0]), "+v"(pq[1]), "+v"(pkk[0]), "+v"(pkk[1]));
            asm volatile("" : "+v"(pvv[0]), "+v"(pvv[1]), "+v"(pvv[2]), "+v"(pvv[3]), "+v"(pgi), "+v"(pgf));
#pragma unroll 1
            for (int x = 0; x < 4; ++x) {
                f32x4 acc[2];
                acc[0] = (f32x4){0.f, 0.f, 0.f, 0.f}; acc[1] = (f32x4){0.f, 0.f, 0.f, 0.f};
#pragma unroll
                for (int kb = 0; kb < 4; ++kb) {
                    const LAS bf16_t* qr = sQ + (16 * x + l15) * M4_QS + 32 * kb + 4 * q4;
                    const u32x2 lo = *(const LAS u32x2*)qr, hi = *(const LAS u32x2*)(qr + 16);
                    const bf16x8 aop = __builtin_bit_cast(bf16x8, (u32x4){lo.x, lo.y, hi.x, hi.y});
#pragma unroll
                    for (int e = 0; e < 2; ++e) { const f32x4 c0 = Cacc[2 * kb][e], c1 = Cacc[2 * kb + 1][e];
                        u32x4 p; p.x = pk2a(c0[0], c0[1]); p.y = pk2a(c0[2], c0[3]); p.z = pk2a(c1[0], c1[1]); p.w = pk2a(c1[2], c1[3]);
                        acc[e] = __builtin_amdgcn_mfma_f32_16x16x32_bf16(aop, __builtin_bit_cast(bf16x8, p), acc[e], 0, 0, 0); } }
                { const f32x4 wi = *(const LAS f32x4*)(fWI + 16 * x + 4 * q4); acc[0] = acc[0] * wi; acc[1] = acc[1] * wi; }
#pragma unroll
                for (int ks = 0; ks < 2; ++ks) { const bf16x8 aop = *(const LAS bf16x8*)(sP + (16 * x + l15) * M4_TS + 32 * ks + 8 * q4);
#pragma unroll
                    for (int e = 0; e < 2; ++e) { const bf16x8 bop = *(const LAS bf16x8*)(sVT + (16 * (2 * w + e) + l15) * M4_TS + 32 * ks + 8 * q4);
                        acc[e] = __builtin_amdgcn_mfma_f32_16x16x32_bf16(aop, bop, acc[e], 0, 0, 0); } }
#pragma unroll
                for (int i = 0; i < 4; ++i) { const int tt = 16 * x + 4 * q4 + i;
                    const float den = fWI[tt] * fQN[tt] + fRS[tt] + fRS[64 + tt]; const float dv = __builtin_amdgcn_rcpf(fmaxf(fabsf(den), fEN[tt]));
                    const size_t row = rowb + sbase + sdir * tt;
#pragma unroll
                    for (int e = 0; e < 2; ++e) HZ[row * D + h * MDV + 16 * (2 * w + e) + l15] = (bf16_t)f2bfa(acc[e][i] * dv); }
            }
            { const float dec = fSC[0];
#pragma unroll
              for (int db = 0; db < 8; ++db)
#pragma unroll
                  for (int e = 0; e < 2; ++e) Cacc[db][e] = Cacc[db][e] * dec;
#pragma unroll
              for (int ks = 0; ks < 2; ++ks) {
                  bf16x8 bop[2];
#pragma unroll
                  for (int e = 0; e < 2; ++e) bop[e] = *(const LAS bf16x8*)(sVT + (16 * (2 * w + e) + l15) * M4_TS + 32 * ks + 8 * q4);
#pragma unroll
                  for (int db = 0; db < 8; ++db) { const bf16x8 aop = *(const LAS bf16x8*)(sWKT + (16 * db + l15) * M4_TS + 32 * ks + 8 * q4);
#pragma unroll
                      for (int e = 0; e < 2; ++e) Cacc[db][e] = __builtin_amdgcn_mfma_f32_16x16x32_bf16(aop, bop[e], Cacc[db][e], 0, 0, 0); } }
 }
            m_old = fSC[1];
            __syncthreads();
        }
#undef M4_LOAD
    }
}

__device__ __forceinline__ void m5_readout(const Tc& t, CArgs a, int jl) {
    const bf16_t* H0 = (const bf16_t*)(a->ws + WS_ACT + AM_HB), *H1 = (const bf16_t*)(a->ws + WS_ACT + AM_HZ1);
    const bf16_t* U = (const bf16_t*)(a->ws + WS_ACT + AM_U);
    bf16_t* Ao = (bf16_t*)(a->ws + WS_ACT + AM_QK);
    const int sl = t.gw & 3, c0 = 512 * sl + 8 * t.lane;
    const float* nw = a->in[I_MNORMW] + (size_t)jl * D + c0;
    const f32x4 w0 = *(const f32x4*)nw, w1 = *(const f32x4*)(nw + 4);
    const float w8[8] = {w0.x, w0.y, w0.z, w0.w, w1.x, w1.y, w1.z, w1.w};
    const int rstep = t.ngw >> 2;
    for (int r0 = t.gw >> 2; r0 < T; r0 += 4 * rstep) {
        u32x4 h0[4], h1[4], ov[4];
#pragma unroll
        for (int k = 0; k < 4; ++k) { const int row = r0 + k * rstep < T ? r0 + k * rstep : r0; const size_t off = (size_t)row * D + c0;
            h0[k] = *(const u32x4*)(H0 + off); h1[k] = *(const u32x4*)(H1 + off); ov[k] = *(const u32x4*)(U + (size_t)row * ULD + 4096 + c0); }
        asm volatile("" ::: "memory");
#pragma unroll
        for (int k = 0; k < 4; ++k) { const int row = r0 + k * rstep; if (row >= T) break; const size_t off = (size_t)row * D + c0;
            const unsigned a0[4] = {h0[k].x, h0[k].y, h0[k].z, h0[k].w}, a1[4] = {h1[k].x, h1[k].y, h1[k].z, h1[k].w}, ao[4] = {ov[k].x, ov[k].y, ov[k].z, ov[k].w};
            float y[8]; float s = 0.f;
#pragma unroll
            for (int i = 0; i < 4; ++i) { y[2 * i] = lo_bf(a0[i]) + lo_bf(a1[i]); y[2 * i + 1] = hi_bf(a0[i]) + hi_bf(a1[i]); s += y[2 * i] + y[2 * i + 1]; }
            s = sum16_(s); s += shfl_xor_(s, 16, t.lane);
            const float mean = s * (1.0f / 256.0f);
            float qq = 0.f;
#pragma unroll
            for (int i = 0; i < 8; ++i) { y[i] -= mean; qq += y[i] * y[i]; }
            qq = sum16_(qq); qq += shfl_xor_(qq, 16, t.lane);
            const float rstd = rsqrtf(qq * (1.0f / 256.0f) + 1e-6f);
            float o[8];
#pragma unroll
            for (int i = 0; i < 4; ++i) { o[2 * i] = y[2 * i] * rstd * w8[2 * i] * sigmoidf_(lo_bf(ao[i])); o[2 * i + 1] = y[2 * i + 1] * rstd * w8[2 * i + 1] * sigmoidf_(hi_bf(ao[i])); }
            u32x4 wv; wv.x = pk2(o[0], o[1]); wv.y = pk2(o[2], o[3]); wv.z = pk2(o[4], o[5]); wv.w = pk2(o[6], o[7]);
            *(u32x4*)(Ao + off) = wv; }
        asm volatile("" ::: "memory");
    }
}

__device__ __forceinline__ void final_norm(const Tc& t, CArgs a) {
    const float* xres = (const float*)(a->ws + WS_XRES);
    f32x4 gg[8];
    { const f32x4* gp = (const f32x4*)a->in[I_FINALG] + t.lane;
#pragma unroll
      for (int j = 0; j < 8; ++j) gg[j] = gp[64 * j]; }
    for (int r0 = t.gw; r0 < NB * SEQ; r0 += 2 * t.ngw) {
        f32x4 v[2][8];
#pragma unroll
        for (int k = 0; k < 2; ++k) { const int r = r0 + k * t.ngw < NB * SEQ ? r0 + k * t.ngw : r0; const size_t row = (size_t)(r / SEQ) * SROW + CTXL + (r % SEQ);
            const f32x4* xr = (const f32x4*)(xres + row * D) + t.lane;
#pragma unroll
            for (int j = 0; j < 8; ++j) v[k][j] = xr[64 * j]; }
        asm volatile("" ::: "memory");
#pragma unroll
        for (int k = 0; k < 2; ++k) { const int r = r0 + k * t.ngw; if (r >= NB * SEQ) break;
            float ss = 0.f;
#pragma unroll
            for (int j = 0; j < 8; ++j) ss += (v[k][j].x * v[k][j].x + v[k][j].y * v[k][j].y) + (v[k][j].z * v[k][j].z + v[k][j].w * v[k][j].w);
            const float rstd = rsqrtf(wave_sum_dpp(ss) * (1.0f / D) + 1e-6f);
            f32x4* o = (f32x4*)(a->out + (size_t)r * D) + t.lane;
#pragma unroll
            for (int j = 0; j < 8; ++j) o[64 * j] = v[k][j] * rstd * gg[j]; }
        asm volatile("" ::: "memory");
    }
}
constexpr int NU_FULL = (T / 256) * (D / 256), NU_SKIP = (T / 9 * 8 / 256) * (D / 256);
constexpr int NSEG = 1 + 2 * (12 + 1 + 3) + 2 * (6 + 3) + 1;

__global__ void __launch_bounds__(512, 2) hybrid_fwd(Args args) {
    extern __shared__ __attribute__((aligned(16))) unsigned char lds_raw[];
    LAS unsigned char* const lds = (LAS unsigned char*)lds_raw;
    volatile LAS unsigned* MISC = (volatile LAS unsigned*)(lds + LDSCTL_OFF);
    if (threadIdx.x < 64) MISC[threadIdx.x] = 0u;
    __syncthreads();
    const int lo = args.ph_lo, hi = args.ph_hi;
    const bool fused = (hi - lo) > 1;
    unsigned* barw = (unsigned*)(args.ws + WS_CTL) + 4096;
    XcdBarrier bar; bar.bar = barw; bar.x = 0; bar.st = MISC + 8;
    if (fused) bar = xcd_barrier_post(barw, MISC + 8);
    int seg = 0;
    int urot = 0;
#define ACTIVE (seg >= lo && seg < hi)
#define PH_BEGIN const Tc t = mk_tc(lds); const CArgs a = opaque_args(); unsigned char* const act = a->ws + WS_ACT; (void)act; (void)t;
#define SEAM() do { if (fused && seg >= lo && seg + 1 < hi) xcd_barrier(bar); ++seg; } while (0)

    if (ACTIVE) { PH_BEGIN ph_prologue(t, a); }
    SEAM();
    for (int layer = 0; layer < 4; ++layer) {
        const int jl = layer >> 1;
        if ((layer & 1) == 0) {
            for (int g = 0; g < NGRP; ++g) {
                if (ACTIVE) { PH_BEGIN if (g == 0 && layer == 0) { convert_rwkv(t, a, 0); convert_ffn_in(t, a, 0); }
                    norm_rows<true>(t, a, layer, 0, g * TG, TG, act + AR_H, layer == 0); }
                SEAM();
                if (ACTIVE) { PH_BEGIN r2_mix(t, a, jl); }
                SEAM();
                if (ACTIVE) {
                    PH_BEGIN const bf16_t* wm = (const bf16_t*)(a->ws + WS_WMIX);
                    bf16_t* vdst = (layer == 0) ? (bf16_t*)(a->ws + WS_VF) + (size_t)g * TG * D : (bf16_t*)(act + AR_V);
                    const bf16_t* mix[6];
#pragma unroll
                    for (int m = 0; m < 6; ++m) mix[m] = (const bf16_t*)(act + AR_MIX + (size_t)m * SLOT);
                    for (int q = 0; q < 7; ++q) {
                        if (q == 6 && jl == 0) break;
                        const bf16_t* A = q == 0 ? mix[0] : q == 1 ? mix[2] : q == 2 ? mix[3] : q == 3 ? mix[1] : q == 4 ? mix[4] : q == 5 ? mix[5] : mix[3];
                        const size_t wo = q == 0 ? WM_R : q == 1 ? WM_K : q == 2 ? WM_V : q == 3 ? WM_W1 : q == 4 ? WM_A1 : q == 5 ? WM_G1 : WM_V1;
                        bf16_t* O = q == 0 ? (bf16_t*)(act + AR_R) : q == 1 ? (bf16_t*)(act + AR_K) : q == 2 ? vdst : (bf16_t*)(act + AR_LORA + (size_t)(q - 3) * 9 * MiB);
                        const int N = q < 3 ? D : 256; const int actf = q == 3 ? 1 : q == 5 ? 2 : 0;
                        pg8::EpiStore E{O, N, actf, 0, 0, -1, nullptr, nullptr};
                        run_gemm(t.lds, A, (const bf16_t*)((const char*)wm + wo), TG, N, D, E, urot);
                    }
                }
                SEAM();
                if (ACTIVE) {
                    PH_BEGIN const bf16_t* wm = (const bf16_t*)(a->ws + WS_WMIX);
                    const bf16_t* lora = (const bf16_t*)(act + AR_LORA);
                    for (int q = 0; q < 2; ++q) {
                        pg8::EpiSigAff E{(bf16_t*)(act + AR_MIX + (size_t)(2 * q) * SLOT), (size_t)TG * D, a->in[q == 0 ? I_W0 : I_A0] + (size_t)jl * 2 * D, q == 0 ? -0.6065306597126334f : 1.0f};
                        run_gemm(t.lds, lora + (size_t)q * TG * 256, (const bf16_t*)((const char*)wm + (q == 0 ? WM_W2 : WM_A2)), TG, 2 * D, 256, E, urot);
                    }
                    { pg8::EpiStore E{(bf16_t*)(act + AR_MIX + 4 * SLOT), D, 0, 0, 0, -1, nullptr, nullptr};
                      run_gemm(t.lds, lora + (size_t)2 * TG * 256, (const bf16_t*)((const char*)wm + WM_G2), TG, D, 256, E, urot); }
                    if (jl > 0) { pg8::EpiVmix E{(bf16_t*)(act + AR_V), (const bf16_t*)(a->ws + WS_VF) + (size_t)g * TG * D, a->in[I_V0] + (size_t)(jl - 1) * D};
                      run_gemm(t.lds, lora + (size_t)3 * TG * 256, (const bf16_t*)((const char*)wm + WM_V2), TG, D, 256, E, urot); }
                }
                SEAM();
                if (ACTIVE) { PH_BEGIN r5_scan(t, a, jl, layer, g); }
                SEAM();
                if (ACTIVE) { PH_BEGIN r6_readout(t, a, jl, layer, g); }
                SEAM();
            }
            if (ACTIVE) { PH_BEGIN pg8::EpiResid E{(float*)(a->ws + WS_XRES), (const float*)(a->ws + WS_MOD) + (size_t)layer * 17 * MODLD + 2 * D, 0, layer == 0 ? a->in[I_X] : nullptr, a->in[I_CTX]};
                run_gemm(t.lds, (const bf16_t*)(act + AR_AO), (const bf16_t*)(a->ws + WS_WMIX + WM_O), T, D, D, E, urot);
                { const Tc t2 = mk_tc(lds); const CArgs a2 = opaque_args(); Tc ts; if (tail_crew(t2, urot - NU_FULL, NU_FULL, ts)) { __syncthreads(); convert_ffn_out(ts, a2, layer); } } }
            SEAM();
        } else {
            if (ACTIVE) { PH_BEGIN norm_rows<true>(t, a, layer, 0, 0, T, act + AM_HB); }
            SEAM();
            if (ACTIVE) { PH_BEGIN pg8::EpiStore E{(bf16_t*)(act + AM_U), ULD, 0, 0, 0, 24, (float*)(act + AM_G), a->in[I_BGATE] + (size_t)jl * 32};
                run_gemm(t.lds, (const bf16_t*)(act + AM_HB), (const bf16_t*)(a->ws + WS_WMIX + WM_MIN), T, 6400, D, E, urot); }
            SEAM();
            if (ACTIVE) { PH_BEGIN m3_conv(t, a, jl); }
            SEAM();
            if (ACTIVE) { PH_BEGIN m4_scan(t, a); }
            SEAM();
            if (ACTIVE) { PH_BEGIN m5_readout(t, a, jl); }
            SEAM();
            if (ACTIVE) { PH_BEGIN pg8::EpiResid E{(float*)(a->ws + WS_XRES), (const float*)(a->ws + WS_MOD) + (size_t)layer * 17 * MODLD + 2 * D, 0, nullptr, nullptr};
                if (layer == 3) run_gemm<pg8::EpiResid, true>(t.lds, (const bf16_t*)(act + AM_QK), (const bf16_t*)(a->ws + WS_WMIX + WM_MOUT), T, D, D, E, urot);
                else run_gemm(t.lds, (const bf16_t*)(act + AM_QK), (const bf16_t*)(a->ws + WS_WMIX + WM_MOUT), T, D, D, E, urot);
                { const Tc t2 = mk_tc(lds); const CArgs a2 = opaque_args(); Tc ts; const int nu = layer == 3 ? NU_SKIP : NU_FULL; if (tail_crew(t2, urot - nu, nu, ts)) { __syncthreads(); convert_ffn_out(ts, a2, layer); } } }
            SEAM();
        }
        if (ACTIVE) { PH_BEGIN norm_rows<true>(t, a, layer, 1, 0, T, act + AF_H2); }
        SEAM();
        if (ACTIVE) { PH_BEGIN pg8::EpiSwiglu E{(bf16_t*)(act + AF_U)};
            if (layer == 3) run_gemm<pg8::EpiSwiglu, true>(t.lds, (const bf16_t*)(act + AF_H2), (const bf16_t*)(a->ws + WS_WFFN + WF_IN), T, 2 * DFF, D, E, urot);
            else run_gemm(t.lds, (const bf16_t*)(act + AF_H2), (const bf16_t*)(a->ws + WS_WFFN + WF_IN), T, 2 * DFF, D, E, urot); }
        SEAM();
        if (ACTIVE) { PH_BEGIN pg8::EpiResid E{(float*)(a->ws + WS_XRES), (const float*)(a->ws + WS_MOD) + (size_t)layer * 17 * MODLD + 5 * D, 0, nullptr, nullptr};
            if (layer == 3) run_gemm<pg8::EpiResid, true>(t.lds, (const bf16_t*)(act + AF_U), (const bf16_t*)(a->ws + WS_WFFN + WF_OUT), T, D, DFF, E, urot);
            else run_gemm(t.lds, (const bf16_t*)(act + AF_U), (const bf16_t*)(a->ws + WS_WFFN + WF_OUT), T, D, DFF, E, urot);
            if (layer < 3) { const Tc t2 = mk_tc(lds); const CArgs a2 = opaque_args(); Tc ts; if (tail_crew(t2, urot - NU_FULL, NU_FULL, ts)) { __syncthreads();
                if (layer & 1) convert_rwkv(ts, a2, (layer + 1) >> 1); else convert_mlstm(ts, a2, (layer + 1) >> 1);
                convert_ffn_in(ts, a2, layer + 1); } } }
        SEAM();
    }
    if (ACTIVE) { PH_BEGIN final_norm(t, a); }
#undef ACTIVE
#undef SEAM
#undef PH_BEGIN
}

#ifndef MK_MULTI
#define MK_MULTI 0
#endif
extern "C" void kernel_launch(void* const* d_in, const int* in_sizes, int n_in, void* d_out, int out_size, void* d_ws, size_t ws_size, hipStream_t stream) {
    static int grid = 0;
    if (grid == 0) {
        if (n_in != NIN || ws_size < WS_END) { fprintf(stderr, "kernel_launch: unexpected n_in %d / ws %zu\n", n_in, ws_size); grid = -1; return; }
        int dev = 0, cus = 0, per_cu = 0;
        if (hipGetDevice(&dev) != hipSuccess || hipDeviceGetAttribute(&cus, hipDeviceAttributeMultiprocessorCount, dev) != hipSuccess) { grid = -1; return; }
        if (hipFuncSetAttribute((const void*)hybrid_fwd, hipFuncAttributeMaxDynamicSharedMemorySize, LDS_BYTES) != hipSuccess) { fprintf(stderr, "kernel_launch: hipFuncSetAttribute failed\n"); grid = -1; return; }
        if (hipOccupancyMaxActiveBlocksPerMultiprocessor(&per_cu, (const void*)hybrid_fwd, 512, LDS_BYTES) != hipSuccess || per_cu < 1)
            fprintf(stderr, "kernel_launch: occupancy query reports %d workgroups per CU\n", per_cu);
        (void)hipGetLastError();
        grid = cus;
    }
    if (grid < 0) return;
    if (hipMemsetAsync((char*)d_ws + WS_CTL, 0, CTL_ZERO_BYTES, stream) != hipSuccess) return;
    Args a{};
    for (int i = 0; i < NIN; ++i) a.in[i] = (const float*)d_in[i];
    a.out = (float*)d_out; a.ws = (unsigned char*)d_ws;
#if MK_MULTI
    for (int s = 0; s < NSEG; ++s) { a.ph_lo = s; a.ph_hi = s + 1; hipLaunchKernelGGL(hybrid_fwd, dim3(grid), dim3(512), LDS_BYTES, stream, a); }
#else
    a.ph_lo = 0; a.ph_hi = NSEG;
    hipLaunchKernelGGL(hybrid_fwd, dim3(grid), dim3(512), LDS_BYTES, stream, a);
#endif
}
```

```cpp
#include <hip/hip_runtime.h>
#include <cstdio>
#include <cstdint>

#define LAS __attribute__((address_space(3)))
#define GAS __attribute__((address_space(1)))
typedef unsigned short bf16_t;
typedef short bf16x8 __attribute__((ext_vector_type(8)));
typedef short bf16x4 __attribute__((ext_vector_type(4)));
typedef float f32x4 __attribute__((ext_vector_type(4)));
typedef float f32x2 __attribute__((ext_vector_type(2)));
typedef unsigned u32x4 __attribute__((ext_vector_type(4)));
typedef unsigned u32x2 __attribute__((ext_vector_type(2)));
#define LDS_WAIT() asm volatile("s_waitcnt lgkmcnt(0)" ::: "memory")
#define LDS_BARRIER() asm volatile("s_waitcnt lgkmcnt(0)\n\ts_barrier" ::: "memory")
#define VM_WAIT() asm volatile("s_waitcnt vmcnt(0)" ::: "memory")

constexpr int D = 2048, NB = 16, SEQ = 2048, CTXL = 256, SROW = 2304, T = NB * SROW;
constexpr int NGRP = 2, BG = 8, TG = BG * SROW;
constexpr int DFF = 5632;
constexpr int RH = 32;
constexpr int MH = 8, MDV = 256, MDK = 128, MPROJ = 6176, ULD = 6144;
constexpr int MODLD = 6 * D;
constexpr int NIN = 37;
enum { I_X = 0, I_C, I_CTX, I_CCTX, I_MODW, I_MODB, I_NORMG, I_FINALG, I_MU, I_WR, I_WK, I_WV, I_WO, I_W0, I_W1, I_W2, I_A0, I_A1, I_A2, I_G1, I_G2, I_KK, I_KA, I_RK, I_LNW, I_LNB,
       I_V0, I_V1, I_V2, I_MWIN, I_BGATE, I_CONVW, I_CONVB, I_MNORMW, I_MWOUT, I_FWIN, I_FWOUT };

constexpr size_t MiB = 1u << 20;
constexpr size_t WS_CTL = 0, CTL_ZERO_BYTES = 1 * MiB;
constexpr size_t WS_MOD = 1 * MiB;
constexpr size_t WS_XRES = 5 * MiB;
constexpr size_t WS_VF = 293 * MiB;
constexpr size_t WS_WMIX = 437 * MiB;
constexpr size_t WS_WFFN = 479 * MiB;
constexpr size_t WS_ACT = 545 * MiB;
constexpr size_t WS_END = WS_ACT + 977 * MiB;
static_assert(WS_END <= (size_t)1536 * MiB, "ws");
constexpr size_t WM_R = 0, WM_K = 8 * MiB, WM_V = 16 * MiB, WM_O = 24 * MiB, WM_W1 = 32 * MiB, WM_A1 = 33 * MiB, WM_G1 = 34 * MiB, WM_V1 = 35 * MiB,
                 WM_W2 = 36 * MiB, WM_A2 = 38 * MiB, WM_G2 = 40 * MiB, WM_V2 = 41 * MiB;
constexpr size_t WM_MIN = 0, WM_MOUT = 25 * MiB;
constexpr size_t WF_IN = 0, WF_OUT = 44 * MiB;
constexpr size_t SLOT = 72 * MiB;
constexpr size_t AR_MIX = 0;
constexpr size_t AR_H = 432 * MiB;
constexpr size_t AR_R = 432 * MiB, AR_K = 504 * MiB, AR_V = 576 * MiB;
constexpr size_t AR_LORA = 648 * MiB;
constexpr size_t AR_Y = 684 * MiB;
constexpr size_t AR_RK = 828 * MiB;
constexpr size_t AR_AO = 833 * MiB;
constexpr size_t AM_HB = 0, AM_U = 144 * MiB, AM_QK = 576 * MiB, AM_HZ1 = 720 * MiB, AM_G = 864 * MiB;
constexpr size_t AF_H2 = 0, AF_U = 144 * MiB;

constexpr int LDS_BYTES = 147456;
constexpr int LDSCTL_OFF = LDS_BYTES - 256;

__device__ __forceinline__ float bf2f(bf16_t b) { return __uint_as_float(((unsigned)b) << 16); }
typedef __bf16 bf16x2n_t __attribute__((ext_vector_type(2)));
__device__ __forceinline__ unsigned pk2(float lo, float hi) { const f32x2 v = {lo, hi}; return __builtin_bit_cast(unsigned, __builtin_convertvector(v, bf16x2n_t)); }
__device__ __forceinline__ unsigned f2bf(float f) { return pk2(f, f) & 0xffffu; }
__device__ __forceinline__ unsigned pk2a(float lo, float hi) { unsigned r; asm("v_cvt_pk_bf16_f32 %0, %1, %2" : "=v"(r) : "v"(lo), "v"(hi)); return r; }
__device__ __forceinline__ unsigned f2bfa(float f) { return pk2a(f, f) & 0xffffu; }
__device__ __forceinline__ float lo_bf(unsigned w) { return __uint_as_float(w << 16); }
__device__ __forceinline__ float hi_bf(unsigned w) { return __uint_as_float(w & 0xffff0000u); }
__device__ __forceinline__ float sigmoidf_(float x) { return __builtin_amdgcn_rcpf(1.0f + __expf(-x)); }
__device__ __forceinline__ float tanhf_(float x) { return 1.0f - 2.0f * __builtin_amdgcn_rcpf(1.0f + __expf(2.0f * x)); }
__device__ __forceinline__ float siluf_(float x) { return x * __builtin_amdgcn_rcpf(1.0f + __expf(-x)); }
template <int CTRL> __device__ __forceinline__ float dpp_(float v) { return __int_as_float(__builtin_amdgcn_update_dpp(0, __float_as_int(v), CTRL, 0xF, 0xF, true)); }
__device__ __forceinline__ float rl_(float v, int k) { return __int_as_float(__builtin_amdgcn_readlane(__float_as_int(v), k)); }
__device__ __forceinline__ float sum8_(float v) { v += dpp_<0xB1>(v); v += dpp_<0x4E>(v); v += dpp_<0x141>(v); return v; }
__device__ __forceinline__ float sum16_(float v) { v = sum8_(v); v += dpp_<0x140>(v); return v; }
__device__ __forceinline__ float wave_sum_dpp(float v) { v = sum16_(v); return (rl_(v, 0) + rl_(v, 16)) + (rl_(v, 32) + rl_(v, 48)); }
__device__ __forceinline__ float wave_sum(float v) { return wave_sum_dpp(v); }
__device__ __forceinline__ float shfl_xor_(float v, int mask, int lane) { return __int_as_float(__builtin_amdgcn_ds_bpermute((lane ^ mask) << 2, __float_as_int(v))); }

#define XB_TMO      128
#define XB_XCNT(j)  (256  + 64 * (j))
#define XB_XSUB(j)  (1280 + 64 * (j))
#define XB_XGEN(j)  (2304 + 64 * (j))
#define XB_TOP      3328
#define XB_TOPGEN   3392
#define XCD_BAR_WORDS 3456
#define XB_SPIN_CAP (1u << 24)

__device__ __forceinline__ unsigned xb_ld(unsigned* p)              { return __hip_atomic_load(p, __ATOMIC_RELAXED, __HIP_MEMORY_SCOPE_AGENT); }
__device__ __forceinline__ unsigned xb_add(unsigned* p, unsigned v) { return __hip_atomic_fetch_add(p, v, __ATOMIC_RELAXED, __HIP_MEMORY_SCOPE_AGENT); }
__device__ __forceinline__ unsigned xb_xcc_id() { return (unsigned)__builtin_amdgcn_s_getreg((3 << 11) | 20) & 0xFu; }
#define XB_SPIN(cond, bar) do { unsigned _sp = 0; while (cond) { __builtin_amdgcn_s_sleep(1); \
    if ((++_sp & 255u) == 0u) { if (xb_ld(&(bar)[XB_TMO])) break; if (_sp > XB_SPIN_CAP) { atomicAdd(&(bar)[XB_TMO], 1u); break; } } } } while (0)

struct XcdBarrier { unsigned* bar; unsigned x; volatile LAS unsigned* st; };

__device__ __forceinline__ XcdBarrier xcd_barrier_post(unsigned* bar, volatile LAS unsigned* st) {
    XcdBarrier b; b.bar = bar; b.x = xb_xcc_id(); b.st = st;
    if (threadIdx.x == 0) (void)xb_add(&bar[XB_XCNT(b.x)], 1u);
    return b;
}
__device__ __forceinline__ void xcd_barrier_complete(unsigned* bar, unsigned x, unsigned& nloc, unsigned& nx) {
    const unsigned G = gridDim.x * gridDim.y * gridDim.z;
    unsigned sum, cnt, mine, sp = 0u;
    for (;;) {
        sum = 0u; cnt = 0u; mine = 0u;
#pragma unroll
        for (unsigned j = 0; j < 16; ++j) { const unsigned c = xb_ld(&bar[XB_XCNT(j)]); sum += c; cnt += (c > 0u) ? 1u : 0u; mine = (j == x) ? c : mine; }
        if (sum == G) break;
        __builtin_amdgcn_s_sleep(1);
        if ((++sp & 255u) == 0u) { if (xb_ld(&bar[XB_TMO])) break; if (sp > XB_SPIN_CAP) { atomicAdd(&bar[XB_TMO], 1u); break; } }
    }
    nloc = mine > 0u ? mine : 1u; nx = cnt > 0u ? cnt : 1u;
}
__device__ __forceinline__ void xcd_barrier(const XcdBarrier& b) {
    asm volatile("s_waitcnt vmcnt(0)" ::: "memory");
    __syncthreads();
    if (threadIdx.x == 0) {
        unsigned* bar = b.bar;
        __builtin_amdgcn_s_waitcnt(0);
        unsigned nloc = b.st[0], nx = b.st[1];
        if (nloc == 0u) { xcd_barrier_complete(bar, b.x, nloc, nx); b.st[0] = nloc; b.st[1] = nx; }
        const unsigned old = xb_add(&bar[XB_XSUB(b.x)], 1u);
        const unsigned gen = old / nloc;
        if (old + 1u == (gen + 1u) * nloc) {
            __builtin_amdgcn_fence(__ATOMIC_RELEASE, "agent");
            asm volatile("s_waitcnt vmcnt(0)" ::: "memory");
            const unsigned og = xb_add(&bar[XB_TOP], 1u);
            const unsigned tg = og / nx;
            if (og + 1u == (tg + 1u) * nx) xb_add(&bar[XB_TOPGEN], 1u);
            else XB_SPIN(xb_ld(&bar[XB_TOPGEN]) == tg, bar);
            __builtin_amdgcn_fence(__ATOMIC_ACQUIRE, "agent");
            xb_add(&bar[XB_XGEN(b.x)], 1u);
            asm volatile("s_waitcnt vmcnt(0)" ::: "memory");
        } else {
            XB_SPIN(xb_ld(&bar[XB_XGEN(b.x)]) == gen, bar);
            __builtin_amdgcn_fence(__ATOMIC_ACQUIRE, "agent");
            asm volatile("s_waitcnt vmcnt(0)" ::: "memory");
        }
    }
    __syncthreads();
}
#ifndef GP_ALIGN
#define GP_ALIGN true
#endif
#ifndef GP_SP2
#define GP_SP2 true
#endif
namespace pg8 {
constexpr int BM = 256, BK = 64, HALF = 128, HTB = HALF * BK * 2  , STAGE_BYTES = 8 * HTB, NXCD = 8, WGM = 8;

__host__ __device__ __forceinline__ int lds_byte(int r, int c) { const int st = (r >> 4) * 2 + (c >> 5), rr = r & 15, cc = c & 31, ob = rr * 64 + cc * 2; return st * 1024 + (ob ^ (((ob >> 9) & 1) << 5)); }
__host__ __device__ __forceinline__ void stage_rc(int b, int& R, int& C) { const int st = b / 1024, sb = b % 1024, swz = sb ^ (((sb >> 9) & 1) << 5); R = (st >> 1) * 16 + swz / 64; C = (st & 1) * 32 + (swz % 64) / 2; }
__host__ __device__ __forceinline__ int perm32(int rho) { const int n = rho >> 4, i = rho & 15; return 8 * (i >> 2) + 4 * n + (i & 3); }

struct Unit { int pm, pn; };
struct Gemm { const bf16_t* A; const bf16_t* Bt; int M, N, K; };

struct StaticOrder {
    int nM, nN, nwg, G, c;
    __host__ __device__ void init(int M, int N, int G_, int c_) { nM = M / BM; nN = N / BM; nwg = nM * nN; G = G_; c = c_; }
    __host__ __device__ bool next(int i, Unit& u) const {
        const long L = (long)i * G + c; if (L >= nwg) return false;
        int wgid = (int)L; { const int q = nwg / NXCD, r = nwg % NXCD, xcd = wgid % NXCD, off = wgid / NXCD; wgid = (xcd < r ? xcd * (q + 1) : r * (q + 1) + (xcd - r) * q) + off; }
        const int nig = WGM * nN, gid = wgid / nig, fm = gid * WGM, gsz = (nM - fm) < WGM ? (nM - fm) : WGM;
        u.pm = fm + ((wgid % nig) % gsz); u.pn = (wgid % nig) / gsz; return true;
    }
    __device__ __forceinline__ void a_ready(const Unit&) const {}
    __device__ __forceinline__ void done(const Unit&) const {}
};
__device__ __forceinline__ unsigned cvt_pk_bf16(float lo, float hi) { unsigned r; asm volatile("v_cvt_pk_bf16_f32 %0, %1, %2" : "=v"(r) : "v"(lo), "v"(hi)); return r; }
template <class Epi, class Sched, bool ALIGN_EPI = false, bool SP2 = false>
__device__ __forceinline__ void gemm_phase(LAS unsigned char* lds, const Gemm g, const Sched& S, const Epi& E) {
    int tid_ = threadIdx.x; asm volatile("" : "+v"(tid_));
    const int tid = tid_, wid = __builtin_amdgcn_readfirstlane(tid >> 6), lane = tid & 63, wr = wid >> 2, wc = wid & 3, fr = lane & 15, fq = lane >> 4;
    const int K = g.K, nt = K / BK;
    unsigned voffA[2], voffB[2];
#pragma unroll
    for (int i = 0; i < 2; ++i) { int R, C; stage_rc(tid * 16 + i * 8192, R, C); const int Rb = Epi::PERM ? ((R & ~31) + perm32(R & 31)) : R;
        voffA[i] = (unsigned)(R * K + C) * 2u; voffB[i] = (unsigned)(Rb * K + C) * 2u; }
    const size_t kstep = (size_t)(BK * 2);
    const size_t hstep = (size_t)HALF * K * 2;
    const size_t tstep = 2 * hstep;
    const unsigned ldsw = (unsigned)wid * 1024u;
    const int aoff = lds_byte(wr * 64 + fr, fq * 8), boff = lds_byte(wc * 32 + fr, fq * 8);
#define PG8_SA(b, h) (((b) * 2 + (h)) * HTB)
#define PG8_SB(b, h) ((4 + (b) * 2 + (h)) * HTB)
#define PG8_STAGE(bufoff, gbase, voff) do { _Pragma("unroll") for (int _i = 0; _i < 2; ++_i) \
        __builtin_amdgcn_global_load_lds((const unsigned*)((const char*)(gbase) + (voff)[_i]), (LAS unsigned*)(lds + (bufoff) + ldsw + _i * 8192), 16, 0, 0); } while (0)
#define PG8_LDA(dst, b, h) do { _Pragma("unroll") for (int m = 0; m < 4; ++m) _Pragma("unroll") for (int k = 0; k < 2; ++k) dst[m][k] = *(const LAS bf16x8*)(lds + PG8_SA(b, h) + aoff + m * 2048 + k * 1024); } while (0)
#define PG8_LDB(dst, b, h) do { _Pragma("unroll") for (int n = 0; n < 2; ++n) _Pragma("unroll") for (int k = 0; k < 2; ++k) dst[n][k] = *(const LAS bf16x8*)(lds + PG8_SB(b, h) + boff + n * 2048 + k * 1024); } while (0)
#define PG8_MMA(ai, bj, At, Bt) do { __builtin_amdgcn_s_setprio(1); _Pragma("unroll") for (int m = 0; m < 4; ++m) _Pragma("unroll") for (int n = 0; n < 2; ++n) _Pragma("unroll") for (int k = 0; k < 2; ++k) \
        acc[ai][bj][m][n] = __builtin_amdgcn_mfma_f32_16x16x32_bf16(Bt[n][k], At[m][k], acc[ai][bj][m][n], 0, 0, 0); __builtin_amdgcn_s_setprio(0); } while (0)
#define PG8_WAIT_V(n) asm volatile("s_waitcnt vmcnt(" #n ")" ::: "memory")
#define PG8_WAIT_L(n) asm volatile("s_waitcnt lgkmcnt(" #n ")" ::: "memory")
#define PG8_BAR __builtin_amdgcn_s_barrier()
#define PG8_SCHED __builtin_amdgcn_sched_barrier(0)
    Unit cur, nxt; int ui = 0;
    if (!S.next(0, cur)) return;
    f32x4 acc[2][2][4][2];
#pragma unroll
    for (int a = 0; a < 2; ++a)
#pragma unroll
        for (int b = 0; b < 2; ++b)
#pragma unroll
            for (int m = 0; m < 4; ++m)
#pragma unroll
                for (int n = 0; n < 2; ++n) acc[a][b][m][n] = (f32x4){0.f, 0.f, 0.f, 0.f};
    bf16x8 At[4][2], B0[2][2], B1[2][2];
    const char* cA = (const char*)g.A + (size_t)cur.pm * tstep; const char* cB = (const char*)g.Bt + (size_t)cur.pn * tstep;
    S.a_ready(cur);
    if constexpr (SP2) {
        PG8_STAGE(PG8_SB(0, 0), cB, voffB); PG8_STAGE(PG8_SB(0, 1), cB + hstep, voffB); PG8_STAGE(PG8_SA(0, 0), cA, voffA); PG8_STAGE(PG8_SA(0, 1), cA + hstep, voffA);
        if (wr == 1) PG8_BAR;
        PG8_WAIT_V(2); PG8_BAR;
        PG8_STAGE(PG8_SB(1, 0), cB + kstep, voffB); PG8_STAGE(PG8_SA(1, 0), cA + kstep, voffA); PG8_STAGE(PG8_SB(1, 1), cB + hstep + kstep, voffB);
        PG8_WAIT_V(6); PG8_BAR;
    } else {
        PG8_STAGE(PG8_SB(0, 0), cB, voffB); PG8_STAGE(PG8_SA(0, 0), cA, voffA); PG8_STAGE(PG8_SB(0, 1), cB + hstep, voffB); PG8_STAGE(PG8_SA(0, 1), cA + hstep, voffA);
        if (wr == 1) PG8_BAR;
        PG8_WAIT_V(4); PG8_BAR;
        PG8_STAGE(PG8_SB(1, 0), cB + kstep, voffB); PG8_STAGE(PG8_SA(1, 0), cA + kstep, voffA); PG8_STAGE(PG8_SB(1, 1), cB + hstep + kstep, voffB);
        PG8_WAIT_V(6); PG8_BAR;
    }
    for (;;) {
        const bool has_next = S.next(ui + 1, nxt);
        const char* nA = has_next ? (const char*)g.A + (size_t)nxt.pm * tstep : cA; const char* nB = has_next ? (const char*)g.Bt + (size_t)nxt.pn * tstep : cB;
#pragma unroll 1
        for (int t = 0; t < nt; t += 2) {
            const bool last = (t == nt - 2);
            const char* a1 = cA + (size_t)(t + 1) * kstep;
            const char* a2 = last ? nA : cA + (size_t)(t + 2) * kstep; const char* b2 = last ? nB : cB + (size_t)(t + 2) * kstep;
            const char* a3 = a2 + kstep; const char* b3 = b2 + kstep;
            if (last && has_next) S.a_ready(nxt);
            if constexpr (SP2) {
            PG8_LDB(B0, 0, 0); PG8_LDB(B1, 0, 1); PG8_SCHED; PG8_LDA(At, 0, 0); PG8_STAGE(PG8_SA(1, 1), a1 + hstep, voffA);
            PG8_WAIT_V(8); PG8_WAIT_L(0); PG8_BAR; PG8_MMA(0, 0, At, B0); PG8_MMA(0, 1, At, B1); PG8_BAR; PG8_SCHED;
            PG8_LDA(At, 0, 1); PG8_STAGE(PG8_SB(0, 0), b2, voffB); PG8_STAGE(PG8_SB(0, 1), b2 + hstep, voffB); PG8_STAGE(PG8_SA(0, 0), a2, voffA);
            PG8_WAIT_V(8); PG8_WAIT_L(0); PG8_BAR; PG8_MMA(1, 0, At, B0); PG8_MMA(1, 1, At, B1); PG8_BAR; PG8_SCHED;
            PG8_LDB(B0, 1, 0); PG8_LDB(B1, 1, 1); PG8_SCHED; PG8_LDA(At, 1, 0); PG8_STAGE(PG8_SA(0, 1), a2 + hstep, voffA);
            PG8_WAIT_V(8); PG8_WAIT_L(0); PG8_BAR; PG8_MMA(0, 0, At, B0); PG8_MMA(0, 1, At, B1); PG8_BAR; PG8_SCHED;
            PG8_LDA(At, 1, 1); PG8_STAGE(PG8_SB(1, 0), b3, voffB); PG8_STAGE(PG8_SB(1, 1), b3 + hstep, voffB); PG8_STAGE(PG8_SA(1, 0), a3, voffA);
            PG8_WAIT_V(8); PG8_WAIT_L(0); PG8_BAR; PG8_MMA(1, 0, At, B0); PG8_MMA(1, 1, At, B1); PG8_BAR; PG8_SCHED;
            } else {
            PG8_LDB(B0, 0, 0); PG8_SCHED; PG8_LDA(At, 0, 0); PG8_STAGE(PG8_SA(1, 1), a1 + hstep, voffA);
            PG8_WAIT_L(8); PG8_BAR; PG8_WAIT_L(0); PG8_MMA(0, 0, At, B0); PG8_BAR; PG8_SCHED;
            PG8_LDB(B1, 0, 1); PG8_STAGE(PG8_SB(0, 0), b2, voffB);
            PG8_BAR; PG8_WAIT_L(0); PG8_MMA(0, 1, At, B1); PG8_BAR;
            PG8_LDA(At, 0, 1); PG8_STAGE(PG8_SA(0, 0), a2, voffA);
            PG8_BAR; PG8_WAIT_L(0); PG8_MMA(1, 0, At, B0); PG8_BAR; PG8_SCHED;
            PG8_STAGE(PG8_SB(0, 1), b2 + hstep, voffB);
            PG8_WAIT_V(6); PG8_BAR; PG8_MMA(1, 1, At, B1); PG8_BAR;
            PG8_LDB(B0, 1, 0); PG8_SCHED; PG8_LDA(At, 1, 0); PG8_STAGE(PG8_SA(0, 1), a2 + hstep, voffA);
            PG8_WAIT_L(8); PG8_BAR; PG8_WAIT_L(0); PG8_MMA(0, 0, At, B0); PG8_BAR; PG8_SCHED;
            PG8_LDB(B1, 1, 1); PG8_STAGE(PG8_SB(1, 0), b3, voffB);
            PG8_BAR; PG8_WAIT_L(0); PG8_MMA(0, 1, At, B1); PG8_BAR;
            PG8_LDA(At, 1, 1); PG8_STAGE(PG8_SA(1, 0), a3, voffA);
            PG8_BAR; PG8_WAIT_L(0); PG8_MMA(1, 0, At, B0); PG8_BAR; PG8_SCHED;
            PG8_STAGE(PG8_SB(1, 1), b3 + hstep, voffB);
            PG8_WAIT_V(6); PG8_BAR; PG8_MMA(1, 1, At, B1); PG8_BAR;
            }
        }
        if constexpr (ALIGN_EPI) { if (wr == 0) PG8_BAR; }
        if constexpr (!Epi::AFTER_DRAIN) { E(acc, cur, wr, wc, fr, fq); S.done(cur); }
        if (!has_next) break;
#pragma unroll
        for (int a = 0; a < 2; ++a)
#pragma unroll
            for (int b = 0; b < 2; ++b)
#pragma unroll
                for (int m = 0; m < 4; ++m)
#pragma unroll
                    for (int n = 0; n < 2; ++n) acc[a][b][m][n] = (f32x4){0.f, 0.f, 0.f, 0.f};
        cur = nxt; cA = nA; cB = nB; ++ui;
        if constexpr (ALIGN_EPI) { if (wr == 1) PG8_BAR; }
    }
    PG8_WAIT_V(0);
    if constexpr (!ALIGN_EPI) { if (wr == 0) PG8_BAR; }
    PG8_BAR;
    if constexpr (Epi::AFTER_DRAIN) { E.fused(acc, cur, wr, wc, fr, fq, lds, wid, lane); S.done(cur); }
#undef PG8_SA
#undef PG8_SB
#undef PG8_STAGE
#undef PG8_LDA
#undef PG8_LDB
#undef PG8_MMA
#undef PG8_WAIT_V
#undef PG8_WAIT_L
#undef PG8_BAR
#undef PG8_SCHED
}
}
namespace pg8 {
typedef const f32x4 (&AccRef)[2][2][4][2];

struct EpiStore {
    static constexpr bool PERM = true, AFTER_DRAIN = false;
    bf16_t* O; int ldc; int act; int split_cols; size_t split_stride; int gate_pn; float* G; const float* bgate;
    __device__ __forceinline__ void operator()(AccRef acc, const Unit& u, int wr, int wc, int fr, int fq) const {
        const int row0 = u.pm * BM + wr * 64 + fr;
        if (u.pn == gate_pn) {
            if (wc == 0) {
#pragma unroll
                for (int n = 0; n < 2; ++n) {
                    const int c0 = 8 * fq + 4 * n;
                    const f32x4 bg = *(const f32x4*)(bgate + c0);
                    const bool isf = (c0 & 8) != 0;
#pragma unroll
                    for (int ai = 0; ai < 2; ++ai)
#pragma unroll
                        for (int m = 0; m < 4; ++m) {
                            f32x4 v = acc[ai][0][m][n] + bg, o;
#pragma unroll
                            for (int j = 0; j < 4; ++j) { const float cpd = 15.0f * tanhf_(v[j] * (1.0f / 15.0f)); const float eu = __expf(-cpd); o[j] = isf ? -(eu < 9.765625e-4f ? eu - 0.5f * eu * eu : __logf(1.0f + eu)) : cpd; }
                            *(f32x4*)(G + (size_t)(row0 + ai * HALF + m * 16) * 32 + c0) = o;
                        }
                }
            }
            return;
        }
        int colt = u.pn * BM; bf16_t* base = O;
        if (split_cols) { const int t = colt / split_cols; base += (size_t)t * split_stride; colt -= t * split_cols; }
        const int col0 = colt + wc * 32 + 8 * fq;
#pragma unroll
        for (int ai = 0; ai < 2; ++ai)
#pragma unroll
            for (int m = 0; m < 4; ++m) { bf16_t* rowp = base + (size_t)(row0 + ai * HALF + m * 16) * ldc + col0;
#pragma unroll
                for (int bj = 0; bj < 2; ++bj) { f32x4 v0 = acc[ai][bj][m][0], v1 = acc[ai][bj][m][1];
                    if (act == 1) {
#pragma unroll
                        for (int j = 0; j < 4; ++j) { v0[j] = tanhf_(v0[j]); v1[j] = tanhf_(v1[j]); } }
                    else if (act == 2) {
#pragma unroll
                        for (int j = 0; j < 4; ++j) { v0[j] = sigmoidf_(v0[j]); v1[j] = sigmoidf_(v1[j]); } }
                    u32x4 w; w.x = cvt_pk_bf16(v0[0], v0[1]); w.y = cvt_pk_bf16(v0[2], v0[3]); w.z = cvt_pk_bf16(v1[0], v1[1]); w.w = cvt_pk_bf16(v1[2], v1[3]);
                    *(u32x4*)(rowp + bj * HALF) = w; } }
    }
};

struct EpiSigAff {
    static constexpr bool PERM = true, AFTER_DRAIN = false;
    bf16_t* O; size_t split_stride; const float* bias; float scale;
    __device__ __forceinline__ void operator()(AccRef acc, const Unit& u, int wr, int wc, int fr, int fq) const {
        const int row0 = u.pm * BM + wr * 64 + fr;
        int colt = u.pn * BM; const int t = colt / D; bf16_t* base = O + (size_t)t * split_stride; colt -= t * D;
        const int col0 = colt + wc * 32 + 8 * fq, bcol0 = u.pn * BM + wc * 32 + 8 * fq;
        f32x4 bv[2][2];
#pragma unroll
        for (int bj = 0; bj < 2; ++bj)
#pragma unroll
            for (int n = 0; n < 2; ++n) bv[bj][n] = *(const f32x4*)(bias + bcol0 + bj * HALF + 4 * n);
#pragma unroll
        for (int ai = 0; ai < 2; ++ai)
#pragma unroll
            for (int m = 0; m < 4; ++m) { bf16_t* rowp = base + (size_t)(row0 + ai * HALF + m * 16) * D + col0;
#pragma unroll
                for (int bj = 0; bj < 2; ++bj) { f32x4 v0 = acc[ai][bj][m][0] + bv[bj][0], v1 = acc[ai][bj][m][1] + bv[bj][1];
#pragma unroll
                    for (int j = 0; j < 4; ++j) { v0[j] = scale * sigmoidf_(v0[j]); v1[j] = scale * sigmoidf_(v1[j]); }
                    u32x4 w; w.x = cvt_pk_bf16(v0[0], v0[1]); w.y = cvt_pk_bf16(v0[2], v0[3]); w.z = cvt_pk_bf16(v1[0], v1[1]); w.w = cvt_pk_bf16(v1[2], v1[3]);
                    *(u32x4*)(rowp + bj * HALF) = w; } }
    }
};

struct EpiVmix {
    static constexpr bool PERM = true, AFTER_DRAIN = false;
    bf16_t* V; const bf16_t* VF; const float* v0;
    __device__ __forceinline__ void operator()(AccRef acc, const Unit& u, int wr, int wc, int fr, int fq) const {
        const int row0 = u.pm * BM + wr * 64 + fr; const int col0 = u.pn * BM + wc * 32 + 8 * fq;
        f32x4 bv[2][2];
#pragma unroll
        for (int bj = 0; bj < 2; ++bj)
#pragma unroll
            for (int n = 0; n < 2; ++n) bv[bj][n] = *(const f32x4*)(v0 + col0 + bj * HALF + 4 * n);
#pragma unroll
        for (int ai = 0; ai < 2; ++ai) {
            u32x4 vvs[4][2], ffs[4][2];
#pragma unroll
            for (int m = 0; m < 4; ++m) { const size_t off = (size_t)(row0 + ai * HALF + m * 16) * D + col0;
#pragma unroll
                for (int bj = 0; bj < 2; ++bj) { vvs[m][bj] = *(const u32x4*)(V + off + bj * HALF); ffs[m][bj] = *(const u32x4*)(VF + off + bj * HALF); } }
            asm volatile("" ::: "memory");
#pragma unroll
            for (int m = 0; m < 4; ++m) { const size_t off = (size_t)(row0 + ai * HALF + m * 16) * D + col0;
#pragma unroll
                for (int bj = 0; bj < 2; ++bj) {
                    const u32x4 vv = vvs[m][bj], ff = ffs[m][bj];
                    const f32x4 a0 = acc[ai][bj][m][0] + bv[bj][0], a1 = acc[ai][bj][m][1] + bv[bj][1];
                    float o[8];
#pragma unroll
                    for (int j = 0; j < 4; ++j) {
                        const unsigned vw = j == 0 ? vv.x : j == 1 ? vv.y : j == 2 ? vv.z : vv.w, fw = j == 0 ? ff.x : j == 1 ? ff.y : j == 2 ? ff.z : ff.w;
                        const float s0 = sigmoidf_(j < 2 ? a0[2 * j] : a1[2 * j - 4]), s1 = sigmoidf_(j < 2 ? a0[2 * j + 1] : a1[2 * j - 3]);
                        const float x0 = lo_bf(vw), x1 = hi_bf(vw), f0 = lo_bf(fw), f1 = hi_bf(fw);
                        o[2 * j] = x0 + (f0 - x0) * s0; o[2 * j + 1] = x1 + (f1 - x1) * s1; }
                    u32x4 w; w.x = cvt_pk_bf16(o[0], o[1]); w.y = cvt_pk_bf16(o[2], o[3]); w.z = cvt_pk_bf16(o[4], o[5]); w.w = cvt_pk_bf16(o[6], o[7]);
                    *(u32x4*)(V + off + bj * HALF) = w; } }
            asm volatile("" ::: "memory"); }
    }
};

struct EpiResid {
    static constexpr bool PERM = false, AFTER_DRAIN = false;
    float* X; const float* gate; int tile0; const float* srcx; const float* srcc;
    __device__ __forceinline__ void operator()(AccRef acc, const Unit& u, int wr, int wc, int fr, int fq) const {
        const int gpm = tile0 + u.pm; const int b = gpm / 9, tix = gpm % 9; const int idx = (tix == 0) ? 16 : b;
        const int rloc = wr * 64 + fr, col0 = u.pn * BM + wc * 32 + 4 * fq;
        const float* src = srcx ? (tix == 0 ? srcc + (size_t)b * CTXL * D : srcx + ((size_t)b * SEQ + (size_t)(tix - 1) * BM) * D) : X + (size_t)gpm * BM * D;
        float* dst = X + (size_t)gpm * BM * D;
        f32x4 gv[2][2];
#pragma unroll
        for (int bj = 0; bj < 2; ++bj)
#pragma unroll
            for (int n = 0; n < 2; ++n) gv[bj][n] = *(const f32x4*)(gate + (size_t)idx * MODLD + col0 + bj * HALF + n * 16);
        f32x4 (&ac)[2][2][4][2] = const_cast<f32x4 (&)[2][2][4][2]>(acc);
        f32x4 xa[2][2], xb[2][2];
#define RES_LD(dstv, ai_, m_) do { const size_t off_ = (size_t)(rloc + (ai_) * HALF + (m_) * 16) * D + col0; _Pragma("unroll") for (int bj = 0; bj < 2; ++bj) _Pragma("unroll") for (int n = 0; n < 2; ++n) \
            dstv[bj][n] = *(const f32x4*)(src + off_ + bj * HALF + n * 16); } while (0)
#define RES_FMA(srcv, ai_, m_) do { _Pragma("unroll") for (int bj = 0; bj < 2; ++bj) _Pragma("unroll") for (int n = 0; n < 2; ++n) ac[ai_][bj][m_][n] = srcv[bj][n] + gv[bj][n] * ac[ai_][bj][m_][n]; } while (0)
        RES_LD(xa, 0, 0); RES_LD(xb, 0, 1);
        RES_FMA(xa, 0, 0); RES_LD(xa, 0, 2); RES_FMA(xb, 0, 1); RES_LD(xb, 0, 3);
        RES_FMA(xa, 0, 2); RES_LD(xa, 1, 0); RES_FMA(xb, 0, 3); RES_LD(xb, 1, 1);
        RES_FMA(xa, 1, 0); RES_LD(xa, 1, 2); RES_FMA(xb, 1, 1); RES_LD(xb, 1, 3);
        RES_FMA(xa, 1, 2); RES_FMA(xb, 1, 3);
#undef RES_LD
#undef RES_FMA
        asm volatile("" ::: "memory");
#pragma unroll
        for (int ai = 0; ai < 2; ++ai)
#pragma unroll
            for (int m = 0; m < 4; ++m) { const size_t off = (size_t)(rloc + ai * HALF + m * 16) * D + col0;
#pragma unroll
                for (int bj = 0; bj < 2; ++bj)
#pragma unroll
                    for (int n = 0; n < 2; ++n) *(f32x4*)(dst + off + bj * HALF + n * 16) = ac[ai][bj][m][n]; }
    }
};

struct EpiSwiglu {
    static constexpr bool PERM = true, AFTER_DRAIN = false;
    bf16_t* O;
    __device__ __forceinline__ void operator()(AccRef acc, const Unit& u, int wr, int wc, int fr, int fq) const {
        const int row0 = u.pm * BM + wr * 64 + fr; const int col0 = u.pn * HALF + wc * 32 + 8 * fq;
#pragma unroll
        for (int ai = 0; ai < 2; ++ai)
#pragma unroll
            for (int m = 0; m < 4; ++m) { bf16_t* rowp = O + (size_t)(row0 + ai * HALF + m * 16) * DFF + col0;
                f32x4 v0, v1;
#pragma unroll
                for (int j = 0; j < 4; ++j) { v0[j] = siluf_(acc[ai][0][m][0][j]) * acc[ai][1][m][0][j]; v1[j] = siluf_(acc[ai][0][m][1][j]) * acc[ai][1][m][1][j]; }
                u32x4 w; w.x = cvt_pk_bf16(v0[0], v0[1]); w.y = cvt_pk_bf16(v0[2], v0[3]); w.z = cvt_pk_bf16(v1[0], v1[1]); w.w = cvt_pk_bf16(v1[2], v1[3]);
                *(u32x4*)rowp = w; }
    }
};
}

namespace pg8 {
struct SkipCtxOrder : StaticOrder {
    __device__ __forceinline__ bool next(int i, Unit& u) const { if (!StaticOrder::next(i, u)) return false; u.pm = u.pm + (u.pm >> 3) + 1; return true; }
};
}
template <class Epi, bool SKIPCTX = false>
__device__ __forceinline__ void run_gemm(LAS unsigned char* lds, const bf16_t* A, const bf16_t* Bt, int M, int N, int K, const Epi& E, int& urot) {
    pg8::Gemm g{A, Bt, M, N, K};
    const int G = (int)gridDim.x; const int Meff = SKIPCTX ? (M / 9) * 8 : M; const int nwg = (Meff / 256) * (N / 256);
    const int c = ((int)blockIdx.x + G - (urot % G)) % G;
    if constexpr (SKIPCTX) { pg8::SkipCtxOrder S; S.init(Meff, N, G, c); pg8::gemm_phase<Epi, pg8::SkipCtxOrder, GP_ALIGN, GP_SP2>(lds, g, S, E); }
    else { pg8::StaticOrder S; S.init(M, N, G, c); pg8::gemm_phase<Epi, pg8::StaticOrder, GP_ALIGN, GP_SP2>(lds, g, S, E); }
    urot += nwg;
}
struct Args { const float* in[NIN]; float* out; unsigned char* ws; int ph_lo, ph_hi; };
static_assert(sizeof(Args) == NIN * 8 + 8 + 8 + 8, "Args has no padding");

typedef const __attribute__((address_space(4))) Args* CArgs;
__device__ __forceinline__ CArgs opaque_args() { CArgs p = (CArgs)__builtin_amdgcn_kernarg_segment_ptr(); asm volatile("" : "+s"(p)); return p; }
struct Tc { LAS unsigned char* lds; int tid, lane, wave, bid, G, gw, ngw; };
__device__ __forceinline__ Tc mk_tc(LAS unsigned char* lds) { Tc t; int tid = threadIdx.x; asm volatile("" : "+v"(tid)); t.lds = lds; t.tid = tid; t.lane = tid & 63; t.wave = __builtin_amdgcn_readfirstlane(tid >> 6);
    t.bid = blockIdx.x; t.G = gridDim.x; t.gw = t.bid * 8 + t.wave; t.ngw = t.G * 8; return t; }

template <class RM>
__device__ __forceinline__ void tr_item(const float* W, int ldw, bf16_t* WT, int ldk, const RM& rm, LAS float* scr, int kb, int nb, int lane) {
    const int k0 = 64 * kb, n0 = 32 * nb;
    float tmp[32];
#pragma unroll
    for (int i = 0; i < 32; ++i) { const int kk = 2 * i + (lane >> 5); tmp[i] = W[(size_t)(k0 + kk) * ldw + n0 + (lane & 31)]; }
    asm volatile("" ::: "memory");
#pragma unroll
    for (int i = 0; i < 32; ++i) { const int kk = 2 * i + (lane >> 5); scr[kk * 33 + (lane & 31)] = tmp[i]; }
    LDS_WAIT();
    const int c = lane & 7;
#pragma unroll
    for (int j = 0; j < 4; ++j) { const int n = (lane >> 3) + 8 * j; const LAS float* s = scr + (8 * c) * 33 + n;
        u32x4 o; o.x = pk2(s[0 * 33], s[1 * 33]); o.y = pk2(s[2 * 33], s[3 * 33]); o.z = pk2(s[4 * 33], s[5 * 33]); o.w = pk2(s[6 * 33], s[7 * 33]);
        *(u32x4*)(WT + (size_t)rm(n0 + n) * ldk + k0 + 8 * c) = o; }
    LDS_WAIT();
}
struct RmId { __device__ __forceinline__ int operator()(int n) const { return n; } };
struct RmSwiglu { __device__ __forceinline__ int operator()(int n) const { const int up = n >= DFF ? 1 : 0; const int m = n - up * DFF; return 256 * (m >> 7) + 128 * up + (m & 127); } };

template <class RM>
__device__ __forceinline__ void tr_matrix(const Tc& t, const float* W, int K, int N, int ldw, bf16_t* WT, int ldk, const RM& rm) {
    LAS float* scr = (LAS float*)(t.lds + t.wave * 16384);
    const int nkb = K / 64, nnb = N / 32, items = nkb * nnb;
    for (int it = t.gw; it < items; it += t.ngw) tr_item(W, ldw, WT, ldk, rm, scr, it / nnb, it % nnb, t.lane);
}
template <class SRC>
__device__ __forceinline__ void build_small(const Tc& t, bf16_t* dst, int NR, int KC, const SRC& src) {
    const int total = NR * (KC / 8);
    for (int i = t.gw * 64 + t.lane; i < total; i += t.ngw * 64) { const int n = i % NR, ko = i / NR;
        float v[8];
#pragma unroll
        for (int j = 0; j < 8; ++j) v[j] = src(n, 8 * ko + j);
        u32x4 o; o.x = pk2(v[0], v[1]); o.y = pk2(v[2], v[3]); o.z = pk2(v[4], v[5]); o.w = pk2(v[6], v[7]);
        *(u32x4*)(dst + (size_t)n * KC + 8 * ko) = o; }
}

__device__ __forceinline__ void convert_rwkv(const Tc& t, CArgs a, int jl) {
    bf16_t* wm = (bf16_t*)(a->ws + WS_WMIX);
    const size_t dd = (size_t)D * D;
    tr_matrix(t, a->in[I_WR] + jl * dd, D, D, D, (bf16_t*)((char*)wm + WM_R), D, RmId());
    tr_matrix(t, a->in[I_WK] + jl * dd, D, D, D, (bf16_t*)((char*)wm + WM_K), D, RmId());
    tr_matrix(t, a->in[I_WV] + jl * dd, D, D, D, (bf16_t*)((char*)wm + WM_V), D, RmId());
    tr_matrix(t, a->in[I_WO] + jl * dd, D, D, D, (bf16_t*)((char*)wm + WM_O), D, RmId());
    { const float* w1 = a->in[I_W1] + (size_t)jl * 2 * D * 96;
      build_small(t, (bf16_t*)((char*)wm + WM_W1), 256, D, [=](int n, int k) -> float { if (n >= 192) return 0.f; const int z = n >= 96 ? 1 : 0, r = n - 96 * z; return w1[((size_t)z * D + k) * 96 + r]; }); }
    { const float* a1 = a->in[I_A1] + (size_t)jl * 2 * D * 96;
      build_small(t, (bf16_t*)((char*)wm + WM_A1), 256, D, [=](int n, int k) -> float { if (n >= 192) return 0.f; const int z = n >= 96 ? 1 : 0, r = n - 96 * z; return a1[((size_t)z * D + k) * 96 + r]; }); }
    { const float* g1 = a->in[I_G1] + (size_t)jl * D * 256;
      build_small(t, (bf16_t*)((char*)wm + WM_G1), 256, D, [=](int n, int k) -> float { return g1[(size_t)k * 256 + n]; }); }
    if (jl > 0) { const float* v1 = a->in[I_V1] + (size_t)(jl - 1) * D * 64;
      build_small(t, (bf16_t*)((char*)wm + WM_V1), 256, D, [=](int n, int k) -> float { return n < 64 ? v1[(size_t)k * 64 + n] : 0.f; }); }
    { const float* w2 = a->in[I_W2] + (size_t)jl * 2 * 96 * D;
      build_small(t, (bf16_t*)((char*)wm + WM_W2), 2 * D, 256, [=](int n, int k) -> float { const int z = n >= D ? 1 : 0, ch = n - z * D, kk = k - 96 * z; return (kk >= 0 && kk < 96) ? w2[((size_t)z * 96 + kk) * D + ch] : 0.f; }); }
    { const float* a2 = a->in[I_A2] + (size_t)jl * 2 * 96 * D;
      build_small(t, (bf16_t*)((char*)wm + WM_A2), 2 * D, 256, [=](int n, int k) -> float { const int z = n >= D ? 1 : 0, ch = n - z * D, kk = k - 96 * z; return (kk >= 0 && kk < 96) ? a2[((size_t)z * 96 + kk) * D + ch] : 0.f; }); }
    { const float* g2 = a->in[I_G2] + (size_t)jl * 256 * D;
      build_small(t, (bf16_t*)((char*)wm + WM_G2), D, 256, [=](int n, int k) -> float { return g2[(size_t)k * D + n]; }); }
    if (jl > 0) { const float* v2 = a->in[I_V2] + (size_t)(jl - 1) * 64 * D;
      build_small(t, (bf16_t*)((char*)wm + WM_V2), D, 256, [=](int n, int k) -> float { return k < 64 ? v2[(size_t)k * D + n] : 0.f; }); }
}
__device__ __forceinline__ void convert_mlstm(const Tc& t, CArgs a, int jl) {
    bf16_t* win = (bf16_t*)(a->ws + WS_WMIX + WM_MIN); bf16_t* wout = (bf16_t*)(a->ws + WS_WMIX + WM_MOUT);
    tr_matrix(t, a->in[I_MWIN] + (size_t)jl * D * MPROJ, D, MPROJ, MPROJ, win, D, RmId());
    { u32x4* z = (u32x4*)(win + (size_t)MPROJ * D); const int total = (6400 - MPROJ) * D / 8; unsigned zz = 0u; asm volatile("" : "+v"(zz)); const u32x4 zero = {zz, zz, zz, zz};
      for (int i = t.gw * 64 + t.lane; i < total; i += t.ngw * 64) z[i] = zero; }
    tr_matrix(t, a->in[I_MWOUT] + (size_t)jl * D * D, D, D, D, wout, D, RmId());
}
__device__ __forceinline__ void convert_ffn_in(const Tc& t, CArgs a, int layer) {
    tr_matrix(t, a->in[I_FWIN] + (size_t)layer * D * 2 * DFF, D, 2 * DFF, 2 * DFF, (bf16_t*)(a->ws + WS_WFFN + WF_IN), D, RmSwiglu());
}
__device__ __forceinline__ void convert_ffn_out(const Tc& t, CArgs a, int layer) {
    tr_matrix(t, a->in[I_FWOUT] + (size_t)layer * DFF * D, DFF, D, D, (bf16_t*)(a->ws + WS_WFFN + WF_OUT), DFF, RmId());
}
__device__ __forceinline__ bool tail_crew(const Tc& t, int urot0, int nwg, Tc& ts) {
    const int G = t.G, r = nwg % G, c = (t.bid + G - (urot0 % G)) % G;
    ts = t;
    if (r == 0) return true;
    if (c < r) return false;
    ts.bid = c - r; ts.G = G - r; ts.gw = ts.bid * 8 + t.wave; ts.ngw = ts.G * 8; return true;
}

__device__ __forceinline__ void ph_prologue(const Tc& t, CArgs a) {
    LAS float* S = (LAS float*)t.lds;
    { f32x4 cv[17];
#pragma unroll
      for (int b = 0; b < 17; ++b) cv[b] = *(const f32x4*)((b < 16 ? a->in[I_C] + (size_t)b * D : a->in[I_CCTX]) + 4 * t.tid);
      const int k = 4 * t.tid;
#pragma unroll
      for (int b = 0; b < 17; ++b) { const f32x4 s = {siluf_(cv[b][0]), siluf_(cv[b][1]), siluf_(cv[b][2]), siluf_(cv[b][3])};
          *(LAS f32x4*)(S + b * 2056 + (k >> 10) * 1028 + (k & 1023)) = s; } }
    __syncthreads();
    float* mod = (float*)(a->ws + WS_MOD);
    const int col = t.lane & 31, kh = t.lane >> 5;
    for (int it = t.wave * t.G + t.bid; it < 4 * 384; it += t.ngw) { const int layer = it / 384, n0 = 32 * (it % 384);
        const auto wrs = __builtin_amdgcn_make_buffer_rsrc((void*)(a->in[I_MODW] + (size_t)layer * D * MODLD), (short)0, (int)((size_t)D * MODLD * 4), 0x00020000);
        const unsigned voff = (unsigned)(kh * 1024 * MODLD + n0 + col) * 4u;
        const LAS float* Sk = S + kh * 1028;
        f32x2 acc[17];
#pragma unroll
        for (int b = 0; b < 17; ++b) acc[b] = (f32x2){0.f, 0.f};
        float wa[8], wb[8];
#define MOD_LD(dst, k0_) do { _Pragma("unroll") for (int j = 0; j < 8; ++j) dst[j] = __builtin_bit_cast(float, __builtin_amdgcn_raw_buffer_load_b32(wrs, voff, (unsigned)(((k0_) + j) * MODLD * 4), 0)); } while (0)
#define MOD_FMA(src, k0_) do { _Pragma("unroll") for (int j4 = 0; j4 < 2; ++j4) { _Pragma("unroll") for (int b = 0; b < 17; ++b) { const f32x4 s = *(const LAS f32x4*)(Sk + b * 2056 + (k0_) + 4 * j4); \
            acc[b] = acc[b] + (f32x2){s[0], s[1]} * (f32x2){src[4 * j4], src[4 * j4 + 1]} + (f32x2){s[2], s[3]} * (f32x2){src[4 * j4 + 2], src[4 * j4 + 3]}; } asm volatile("" ::: "memory"); } } while (0)
        MOD_LD(wa, 0);
#pragma unroll 1
        for (int k0 = 0; k0 < 1024; k0 += 16) {
            MOD_LD(wb, k0 + 8);
            MOD_FMA(wa, k0);
            if (k0 + 16 < 1024) MOD_LD(wa, k0 + 16);
            MOD_FMA(wb, k0 + 8); }
#undef MOD_LD
#undef MOD_FMA
#pragma unroll
        for (int b = 0; b < 17; ++b) { float v = acc[b].x + acc[b].y; v += shfl_xor_(v, 32, t.lane);
            if (kh == 0) mod[((size_t)layer * 17 + b) * MODLD + n0 + col] = v + a->in[I_MODB][layer * MODLD + n0 + col]; } }
    __syncthreads();
}

template <bool OUT_BF16>
__device__ __forceinline__ void norm_rows(const Tc& t, CArgs a, int layer, int which, int row_begin, int nrows, void* out, bool from_inputs = false) {
    const float* xres = (const float*)(a->ws + WS_XRES);
    const float* mod = (const float*)(a->ws + WS_MOD) + (size_t)layer * 17 * MODLD;
    const int npw = (nrows + t.ngw - 1) / t.ngw;
    f32x4 gg[8], gm[8], sh[8];
    { const f32x4* gp = (const f32x4*)(a->in[I_NORMG] + (size_t)(layer * 2 + which) * D) + t.lane;
#pragma unroll
      for (int j = 0; j < 8; ++j) gg[j] = gp[64 * j]; }
    int cur_idx = -1;
    auto rowptr = [&](int r) -> const f32x4* { const int grow = row_begin + r; const int gb = grow / SROW, gs = grow % SROW;
        const float* rp = from_inputs ? (gs < CTXL ? a->in[I_CTX] + ((size_t)gb * CTXL + gs) * D : a->in[I_X] + ((size_t)gb * SEQ + (gs - CTXL)) * D) : xres + (size_t)grow * D;
        return (const f32x4*)rp + t.lane; };
    const int rfirst = t.gw * npw;
    if (rfirst >= nrows) return;
    const int nmine = (nrows - rfirst) < npw ? (nrows - rfirst) : npw;
    f32x4 xn[8];
    { const f32x4* xr = rowptr(rfirst);
#pragma unroll
      for (int j = 0; j < 8; ++j) xn[j] = xr[64 * j]; }
    for (int i = 0; i < nmine; ++i) { const int r = rfirst + i; const int grow = row_begin + r; const int idx = (grow % SROW) < CTXL ? 16 : grow / SROW;
        f32x4 v[8];
#pragma unroll
        for (int j = 0; j < 8; ++j) v[j] = xn[j];
        if (idx != cur_idx) { cur_idx = idx;
            const f32x4* shp = (const f32x4*)(mod + (size_t)idx * MODLD + (3 * which) * D) + t.lane; const f32x4* scp = (const f32x4*)(mod + (size_t)idx * MODLD + (3 * which + 1) * D) + t.lane;
#pragma unroll
            for (int j = 0; j < 8; ++j) { sh[j] = shp[64 * j]; gm[j] = gg[j] * (scp[64 * j] + 1.0f); } }
        if (i + 1 < nmine) { const f32x4* xr = rowptr(r + 1);
#pragma unroll
            for (int j = 0; j < 8; ++j) xn[j] = xr[64 * j]; }
        asm volatile("" ::: "memory");
        float ss = 0.f;
#pragma unroll
        for (int j = 0; j < 8; ++j) ss += (v[j].x * v[j].x + v[j].y * v[j].y) + (v[j].z * v[j].z + v[j].w * v[j].w);
        const float rstd = rsqrtf(wave_sum_dpp(ss) * (1.0f / D) + 1e-6f);
#pragma unroll
        for (int j = 0; j < 8; ++j) { const f32x4 o = v[j] * rstd * gm[j] + sh[j];
            if (OUT_BF16) { u32x2 w; w.x = pk2(o.x, o.y); w.y = pk2(o.z, o.w); ((u32x2*)((bf16_t*)out + (size_t)r * D))[64 * j + t.lane] = w; }
            else ((f32x4*)((float*)out + (size_t)r * D))[64 * j + t.lane] = o; }
        asm volatile("" ::: "memory");
    }
}

__device__ __forceinline__ void r2_mix(const Tc& t, CArgs a, int jl) {
    const bf16_t* H = (const bf16_t*)(a->ws + WS_ACT + AR_H);
    const int sl = t.gw & 3, c0 = 512 * sl + 8 * t.lane;
    const float* mu = a->in[I_MU] + (size_t)jl * 6 * D + c0;
    f32x4 m0[6], m1[6];
#pragma unroll
    for (int m = 0; m < 6; ++m) { m0[m] = *(const f32x4*)(mu + m * D); m1[m] = *(const f32x4*)(mu + m * D + 4); }
    const int rstep = t.ngw >> 2;
    for (int r0 = t.gw >> 2; r0 < TG; r0 += 4 * rstep) {
        u32x4 hw[4], nw[4];
#pragma unroll
        for (int k = 0; k < 4; ++k) { const int r = r0 + k * rstep; hw[k] = (u32x4){0u, 0u, 0u, 0u}; nw[k] = hw[k];
            if (r < TG) { const int s = r % SROW; int nr;
                if (s < CTXL) nr = sl < 2 ? (s > 0 ? r - 1 : -1) : (s < CTXL - 1 ? r + 1 : -1);
                else { const int i = s - CTXL, gr = i >> 6, gc = i & 63; nr = sl == 0 ? (gc > 0 ? r - 1 : -1) : sl == 1 ? (gc < 63 ? r + 1 : -1) : sl == 2 ? (gr > 0 ? r - 64 : -1) : (gr < 31 ? r + 64 : -1); }
                hw[k] = *(const u32x4*)(H + (size_t)r * D + c0);
                if (nr >= 0) nw[k] = *(const u32x4*)(H + (size_t)nr * D + c0); } }
        asm volatile("" ::: "memory");
#pragma unroll
        for (int k = 0; k < 4; ++k) { const int r = r0 + k * rstep;
            if (r < TG) {
                const f32x4 h0 = {lo_bf(hw[k].x), hi_bf(hw[k].x), lo_bf(hw[k].y), hi_bf(hw[k].y)}, h1 = {lo_bf(hw[k].z), hi_bf(hw[k].z), lo_bf(hw[k].w), hi_bf(hw[k].w)};
                const f32x4 n0 = {lo_bf(nw[k].x), hi_bf(nw[k].x), lo_bf(nw[k].y), hi_bf(nw[k].y)}, n1 = {lo_bf(nw[k].z), hi_bf(nw[k].z), lo_bf(nw[k].w), hi_bf(nw[k].w)};
                const f32x4 x0 = n0 - h0, x1 = n1 - h1;
#pragma unroll
                for (int m = 0; m < 6; ++m) { const f32x4 o0 = h0 + x0 * m0[m], o1 = h1 + x1 * m1[m];
                    u32x4 w; w.x = pk2(o0.x, o0.y); w.y = pk2(o0.z, o0.w); w.z = pk2(o1.x, o1.y); w.w = pk2(o1.z, o1.w);
                    *(u32x4*)(a->ws + WS_ACT + AR_MIX + (size_t)m * SLOT + ((size_t)r * D + c0) * 2) = w; } } }
        asm volatile("" ::: "memory");
    }
}

constexpr int R5_L = 16;
constexpr int R5_ZR = 0, R5_BK = 4608, R5_BKT = 9216, R5_V = 14336, R5_GL = 18432, R5_CH = 18688;
constexpr int R5_BUF = 2 * R5_CH;
constexpr int R5_GR = 2 * R5_BUF;
constexpr int R5_GRCH = 3072;
constexpr int R5_DS = R5_GR + 2 * R5_GRCH;
constexpr int R5_YS = R5_DS + 8 * 1024;
constexpr int R5_PW = R5_YS + 2 * 2 * 4096;
constexpr int R5_END = R5_PW + 4 * 8192 + 512;
static_assert(R5_END <= LDSCTL_OFF, "scan LDS");
__device__ __forceinline__ int r5_seq(int z, int tt) { return z == 0 ? tt : (tt < CTXL ? CTXL - 1 - tt : SROW + CTXL - 1 - tt); }

__device__ __forceinline__ void r5_scan(const Tc& t, CArgs a, int jl, int layer, int g) {
    const bf16_t* R = (const bf16_t*)(a->ws + WS_ACT + AR_R);
    const bf16_t* Kb = (const bf16_t*)(a->ws + WS_ACT + AR_K);
    const bf16_t* Vb = (layer == 0) ? (const bf16_t*)(a->ws + WS_VF) + (size_t)g * TG * D : (const bf16_t*)(a->ws + WS_ACT + AR_V);
    const int w = t.wave, lane = t.lane, c2 = w >> 2, q = w & 3, l15 = lane & 15, q4 = lane >> 4;
    for (int pair = t.bid; pair < BG * RH; pair += t.G) {
        const int z = pair / (BG * RH / 2), bl = (pair / (RH / 2)) % BG, h = 2 * (pair % (RH / 2)) + c2;
        const bf16_t* E = (const bf16_t*)(a->ws + WS_ACT + AR_MIX + (size_t)z * SLOT);
        const bf16_t* Aa = (const bf16_t*)(a->ws + WS_ACT + AR_MIX + (size_t)(2 + z) * SLOT);
        bf16_t* Y = (bf16_t*)(a->ws + WS_ACT + AR_Y + (size_t)z * SLOT);
        float* RKo = (float*)(a->ws + WS_ACT + AR_RK) + (size_t)z * TG * 32;
        const size_t colb = (size_t)h * 64 + lane;
        f32x4 ST[4];
#pragma unroll
        for (int cb = 0; cb < 4; ++cb) ST[cb] = (f32x4){0.f, 0.f, 0.f, 0.f};
        const int pst = q == 0 ? 0 : 6 * (q - 1), npass = q == 0 ? 0 : (q == 3 ? 2 : 3);
        const int hf = lane >> 5, pi = lane & 31;
        unsigned ce[8], pr[3], pk[3], pv[3], pa[3];
        const int sd = z == 0 ? 1 : -1;
        const bf16_t* Eh = E + (size_t)bl * SROW * D + (size_t)h * 64; const bf16_t* Rh = R + (size_t)bl * SROW * D + (size_t)h * 64; const bf16_t* Kh = Kb + (size_t)bl * SROW * D + (size_t)h * 64;
        const bf16_t* Vh = Vb + (size_t)bl * SROW * D + (size_t)h * 64; const bf16_t* Ah = Aa + (size_t)bl * SROW * D + (size_t)h * 64;
        f32x2 kkc2, kac2, rkc2;
        { const size_t c0 = (size_t)jl * D + (size_t)h * 64 + 2 * pi; kkc2 = *(const f32x2*)(a->in[I_KK] + c0); kac2 = *(const f32x2*)(a->in[I_KA] + c0); rkc2 = *(const f32x2*)(a->in[I_RK] + c0); }
        auto prep_load = [&](int n) {
            if (q == 0) return;
            const int s0 = r5_seq(z, n * R5_L); const unsigned rlo = (unsigned)(sd > 0 ? s0 : s0 - 15) * (unsigned)D;
#pragma unroll
            for (int ps = 0; ps < 3; ++ps) if (ps < npass) { const int st = pst + 2 * ps + hf; const unsigned off = rlo + (unsigned)((sd > 0 ? st : 15 - st) * D) + 2u * (unsigned)pi;
                pr[ps] = *(const unsigned*)(Rh + off); pk[ps] = *(const unsigned*)(Kh + off); pv[ps] = *(const unsigned*)(Vh + off); pa[ps] = *(const unsigned*)(Ah + off); }
        };
        auto halfsum = [&](float v) -> float { v = sum16_(v); const float h0 = rl_(v, 0) + rl_(v, 16), h1 = rl_(v, 32) + rl_(v, 48); return hf ? h1 : h0; };
        auto prep_finish = [&](int n) {
            if (q == 0) return;
            LAS unsigned char* cbuf = t.lds + (n & 1) * R5_BUF + c2 * R5_CH;
            LAS bf16_t* ZR = (LAS bf16_t*)(cbuf + R5_ZR); LAS bf16_t* BK = (LAS bf16_t*)(cbuf + R5_BK); LAS bf16_t* BKT = (LAS bf16_t*)(cbuf + R5_BKT);
            LAS float* Vs = (LAS float*)(cbuf + R5_V); LAS float* GL = (LAS float*)(cbuf + R5_GL);
            const LAS f32x2* GT = (const LAS f32x2*)(t.lds + R5_PW + ((n & 1) * 2 + c2) * 8192);
            const LAS f32x2* GI = GT + 512;
            if (q == 3 && hf == 0) *(LAS f32x2*)(GL + 2 * pi) = GT[15 * 32 + pi];
            const int s0 = r5_seq(z, n * R5_L); float rkv[3] = {0.f, 0.f, 0.f};
#pragma unroll
            for (int ps = 0; ps < 3; ++ps) if (ps < npass) { const int st = pst + 2 * ps + hf;
                const f32x2 gt = GT[st * 32 + pi]; const f32x2 gi = {__builtin_amdgcn_rcpf(gt.x), __builtin_amdgcn_rcpf(gt.y)}; f32x2 gp = {1.f, 1.f}; if (st > 0) gp = GT[(st - 1) * 32 + pi];
                const f32x2 r2 = {lo_bf(pr[ps]), hi_bf(pr[ps])}, k2 = {lo_bf(pk[ps]), hi_bf(pk[ps])}, v2 = {lo_bf(pv[ps]), hi_bf(pv[ps])}, a2 = {lo_bf(pa[ps]), hi_bf(pa[ps])};
                f32x2 kk2 = k2 * kkc2; const float n2 = halfsum(kk2.x * kk2.x + kk2.y * kk2.y); kk2 = kk2 * __builtin_amdgcn_rsqf(fmaxf(n2, 1e-24f));
                const f32x2 km2 = k2 * ((a2 - 1.0f) * kac2 + 1.0f);
                const f32x2 rkm = r2 * km2 * rkc2; const float rk = halfsum(rkm.x + rkm.y);
                rkv[ps] = rk;
                const f32x2 zt = kk2 * gp * -1.0f, rt = r2 * gt, bt = kk2 * a2 * gi, kt = km2 * gi;
                const unsigned zw = pk2(zt.x, zt.y), rw = pk2(rt.x, rt.y), bw = pk2(bt.x, bt.y), kw = pk2(kt.x, kt.y);
                *(LAS unsigned*)(ZR + st * 72 + 2 * pi) = zw; *(LAS unsigned*)(ZR + (16 + st) * 72 + 2 * pi) = rw; *(LAS unsigned*)(BK + st * 72 + 2 * pi) = bw; *(LAS unsigned*)(BK + (16 + st) * 72 + 2 * pi) = kw;
                BKT[(2 * pi) * 40 + st] = (bf16_t)(bw & 0xffffu); BKT[(2 * pi + 1) * 40 + st] = (bf16_t)(bw >> 16);
                BKT[(2 * pi) * 40 + 16 + st] = (bf16_t)(kw & 0xffffu); BKT[(2 * pi + 1) * 40 + 16 + st] = (bf16_t)(kw >> 16);
                *(LAS f32x2*)(Vs + st * 64 + 2 * pi) = v2; }
            if (pi == 0) {
#pragma unroll
                for (int ps = 0; ps < 3; ++ps) if (ps < npass) RKo[((size_t)bl * SROW + s0 + sd * (pst + 2 * ps + hf)) * 32 + h] = rkv[ps]; }
        };
        auto cum_load = [&](int m) {
            const int s0 = r5_seq(z, m * R5_L); const unsigned rlo = (unsigned)(sd > 0 ? s0 : s0 - 15) * (unsigned)D;
#pragma unroll
            for (int j = 0; j < 8; ++j) { const int i = 8 * hf + j; ce[j] = *(const unsigned*)(Eh + rlo + (unsigned)((sd > 0 ? i : 15 - i) * D) + 2u * (unsigned)pi); }
        };
        auto cum_finish = [&](int m) {
            LAS f32x2* GT = (LAS f32x2*)(t.lds + R5_PW + ((m & 1) * 2 + c2) * 8192); LAS f32x2* GI = GT + 512;
            LAS f32x2* HB = (LAS f32x2*)(t.lds + R5_PW + 4 * 8192 + c2 * 256);
            f32x2 cs[8]; f32x2 lg = {0.f, 0.f};
#pragma unroll
            for (int j = 0; j < 8; ++j) { lg = lg + (f32x2){lo_bf(ce[j]), hi_bf(ce[j])}; cs[j] = lg; }
            if (hf == 0) HB[pi] = lg;
            asm volatile("s_waitcnt lgkmcnt(0)" ::: "memory");
            f32x2 base = HB[pi]; if (hf == 0) base = (f32x2){0.f, 0.f};
#pragma unroll
            for (int j = 0; j < 8; ++j) { const f32x2 c = cs[j] + base;
                GT[(8 * hf + j) * 32 + pi] = (f32x2){__expf(c.x), __expf(c.y)}; }
        };
        constexpr int NCH = SROW / R5_L;
        if (q == 0) { cum_load(0); cum_finish(0); cum_load(1); cum_finish(1); cum_load(2); } else prep_load(0);
        LDS_BARRIER();
        prep_finish(0); prep_load(1);
        LDS_BARRIER();
        for (int n = 0; n < NCH; ++n) {
            LAS unsigned char* cbuf = t.lds + (n & 1) * R5_BUF + c2 * R5_CH;
            const LAS bf16_t* ZR = (const LAS bf16_t*)(cbuf + R5_ZR); const LAS bf16_t* BK = (const LAS bf16_t*)(cbuf + R5_BK); const LAS bf16_t* BKT = (const LAS bf16_t*)(cbuf + R5_BKT);
            const LAS float* Vs = (const LAS float*)(cbuf + R5_V); const LAS float* GL = (const LAS float*)(cbuf + R5_GL);
            LAS float* Nm = (LAS float*)(t.lds + R5_GR + c2 * R5_GRCH); LAS bf16_t* MKZ = (LAS bf16_t*)(t.lds + R5_GR + c2 * R5_GRCH + 1024); LAS bf16_t* MBK = (LAS bf16_t*)(t.lds + R5_GR + c2 * R5_GRCH + 1536);
            LAS bf16_t* MT = (LAS bf16_t*)(t.lds + R5_GR + c2 * R5_GRCH + 2560);
            { f32x4 gacc = (f32x4){0.f, 0.f, 0.f, 0.f};
#pragma unroll
              for (int ks = 0; ks < 2; ++ks) { const bf16x8 av = *(const LAS bf16x8*)(ZR + ((q & 2) ? 16 + l15 : l15) * 72 + 32 * ks + 8 * q4);
                  const bf16x8 bv = *(const LAS bf16x8*)(BK + ((q & 1) ? 16 + l15 : l15) * 72 + 32 * ks + 8 * q4);
                  gacc = __builtin_amdgcn_mfma_f32_16x16x32_bf16(av, bv, gacc, 0, 0, 0); }
#pragma unroll
              for (int i = 0; i < 4; ++i) { const int tt = 4 * q4 + i, j = l15; const bool keep = (q & 2) ? (j <= tt) : (j < tt); const float val = keep ? gacc[i] : 0.f;
                  if (q == 0) Nm[tt * 16 + j] = val; else if (q == 1) MKZ[tt * 16 + j] = (bf16_t)f2bf(val); else MBK[tt * 32 + (q == 3 ? 16 : 0) + j] = (bf16_t)f2bf(val); }
              if (q == 0) {
                  asm volatile("s_waitcnt lgkmcnt(0)" ::: "memory");
                  float tc[16];
                  tc[0] = (l15 == 0) ? 1.0f : 0.0f;
                  f32x4 nA[12], nB[12];
#define R5_SLOT_A(i, jb) ((i) <= 4 ? (i) - 1 : 4 + 2 * ((i) - 5) + (jb))
#pragma unroll
                  for (int i = 1; i <= 8; ++i)
#pragma unroll
                      for (int jb = 0; 4 * jb < i; ++jb) nA[R5_SLOT_A(i, jb)] = *(const LAS f32x4*)(Nm + i * 16 + 4 * jb);
#pragma unroll
                  for (int i = 9; i <= 12; ++i)
#pragma unroll
                      for (int jb = 0; jb < 3; ++jb) nB[(i - 9) * 3 + jb] = *(const LAS f32x4*)(Nm + i * 16 + 4 * jb);
                  asm volatile("" ::: "memory");
#pragma unroll
                  for (int i = 1; i <= 8; ++i) { float s = (l15 == i) ? 1.0f : 0.0f;
#pragma unroll
                      for (int jb = 0; 4 * jb < i; ++jb) { const f32x4 nv = nA[R5_SLOT_A(i, jb)];
#pragma unroll
                          for (int j = 0; j < 4; ++j) if (4 * jb + j < i) s += nv[j] * tc[4 * jb + j]; }
                      tc[i] = s; }
#pragma unroll
                  for (int i = 13; i <= 15; ++i)
#pragma unroll
                      for (int jb = 0; jb < 4; ++jb) nA[(i - 13) * 4 + jb] = *(const LAS f32x4*)(Nm + i * 16 + 4 * jb);
                  asm volatile("" ::: "memory");
#pragma unroll
                  for (int i = 9; i <= 12; ++i) { float s = (l15 == i) ? 1.0f : 0.0f;
#pragma unroll
                      for (int jb = 0; jb < 3; ++jb) { const f32x4 nv = nB[(i - 9) * 3 + jb];
#pragma unroll
                          for (int j = 0; j < 4; ++j) if (4 * jb + j < i) s += nv[j] * tc[4 * jb + j]; }
                      tc[i] = s; }
#pragma unroll
                  for (int i = 13; i <= 15; ++i) { float s = (l15 == i) ? 1.0f : 0.0f;
#pragma unroll
                      for (int jb = 0; jb < 4; ++jb) { const f32x4 nv = nA[(i - 13) * 4 + jb];
#pragma unroll
                          for (int j = 0; j < 4; ++j) if (4 * jb + j < i) s += nv[j] * tc[4 * jb + j]; }
                      tc[i] = s; }
#undef R5_SLOT_A
#pragma unroll
                  for (int i = 0; i < 4; ++i) { const float v = q4 == 0 ? tc[i] : q4 == 1 ? tc[4 + i] : q4 == 2 ? tc[8 + i] : tc[12 + i];
                      MT[(4 * q4 + i) * 16 + l15] = (bf16_t)f2bf(v); } } }
            if (n + 1 < NCH) prep_finish(n + 1);
            if (n + 2 < NCH) prep_load(n + 2);
            if (q == 0) {
                if (n + 2 < NCH) cum_finish(n + 2);
                if (n + 3 < NCH) cum_load(n + 3); }
            if (q == 3) {
                if (n > 0) { const LAS float* ys = (const LAS float*)(t.lds + R5_YS + ((n - 1) & 1) * 8192 + c2 * 4096);
#pragma unroll
                    for (int tt = 0; tt < 16; ++tt) Y[((size_t)bl * SROW + r5_seq(z, (n - 1) * R5_L) + sd * tt) * D + colb] = (bf16_t)f2bf(ys[tt * 64 + lane]); } }
            LDS_BARRIER();
            {
              f32x4 Pz = (f32x4){0.f, 0.f, 0.f, 0.f}, Pr = Pz;
#pragma unroll
              for (int ks = 0; ks < 2; ++ks) { const f32x4 s0 = ST[2 * ks], s1 = ST[2 * ks + 1];
                  u32x4 p; p.x = pk2(s0[0], s0[1]); p.y = pk2(s0[2], s0[3]); p.z = pk2(s1[0], s1[1]); p.w = pk2(s1[2], s1[3]);
                  const bf16x8 bop = __builtin_bit_cast(bf16x8, p);
                  const LAS bf16_t* zr = ZR + l15 * 72 + 32 * ks + 4 * q4; const LAS bf16_t* rr = ZR + (16 + l15) * 72 + 32 * ks + 4 * q4;
                  const u32x2 z0 = *(const LAS u32x2*)zr, z1 = *(const LAS u32x2*)(zr + 16), r0 = *(const LAS u32x2*)rr, r1 = *(const LAS u32x2*)(rr + 16);
                  Pz = __builtin_amdgcn_mfma_f32_16x16x32_bf16(__builtin_bit_cast(bf16x8, (u32x4){z0.x, z0.y, z1.x, z1.y}), bop, Pz, 0, 0, 0);
                  Pr = __builtin_amdgcn_mfma_f32_16x16x32_bf16(__builtin_bit_cast(bf16x8, (u32x4){r0.x, r0.y, r1.x, r1.y}), bop, Pr, 0, 0, 0); }
              float vd[4];
#pragma unroll
              for (int i = 0; i < 4; ++i) vd[i] = Vs[(4 * q4 + i) * 64 + 16 * q + l15];
              const unsigned vp0 = pk2(vd[0], vd[1]), vp1 = pk2(vd[2], vd[3]);
              { const u32x2 m = *(const LAS u32x2*)(MKZ + l15 * 16 + 4 * q4);
                Pz = __builtin_amdgcn_mfma_f32_16x16x32_bf16(__builtin_bit_cast(bf16x8, (u32x4){m.x, m.y, 0u, 0u}), __builtin_bit_cast(bf16x8, (u32x4){vp0, vp1, 0u, 0u}), Pz, 0, 0, 0); }
              { float x[4];
                { const u32x2 mt = *(const LAS u32x2*)(MT + l15 * 16 + 4 * q4);
                  const f32x4 dv = __builtin_amdgcn_mfma_f32_16x16x32_bf16(__builtin_bit_cast(bf16x8, (u32x4){mt.x, mt.y, 0u, 0u}), __builtin_bit_cast(bf16x8, (u32x4){pk2(Pz[0], Pz[1]), pk2(Pz[2], Pz[3]), 0u, 0u}), (f32x4){0.f, 0.f, 0.f, 0.f}, 0, 0, 0);
                  x[0] = dv[0]; x[1] = dv[1]; x[2] = dv[2]; x[3] = dv[3]; }
                const unsigned dp0 = pk2(x[0], x[1]), dp1 = pk2(x[2], x[3]);
                const bf16x8 bdv = __builtin_bit_cast(bf16x8, (u32x4){dp0, dp1, vp0, vp1});
                { const u32x2 m0 = *(const LAS u32x2*)(MBK + l15 * 32 + 4 * q4), m1 = *(const LAS u32x2*)(MBK + l15 * 32 + 16 + 4 * q4);
                  Pr = __builtin_amdgcn_mfma_f32_16x16x32_bf16(__builtin_bit_cast(bf16x8, (u32x4){m0.x, m0.y, m1.x, m1.y}), bdv, Pr, 0, 0, 0); }
                { LAS float* ys = (LAS float*)(t.lds + R5_YS + (n & 1) * 8192 + c2 * 4096);
#pragma unroll
                  for (int i = 0; i < 4; ++i) ys[(4 * q4 + i) * 64 + 16 * q + l15] = Pr[i]; }
#pragma unroll
                for (int cb = 0; cb < 4; ++cb) { const LAS bf16_t* bt = BKT + (16 * cb + l15) * 40 + 4 * q4;
                    const u32x2 b0 = *(const LAS u32x2*)bt, k0 = *(const LAS u32x2*)(bt + 16);
                    ST[cb] = __builtin_amdgcn_mfma_f32_16x16x32_bf16(__builtin_bit_cast(bf16x8, (u32x4){b0.x, b0.y, k0.x, k0.y}), bdv, ST[cb], 0, 0, 0);
                    const f32x4 gl = *(const LAS f32x4*)(GL + 16 * cb + 4 * q4);
                    ST[cb] = ST[cb] * gl; } } }
            LDS_BARRIER();
        }
        if (q == 3) { const LAS float* ys = (const LAS float*)(t.lds + R5_YS + ((NCH - 1) & 1) * 8192 + c2 * 4096);
#pragma unroll
          for (int tt = 0; tt < 16; ++tt) Y[((size_t)bl * SROW + r5_seq(z, (NCH - 1) * R5_L) + sd * tt) * D + colb] = (bf16_t)f2bf(ys[tt * 64 + lane]); }
        LDS_BARRIER();
    }
}
__device__ __forceinline__ void r6_readout(const Tc& t, CArgs a, int jl, int layer, int g) {
    const bf16_t* Y0 = (const bf16_t*)(a->ws + WS_ACT + AR_Y), *Y1 = (const bf16_t*)(a->ws + WS_ACT + AR_Y + SLOT);
    const float* RK0 = (const float*)(a->ws + WS_ACT + AR_RK), *RK1 = RK0 + (size_t)TG * 32;
    const bf16_t* Vb = (layer == 0) ? (const bf16_t*)(a->ws + WS_VF) + (size_t)g * TG * D : (const bf16_t*)(a->ws + WS_ACT + AR_V);
    const bf16_t* Gb = (const bf16_t*)(a->ws + WS_ACT + AR_MIX + 4 * SLOT);
    bf16_t* Ao = (bf16_t*)(a->ws + WS_ACT + AR_AO) + (size_t)g * TG * D;
    const int sl = t.gw & 3, c0 = 512 * sl + 8 * t.lane, head = c0 >> 6;
    const float* lnw = a->in[I_LNW] + (size_t)jl * D + c0, *lnb = a->in[I_LNB] + (size_t)jl * D + c0;
    const f32x4 lw0 = *(const f32x4*)lnw, lw1 = *(const f32x4*)(lnw + 4), lb0 = *(const f32x4*)lnb, lb1 = *(const f32x4*)(lnb + 4);
    const float lw[8] = {lw0.x, lw0.y, lw0.z, lw0.w, lw1.x, lw1.y, lw1.z, lw1.w}, lb[8] = {lb0.x, lb0.y, lb0.z, lb0.w, lb1.x, lb1.y, lb1.z, lb1.w};
    const int rstep = t.ngw >> 2;
    for (int r0 = t.gw >> 2; r0 < TG; r0 += 2 * rstep) {
        u32x4 y0[2], y1[2], vv[2], gg[2]; float rk[2];
#pragma unroll
        for (int k = 0; k < 2; ++k) { const int r = r0 + k * rstep < TG ? r0 + k * rstep : r0; const size_t off = (size_t)r * D + c0;
            y0[k] = *(const u32x4*)(Y0 + off); y1[k] = *(const u32x4*)(Y1 + off); vv[k] = *(const u32x4*)(Vb + off); gg[k] = *(const u32x4*)(Gb + off);
            rk[k] = RK0[(size_t)r * 32 + head] + RK1[(size_t)r * 32 + head]; }
        asm volatile("" ::: "memory");
#pragma unroll
        for (int k = 0; k < 2; ++k) { const int r = r0 + k * rstep; if (r >= TG) break; const size_t off = (size_t)r * D + c0;
            const unsigned a0[4] = {y0[k].x, y0[k].y, y0[k].z, y0[k].w}, a1[4] = {y1[k].x, y1[k].y, y1[k].z, y1[k].w};
            const unsigned av[4] = {vv[k].x, vv[k].y, vv[k].z, vv[k].w}, ag[4] = {gg[k].x, gg[k].y, gg[k].z, gg[k].w};
            float y[8]; float s = 0.f;
#pragma unroll
            for (int i = 0; i < 4; ++i) { y[2 * i] = lo_bf(a0[i]) + lo_bf(a1[i]); y[2 * i + 1] = hi_bf(a0[i]) + hi_bf(a1[i]); s += y[2 * i] + y[2 * i + 1]; }
            s = sum8_(s);
            const float mean = s * (1.0f / 64.0f);
            float qq = 0.f;
#pragma unroll
            for (int i = 0; i < 8; ++i) { y[i] -= mean; qq += y[i] * y[i]; }
            qq = sum8_(qq);
            const float rstd = rsqrtf(qq * (1.0f / 64.0f) + 64e-5f);
            float o[8];
#pragma unroll
            for (int i = 0; i < 4; ++i) { o[2 * i] = (y[2 * i] * rstd * lw[2 * i] + lb[2 * i] + rk[k] * lo_bf(av[i])) * lo_bf(ag[i]);
                o[2 * i + 1] = (y[2 * i + 1] * rstd * lw[2 * i + 1] + lb[2 * i + 1] + rk[k] * hi_bf(av[i])) * hi_bf(ag[i]); }
            u32x4 w; w.x = pk2(o[0], o[1]); w.y = pk2(o[2], o[3]); w.z = pk2(o[4], o[5]); w.w = pk2(o[6], o[7]);
            *(u32x4*)(Ao + off) = w; }
        asm volatile("" ::: "memory");
    }
}

__device__ __forceinline__ void m3_conv(const Tc& t, CArgs a, int jl) {
    const bf16_t* U = (const bf16_t*)(a->ws + WS_ACT + AM_U);
    bf16_t* QK = (bf16_t*)(a->ws + WS_ACT + AM_QK);
    const int sl = t.gw & 7, c0 = 256 * sl + 4 * t.lane;
    const float* cw = a->in[I_CONVW] + (size_t)jl * 9 * D + c0;
    f32x4 wt[9];
#pragma unroll
    for (int k = 0; k < 9; ++k) wt[k] = *(const f32x4*)(cw + k * D);
    const f32x4 bias = *(const f32x4*)(a->in[I_CONVB] + (size_t)jl * D + c0);
    const float sc = c0 < 1024 ? 0.08838834764831845f : 1.0f;
    for (int row = t.gw >> 3; row < T; row += t.ngw >> 3) { const int s = row % SROW;
        f32x4 acc = bias;
        if (s < CTXL) {
#pragma unroll
            for (int dc = -1; dc <= 1; ++dc) if (s + dc >= 0 && s + dc < CTXL) { const u32x2 u = *(const u32x2*)(U + (size_t)(row + dc) * ULD + c0); const f32x4 w = wt[3 + dc + 1];
                acc.x += lo_bf(u.x) * w.x; acc.y += hi_bf(u.x) * w.y; acc.z += lo_bf(u.y) * w.z; acc.w += hi_bf(u.y) * w.w; }
        } else { const int i = s - CTXL, gr = i >> 6, gc = i & 63;
            u32x2 u[9];
#pragma unroll
            for (int dr = -1; dr <= 1; ++dr)
#pragma unroll
                for (int dc = -1; dc <= 1; ++dc) { const bool ok = (gr + dr >= 0) && (gr + dr < 32) && (gc + dc >= 0) && (gc + dc < 64);
                    u[(dr + 1) * 3 + dc + 1] = ok ? *(const u32x2*)(U + (size_t)(row + dr * 64 + dc) * ULD + c0) : (u32x2){0u, 0u}; }
#pragma unroll
            for (int k = 0; k < 9; ++k) { acc.x += lo_bf(u[k].x) * wt[k].x; acc.y += hi_bf(u[k].x) * wt[k].y; acc.z += lo_bf(u[k].y) * wt[k].z; acc.w += hi_bf(u[k].y) * wt[k].w; }
        }
        u32x2 w; w.x = pk2(siluf_(acc.x) * sc, siluf_(acc.y) * sc); w.y = pk2(siluf_(acc.z) * sc, siluf_(acc.w) * sc);
        *(u32x2*)(QK + (size_t)row * D + c0) = w;
    }
}

template <int CTRL> __device__ __forceinline__ float dppz_(float v) { return __int_as_float(__builtin_amdgcn_update_dpp(0, __float_as_int(v), CTRL, 0xF, 0xF, false)); }
template <int CTRL> __device__ __forceinline__ float dppm_(float v) { return __int_as_float(__builtin_amdgcn_update_dpp((int)0xff800000u, __float_as_int(v), CTRL, 0xF, 0xF, false)); }
constexpr int M4_QS = 136, M4_TS = 72;
constexpr int M4_SQ = 0, M4_SK = 17408, M4_SVT = 34816, M4_SWKT = 71680, M4_SP = 90112, M4_F = 99328;
__device__ __forceinline__ void m4_scan(const Tc& t, CArgs a) {
    LAS bf16_t* sQ = (LAS bf16_t*)(t.lds + M4_SQ); LAS bf16_t* sK = (LAS bf16_t*)(t.lds + M4_SK); LAS bf16_t* sVT = (LAS bf16_t*)(t.lds + M4_SVT);
    LAS bf16_t* sWKT = (LAS bf16_t*)(t.lds + M4_SWKT); LAS bf16_t* sP = (LAS bf16_t*)(t.lds + M4_SP);
    LAS float* fI = (LAS float*)(t.lds + M4_F);
    LAS float* fF = fI + 64;
    LAS float* fU = fI + 128;
    LAS float* fG = fI + 192;
    LAS float* fWI = fI + 256;
    LAS float* fEN = fI + 320;
    LAS float* fWS = fI + 384;
    LAS float* fRS = fI + 448;
    LAS float* fQN = fI + 576;
    LAS float* fN = fI + 640;
    LAS float* fSC = fI + 768;
    LAS float* fNP = fI + 832;
    const bf16_t* QK = (const bf16_t*)(a->ws + WS_ACT + AM_QK);
    const bf16_t* U = (const bf16_t*)(a->ws + WS_ACT + AM_U);
    const float* Gt = (const float*)(a->ws + WS_ACT + AM_G);
    const int tid = t.tid, lane = t.lane, w = t.wave, l15 = lane & 15, q4 = lane >> 4;
    for (int chain = t.bid; chain < 2 * NB * MH; chain += t.G) {
        const int z = chain / (NB * MH), b = (chain / MH) % NB, h = chain % MH;
        bf16_t* HZ = (bf16_t*)(a->ws + WS_ACT + (z == 0 ? AM_HB : AM_HZ1));
        f32x4 Cacc[8][2];
#pragma unroll
        for (int db = 0; db < 8; ++db)
#pragma unroll
            for (int e = 0; e < 2; ++e) Cacc[db][e] = (f32x4){0.f, 0.f, 0.f, 0.f};
        float m_old = 0.f;
        if (tid < 128) fN[tid] = 0.f;
        LDS_BARRIER();
        const size_t rowb = (size_t)b * SROW; const int sdir = z == 0 ? 1 : -1;
        u32x4 pq[2], pkk[2], pvv[4]; float pgi = 0.f, pgf = 0.f;
#define M4_LOAD(chn) do { const int t0_ = (chn) * 64; const int sb_ = z == 0 ? t0_ : (t0_ < CTXL ? CTXL - 1 - t0_ : SROW + CTXL - 1 - t0_); \
            _Pragma("unroll") for (int rep = 0; rep < 2; ++rep) { const int cid = tid + 512 * rep, i = cid >> 4, cc = cid & 15; const size_t row = rowb + sb_ + sdir * i; \
                pq[rep] = *(const u32x4*)(QK + row * D + h * MDK + 8 * cc); pkk[rep] = *(const u32x4*)(QK + row * D + 1024 + h * MDK + 8 * cc); } \
            _Pragma("unroll") for (int rep = 0; rep < 4; ++rep) { const int cid = tid + 512 * rep, i = cid & 63, cc = cid >> 6; const size_t row = rowb + sb_ + sdir * i; \
                pvv[rep] = *(const u32x4*)(U + row * ULD + 2048 + h * MDV + 8 * cc); } \
            if (tid < 64) { const size_t row = rowb + sb_ + sdir * tid; pgi = Gt[row * 32 + z * 16 + h]; pgf = Gt[row * 32 + z * 16 + 8 + h]; } } while (0)
        M4_LOAD(0);
        asm volatile("s_waitcnt vmcnt(0)" ::: "memory");
        asm volatile("" : "+v"(pq[0]), "+v"(pq[1]), "+v"(pkk[0]), "+v"(pkk[1]));
        asm volatile("" : "+v"(pvv[0]), "+v"(pvv[1]), "+v"(pvv[2]), "+v"(pvv[3]), "+v"(pgi), "+v"(pgf));
        for (int ch = 0; ch < SROW / 64; ++ch) {
            const int t0 = ch * 64;
            const int sbase = z == 0 ? t0 : (t0 < CTXL ? CTXL - 1 - t0 : SROW + CTXL - 1 - t0);
#pragma unroll
            for (int rep = 0; rep < 2; ++rep) { const int cid = tid + 512 * rep, i = cid >> 4, cc = cid & 15;
                *(LAS u32x4*)(sQ + i * M4_QS + 8 * cc) = pq[rep]; *(LAS u32x4*)(sK + i * M4_QS + 8 * cc) = pkk[rep]; }
#pragma unroll
            for (int rep = 0; rep < 4; ++rep) { const int cid = tid + 512 * rep, i = cid & 63, cc = cid >> 6;
                const unsigned wv[4] = {pvv[rep].x, pvv[rep].y, pvv[rep].z, pvv[rep].w};
#pragma unroll
                for (int jj = 0; jj < 4; ++jj) { sVT[(8 * cc + 2 * jj) * M4_TS + i] = (bf16_t)(wv[jj] & 0xffffu); sVT[(8 * cc + 2 * jj + 1) * M4_TS + i] = (bf16_t)(wv[jj] >> 16); } }
            if (ch > 0 && tid < 128) fN[tid] = fSC[0] * fN[tid] + ((fNP[tid] + fNP[128 + tid]) + (fNP[256 + tid] + fNP[384 + tid]));
            if (tid < 64) { fI[tid] = pgi; fF[tid] = pgf; }
            if (ch + 1 < SROW / 64) M4_LOAD(ch + 1);
            LDS_BARRIER();
            if (w == 0) {
                const float ig = fI[lane], lf = fF[lane];
                float bc = lf;
                bc += dppz_<0x111>(bc); bc += dppz_<0x112>(bc); bc += dppz_<0x114>(bc); bc += dppz_<0x118>(bc);
                { const float t0 = rl_(bc, 15), t1 = rl_(bc, 31), t2 = rl_(bc, 47); bc += (lane >= 16 ? t0 : 0.f) + (lane >= 32 ? t1 : 0.f) + (lane >= 48 ? t2 : 0.f); }
                const float g = ig - bc;
                float pm = g;
                pm = fmaxf(pm, dppm_<0x111>(pm)); pm = fmaxf(pm, dppm_<0x112>(pm)); pm = fmaxf(pm, dppm_<0x114>(pm)); pm = fmaxf(pm, dppm_<0x118>(pm));
                { const float t0 = rl_(pm, 15), t1 = rl_(pm, 31), t2 = rl_(pm, 47); const float ninf = -__builtin_inff();
                  pm = fmaxf(pm, fmaxf(fmaxf(lane >= 16 ? t0 : ninf, lane >= 32 ? t1 : ninf), lane >= 48 ? t2 : ninf)); }
                const float b_end = rl_(bc, 63), pm_all = rl_(pm, 63);
                const float m_new = fmaxf(b_end + m_old, b_end + pm_all);
                const float mx = fmaxf(m_old, pm);
                fU[lane] = -mx; fG[lane] = g; fWI[lane] = __expf(m_old - mx); fEN[lane] = __expf(-mx - bc); fWS[lane] = __expf(b_end + g - m_new);
                if (lane == 0) { fSC[0] = __expf(b_end + m_old - m_new); fSC[1] = m_new; }
            }
            const int tb = w >> 1, jb0 = 2 * (w & 1);
            f32x4 St[2];
#pragma unroll
            for (int jj = 0; jj < 2; ++jj) { St[jj] = (f32x4){0.f, 0.f, 0.f, 0.f};
                if (jb0 + jj <= tb) {
#pragma unroll
                    for (int ks = 0; ks < 4; ++ks) { const bf16x8 av = *(const LAS bf16x8*)(sQ + (16 * tb + l15) * M4_QS + 32 * ks + 8 * q4);
                        const bf16x8 bv = *(const LAS bf16x8*)(sK + (16 * (jb0 + jj) + l15) * M4_QS + 32 * ks + 8 * q4);
                        St[jj] = __builtin_amdgcn_mfma_f32_16x16x32_bf16(av, bv, St[jj], 0, 0, 0); } } }
            LDS_BARRIER();
            { float rs[4] = {0.f, 0.f, 0.f, 0.f};
#pragma unroll
              for (int jj = 0; jj < 2; ++jj) { const int j = 16 * (jb0 + jj) + l15; const float gj = fG[j];
#pragma unroll
                  for (int i = 0; i < 4; ++i) { const int tt = 16 * tb + 4 * q4 + i; const float val = (j <= tt) ? St[jj][i] * __expf(fU[tt] + gj) : 0.f;
                      rs[i] += val; sP[tt * M4_TS + j] = (bf16_t)f2bfa(val); } }
#pragma unroll
              for (int i = 0; i < 4; ++i) { float v = rs[i]; v = sum16_(v);
                  if (l15 == 0) fRS[(w & 1) * 64 + 16 * tb + 4 * q4 + i] = v; } }
            { const int d = tid & 127, jg = tid >> 7; unsigned pk[8]; float nn = 0.f;
#pragma unroll
              for (int jj = 0; jj < 8; ++jj) { const int j0 = 16 * jg + 2 * jj; const float w0 = fWS[j0] * bf2f(sK[j0 * M4_QS + d]), w1 = fWS[j0 + 1] * bf2f(sK[(j0 + 1) * M4_QS + d]);
                  nn += w0 + w1; pk[jj] = pk2a(w0, w1); }
              fNP[jg * 128 + d] = nn;
              *(LAS u32x4*)(sWKT + d * M4_TS + 16 * jg) = (u32x4){pk[0], pk[1], pk[2], pk[3]};
              *(LAS u32x4*)(sWKT + d * M4_TS + 16 * jg + 8) = (u32x4){pk[4], pk[5], pk[6], pk[7]}; }
            { const int tt = tid >> 3, dp = tid & 7; float s = 0.f;
#pragma unroll
              for (int dd = 0; dd < 16; ++dd) s += bf2f(sQ[tt * M4_QS + 16 * dp + dd]) * fN[16 * dp + dd];
              s = sum8_(s);
              if (dp == 0) fQN[tt] = s; }
            LDS_BARRIER();
            asm volatile("s_waitcnt vmcnt(0)" ::: "memory");
            asm volatile("" : "+v"(pq[0]), "+v"(pq[1]), "+v"(pkk[0]), "+v"(pkk[1]));
            asm volatile("" : "+v"(pvv[0]), "+v"(pvv[1]), "+v"(pvv[2]), "+v"(pvv[3]), "+v"(pgi), "+v"(pgf));
#pragma unroll 1
            for (int x = 0; x < 4; ++x) {
                f32x4 acc[2];
                acc[0] = (f32x4){0.f, 0.f, 0.f, 0.f}; acc[1] = (f32x4){0.f, 0.f, 0.f, 0.f};
#pragma unroll
                for (int kb = 0; kb < 4; ++kb) {
                    const LAS bf16_t* qr = sQ + (16 * x + l15) * M4_QS + 32 * kb + 4 * q4;
                    const u32x2 lo = *(const LAS u32x2*)qr, hi = *(const LAS u32x2*)(qr + 16);
                    const bf16x8 aop = __builtin_bit_cast(bf16x8, (u32x4){lo.x, lo.y, hi.x, hi.y});
#pragma unroll
                    for (int e = 0; e < 2; ++e) { const f32x4 c0 = Cacc[2 * kb][e], c1 = Cacc[2 * kb + 1][e];
                        u32x4 p; p.x = pk2a(c0[0], c0[1]); p.y = pk2a(c0[2], c0[3]); p.z = pk2a(c1[0], c1[1]); p.w = pk2a(c1[2], c1[3]);
                        acc[e] = __builtin_amdgcn_mfma_f32_16x16x32_bf16(aop, __builtin_bit_cast(bf16x8, p), acc[e], 0, 0, 0); } }
                { const f32x4 wi = *(const LAS f32x4*)(fWI + 16 * x + 4 * q4); acc[0] = acc[0] * wi; acc[1] = acc[1] * wi; }
#pragma unroll
                for (int ks = 0; ks < 2; ++ks) { const bf16x8 aop = *(const LAS bf16x8*)(sP + (16 * x + l15) * M4_TS + 32 * ks + 8 * q4);
#pragma unroll
                    for (int e = 0; e < 2; ++e) { const bf16x8 bop = *(const LAS bf16x8*)(sVT + (16 * (2 * w + e) + l15) * M4_TS + 32 * ks + 8 * q4);
                        acc[e] = __builtin_amdgcn_mfma_f32_16x16x32_bf16(aop, bop, acc[e], 0, 0, 0); } }
#pragma unroll
                for (int i = 0; i < 4; ++i) { const int tt = 16 * x + 4 * q4 + i;
                    const float den = fWI[tt] * fQN[tt] + fRS[tt] + fRS[64 + tt]; const float dv = __builtin_amdgcn_rcpf(fmaxf(fabsf(den), fEN[tt]));
                    const size_t row = rowb + sbase + sdir * tt;
#pragma unroll
                    for (int e = 0; e < 2; ++e) HZ[row * D + h * MDV + 16 * (2 * w + e) + l15] = (bf16_t)f2bfa(acc[e][i] * dv); }
            }
            { const float dec = fSC[0];
#pragma unroll
              for (int db = 0; db < 8; ++db)
#pragma unroll
                  for (int e = 0; e < 2; ++e) Cacc[db][e] = Cacc[db][e] * dec;
#pragma unroll
              for (int ks = 0; ks < 2; ++ks) {
                  bf16x8 bop[2];
#pragma unroll
                  for (int e = 0; e < 2; ++e) bop[e] = *(const LAS bf16x8*)(sVT + (16 * (2 * w + e) + l15) * M4_TS + 32 * ks + 8 * q4);
#pragma unroll
                  for (int db = 0; db < 8; ++db) { const bf16x8 aop = *(const LAS bf16x8*)(sWKT + (16 * db + l15) * M4_TS + 32 * ks + 8 * q4);
#pragma unroll
                      for (int e = 0; e < 2; ++e) Cacc[db][e] = __builtin_amdgcn_mfma_f32_16x16x32_bf16(aop, bop[e], Cacc[db][e], 0, 0, 0); } }
 }
            m_old = fSC[1];
            LDS_BARRIER();
        }
#undef M4_LOAD
    }
}

__device__ __forceinline__ void m5_readout(const Tc& t, CArgs a, int jl) {
    const bf16_t* H0 = (const bf16_t*)(a->ws + WS_ACT + AM_HB), *H1 = (const bf16_t*)(a->ws + WS_ACT + AM_HZ1);
    const bf16_t* U = (const bf16_t*)(a->ws + WS_ACT + AM_U);
    bf16_t* Ao = (bf16_t*)(a->ws + WS_ACT + AM_QK);
    const int sl = t.gw & 3, c0 = 512 * sl + 8 * t.lane;
    const float* nw = a->in[I_MNORMW] + (size_t)jl * D + c0;
    const f32x4 w0 = *(const f32x4*)nw, w1 = *(const f32x4*)(nw + 4);
    const float w8[8] = {w0.x, w0.y, w0.z, w0.w, w1.x, w1.y, w1.z, w1.w};
    const int rstep = t.ngw >> 2;
    for (int r0 = t.gw >> 2; r0 < T; r0 += 4 * rstep) {
        u32x4 h0[4], h1[4], ov[4];
#pragma unroll
        for (int k = 0; k < 4; ++k) { const int row = r0 + k * rstep < T ? r0 + k * rstep : r0; const size_t off = (size_t)row * D + c0;
            h0[k] = *(const u32x4*)(H0 + off); h1[k] = *(const u32x4*)(H1 + off); ov[k] = *(const u32x4*)(U + (size_t)row * ULD + 4096 + c0); }
        asm volatile("" ::: "memory");
#pragma unroll
        for (int k = 0; k < 4; ++k) { const int row = r0 + k * rstep; if (row >= T) break; const size_t off = (size_t)row * D + c0;
            const unsigned a0[4] = {h0[k].x, h0[k].y, h0[k].z, h0[k].w}, a1[4] = {h1[k].x, h1[k].y, h1[k].z, h1[k].w}, ao[4] = {ov[k].x, ov[k].y, ov[k].z, ov[k].w};
            float y[8]; float s = 0.f;
#pragma unroll
            for (int i = 0; i < 4; ++i) { y[2 * i] = lo_bf(a0[i]) + lo_bf(a1[i]); y[2 * i + 1] = hi_bf(a0[i]) + hi_bf(a1[i]); s += y[2 * i] + y[2 * i + 1]; }
            s = sum16_(s); s += shfl_xor_(s, 16, t.lane);
            const float mean = s * (1.0f / 256.0f);
            float qq = 0.f;
#pragma unroll
            for (int i = 0; i < 8; ++i) { y[i] -= mean; qq += y[i] * y[i]; }
            qq = sum16_(qq); qq += shfl_xor_(qq, 16, t.lane);
            const float rstd = rsqrtf(qq * (1.0f / 256.0f) + 1e-6f);
            float o[8];
#pragma unroll
            for (int i = 0; i < 4; ++i) { o[2 * i] = y[2 * i] * rstd * w8[2 * i] * sigmoidf_(lo_bf(ao[i])); o[2 * i + 1] = y[2 * i + 1] * rstd * w8[2 * i + 1] * sigmoidf_(hi_bf(ao[i])); }
            u32x4 wv; wv.x = pk2(o[0], o[1]); wv.y = pk2(o[2], o[3]); wv.z = pk2(o[4], o[5]); wv.w = pk2(o[6], o[7]);
            *(u32x4*)(Ao + off) = wv; }
        asm volatile("" ::: "memory");
    }
}

__device__ __forceinline__ void final_norm(const Tc& t, CArgs a) {
    const float* xres = (const float*)(a->ws + WS_XRES);
    f32x4 gg[8];
    { const f32x4* gp = (const f32x4*)a->in[I_FINALG] + t.lane;
#pragma unroll
      for (int j = 0; j < 8; ++j) gg[j] = gp[64 * j]; }
    for (int r0 = t.gw; r0 < NB * SEQ; r0 += 2 * t.ngw) {
        f32x4 v[2][8];
#pragma unroll
        for (int k = 0; k < 2; ++k) { const int r = r0 + k * t.ngw < NB * SEQ ? r0 + k * t.ngw : r0; const size_t row = (size_t)(r / SEQ) * SROW + CTXL + (r % SEQ);
            const f32x4* xr = (const f32x4*)(xres + row * D) + t.lane;
#pragma unroll
            for (int j = 0; j < 8; ++j) v[k][j] = xr[64 * j]; }
        asm volatile("" ::: "memory");
#pragma unroll
        for (int k = 0; k < 2; ++k) { const int r = r0 + k * t.ngw; if (r >= NB * SEQ) break;
            float ss = 0.f;
#pragma unroll
            for (int j = 0; j < 8; ++j) ss += (v[k][j].x * v[k][j].x + v[k][j].y * v[k][j].y) + (v[k][j].z * v[k][j].z + v[k][j].w * v[k][j].w);
            const float rstd = rsqrtf(wave_sum_dpp(ss) * (1.0f / D) + 1e-6f);
            f32x4* o = (f32x4*)(a->out + (size_t)r * D) + t.lane;
#pragma unroll
            for (int j = 0; j < 8; ++j) o[64 * j] = v[k][j] * rstd * gg[j]; }
        asm volatile("" ::: "memory");
    }
}
constexpr int NU_FULL = (T / 256) * (D / 256), NU_SKIP = (T / 9 * 8 / 256) * (D / 256);
constexpr int NSEG = 1 + 2 * (12 + 1 + 3) + 2 * (6 + 3) + 1;

__global__ void __launch_bounds__(512, 2) hybrid_fwd(Args args) {
    extern __shared__ __attribute__((aligned(16))) unsigned char lds_raw[];
    LAS unsigned char* const lds = (LAS unsigned char*)lds_raw;
    volatile LAS unsigned* MISC = (volatile LAS unsigned*)(lds + LDSCTL_OFF);
    if (threadIdx.x < 64) MISC[threadIdx.x] = 0u;
    __syncthreads();
    const int lo = args.ph_lo, hi = args.ph_hi;
    const bool fused = (hi - lo) > 1;
    unsigned* barw = (unsigned*)(args.ws + WS_CTL) + 4096;
    XcdBarrier bar; bar.bar = barw; bar.x = 0; bar.st = MISC + 8;
    if (fused) bar = xcd_barrier_post(barw, MISC + 8);
    int seg = 0;
    int urot = 0;
#define ACTIVE (seg >= lo && seg < hi)
#define PH_BEGIN const Tc t = mk_tc(lds); const CArgs a = opaque_args(); unsigned char* const act = a->ws + WS_ACT; (void)act; (void)t;
#define SEAM() do { if (fused && seg >= lo && seg + 1 < hi) xcd_barrier(bar); ++seg; } while (0)

    if (ACTIVE) { PH_BEGIN ph_prologue(t, a); }
    SEAM();
    for (int layer = 0; layer < 4; ++layer) {
        const int jl = layer >> 1;
        if ((layer & 1) == 0) {
            for (int g = 0; g < NGRP; ++g) {
                if (ACTIVE) { PH_BEGIN if (g == 0 && layer == 0) { convert_rwkv(t, a, 0); convert_ffn_in(t, a, 0); }
                    norm_rows<true>(t, a, layer, 0, g * TG, TG, act + AR_H, layer == 0); }
                SEAM();
                if (ACTIVE) { PH_BEGIN r2_mix(t, a, jl); }
                SEAM();
                if (ACTIVE) {
                    PH_BEGIN const bf16_t* wm = (const bf16_t*)(a->ws + WS_WMIX);
                    bf16_t* vdst = (layer == 0) ? (bf16_t*)(a->ws + WS_VF) + (size_t)g * TG * D : (bf16_t*)(act + AR_V);
                    const bf16_t* mix[6];
#pragma unroll
                    for (int m = 0; m < 6; ++m) mix[m] = (const bf16_t*)(act + AR_MIX + (size_t)m * SLOT);
                    for (int q = 0; q < 7; ++q) {
                        if (q == 6 && jl == 0) break;
                        const bf16_t* A = q == 0 ? mix[0] : q == 1 ? mix[2] : q == 2 ? mix[3] : q == 3 ? mix[1] : q == 4 ? mix[4] : q == 5 ? mix[5] : mix[3];
                        const size_t wo = q == 0 ? WM_R : q == 1 ? WM_K : q == 2 ? WM_V : q == 3 ? WM_W1 : q == 4 ? WM_A1 : q == 5 ? WM_G1 : WM_V1;
                        bf16_t* O = q == 0 ? (bf16_t*)(act + AR_R) : q == 1 ? (bf16_t*)(act + AR_K) : q == 2 ? vdst : (bf16_t*)(act + AR_LORA + (size_t)(q - 3) * 9 * MiB);
                        const int N = q < 3 ? D : 256; const int actf = q == 3 ? 1 : q == 5 ? 2 : 0;
                        pg8::EpiStore E{O, N, actf, 0, 0, -1, nullptr, nullptr};
                        run_gemm(t.lds, A, (const bf16_t*)((const char*)wm + wo), TG, N, D, E, urot);
                    }
                }
                SEAM();
                if (ACTIVE) {
                    PH_BEGIN const bf16_t* wm = (const bf16_t*)(a->ws + WS_WMIX);
                    const bf16_t* lora = (const bf16_t*)(act + AR_LORA);
                    for (int q = 0; q < 2; ++q) {
                        pg8::EpiSigAff E{(bf16_t*)(act + AR_MIX + (size_t)(2 * q) * SLOT), (size_t)TG * D, a->in[q == 0 ? I_W0 : I_A0] + (size_t)jl * 2 * D, q == 0 ? -0.6065306597126334f : 1.0f};
                        run_gemm(t.lds, lora + (size_t)q * TG * 256, (const bf16_t*)((const char*)wm + (q == 0 ? WM_W2 : WM_A2)), TG, 2 * D, 256, E, urot);
                    }
                    { pg8::EpiStore E{(bf16_t*)(act + AR_MIX + 4 * SLOT), D, 0, 0, 0, -1, nullptr, nullptr};
                      run_gemm(t.lds, lora + (size_t)2 * TG * 256, (const bf16_t*)((const char*)wm + WM_G2), TG, D, 256, E, urot); }
                    if (jl > 0) { pg8::EpiVmix E{(bf16_t*)(act + AR_V), (const bf16_t*)(a->ws + WS_VF) + (size_t)g * TG * D, a->in[I_V0] + (size_t)(jl - 1) * D};
                      run_gemm(t.lds, lora + (size_t)3 * TG * 256, (const bf16_t*)((const char*)wm + WM_V2), TG, D, 256, E, urot); }
                }
                SEAM();
                if (ACTIVE) { PH_BEGIN r5_scan(t, a, jl, layer, g); }
                SEAM();
                if (ACTIVE) { PH_BEGIN r6_readout(t, a, jl, layer, g); }
                SEAM();
            }
            if (ACTIVE) { PH_BEGIN pg8::EpiResid E{(float*)(a->ws + WS_XRES), (const float*)(a->ws + WS_MOD) + (size_t)layer * 17 * MODLD + 2 * D, 0, layer == 0 ? a->in[I_X] : nullptr, a->in[I_CTX]};
                run_gemm(t.lds, (const bf16_t*)(act + AR_AO), (const bf16_t*)(a->ws + WS_WMIX + WM_O), T, D, D, E, urot);
                { const Tc t2 = mk_tc(lds); const CArgs a2 = opaque_args(); Tc ts; if (tail_crew(t2, urot - NU_FULL, NU_FULL, ts)) { __syncthreads(); convert_ffn_out(ts, a2, layer); } } }
            SEAM();
        } else {
            if (ACTIVE) { PH_BEGIN norm_rows<true>(t, a, layer, 0, 0, T, act + AM_HB); }
            SEAM();
            if (ACTIVE) { PH_BEGIN pg8::EpiStore E{(bf16_t*)(act + AM_U), ULD, 0, 0, 0, 24, (float*)(act + AM_G), a->in[I_BGATE] + (size_t)jl * 32};
                run_gemm(t.lds, (const bf16_t*)(act + AM_HB), (const bf16_t*)(a->ws + WS_WMIX + WM_MIN), T, 6400, D, E, urot); }
            SEAM();
            if (ACTIVE) { PH_BEGIN m3_conv(t, a, jl); }
            SEAM();
            if (ACTIVE) { PH_BEGIN m4_scan(t, a); }
            SEAM();
            if (ACTIVE) { PH_BEGIN m5_readout(t, a, jl); }
            SEAM();
            if (ACTIVE) { PH_BEGIN pg8::EpiResid E{(float*)(a->ws + WS_XRES), (const float*)(a->ws + WS_MOD) + (size_t)layer * 17 * MODLD + 2 * D, 0, nullptr, nullptr};
                if (layer == 3) run_gemm<pg8::EpiResid, true>(t.lds, (const bf16_t*)(act + AM_QK), (const bf16_t*)(a->ws + WS_WMIX + WM_MOUT), T, D, D, E, urot);
                else run_gemm(t.lds, (const bf16_t*)(act + AM_QK), (const bf16_t*)(a->ws + WS_WMIX + WM_MOUT), T, D, D, E, urot);
                { const Tc t2 = mk_tc(lds); const CArgs a2 = opaque_args(); Tc ts; const int nu = layer == 3 ? NU_SKIP : NU_FULL; if (tail_crew(t2, urot - nu, nu, ts)) { __syncthreads(); convert_ffn_out(ts, a2, layer); } } }
            SEAM();
        }
        if (ACTIVE) { PH_BEGIN norm_rows<true>(t, a, layer, 1, 0, T, act + AF_H2); }
        SEAM();
        if (ACTIVE) { PH_BEGIN pg8::EpiSwiglu E{(bf16_t*)(act + AF_U)};
            if (layer == 3) run_gemm<pg8::EpiSwiglu, true>(t.lds, (const bf16_t*)(act + AF_H2), (const bf16_t*)(a->ws + WS_WFFN + WF_IN), T, 2 * DFF, D, E, urot);
            else run_gemm(t.lds, (const bf16_t*)(act + AF_H2), (const bf16_t*)(a->ws + WS_WFFN + WF_IN), T, 2 * DFF, D, E, urot); }
        SEAM();
        if (ACTIVE) { PH_BEGIN pg8::EpiResid E{(float*)(a->ws + WS_XRES), (const float*)(a->ws + WS_MOD) + (size_t)layer * 17 * MODLD + 5 * D, 0, nullptr, nullptr};
            if (layer == 3) run_gemm<pg8::EpiResid, true>(t.lds, (const bf16_t*)(act + AF_U), (const bf16_t*)(a->ws + WS_WFFN + WF_OUT), T, D, DFF, E, urot);
            else run_gemm(t.lds, (const bf16_t*)(act + AF_U), (const bf16_t*)(a->ws + WS_WFFN + WF_OUT), T, D, DFF, E, urot);
            if (layer < 3) { const Tc t2 = mk_tc(lds); const CArgs a2 = opaque_args(); Tc ts; if (tail_crew(t2, urot - NU_FULL, NU_FULL, ts)) { __syncthreads();
                if (layer & 1) convert_rwkv(ts, a2, (layer + 1) >> 1); else convert_mlstm(ts, a2, (layer + 1) >> 1);
                convert_ffn_in(ts, a2, layer + 1); } } }
        SEAM();
    }
    if (ACTIVE) { PH_BEGIN final_norm(t, a); }
#undef ACTIVE
#undef SEAM
#undef PH_BEGIN
}

#ifndef MK_MULTI
#define MK_MULTI 0
#endif
extern "C" void kernel_launch(void* const* d_in, const int* in_sizes, int n_in, void* d_out, int out_size, void* d_ws, size_t ws_size, hipStream_t stream) {
    static int grid = 0;
    if (grid == 0) {
        if (n_in != NIN || ws_size < WS_END) { fprintf(stderr, "kernel_launch: unexpected n_in %d / ws %zu\n", n_in, ws_size); grid = -1; return; }
        int dev = 0, cus = 0, per_cu = 0;
        if (hipGetDevice(&dev) != hipSuccess || hipDeviceGetAttribute(&cus, hipDeviceAttributeMultiprocessorCount, dev) != hipSuccess) { grid = -1; return; }
        if (hipFuncSetAttribute((const void*)hybrid_fwd, hipFuncAttributeMaxDynamicSharedMemorySize, LDS_BYTES) != hipSuccess) { fprintf(stderr, "kernel_launch: hipFuncSetAttribute failed\n"); grid = -1; return; }
        if (hipOccupancyMaxActiveBlocksPerMultiprocessor(&per_cu, (const void*)hybrid_fwd, 512, LDS_BYTES) != hipSuccess || per_cu < 1)
            fprintf(stderr, "kernel_launch: occupancy query reports %d workgroups per CU\n", per_cu);
        (void)hipGetLastError();
        grid = cus;
    }
    if (grid < 0) return;
    if (hipMemsetAsync((char*)d_ws + WS_CTL, 0, CTL_ZERO_BYTES, stream) != hipSuccess) return;
    Args a{};
    for (int i = 0; i < NIN; ++i) a.in[i] = (const float*)d_in[i];
    a.out = (float*)d_out; a.ws = (unsigned char*)d_ws;
#if MK_MULTI
    for (int s = 0; s < NSEG; ++s) { a.ph_lo = s; a.ph_hi = s + 1; hipLaunchKernelGGL(hybrid_fwd, dim3(grid), dim3(512), LDS_BYTES, stream, a); }
#else
    a.ph_lo = 0; a.ph_hi = NSEG;
    hipLaunchKernelGGL(hybrid_fwd, dim3(grid), dim3(512), LDS_BYTES, stream, a);
#endif
}
```

```cpp
#include <hip/hip_runtime.h>
#include <cstdio>
#include <cstdint>

#define LAS __attribute__((address_space(3)))
#define GAS __attribute__((address_space(1)))
typedef unsigned short bf16_t;
typedef short bf16x8 __attribute__((ext_vector_type(8)));
typedef short bf16x4 __attribute__((ext_vector_type(4)));
typedef float f32x4 __attribute__((ext_vector_type(4)));
typedef float f32x2 __attribute__((ext_vector_type(2)));
typedef unsigned u32x4 __attribute__((ext_vector_type(4)));
typedef unsigned u32x2 __attribute__((ext_vector_type(2)));
#define LDS_WAIT() asm volatile("s_waitcnt lgkmcnt(0)" ::: "memory")
#define LDS_BARRIER() asm volatile("s_waitcnt lgkmcnt(0)\n\ts_barrier" ::: "memory")
#define VM_WAIT() asm volatile("s_waitcnt vmcnt(0)" ::: "memory")

constexpr int D = 2048, NB = 16, SEQ = 2048, CTXL = 256, SROW = 2304, T = NB * SROW;
constexpr int NGRP = 2, BG = 8, TG = BG * SROW;
constexpr int DFF = 5632;
constexpr int RH = 32;
constexpr int MH = 8, MDV = 256, MDK = 128, MPROJ = 6176, ULD = 6144;
constexpr int MODLD = 6 * D;
constexpr int NIN = 37;
enum { I_X = 0, I_C, I_CTX, I_CCTX, I_MODW, I_MODB, I_NORMG, I_FINALG, I_MU, I_WR, I_WK, I_WV, I_WO, I_W0, I_W1, I_W2, I_A0, I_A1, I_A2, I_G1, I_G2, I_KK, I_KA, I_RK, I_LNW, I_LNB,
       I_V0, I_V1, I_V2, I_MWIN, I_BGATE, I_CONVW, I_CONVB, I_MNORMW, I_MWOUT, I_FWIN, I_FWOUT };

constexpr size_t MiB = 1u << 20;
constexpr size_t WS_CTL = 0, CTL_ZERO_BYTES = 1 * MiB;
constexpr size_t WS_MOD = 1 * MiB;
constexpr size_t WS_XRES = 5 * MiB;
constexpr size_t WS_VF = 293 * MiB;
constexpr size_t WS_WMIX = 437 * MiB;
constexpr size_t WS_WFFN = 479 * MiB;
constexpr size_t WS_ACT = 545 * MiB;
constexpr size_t WS_END = WS_ACT + 977 * MiB;
static_assert(WS_END <= (size_t)1536 * MiB, "ws");
constexpr size_t WM_R = 0, WM_K = 8 * MiB, WM_V = 16 * MiB, WM_O = 24 * MiB, WM_W1 = 32 * MiB, WM_A1 = 33 * MiB, WM_G1 = 34 * MiB, WM_V1 = 35 * MiB,
                 WM_W2 = 36 * MiB, WM_A2 = 38 * MiB, WM_G2 = 40 * MiB, WM_V2 = 41 * MiB;
constexpr size_t WM_MIN = 0, WM_MOUT = 25 * MiB;
constexpr size_t WF_IN = 0, WF_OUT = 44 * MiB;
constexpr size_t SLOT = 72 * MiB;
constexpr size_t AR_MIX = 0;
constexpr size_t AR_H = 432 * MiB;
constexpr size_t AR_R = 432 * MiB, AR_K = 504 * MiB, AR_V = 576 * MiB;
constexpr size_t AR_LORA = 648 * MiB;
constexpr size_t AR_Y = 684 * MiB;
constexpr size_t AR_RK = 828 * MiB;
constexpr size_t AR_AO = 833 * MiB;
constexpr size_t AM_HB = 0, AM_U = 144 * MiB, AM_QK = 576 * MiB, AM_HZ1 = 720 * MiB, AM_G = 864 * MiB;
constexpr size_t AF_H2 = 0, AF_U = 144 * MiB;

constexpr int LDS_BYTES = 147456;
constexpr int LDSCTL_OFF = LDS_BYTES - 256;

__device__ __forceinline__ float bf2f(bf16_t b) { return __uint_as_float(((unsigned)b) << 16); }
typedef __bf16 bf16x2n_t __attribute__((ext_vector_type(2)));
__device__ __forceinline__ unsigned pk2(float lo, float hi) { const f32x2 v = {lo, hi}; return __builtin_bit_cast(unsigned, __builtin_convertvector(v, bf16x2n_t)); }
__device__ __forceinline__ unsigned f2bf(float f) { return pk2(f, f) & 0xffffu; }
__device__ __forceinline__ unsigned pk2a(float lo, float hi) { unsigned r; asm("v_cvt_pk_bf16_f32 %0, %1, %2" : "=v"(r) : "v"(lo), "v"(hi)); return r; }
__device__ __forceinline__ unsigned f2bfa(float f) { return pk2a(f, f) & 0xffffu; }
__device__ __forceinline__ float lo_bf(unsigned w) { return __uint_as_float(w << 16); }
__device__ __forceinline__ float hi_bf(unsigned w) { return __uint_as_float(w & 0xffff0000u); }
__device__ __forceinline__ float sigmoidf_(float x) { return __builtin_amdgcn_rcpf(1.0f + __expf(-x)); }
__device__ __forceinline__ float tanhf_(float x) { return 1.0f - 2.0f * __builtin_amdgcn_rcpf(1.0f + __expf(2.0f * x)); }
__device__ __forceinline__ float siluf_(float x) { return x * __builtin_amdgcn_rcpf(1.0f + __expf(-x)); }
template <int CTRL> __device__ __forceinline__ float dpp_(float v) { return __int_as_float(__builtin_amdgcn_update_dpp(0, __float_as_int(v), CTRL, 0xF, 0xF, true)); }
__device__ __forceinline__ float rl_(float v, int k) { return __int_as_float(__builtin_amdgcn_readlane(__float_as_int(v), k)); }
__device__ __forceinline__ float sum8_(float v) { v += dpp_<0xB1>(v); v += dpp_<0x4E>(v); v += dpp_<0x141>(v); return v; }
__device__ __forceinline__ float sum16_(float v) { v = sum8_(v); v += dpp_<0x140>(v); return v; }
__device__ __forceinline__ float wave_sum_dpp(float v) { v = sum16_(v); return (rl_(v, 0) + rl_(v, 16)) + (rl_(v, 32) + rl_(v, 48)); }
__device__ __forceinline__ float wave_sum(float v) { return wave_sum_dpp(v); }
__device__ __forceinline__ float shfl_xor_(float v, int mask, int lane) { return __int_as_float(__builtin_amdgcn_ds_bpermute((lane ^ mask) << 2, __float_as_int(v))); }

#define XB_TMO      128
#define XB_XCNT(j)  (256  + 64 * (j))
#define XB_XSUB(j)  (1280 + 64 * (j))
#define XB_XGEN(j)  (2304 + 64 * (j))
#define XB_TOP      3328
#define XB_TOPGEN   3392
#define XCD_BAR_WORDS 3456
#define XB_SPIN_CAP (1u << 24)

__device__ __forceinline__ unsigned xb_ld(unsigned* p)              { return __hip_atomic_load(p, __ATOMIC_RELAXED, __HIP_MEMORY_SCOPE_AGENT); }
__device__ __forceinline__ unsigned xb_add(unsigned* p, unsigned v) { return __hip_atomic_fetch_add(p, v, __ATOMIC_RELAXED, __HIP_MEMORY_SCOPE_AGENT); }
__device__ __forceinline__ unsigned xb_xcc_id() { return (unsigned)__builtin_amdgcn_s_getreg((3 << 11) | 20) & 0xFu; }
#define XB_SPIN(cond, bar) do { unsigned _sp = 0; while (cond) { __builtin_amdgcn_s_sleep(1); \
    if ((++_sp & 255u) == 0u) { if (xb_ld(&(bar)[XB_TMO])) break; if (_sp > XB_SPIN_CAP) { atomicAdd(&(bar)[XB_TMO], 1u); break; } } } } while (0)

struct XcdBarrier { unsigned* bar; unsigned x; volatile LAS unsigned* st; };

__device__ __forceinline__ XcdBarrier xcd_barrier_post(unsigned* bar, volatile LAS unsigned* st) {
    XcdBarrier b; b.bar = bar; b.x = xb_xcc_id(); b.st = st;
    if (threadIdx.x == 0) (void)xb_add(&bar[XB_XCNT(b.x)], 1u);
    return b;
}
__device__ __forceinline__ void xcd_barrier_complete(unsigned* bar, unsigned x, unsigned& nloc, unsigned& nx) {
    const unsigned G = gridDim.x * gridDim.y * gridDim.z;
    unsigned sum, cnt, mine, sp = 0u;
    for (;;) {
        sum = 0u; cnt = 0u; mine = 0u;
#pragma unroll
        for (unsigned j = 0; j < 16; ++j) { const unsigned c = xb_ld(&bar[XB_XCNT(j)]); sum += c; cnt += (c > 0u) ? 1u : 0u; mine = (j == x) ? c : mine; }
        if (sum == G) break;
        __builtin_amdgcn_s_sleep(1);
        if ((++sp & 255u) == 0u) { if (xb_ld(&bar[XB_TMO])) break; if (sp > XB_SPIN_CAP) { atomicAdd(&bar[XB_TMO], 1u); break; } }
    }
    nloc = mine > 0u ? mine : 1u; nx = cnt > 0u ? cnt : 1u;
}
__device__ __forceinline__ void xcd_barrier(const XcdBarrier& b) {
    asm volatile("s_waitcnt vmcnt(0)" ::: "memory");
    __syncthreads();
    if (threadIdx.x == 0) {
        unsigned* bar = b.bar;
        __builtin_amdgcn_s_waitcnt(0);
        unsigned nloc = b.st[0], nx = b.st[1];
        if (nloc == 0u) { xcd_barrier_complete(bar, b.x, nloc, nx); b.st[0] = nloc; b.st[1] = nx; }
        const unsigned old = xb_add(&bar[XB_XSUB(b.x)], 1u);
        const unsigned gen = old / nloc;
        if (old + 1u == (gen + 1u) * nloc) {
            __builtin_amdgcn_fence(__ATOMIC_RELEASE, "agent");
            asm volatile("s_waitcnt vmcnt(0)" ::: "memory");
            const unsigned og = xb_add(&bar[XB_TOP], 1u);
            const unsigned tg = og / nx;
            if (og + 1u == (tg + 1u) * nx) xb_add(&bar[XB_TOPGEN], 1u);
            else XB_SPIN(xb_ld(&bar[XB_TOPGEN]) == tg, bar);
            __builtin_amdgcn_fence(__ATOMIC_ACQUIRE, "agent");
            xb_add(&bar[XB_XGEN(b.x)], 1u);
            asm volatile("s_waitcnt vmcnt(0)" ::: "memory");
        } else {
            XB_SPIN(xb_ld(&bar[XB_XGEN(b.x)]) == gen, bar);
            __builtin_amdgcn_fence(__ATOMIC_ACQUIRE, "agent");
            asm volatile("s_waitcnt vmcnt(0)" ::: "memory");
        }
    }
    __syncthreads();
}
#ifndef GP_ALIGN
#define GP_ALIGN true
#endif
#ifndef GP_SP2
#define GP_SP2 true
#endif
namespace pg8 {
constexpr int BM = 256, BK = 64, HALF = 128, HTB = HALF * BK * 2  , STAGE_BYTES = 8 * HTB, NXCD = 8, WGM = 8;

__host__ __device__ __forceinline__ int lds_byte(int r, int c) { const int st = (r >> 4) * 2 + (c >> 5), rr = r & 15, cc = c & 31, ob = rr * 64 + cc * 2; return st * 1024 + (ob ^ (((ob >> 9) & 1) << 5)); }
__host__ __device__ __forceinline__ void stage_rc(int b, int& R, int& C) { const int st = b / 1024, sb = b % 1024, swz = sb ^ (((sb >> 9) & 1) << 5); R = (st >> 1) * 16 + swz / 64; C = (st & 1) * 32 + (swz % 64) / 2; }
__host__ __device__ __forceinline__ int perm32(int rho) { const int n = rho >> 4, i = rho & 15; return 8 * (i >> 2) + 4 * n + (i & 3); }

struct Unit { int pm, pn; };
struct Gemm { const bf16_t* A; const bf16_t* Bt; int M, N, K; };

struct StaticOrder {
    int nM, nN, nwg, G, c;
    __host__ __device__ void init(int M, int N, int G_, int c_) { nM = M / BM; nN = N / BM; nwg = nM * nN; G = G_; c = c_; }
    __host__ __device__ bool next(int i, Unit& u) const {
        const long L = (long)i * G + c; if (L >= nwg) return false;
        int wgid = (int)L; { const int q = nwg / NXCD, r = nwg % NXCD, xcd = wgid % NXCD, off = wgid / NXCD; wgid = (xcd < r ? xcd * (q + 1) : r * (q + 1) + (xcd - r) * q) + off; }
        const int nig = WGM * nN, gid = wgid / nig, fm = gid * WGM, gsz = (nM - fm) < WGM ? (nM - fm) : WGM;
        u.pm = fm + ((wgid % nig) % gsz); u.pn = (wgid % nig) / gsz; return true;
    }
    __device__ __forceinline__ void a_ready(const Unit&) const {}
    __device__ __forceinline__ void done(const Unit&) const {}
};
__device__ __forceinline__ unsigned cvt_pk_bf16(float lo, float hi) { unsigned r; asm volatile("v_cvt_pk_bf16_f32 %0, %1, %2" : "=v"(r) : "v"(lo), "v"(hi)); return r; }
template <class Epi, class Sched, bool ALIGN_EPI = false, bool SP2 = false>
__device__ __forceinline__ void gemm_phase(LAS unsigned char* lds, const Gemm g, const Sched& S, const Epi& E) {
    int tid_ = threadIdx.x; asm volatile("" : "+v"(tid_));
    const int tid = tid_, wid = __builtin_amdgcn_readfirstlane(tid >> 6), lane = tid & 63, wr = wid >> 2, wc = wid & 3, fr = lane & 15, fq = lane >> 4;
    const int K = g.K, nt = K / BK;
    unsigned voffA[2], voffB[2];
#pragma unroll
    for (int i = 0; i < 2; ++i) { int R, C; stage_rc(tid * 16 + i * 8192, R, C); const int Rb = Epi::PERM ? ((R & ~31) + perm32(R & 31)) : R;
        voffA[i] = (unsigned)(R * K + C) * 2u; voffB[i] = (unsigned)(Rb * K + C) * 2u; }
    const size_t kstep = (size_t)(BK * 2);
    const size_t hstep = (size_t)HALF * K * 2;
    const size_t tstep = 2 * hstep;
    const unsigned ldsw = (unsigned)wid * 1024u;
    const int aoff = lds_byte(wr * 64 + fr, fq * 8), boff = lds_byte(wc * 32 + fr, fq * 8);
#define PG8_SA(b, h) (((b) * 2 + (h)) * HTB)
#define PG8_SB(b, h) ((4 + (b) * 2 + (h)) * HTB)
#define PG8_STAGE(bufoff, gbase, voff) do { _Pragma("unroll") for (int _i = 0; _i < 2; ++_i) \
        __builtin_amdgcn_global_load_lds((const unsigned*)((const char*)(gbase) + (voff)[_i]), (LAS unsigned*)(lds + (bufoff) + ldsw + _i * 8192), 16, 0, 0); } while (0)
#define PG8_LDA(dst, b, h) do { _Pragma("unroll") for (int m = 0; m < 4; ++m) _Pragma("unroll") for (int k = 0; k < 2; ++k) dst[m][k] = *(const LAS bf16x8*)(lds + PG8_SA(b, h) + aoff + m * 2048 + k * 1024); } while (0)
#define PG8_LDB(dst, b, h) do { _Pragma("unroll") for (int n = 0; n < 2; ++n) _Pragma("unroll") for (int k = 0; k < 2; ++k) dst[n][k] = *(const LAS bf16x8*)(lds + PG8_SB(b, h) + boff + n * 2048 + k * 1024); } while (0)
#define PG8_MMA(ai, bj, At, Bt) do { __builtin_amdgcn_s_setprio(1); _Pragma("unroll") for (int m = 0; m < 4; ++m) _Pragma("unroll") for (int n = 0; n < 2; ++n) _Pragma("unroll") for (int k = 0; k < 2; ++k) \
        acc[ai][bj][m][n] = __builtin_amdgcn_mfma_f32_16x16x32_bf16(Bt[n][k], At[m][k], acc[ai][bj][m][n], 0, 0, 0); __builtin_amdgcn_s_setprio(0); } while (0)
#define PG8_WAIT_V(n) asm volatile("s_waitcnt vmcnt(" #n ")" ::: "memory")
#define PG8_WAIT_L(n) asm volatile("s_waitcnt lgkmcnt(" #n ")" ::: "memory")
#define PG8_BAR __builtin_amdgcn_s_barrier()
#define PG8_SCHED __builtin_amdgcn_sched_barrier(0)
    Unit cur, nxt; int ui = 0;
    if (!S.next(0, cur)) return;
    f32x4 acc[2][2][4][2];
#pragma unroll
    for (int a = 0; a < 2; ++a)
#pragma unroll
        for (int b = 0; b < 2; ++b)
#pragma unroll
            for (int m = 0; m < 4; ++m)
#pragma unroll
                for (int n = 0; n < 2; ++n) acc[a][b][m][n] = (f32x4){0.f, 0.f, 0.f, 0.f};
    bf16x8 At[4][2], B0[2][2], B1[2][2];
    const char* cA = (const char*)g.A + (size_t)cur.pm * tstep; const char* cB = (const char*)g.Bt + (size_t)cur.pn * tstep;
    S.a_ready(cur);
    if constexpr (SP2) {
        PG8_STAGE(PG8_SB(0, 0), cB, voffB); PG8_STAGE(PG8_SB(0, 1), cB + hstep, voffB); PG8_STAGE(PG8_SA(0, 0), cA, voffA); PG8_STAGE(PG8_SA(0, 1), cA + hstep, voffA);
        if (wr == 1) PG8_BAR;
        PG8_WAIT_V(2); PG8_BAR;
        PG8_STAGE(PG8_SB(1, 0), cB + kstep, voffB); PG8_STAGE(PG8_SA(1, 0), cA + kstep, voffA); PG8_STAGE(PG8_SB(1, 1), cB + hstep + kstep, voffB);
        PG8_WAIT_V(6); PG8_BAR;
    } else {
        PG8_STAGE(PG8_SB(0, 0), cB, voffB); PG8_STAGE(PG8_SA(0, 0), cA, voffA); PG8_STAGE(PG8_SB(0, 1), cB + hstep, voffB); PG8_STAGE(PG8_SA(0, 1), cA + hstep, voffA);
        if (wr == 1) PG8_BAR;
        PG8_WAIT_V(4); PG8_BAR;
        PG8_STAGE(PG8_SB(1, 0), cB + kstep, voffB); PG8_STAGE(PG8_SA(1, 0), cA + kstep, voffA); PG8_STAGE(PG8_SB(1, 1), cB + hstep + kstep, voffB);
        PG8_WAIT_V(6); PG8_BAR;
    }
    for (;;) {
        const bool has_next = S.next(ui + 1, nxt);
        const char* nA = has_next ? (const char*)g.A + (size_t)nxt.pm * tstep : cA; const char* nB = has_next ? (const char*)g.Bt + (size_t)nxt.pn * tstep : cB;
#pragma unroll 1
        for (int t = 0; t < nt; t += 2) {
            const bool last = (t == nt - 2);
            const char* a1 = cA + (size_t)(t + 1) * kstep;
            const char* a2 = last ? nA : cA + (size_t)(t + 2) * kstep; const char* b2 = last ? nB : cB + (size_t)(t + 2) * kstep;
            const char* a3 = a2 + kstep; const char* b3 = b2 + kstep;
            if (last && has_next) S.a_ready(nxt);
            if constexpr (SP2) {
            PG8_LDB(B0, 0, 0); PG8_LDB(B1, 0, 1); PG8_SCHED; PG8_LDA(At, 0, 0); PG8_STAGE(PG8_SA(1, 1), a1 + hstep, voffA);
            PG8_WAIT_V(8); PG8_WAIT_L(0); PG8_BAR; PG8_MMA(0, 0, At, B0); PG8_MMA(0, 1, At, B1); PG8_BAR; PG8_SCHED;
            PG8_LDA(At, 0, 1); PG8_STAGE(PG8_SB(0, 0), b2, voffB); PG8_STAGE(PG8_SB(0, 1), b2 + hstep, voffB); PG8_STAGE(PG8_SA(0, 0), a2, voffA);
            PG8_WAIT_V(8); PG8_WAIT_L(0); PG8_BAR; PG8_MMA(1, 0, At, B0); PG8_MMA(1, 1, At, B1); PG8_BAR; PG8_SCHED;
            PG8_LDB(B0, 1, 0); PG8_LDB(B1, 1, 1); PG8_SCHED; PG8_LDA(At, 1, 0); PG8_STAGE(PG8_SA(0, 1), a2 + hstep, voffA);
            PG8_WAIT_V(8); PG8_WAIT_L(0); PG8_BAR; PG8_MMA(0, 0, At, B0); PG8_MMA(0, 1, At, B1); PG8_BAR; PG8_SCHED;
            PG8_LDA(At, 1, 1); PG8_STAGE(PG8_SB(1, 0), b3, voffB); PG8_STAGE(PG8_SB(1, 1), b3 + hstep, voffB); PG8_STAGE(PG8_SA(1, 0), a3, voffA);
            PG8_WAIT_V(8); PG8_WAIT_L(0); PG8_BAR; PG8_MMA(1, 0, At, B0); PG8_MMA(1, 1, At, B1); PG8_BAR; PG8_SCHED;
            } else {
            PG8_LDB(B0, 0, 0); PG8_SCHED; PG8_LDA(At, 0, 0); PG8_STAGE(PG8_SA(1, 1), a1 + hstep, voffA);
            PG8_WAIT_L(8); PG8_BAR; PG8_WAIT_L(0); PG8_MMA(0, 0, At, B0); PG8_BAR; PG8_SCHED;
            PG8_LDB(B1, 0, 1); PG8_STAGE(PG8_SB(0, 0), b2, voffB);
            PG8_BAR; PG8_WAIT_L(0); PG8_MMA(0, 1, At, B1); PG8_BAR;
            PG8_LDA(At, 0, 1); PG8_STAGE(PG8_SA(0, 0), a2, voffA);
            PG8_BAR; PG8_WAIT_L(0); PG8_MMA(1, 0, At, B0); PG8_BAR; PG8_SCHED;
            PG8_STAGE(PG8_SB(0, 1), b2 + hstep, voffB);
            PG8_WAIT_V(6); PG8_BAR; PG8_MMA(1, 1, At, B1); PG8_BAR;
            PG8_LDB(B0, 1, 0); PG8_SCHED; PG8_LDA(At, 1, 0); PG8_STAGE(PG8_SA(0, 1), a2 + hstep, voffA);
            PG8_WAIT_L(8); PG8_BAR; PG8_WAIT_L(0); PG8_MMA(0, 0, At, B0); PG8_BAR; PG8_SCHED;
            PG8_LDB(B1, 1, 1); PG8_STAGE(PG8_SB(1, 0), b3, voffB);
            PG8_BAR; PG8_WAIT_L(0); PG8_MMA(0, 1, At, B1); PG8_BAR;
            PG8_LDA(At, 1, 1); PG8_STAGE(PG8_SA(1, 0), a3, voffA);
            PG8_BAR; PG8_WAIT_L(0); PG8_MMA(1, 0, At, B0); PG8_BAR; PG8_SCHED;
            PG8_STAGE(PG8_SB(1, 1), b3 + hstep, voffB);
            PG8_WAIT_V(6); PG8_BAR; PG8_MMA(1, 1, At, B1); PG8_BAR;
            }
        }
        if constexpr (ALIGN_EPI) { if (wr == 0) PG8_BAR; }
        if constexpr (!Epi::AFTER_DRAIN) { E(acc, cur, wr, wc, fr, fq); S.done(cur); }
        if (!has_next) break;
#pragma unroll
        for (int a = 0; a < 2; ++a)
#pragma unroll
            for (int b = 0; b < 2; ++b)
#pragma unroll
                for (int m = 0; m < 4; ++m)
#pragma unroll
                    for (int n = 0; n < 2; ++n) acc[a][b][m][n] = (f32x4){0.f, 0.f, 0.f, 0.f};
        cur = nxt; cA = nA; cB = nB; ++ui;
        if constexpr (ALIGN_EPI) { if (wr == 1) PG8_BAR; }
    }
    PG8_WAIT_V(0);
    if constexpr (!ALIGN_EPI) { if (wr == 0) PG8_BAR; }
    PG8_BAR;
    if constexpr (Epi::AFTER_DRAIN) { E.fused(acc, cur, wr, wc, fr, fq, lds, wid, lane); S.done(cur); }
#undef PG8_SA
#undef PG8_SB
#undef PG8_STAGE
#undef PG8_LDA
#undef PG8_LDB
#undef PG8_MMA
#undef PG8_WAIT_V
#undef PG8_WAIT_L
#undef PG8_BAR
#undef PG8_SCHED
}
}
namespace pg8 {
typedef const f32x4 (&AccRef)[2][2][4][2];

struct EpiStore {
    static constexpr bool PERM = true, AFTER_DRAIN = false;
    bf16_t* O; int ldc; int act; int split_cols; size_t split_stride; int gate_pn; float* G; const float* bgate;
    __device__ __forceinline__ void operator()(AccRef acc, const Unit& u, int wr, int wc, int fr, int fq) const {
        const int row0 = u.pm * BM + wr * 64 + fr;
        if (u.pn == gate_pn) {
            if (wc == 0) {
#pragma unroll
                for (int n = 0; n < 2; ++n) {
                    const int c0 = 8 * fq + 4 * n;
                    const f32x4 bg = *(const f32x4*)(bgate + c0);
                    const bool isf = (c0 & 8) != 0;
#pragma unroll
                    for (int ai = 0; ai < 2; ++ai)
#pragma unroll
                        for (int m = 0; m < 4; ++m) {
                            f32x4 v = acc[ai][0][m][n] + bg, o;
#pragma unroll
                            for (int j = 0; j < 4; ++j) { const float cpd = 15.0f * tanhf_(v[j] * (1.0f / 15.0f)); const float eu = __expf(-cpd); o[j] = isf ? -(eu < 9.765625e-4f ? eu - 0.5f * eu * eu : __logf(1.0f + eu)) : cpd; }
                            *(f32x4*)(G + (size_t)(row0 + ai * HALF + m * 16) * 32 + c0) = o;
                        }
                }
            }
            return;
        }
        int colt = u.pn * BM; bf16_t* base = O;
        if (split_cols) { const int t = colt / split_cols; base += (size_t)t * split_stride; colt -= t * split_cols; }
        const int col0 = colt + wc * 32 + 8 * fq;
#pragma unroll
        for (int ai = 0; ai < 2; ++ai)
#pragma unroll
            for (int m = 0; m < 4; ++m) { bf16_t* rowp = base + (size_t)(row0 + ai * HALF + m * 16) * ldc + col0;
#pragma unroll
                for (int bj = 0; bj < 2; ++bj) { f32x4 v0 = acc[ai][bj][m][0], v1 = acc[ai][bj][m][1];
                    if (act == 1) {
#pragma unroll
                        for (int j = 0; j < 4; ++j) { v0[j] = tanhf_(v0[j]); v1[j] = tanhf_(v1[j]); } }
                    else if (act == 2) {
#pragma unroll
                        for (int j = 0; j < 4; ++j) { v0[j] = sigmoidf_(v0[j]); v1[j] = sigmoidf_(v1[j]); } }
                    u32x4 w; w.x = cvt_pk_bf16(v0[0], v0[1]); w.y = cvt_pk_bf16(v0[2], v0[3]); w.z = cvt_pk_bf16(v1[0], v1[1]); w.w = cvt_pk_bf16(v1[2], v1[3]);
                    *(u32x4*)(rowp + bj * HALF) = w; } }
    }
};

struct EpiSigAff {
    static constexpr bool PERM = true, AFTER_DRAIN = false;
    bf16_t* O; size_t split_stride; const float* bias; float scale;
    __device__ __forceinline__ void operator()(AccRef acc, const Unit& u, int wr, int wc, int fr, int fq) const {
        const int row0 = u.pm * BM + wr * 64 + fr;
        int colt = u.pn * BM; const int t = colt / D; bf16_t* base = O + (size_t)t * split_stride; colt -= t * D;
        const int col0 = colt + wc * 32 + 8 * fq, bcol0 = u.pn * BM + wc * 32 + 8 * fq;
        f32x4 bv[2][2];
#pragma unroll
        for (int bj = 0; bj < 2; ++bj)
#pragma unroll
            for (int n = 0; n < 2; ++n) bv[bj][n] = *(const f32x4*)(bias + bcol0 + bj * HALF + 4 * n);
#pragma unroll
        for (int ai = 0; ai < 2; ++ai)
#pragma unroll
            for (int m = 0; m < 4; ++m) { bf16_t* rowp = base + (size_t)(row0 + ai * HALF + m * 16) * D + col0;
#pragma unroll
                for (int bj = 0; bj < 2; ++bj) { f32x4 v0 = acc[ai][bj][m][0] + bv[bj][0], v1 = acc[ai][bj][m][1] + bv[bj][1];
#pragma unroll
                    for (int j = 0; j < 4; ++j) { v0[j] = scale * sigmoidf_(v0[j]); v1[j] = scale * sigmoidf_(v1[j]); }
                    u32x4 w; w.x = cvt_pk_bf16(v0[0], v0[1]); w.y = cvt_pk_bf16(v0[2], v0[3]); w.z = cvt_pk_bf16(v1[0], v1[1]); w.w = cvt_pk_bf16(v1[2], v1[3]);
                    *(u32x4*)(rowp + bj * HALF) = w; } }
    }
};

struct EpiVmix {
    static constexpr bool PERM = true, AFTER_DRAIN = false;
    bf16_t* V; const bf16_t* VF; const float* v0;
    __device__ __forceinline__ void operator()(AccRef acc, const Unit& u, int wr, int wc, int fr, int fq) const {
        const int row0 = u.pm * BM + wr * 64 + fr; const int col0 = u.pn * BM + wc * 32 + 8 * fq;
        f32x4 bv[2][2];
#pragma unroll
        for (int bj = 0; bj < 2; ++bj)
#pragma unroll
            for (int n = 0; n < 2; ++n) bv[bj][n] = *(const f32x4*)(v0 + col0 + bj * HALF + 4 * n);
#pragma unroll
        for (int ai = 0; ai < 2; ++ai) {
            u32x4 vvs[4][2], ffs[4][2];
#pragma unroll
            for (int m = 0; m < 4; ++m) { const size_t off = (size_t)(row0 + ai * HALF + m * 16) * D + col0;
#pragma unroll
                for (int bj = 0; bj < 2; ++bj) { vvs[m][bj] = *(const u32x4*)(V + off + bj * HALF); ffs[m][bj] = *(const u32x4*)(VF + off + bj * HALF); } }
            asm volatile("" ::: "memory");
#pragma unroll
            for (int m = 0; m < 4; ++m) { const size_t off = (size_t)(row0 + ai * HALF + m * 16) * D + col0;
#pragma unroll
                for (int bj = 0; bj < 2; ++bj) {
                    const u32x4 vv = vvs[m][bj], ff = ffs[m][bj];
                    const f32x4 a0 = acc[ai][bj][m][0] + bv[bj][0], a1 = acc[ai][bj][m][1] + bv[bj][1];
                    float o[8];
#pragma unroll
                    for (int j = 0; j < 4; ++j) {
                        const unsigned vw = j == 0 ? vv.x : j == 1 ? vv.y : j == 2 ? vv.z : vv.w, fw = j == 0 ? ff.x : j == 1 ? ff.y : j == 2 ? ff.z : ff.w;
                        const float s0 = sigmoidf_(j < 2 ? a0[2 * j] : a1[2 * j - 4]), s1 = sigmoidf_(j < 2 ? a0[2 * j + 1] : a1[2 * j - 3]);
                        const float x0 = lo_bf(vw), x1 = hi_bf(vw), f0 = lo_bf(fw), f1 = hi_bf(fw);
                        o[2 * j] = x0 + (f0 - x0) * s0; o[2 * j + 1] = x1 + (f1 - x1) * s1; }
                    u32x4 w; w.x = cvt_pk_bf16(o[0], o[1]); w.y = cvt_pk_bf16(o[2], o[3]); w.z = cvt_pk_bf16(o[4], o[5]); w.w = cvt_pk_bf16(o[6], o[7]);
                    *(u32x4*)(V + off + bj * HALF) = w; } }
            asm volatile("" ::: "memory"); }
    }
};

struct EpiResid {
    static constexpr bool PERM = false, AFTER_DRAIN = false;
    float* X; const float* gate; int tile0; const float* srcx; const float* srcc;
    __device__ __forceinline__ void operator()(AccRef acc, const Unit& u, int wr, int wc, int fr, int fq) const {
        const int gpm = tile0 + u.pm; const int b = gpm / 9, tix = gpm % 9; const int idx = (tix == 0) ? 16 : b;
        const int rloc = wr * 64 + fr, col0 = u.pn * BM + wc * 32 + 4 * fq;
        const float* src = srcx ? (tix == 0 ? srcc + (size_t)b * CTXL * D : srcx + ((size_t)b * SEQ + (size_t)(tix - 1) * BM) * D) : X + (size_t)gpm * BM * D;
        float* dst = X + (size_t)gpm * BM * D;
        f32x4 gv[2][2];
#pragma unroll
        for (int bj = 0; bj < 2; ++bj)
#pragma unroll
            for (int n = 0; n < 2; ++n) gv[bj][n] = *(const f32x4*)(gate + (size_t)idx * MODLD + col0 + bj * HALF + n * 16);
        f32x4 (&ac)[2][2][4][2] = const_cast<f32x4 (&)[2][2][4][2]>(acc);
        f32x4 xa[2][2], xb[2][2];
#define RES_LD(dstv, ai_, m_) do { const size_t off_ = (size_t)(rloc + (ai_) * HALF + (m_) * 16) * D + col0; _Pragma("unroll") for (int bj = 0; bj < 2; ++bj) _Pragma("unroll") for (int n = 0; n < 2; ++n) \
            dstv[bj][n] = *(const f32x4*)(src + off_ + bj * HALF + n * 16); } while (0)
#define RES_FMA(srcv, ai_, m_) do { _Pragma("unroll") for (int bj = 0; bj < 2; ++bj) _Pragma("unroll") for (int n = 0; n < 2; ++n) ac[ai_][bj][m_][n] = srcv[bj][n] + gv[bj][n] * ac[ai_][bj][m_][n]; } while (0)
        RES_LD(xa, 0, 0); RES_LD(xb, 0, 1);
        RES_FMA(xa, 0, 0); RES_LD(xa, 0, 2); RES_FMA(xb, 0, 1); RES_LD(xb, 0, 3);
        RES_FMA(xa, 0, 2); RES_LD(xa, 1, 0); RES_FMA(xb, 0, 3); RES_LD(xb, 1, 1);
        RES_FMA(xa, 1, 0); RES_LD(xa, 1, 2); RES_FMA(xb, 1, 1); RES_LD(xb, 1, 3);
        RES_FMA(xa, 1, 2); RES_FMA(xb, 1, 3);
#undef RES_LD
#undef RES_FMA
        asm volatile("" ::: "memory");
#pragma unroll
        for (int ai = 0; ai < 2; ++ai)
#pragma unroll
            for (int m = 0; m < 4; ++m) { const size_t off = (size_t)(rloc + ai * HALF + m * 16) * D + col0;
#pragma unroll
                for (int bj = 0; bj < 2; ++bj)
#pragma unroll
                    for (int n = 0; n < 2; ++n) *(f32x4*)(dst + off + bj * HALF + n * 16) = ac[ai][bj][m][n]; }
    }
};

struct EpiSwiglu {
    static constexpr bool PERM = true, AFTER_DRAIN = false;
    bf16_t* O;
    __device__ __forceinline__ void operator()(AccRef acc, const Unit& u, int wr, int wc, int fr, int fq) const {
        const int row0 = u.pm * BM + wr * 64 + fr; const int col0 = u.pn * HALF + wc * 32 + 8 * fq;
#pragma unroll
        for (int ai = 0; ai < 2; ++ai)
#pragma unroll
            for (int m = 0; m < 4; ++m) { bf16_t* rowp = O + (size_t)(row0 + ai * HALF + m * 16) * DFF + col0;
                f32x4 v0, v1;
#pragma unroll
                for (int j = 0; j < 4; ++j) { v0[j] = siluf_(acc[ai][0][m][0][j]) * acc[ai][1][m][0][j]; v1[j] = siluf_(acc[ai][0][m][1][j]) * acc[ai][1][m][1][j]; }
                u32x4 w; w.x = cvt_pk_bf16(v0[0], v0[1]); w.y = cvt_pk_bf16(v0[2], v0[3]); w.z = cvt_pk_bf16(v1[0], v1[1]); w.w = cvt_pk_bf16(v1[2], v1[3]);
                *(u32x4*)rowp = w; }
    }
};
}

namespace pg8 {
struct SkipCtxOrder : StaticOrder {
    __device__ __forceinline__ bool next(int i, Unit& u) const { if (!StaticOrder::next(i, u)) return false; u.pm = u.pm + (u.pm >> 3) + 1; return true; }
};
}
template <class Epi, bool SKIPCTX = false>
__device__ __forceinline__ void run_gemm(LAS unsigned char* lds, const bf16_t* A, const bf16_t* Bt, int M, int N, int K, const Epi& E, int& urot) {
    pg8::Gemm g{A, Bt, M, N, K};
    const int G = (int)gridDim.x; const int Meff = SKIPCTX ? (M / 9) * 8 : M; const int nwg = (Meff / 256) * (N / 256);
    const int c = ((int)blockIdx.x + G - (urot % G)) % G;
    if constexpr (SKIPCTX) { pg8::SkipCtxOrder S; S.init(Meff, N, G, c); pg8::gemm_phase<Epi, pg8::SkipCtxOrder, GP_ALIGN, GP_SP2>(lds, g, S, E); }
    else { pg8::StaticOrder S; S.init(M, N, G, c); pg8::gemm_phase<Epi, pg8::StaticOrder, GP_ALIGN, GP_SP2>(lds, g, S, E); }
    urot += nwg;
}
struct Args { const float* in[NIN]; float* out; unsigned char* ws; int ph_lo, ph_hi; };
static_assert(sizeof(Args) == NIN * 8 + 8 + 8 + 8, "Args has no padding");

typedef const __attribute__((address_space(4))) Args* CArgs;
__device__ __forceinline__ CArgs opaque_args() { CArgs p = (CArgs)__builtin_amdgcn_kernarg_segment_ptr(); asm volatile("" : "+s"(p)); return p; }
struct Tc { LAS unsigned char* lds; int tid, lane, wave, bid, G, gw, ngw; };
__device__ __forceinline__ Tc mk_tc(LAS unsigned char* lds) { Tc t; int tid = threadIdx.x; asm volatile("" : "+v"(tid)); t.lds = lds; t.tid = tid; t.lane = tid & 63; t.wave = __builtin_amdgcn_readfirstlane(tid >> 6);
    t.bid = blockIdx.x; t.G = gridDim.x; t.gw = t.bid * 8 + t.wave; t.ngw = t.G * 8; return t; }

template <class RM>
__device__ __forceinline__ void tr_item(const float* W, int ldw, bf16_t* WT, int ldk, const RM& rm, LAS float* scr, int kb, int nb, int lane) {
    const int k0 = 64 * kb, n0 = 32 * nb;
    float tmp[32];
#pragma unroll
    for (int i = 0; i < 32; ++i) { const int kk = 2 * i + (lane >> 5); tmp[i] = W[(size_t)(k0 + kk) * ldw + n0 + (lane & 31)]; }
    asm volatile("" ::: "memory");
#pragma unroll
    for (int i = 0; i < 32; ++i) { const int kk = 2 * i + (lane >> 5); scr[kk * 33 + (lane & 31)] = tmp[i]; }
    LDS_WAIT();
    const int c = lane & 7;
#pragma unroll
    for (int j = 0; j < 4; ++j) { const int n = (lane >> 3) + 8 * j; const LAS float* s = scr + (8 * c) * 33 + n;
        u32x4 o; o.x = pk2(s[0 * 33], s[1 * 33]); o.y = pk2(s[2 * 33], s[3 * 33]); o.z = pk2(s[4 * 33], s[5 * 33]); o.w = pk2(s[6 * 33], s[7 * 33]);
        *(u32x4*)(WT + (size_t)rm(n0 + n) * ldk + k0 + 8 * c) = o; }
    LDS_WAIT();
}
struct RmId { __device__ __forceinline__ int operator()(int n) const { return n; } };
struct RmSwiglu { __device__ __forceinline__ int operator()(int n) const { const int up = n >= DFF ? 1 : 0; const int m = n - up * DFF; return 256 * (m >> 7) + 128 * up + (m & 127); } };

template <class RM>
__device__ __forceinline__ void tr_matrix(const Tc& t, const float* W, int K, int N, int ldw, bf16_t* WT, int ldk, const RM& rm) {
    LAS float* scr = (LAS float*)(t.lds + t.wave * 16384);
    const int nkb = K / 64, nnb = N / 32, items = nkb * nnb;
    for (int it = t.gw; it < items; it += t.ngw) tr_item(W, ldw, WT, ldk, rm, scr, it / nnb, it % nnb, t.lane);
}
template <class SRC>
__device__ __forceinline__ void build_small(const Tc& t, bf16_t* dst, int NR, int KC, const SRC& src) {
    const int total = NR * (KC / 8);
    for (int i = t.gw * 64 + t.lane; i < total; i += t.ngw * 64) { const int n = i % NR, ko = i / NR;
        float v[8];
#pragma unroll
        for (int j = 0; j < 8; ++j) v[j] = src(n, 8 * ko + j);
        u32x4 o; o.x = pk2(v[0], v[1]); o.y = pk2(v[2], v[3]); o.z = pk2(v[4], v[5]); o.w = pk2(v[6], v[7]);
        *(u32x4*)(dst + (size_t)n * KC + 8 * ko) = o; }
}

__device__ __forceinline__ void convert_rwkv(const Tc& t, CArgs a, int jl) {
    bf16_t* wm = (bf16_t*)(a->ws + WS_WMIX);
    const size_t dd = (size_t)D * D;
    tr_matrix(t, a->in[I_WR] + jl * dd, D, D, D, (bf16_t*)((char*)wm + WM_R), D, RmId());
    tr_matrix(t, a->in[I_WK] + jl * dd, D, D, D, (bf16_t*)((char*)wm + WM_K), D, RmId());
    tr_matrix(t, a->in[I_WV] + jl * dd, D, D, D, (bf16_t*)((char*)wm + WM_V), D, RmId());
    tr_matrix(t, a->in[I_WO] + jl * dd, D, D, D, (bf16_t*)((char*)wm + WM_O), D, RmId());
    { const float* w1 = a->in[I_W1] + (size_t)jl * 2 * D * 96;
      build_small(t, (bf16_t*)((char*)wm + WM_W1), 256, D, [=](int n, int k) -> float { if (n >= 192) return 0.f; const int z = n >= 96 ? 1 : 0, r = n - 96 * z; return w1[((size_t)z * D + k) * 96 + r]; }); }
    { const float* a1 = a->in[I_A1] + (size_t)jl * 2 * D * 96;
      build_small(t, (bf16_t*)((char*)wm + WM_A1), 256, D, [=](int n, int k) -> float { if (n >= 192) return 0.f; const int z = n >= 96 ? 1 : 0, r = n - 96 * z; return a1[((size_t)z * D + k) * 96 + r]; }); }
    { const float* g1 = a->in[I_G1] + (size_t)jl * D * 256;
      build_small(t, (bf16_t*)((char*)wm + WM_G1), 256, D, [=](int n, int k) -> float { return g1[(size_t)k * 256 + n]; }); }
    if (jl > 0) { const float* v1 = a->in[I_V1] + (size_t)(jl - 1) * D * 64;
      build_small(t, (bf16_t*)((char*)wm + WM_V1), 256, D, [=](int n, int k) -> float { return n < 64 ? v1[(size_t)k * 64 + n] : 0.f; }); }
    { const float* w2 = a->in[I_W2] + (size_t)jl * 2 * 96 * D;
      build_small(t, (bf16_t*)((char*)wm + WM_W2), 2 * D, 256, [=](int n, int k) -> float { const int z = n >= D ? 1 : 0, ch = n - z * D, kk = k - 96 * z; return (kk >= 0 && kk < 96) ? w2[((size_t)z * 96 + kk) * D + ch] : 0.f; }); }
    { const float* a2 = a->in[I_A2] + (size_t)jl * 2 * 96 * D;
      build_small(t, (bf16_t*)((char*)wm + WM_A2), 2 * D, 256, [=](int n, int k) -> float { const int z = n >= D ? 1 : 0, ch = n - z * D, kk = k - 96 * z; return (kk >= 0 && kk < 96) ? a2[((size_t)z * 96 + kk) * D + ch] : 0.f; }); }
    { const float* g2 = a->in[I_G2] + (size_t)jl * 256 * D;
      build_small(t, (bf16_t*)((char*)wm + WM_G2), D, 256, [=](int n, int k) -> float { return g2[(size_t)k * D + n]; }); }
    if (jl > 0) { const float* v2 = a->in[I_V2] + (size_t)(jl - 1) * 64 * D;
      build_small(t, (bf16_t*)((char*)wm + WM_V2), D, 256, [=](int n, int k) -> float { return k < 64 ? v2[(size_t)k * D + n] : 0.f; }); }
}
__device__ __forceinline__ void convert_mlstm(const Tc& t, CArgs a, int jl) {
    bf16_t* win = (bf16_t*)(a->ws + WS_WMIX + WM_MIN); bf16_t* wout = (bf16_t*)(a->ws + WS_WMIX + WM_MOUT);
    tr_matrix(t, a->in[I_MWIN] + (size_t)jl * D * MPROJ, D, MPROJ, MPROJ, win, D, RmId());
    { u32x4* z = (u32x4*)(win + (size_t)MPROJ * D); const int total = (6400 - MPROJ) * D / 8; unsigned zz = 0u; asm volatile("" : "+v"(zz)); const u32x4 zero = {zz, zz, zz, zz};
      for (int i = t.gw * 64 + t.lane; i < total; i += t.ngw * 64) z[i] = zero; }
    tr_matrix(t, a->in[I_MWOUT] + (size_t)jl * D * D, D, D, D, wout, D, RmId());
}
__device__ __forceinline__ void convert_ffn_in(const Tc& t, CArgs a, int layer) {
    tr_matrix(t, a->in[I_FWIN] + (size_t)layer * D * 2 * DFF, D, 2 * DFF, 2 * DFF, (bf16_t*)(a->ws + WS_WFFN + WF_IN), D, RmSwiglu());
}
__device__ __forceinline__ void convert_ffn_out(const Tc& t, CArgs a, int layer) {
    tr_matrix(t, a->in[I_FWOUT] + (size_t)layer * DFF * D, DFF, D, D, (bf16_t*)(a->ws + WS_WFFN + WF_OUT), DFF, RmId());
}
__device__ __forceinline__ bool tail_crew(const Tc& t, int urot0, int nwg, Tc& ts) {
    const int G = t.G, r = nwg % G, c = (t.bid + G - (urot0 % G)) % G;
    ts = t;
    if (r == 0) return true;
    if (c < r) return false;
    ts.bid = c - r; ts.G = G - r; ts.gw = ts.bid * 8 + t.wave; ts.ngw = ts.G * 8; return true;
}

__device__ __forceinline__ void ph_prologue(const Tc& t, CArgs a) {
    LAS float* S = (LAS float*)t.lds;
    { f32x4 cv[17];
#pragma unroll
      for (int b = 0; b < 17; ++b) cv[b] = *(const f32x4*)((b < 16 ? a->in[I_C] + (size_t)b * D : a->in[I_CCTX]) + 4 * t.tid);
      const int k = 4 * t.tid;
#pragma unroll
      for (int b = 0; b < 17; ++b) { const f32x4 s = {siluf_(cv[b][0]), siluf_(cv[b][1]), siluf_(cv[b][2]), siluf_(cv[b][3])};
          *(LAS f32x4*)(S + b * 2056 + (k >> 10) * 1028 + (k & 1023)) = s; } }
    __syncthreads();
    float* mod = (float*)(a->ws + WS_MOD);
    const int col = t.lane & 31, kh = t.lane >> 5;
    for (int it = t.wave * t.G + t.bid; it < 4 * 384; it += t.ngw) { const int layer = it / 384, n0 = 32 * (it % 384);
        const auto wrs = __builtin_amdgcn_make_buffer_rsrc((void*)(a->in[I_MODW] + (size_t)layer * D * MODLD), (short)0, (int)((size_t)D * MODLD * 4), 0x00020000);
        const unsigned voff = (unsigned)(kh * 1024 * MODLD + n0 + col) * 4u;
        const LAS float* Sk = S + kh * 1028;
        f32x2 acc[17];
#pragma unroll
        for (int b = 0; b < 17; ++b) acc[b] = (f32x2){0.f, 0.f};
        float wa[8], wb[8];
#define MOD_LD(dst, k0_) do { _Pragma("unroll") for (int j = 0; j < 8; ++j) dst[j] = __builtin_bit_cast(float, __builtin_amdgcn_raw_buffer_load_b32(wrs, voff, (unsigned)(((k0_) + j) * MODLD * 4), 0)); } while (0)
#define MOD_FMA(src, k0_) do { _Pragma("unroll") for (int j4 = 0; j4 < 2; ++j4) { _Pragma("unroll") for (int b = 0; b < 17; ++b) { const f32x4 s = *(const LAS f32x4*)(Sk + b * 2056 + (k0_) + 4 * j4); \
            acc[b] = acc[b] + (f32x2){s[0], s[1]} * (f32x2){src[4 * j4], src[4 * j4 + 1]} + (f32x2){s[2], s[3]} * (f32x2){src[4 * j4 + 2], src[4 * j4 + 3]}; } asm volatile("" ::: "memory"); } } while (0)
        MOD_LD(wa, 0);
#pragma unroll 1
        for (int k0 = 0; k0 < 1024; k0 += 16) {
            MOD_LD(wb, k0 + 8);
            MOD_FMA(wa, k0);
            if (k0 + 16 < 1024) MOD_LD(wa, k0 + 16);
            MOD_FMA(wb, k0 + 8); }
#undef MOD_LD
#undef MOD_FMA
#pragma unroll
        for (int b = 0; b < 17; ++b) { float v = acc[b].x + acc[b].y; v += shfl_xor_(v, 32, t.lane);
            if (kh == 0) mod[((size_t)layer * 17 + b) * MODLD + n0 + col] = v + a->in[I_MODB][layer * MODLD + n0 + col]; } }
    __syncthreads();
}

template <bool OUT_BF16>
__device__ __forceinline__ void norm_rows(const Tc& t, CArgs a, int layer, int which, int row_begin, int nrows, void* out, bool from_inputs = false) {
    const float* xres = (const float*)(a->ws + WS_XRES);
    const float* mod = (const float*)(a->ws + WS_MOD) + (size_t)layer * 17 * MODLD;
    const int npw = (nrows + t.ngw - 1) / t.ngw;
    f32x4 gg[8], gm[8], sh[8];
    { const f32x4* gp = (const f32x4*)(a->in[I_NORMG] + (size_t)(layer * 2 + which) * D) + t.lane;
#pragma unroll
      for (int j = 0; j < 8; ++j) gg[j] = gp[64 * j]; }
    int cur_idx = -1;
    auto rowptr = [&](int r) -> const f32x4* { const int grow = row_begin + r; const int gb = grow / SROW, gs = grow % SROW;
        const float* rp = from_inputs ? (gs < CTXL ? a->in[I_CTX] + ((size_t)gb * CTXL + gs) * D : a->in[I_X] + ((size_t)gb * SEQ + (gs - CTXL)) * D) : xres + (size_t)grow * D;
        return (const f32x4*)rp + t.lane; };
    const int rfirst = t.gw * npw;
    if (rfirst >= nrows) return;
    const int nmine = (nrows - rfirst) < npw ? (nrows - rfirst) : npw;
    f32x4 xn[8];
    { const f32x4* xr = rowptr(rfirst);
#pragma unroll
      for (int j = 0; j < 8; ++j) xn[j] = xr[64 * j]; }
    for (int i = 0; i < nmine; ++i) { const int r = rfirst + i; const int grow = row_begin + r; const int idx = (grow % SROW) < CTXL ? 16 : grow / SROW;
        f32x4 v[8];
#pragma unroll
        for (int j = 0; j < 8; ++j) v[j] = xn[j];
        if (idx != cur_idx) { cur_idx = idx;
            const f32x4* shp = (const f32x4*)(mod + (size_t)idx * MODLD + (3 * which) * D) + t.lane; const f32x4* scp = (const f32x4*)(mod + (size_t)idx * MODLD + (3 * which + 1) * D) + t.lane;
#pragma unroll
            for (int j = 0; j < 8; ++j) { sh[j] = shp[64 * j]; gm[j] = gg[j] * (scp[64 * j] + 1.0f); } }
        if (i + 1 < nmine) { const f32x4* xr = rowptr(r + 1);
#pragma unroll
            for (int j = 0; j < 8; ++j) xn[j] = xr[64 * j]; }
        asm volatile("" ::: "memory");
        float ss = 0.f;
#pragma unroll
        for (int j = 0; j < 8; ++j) ss += (v[j].x * v[j].x + v[j].y * v[j].y) + (v[j].z * v[j].z + v[j].w * v[j].w);
        const float rstd = rsqrtf(wave_sum_dpp(ss) * (1.0f / D) + 1e-6f);
#pragma unroll
        for (int j = 0; j < 8; ++j) { const f32x4 o = v[j] * rstd * gm[j] + sh[j];
            if (OUT_BF16) { u32x2 w; w.x = pk2(o.x, o.y); w.y = pk2(o.z, o.w); ((u32x2*)((bf16_t*)out + (size_t)r * D))[64 * j + t.lane] = w; }
            else ((f32x4*)((float*)out + (size_t)r * D))[64 * j + t.lane] = o; }
        asm volatile("" ::: "memory");
    }
}

__device__ __forceinline__ void r2_mix(const Tc& t, CArgs a, int jl) {
    const bf16_t* H = (const bf16_t*)(a->ws + WS_ACT + AR_H);
    const int sl = t.gw & 3, c0 = 512 * sl + 8 * t.lane;
    const float* mu = a->in[I_MU] + (size_t)jl * 6 * D + c0;
    f32x4 m0[6], m1[6];
#pragma unroll
    for (int m = 0; m < 6; ++m) { m0[m] = *(const f32x4*)(mu + m * D); m1[m] = *(const f32x4*)(mu + m * D + 4); }
    const int rstep = t.ngw >> 2;
    for (int r0 = t.gw >> 2; r0 < TG; r0 += 4 * rstep) {
        u32x4 hw[4], nw[4];
#pragma unroll
        for (int k = 0; k < 4; ++k) { const int r = r0 + k * rstep; hw[k] = (u32x4){0u, 0u, 0u, 0u}; nw[k] = hw[k];
            if (r < TG) { const int s = r % SROW; int nr;
                if (s < CTXL) nr = sl < 2 ? (s > 0 ? r - 1 : -1) : (s < CTXL - 1 ? r + 1 : -1);
                else { const int i = s - CTXL, gr = i >> 6, gc = i & 63; nr = sl == 0 ? (gc > 0 ? r - 1 : -1) : sl == 1 ? (gc < 63 ? r + 1 : -1) : sl == 2 ? (gr > 0 ? r - 64 : -1) : (gr < 31 ? r + 64 : -1); }
                hw[k] = *(const u32x4*)(H + (size_t)r * D + c0);
                if (nr >= 0) nw[k] = *(const u32x4*)(H + (size_t)nr * D + c0); } }
        asm volatile("" ::: "memory");
#pragma unroll
        for (int k = 0; k < 4; ++k) { const int r = r0 + k * rstep;
            if (r < TG) {
                const f32x4 h0 = {lo_bf(hw[k].x), hi_bf(hw[k].x), lo_bf(hw[k].y), hi_bf(hw[k].y)}, h1 = {lo_bf(hw[k].z), hi_bf(hw[k].z), lo_bf(hw[k].w), hi_bf(hw[k].w)};
                const f32x4 n0 = {lo_bf(nw[k].x), hi_bf(nw[k].x), lo_bf(nw[k].y), hi_bf(nw[k].y)}, n1 = {lo_bf(nw[k].z), hi_bf(nw[k].z), lo_bf(nw[k].w), hi_bf(nw[k].w)};
                const f32x4 x0 = n0 - h0, x1 = n1 - h1;
#pragma unroll
                for (int m = 0; m < 6; ++m) { const f32x4 o0 = h0 + x0 * m0[m], o1 = h1 + x1 * m1[m];
                    u32x4 w; w.x = pk2(o0.x, o0.y); w.y = pk2(o0.z, o0.w); w.z = pk2(o1.x, o1.y); w.w = pk2(o1.z, o1.w);
                    *(u32x4*)(a->ws + WS_ACT + AR_MIX + (size_t)m * SLOT + ((size_t)r * D + c0) * 2) = w; } } }
        asm volatile("" ::: "memory");
    }
}

constexpr int R5_L = 16;
constexpr int R5_ZR = 0, R5_BK = 4608, R5_BKT = 9216, R5_V = 14336, R5_GL = 18432, R5_CH = 18688;
constexpr int R5_BUF = 2 * R5_CH;
constexpr int R5_GR = 2 * R5_BUF;
constexpr int R5_GRCH = 3072;
constexpr int R5_DS = R5_GR + 2 * R5_GRCH;
constexpr int R5_YS = R5_DS + 8 * 1024;
constexpr int R5_PW = R5_YS + 2 * 2 * 4096;
constexpr int R5_END = R5_PW + 4 * 8192 + 512;
static_assert(R5_END <= LDSCTL_OFF, "scan LDS");
__device__ __forceinline__ int r5_seq(int z, int tt) { return z == 0 ? tt : (tt < CTXL ? CTXL - 1 - tt : SROW + CTXL - 1 - tt); }

__device__ __forceinline__ void r5_scan(const Tc& t, CArgs a, int jl, int layer, int g) {
    const bf16_t* R = (const bf16_t*)(a->ws + WS_ACT + AR_R);
    const bf16_t* Kb = (const bf16_t*)(a->ws + WS_ACT + AR_K);
    const bf16_t* Vb = (layer == 0) ? (const bf16_t*)(a->ws + WS_VF) + (size_t)g * TG * D : (const bf16_t*)(a->ws + WS_ACT + AR_V);
    const int w = t.wave, lane = t.lane, c2 = w >> 2, q = w & 3, l15 = lane & 15, q4 = lane >> 4;
    for (int pair = t.bid; pair < BG * RH; pair += t.G) {
        const int z = pair / (BG * RH / 2), bl = (pair / (RH / 2)) % BG, h = 2 * (pair % (RH / 2)) + c2;
        const bf16_t* E = (const bf16_t*)(a->ws + WS_ACT + AR_MIX + (size_t)z * SLOT);
        const bf16_t* Aa = (const bf16_t*)(a->ws + WS_ACT + AR_MIX + (size_t)(2 + z) * SLOT);
        bf16_t* Y = (bf16_t*)(a->ws + WS_ACT + AR_Y + (size_t)z * SLOT);
        float* RKo = (float*)(a->ws + WS_ACT + AR_RK) + (size_t)z * TG * 32;
        const size_t colb = (size_t)h * 64 + lane;
        f32x4 ST[4];
#pragma unroll
        for (int cb = 0; cb < 4; ++cb) ST[cb] = (f32x4){0.f, 0.f, 0.f, 0.f};
        const int pst = q == 0 ? 0 : 6 * (q - 1), npass = q == 0 ? 0 : (q == 3 ? 2 : 3);
        const int hf = lane >> 5, pi = lane & 31;
        unsigned ce[8], pr[3], pk[3], pv[3], pa[3];
        const int sd = z == 0 ? 1 : -1;
        const bf16_t* Eh = E + (size_t)bl * SROW * D + (size_t)h * 64; const bf16_t* Rh = R + (size_t)bl * SROW * D + (size_t)h * 64; const bf16_t* Kh = Kb + (size_t)bl * SROW * D + (size_t)h * 64;
        const bf16_t* Vh = Vb + (size_t)bl * SROW * D + (size_t)h * 64; const bf16_t* Ah = Aa + (size_t)bl * SROW * D + (size_t)h * 64;
        f32x2 kkc2, kac2, rkc2;
        { const size_t c0 = (size_t)jl * D + (size_t)h * 64 + 2 * pi; kkc2 = *(const f32x2*)(a->in[I_KK] + c0); kac2 = *(const f32x2*)(a->in[I_KA] + c0); rkc2 = *(const f32x2*)(a->in[I_RK] + c0); }
        auto prep_load = [&](int n) {
            if (q == 0) return;
            const int s0 = r5_seq(z, n * R5_L); const unsigned rlo = (unsigned)(sd > 0 ? s0 : s0 - 15) * (unsigned)D;
#pragma unroll
            for (int ps = 0; ps < 3; ++ps) if (ps < npass) { const int st = pst + 2 * ps + hf; const unsigned off = rlo + (unsigned)((sd > 0 ? st : 15 - st) * D) + 2u * (unsigned)pi;
                pr[ps] = *(const unsigned*)(Rh + off); pk[ps] = *(const unsigned*)(Kh + off); pv[ps] = *(const unsigned*)(Vh + off); pa[ps] = *(const unsigned*)(Ah + off); }
        };
        auto halfsum = [&](float v) -> float { v = sum16_(v); const float h0 = rl_(v, 0) + rl_(v, 16), h1 = rl_(v, 32) + rl_(v, 48); return hf ? h1 : h0; };
        auto prep_finish = [&](int n) {
            if (q == 0) return;
            LAS unsigned char* cbuf = t.lds + (n & 1) * R5_BUF + c2 * R5_CH;
            LAS bf16_t* ZR = (LAS bf16_t*)(cbuf + R5_ZR); LAS bf16_t* BK = (LAS bf16_t*)(cbuf + R5_BK); LAS bf16_t* BKT = (LAS bf16_t*)(cbuf + R5_BKT);
            LAS float* Vs = (LAS float*)(cbuf + R5_V); LAS float* GL = (LAS float*)(cbuf + R5_GL);
            const LAS f32x2* GT = (const LAS f32x2*)(t.lds + R5_PW + ((n & 1) * 2 + c2) * 8192);
            const LAS f32x2* GI = GT + 512;
            if (q == 3 && hf == 0) *(LAS f32x2*)(GL + 2 * pi) = GT[15 * 32 + pi];
            const int s0 = r5_seq(z, n * R5_L); float rkv[3] = {0.f, 0.f, 0.f};
#pragma unroll
            for (int ps = 0; ps < 3; ++ps) if (ps < npass) { const int st = pst + 2 * ps + hf;
                const f32x2 gt = GT[st * 32 + pi]; const f32x2 gi = {__builtin_amdgcn_rcpf(gt.x), __builtin_amdgcn_rcpf(gt.y)}; f32x2 gp = {1.f, 1.f}; if (st > 0) gp = GT[(st - 1) * 32 + pi];
                const f32x2 r2 = {lo_bf(pr[ps]), hi_bf(pr[ps])}, k2 = {lo_bf(pk[ps]), hi_bf(pk[ps])}, v2 = {lo_bf(pv[ps]), hi_bf(pv[ps])}, a2 = {lo_bf(pa[ps]), hi_bf(pa[ps])};
                f32x2 kk2 = k2 * kkc2; const float n2 = halfsum(kk2.x * kk2.x + kk2.y * kk2.y); kk2 = kk2 * __builtin_amdgcn_rsqf(fmaxf(n2, 1e-24f));
                const f32x2 km2 = k2 * ((a2 - 1.0f) * kac2 + 1.0f);
                const f32x2 rkm = r2 * km2 * rkc2; const float rk = halfsum(rkm.x + rkm.y);
                rkv[ps] = rk;
                const f32x2 zt = kk2 * gp * -1.0f, rt = r2 * gt, bt = kk2 * a2 * gi, kt = km2 * gi;
                const unsigned zw = pk2(zt.x, zt.y), rw = pk2(rt.x, rt.y), bw = pk2(bt.x, bt.y), kw = pk2(kt.x, kt.y);
                *(LAS unsigned*)(ZR + st * 72 + 2 * pi) = zw; *(LAS unsigned*)(ZR + (16 + st) * 72 + 2 * pi) = rw; *(LAS unsigned*)(BK + st * 72 + 2 * pi) = bw; *(LAS unsigned*)(BK + (16 + st) * 72 + 2 * pi) = kw;
                BKT[(2 * pi) * 40 + st] = (bf16_t)(bw & 0xffffu); BKT[(2 * pi + 1) * 40 + st] = (bf16_t)(bw >> 16);
                BKT[(2 * pi) * 40 + 16 + st] = (bf16_t)(kw & 0xffffu); BKT[(2 * pi + 1) * 40 + 16 + st] = (bf16_t)(kw >> 16);
                *(LAS f32x2*)(Vs + st * 64 + 2 * pi) = v2; }
            if (pi == 0) {
#pragma unroll
                for (int ps = 0; ps < 3; ++ps) if (ps < npass) RKo[((size_t)bl * SROW + s0 + sd * (pst + 2 * ps + hf)) * 32 + h] = rkv[ps]; }
        };
        auto cum_load = [&](int m) {
            const int s0 = r5_seq(z, m * R5_L); const unsigned rlo = (unsigned)(sd > 0 ? s0 : s0 - 15) * (unsigned)D;
#pragma unroll
            for (int j = 0; j < 8; ++j) { const int i = 8 * hf + j; ce[j] = *(const unsigned*)(Eh + rlo + (unsigned)((sd > 0 ? i : 15 - i) * D) + 2u * (unsigned)pi); }
        };
        auto cum_finish = [&](int m) {
            LAS f32x2* GT = (LAS f32x2*)(t.lds + R5_PW + ((m & 1) * 2 + c2) * 8192); LAS f32x2* GI = GT + 512;
            LAS f32x2* HB = (LAS f32x2*)(t.lds + R5_PW + 4 * 8192 + c2 * 256);
            f32x2 cs[8]; f32x2 lg = {0.f, 0.f};
#pragma unroll
            for (int j = 0; j < 8; ++j) { lg = lg + (f32x2){lo_bf(ce[j]), hi_bf(ce[j])}; cs[j] = lg; }
            if (hf == 0) HB[pi] = lg;
            asm volatile("s_waitcnt lgkmcnt(0)" ::: "memory");
            f32x2 base = HB[pi]; if (hf == 0) base = (f32x2){0.f, 0.f};
#pragma unroll
            for (int j = 0; j < 8; ++j) { const f32x2 c = cs[j] + base;
                GT[(8 * hf + j) * 32 + pi] = (f32x2){__expf(c.x), __expf(c.y)}; }
        };
        constexpr int NCH = SROW / R5_L;
        if (q == 0) { cum_load(0); cum_finish(0); cum_load(1); cum_finish(1); cum_load(2); } else prep_load(0);
        LDS_BARRIER();
        prep_finish(0); prep_load(1);
        LDS_BARRIER();
        for (int n = 0; n < NCH; ++n) {
            LAS unsigned char* cbuf = t.lds + (n & 1) * R5_BUF + c2 * R5_CH;
            const LAS bf16_t* ZR = (const LAS bf16_t*)(cbuf + R5_ZR); const LAS bf16_t* BK = (const LAS bf16_t*)(cbuf + R5_BK); const LAS bf16_t* BKT = (const LAS bf16_t*)(cbuf + R5_BKT);
            const LAS float* Vs = (const LAS float*)(cbuf + R5_V); const LAS float* GL = (const LAS float*)(cbuf + R5_GL);
            LAS float* Nm = (LAS float*)(t.lds + R5_GR + c2 * R5_GRCH); LAS bf16_t* MKZ = (LAS bf16_t*)(t.lds + R5_GR + c2 * R5_GRCH + 1024); LAS bf16_t* MBK = (LAS bf16_t*)(t.lds + R5_GR + c2 * R5_GRCH + 1536);
            LAS bf16_t* MT = (LAS bf16_t*)(t.lds + R5_GR + c2 * R5_GRCH + 2560);
            { f32x4 gacc = (f32x4){0.f, 0.f, 0.f, 0.f};
#pragma unroll
              for (int ks = 0; ks < 2; ++ks) { const bf16x8 av = *(const LAS bf16x8*)(ZR + ((q & 2) ? 16 + l15 : l15) * 72 + 32 * ks + 8 * q4);
                  const bf16x8 bv = *(const LAS bf16x8*)(BK + ((q & 1) ? 16 + l15 : l15) * 72 + 32 * ks + 8 * q4);
                  gacc = __builtin_amdgcn_mfma_f32_16x16x32_bf16(av, bv, gacc, 0, 0, 0); }
#pragma unroll
              for (int i = 0; i < 4; ++i) { const int tt = 4 * q4 + i, j = l15; const bool keep = (q & 2) ? (j <= tt) : (j < tt); const float val = keep ? gacc[i] : 0.f;
                  if (q == 0) Nm[tt * 16 + j] = val; else if (q == 1) MKZ[tt * 16 + j] = (bf16_t)f2bf(val); else MBK[tt * 32 + (q == 3 ? 16 : 0) + j] = (bf16_t)f2bf(val); }
              if (q == 0) {
                  asm volatile("s_waitcnt lgkmcnt(0)" ::: "memory");
                  float tc[16];
                  tc[0] = (l15 == 0) ? 1.0f : 0.0f;
                  f32x4 nA[12], nB[12];
#define R5_SLOT_A(i, jb) ((i) <= 4 ? (i) - 1 : 4 + 2 * ((i) - 5) + (jb))
#pragma unroll
                  for (int i = 1; i <= 8; ++i)
#pragma unroll
                      for (int jb = 0; 4 * jb < i; ++jb) nA[R5_SLOT_A(i, jb)] = *(const LAS f32x4*)(Nm + i * 16 + 4 * jb);
#pragma unroll
                  for (int i = 9; i <= 12; ++i)
#pragma unroll
                      for (int jb = 0; jb < 3; ++jb) nB[(i - 9) * 3 + jb] = *(const LAS f32x4*)(Nm + i * 16 + 4 * jb);
                  asm volatile("" ::: "memory");
#pragma unroll
                  for (int i = 1; i <= 8; ++i) { float s = (l15 == i) ? 1.0f : 0.0f;
#pragma unroll
                      for (int jb = 0; 4 * jb < i; ++jb) { const f32x4 nv = nA[R5_SLOT_A(i, jb)];
#pragma unroll
                          for (int j = 0; j < 4; ++j) if (4 * jb + j < i) s += nv[j] * tc[4 * jb + j]; }
                      tc[i] = s; }
#pragma unroll
                  for (int i = 13; i <= 15; ++i)
#pragma unroll
                      for (int jb = 0; jb < 4; ++jb) nA[(i - 13) * 4 + jb] = *(const LAS f32x4*)(Nm + i * 16 + 4 * jb);
                  asm volatile("" ::: "memory");
#pragma unroll
                  for (int i = 9; i <= 12; ++i) { float s = (l15 == i) ? 1.0f : 0.0f;
#pragma unroll
                      for (int jb = 0; jb < 3; ++jb) { const f32x4 nv = nB[(i - 9) * 3 + jb];
#pragma unroll
                          for (int j = 0; j < 4; ++j) if (4 * jb + j < i) s += nv[j] * tc[4 * jb + j]; }
                      tc[i] = s; }
#pragma unroll
                  for (int i = 13; i <= 15; ++i) { float s = (l15 == i) ? 1.0f : 0.0f;
#pragma unroll
                      for (int jb = 0; jb < 4; ++jb) { const f32x4 nv = nA[(i - 13) * 4 + jb];
#pragma unroll
                          for (int j = 0; j < 4; ++j) if (4 * jb + j < i) s += nv[j] * tc[4 * jb + j]; }
                      tc[i] = s; }
#undef R5_SLOT_A
#pragma unroll
                  for (int i = 0; i < 4; ++i) { const float v = q4 == 0 ? tc[i] : q4 == 1 ? tc[4 + i] : q4 == 2 ? tc[8 + i] : tc[12 + i];
                      MT[(4 * q4 + i) * 16 + l15] = (bf16_t)f2bf(v); } } }
            if (n + 1 < NCH) prep_finish(n + 1);
            if (n + 2 < NCH) prep_load(n + 2);
            if (q == 0) {
                if (n + 2 < NCH) cum_finish(n + 2);
                if (n + 3 < NCH) cum_load(n + 3); }
            if (q == 3) {
                if (n > 0) { const LAS float* ys = (const LAS float*)(t.lds + R5_YS + ((n - 1) & 1) * 8192 + c2 * 4096);
#pragma unroll
                    for (int tt = 0; tt < 16; ++tt) Y[((size_t)bl * SROW + r5_seq(z, (n - 1) * R5_L) + sd * tt) * D + colb] = (bf16_t)f2bf(ys[tt * 64 + lane]); } }
            LDS_BARRIER();
            {
              f32x4 Pz = (f32x4){0.f, 0.f, 0.f, 0.f}, Pr = Pz;
#pragma unroll
              for (int ks = 0; ks < 2; ++ks) { const f32x4 s0 = ST[2 * ks], s1 = ST[2 * ks + 1];
                  u32x4 p; p.x = pk2(s0[0], s0[1]); p.y = pk2(s0[2], s0[3]); p.z = pk2(s1[0], s1[1]); p.w = pk2(s1[2], s1[3]);
                  const bf16x8 bop = __builtin_bit_cast(bf16x8, p);
                  const LAS bf16_t* zr = ZR + l15 * 72 + 32 * ks + 4 * q4; const LAS bf16_t* rr = ZR + (16 + l15) * 72 + 32 * ks + 4 * q4;
                  const u32x2 z0 = *(const LAS u32x2*)zr, z1 = *(const LAS u32x2*)(zr + 16), r0 = *(const LAS u32x2*)rr, r1 = *(const LAS u32x2*)(rr + 16);
                  Pz = __builtin_amdgcn_mfma_f32_16x16x32_bf16(__builtin_bit_cast(bf16x8, (u32x4){z0.x, z0.y, z1.x, z1.y}), bop, Pz, 0, 0, 0);
                  Pr = __builtin_amdgcn_mfma_f32_16x16x32_bf16(__builtin_bit_cast(bf16x8, (u32x4){r0.x, r0.y, r1.x, r1.y}), bop, Pr, 0, 0, 0); }
              float vd[4];
#pragma unroll
              for (int i = 0; i < 4; ++i) vd[i] = Vs[(4 * q4 + i) * 64 + 16 * q + l15];
              const unsigned vp0 = pk2(vd[0], vd[1]), vp1 = pk2(vd[2], vd[3]);
              { const u32x2 m = *(const LAS u32x2*)(MKZ + l15 * 16 + 4 * q4);
                Pz = __builtin_amdgcn_mfma_f32_16x16x32_bf16(__builtin_bit_cast(bf16x8, (u32x4){m.x, m.y, 0u, 0u}), __builtin_bit_cast(bf16x8, (u32x4){vp0, vp1, 0u, 0u}), Pz, 0, 0, 0); }
              { float x[4];
                { const u32x2 mt = *(const LAS u32x2*)(MT + l15 * 16 + 4 * q4);
                  const f32x4 dv = __builtin_amdgcn_mfma_f32_16x16x32_bf16(__builtin_bit_cast(bf16x8, (u32x4){mt.x, mt.y, 0u, 0u}), __builtin_bit_cast(bf16x8, (u32x4){pk2(Pz[0], Pz[1]), pk2(Pz[2], Pz[3]), 0u, 0u}), (f32x4){0.f, 0.f, 0.f, 0.f}, 0, 0, 0);
                  x[0] = dv[0]; x[1] = dv[1]; x[2] = dv[2]; x[3] = dv[3]; }
                const unsigned dp0 = pk2(x[0], x[1]), dp1 = pk2(x[2], x[3]);
                const bf16x8 bdv = __builtin_bit_cast(bf16x8, (u32x4){dp0, dp1, vp0, vp1});
                { const u32x2 m0 = *(const LAS u32x2*)(MBK + l15 * 32 + 4 * q4), m1 = *(const LAS u32x2*)(MBK + l15 * 32 + 16 + 4 * q4);
                  Pr = __builtin_amdgcn_mfma_f32_16x16x32_bf16(__builtin_bit_cast(bf16x8, (u32x4){m0.x, m0.y, m1.x, m1.y}), bdv, Pr, 0, 0, 0); }
                { LAS float* ys = (LAS float*)(t.lds + R5_YS + (n & 1) * 8192 + c2 * 4096);
#pragma unroll
                  for (int i = 0; i < 4; ++i) ys[(4 * q4 + i) * 64 + 16 * q + l15] = Pr[i]; }
#pragma unroll
                for (int cb = 0; cb < 4; ++cb) { const LAS bf16_t* bt = BKT + (16 * cb + l15) * 40 + 4 * q4;
                    const u32x2 b0 = *(const LAS u32x2*)bt, k0 = *(const LAS u32x2*)(bt + 16);
                    ST[cb] = __builtin_amdgcn_mfma_f32_16x16x32_bf16(__builtin_bit_cast(bf16x8, (u32x4){b0.x, b0.y, k0.x, k0.y}), bdv, ST[cb], 0, 0, 0);
                    const f32x4 gl = *(const LAS f32x4*)(GL + 16 * cb + 4 * q4);
                    ST[cb] = ST[cb] * gl; } } }
            LDS_BARRIER();
        }
        if (q == 3) { const LAS float* ys = (const LAS float*)(t.lds + R5_YS + ((NCH - 1) & 1) * 8192 + c2 * 4096);
#pragma unroll
          for (int tt = 0; tt < 16; ++tt) Y[((size_t)bl * SROW + r5_seq(z, (NCH - 1) * R5_L) + sd * tt) * D + colb] = (bf16_t)f2bf(ys[tt * 64 + lane]); }
        LDS_BARRIER();
    }
}
__device__ __forceinline__ void r6_readout(const Tc& t, CArgs a, int jl, int layer, int g) {
    const bf16_t* Y0 = (const bf16_t*)(a->ws + WS_ACT + AR_Y), *Y1 = (const bf16_t*)(a->ws + WS_ACT + AR_Y + SLOT);
    const float* RK0 = (const float*)(a->ws + WS_ACT + AR_RK), *RK1 = RK0 + (size_t)TG * 32;
    const bf16_t* Vb = (layer == 0) ? (const bf16_t*)(a->ws + WS_VF) + (size_t)g * TG * D : (const bf16_t*)(a->ws + WS_ACT + AR_V);
    const bf16_t* Gb = (const bf16_t*)(a->ws + WS_ACT + AR_MIX + 4 * SLOT);
    bf16_t* Ao = (bf16_t*)(a->ws + WS_ACT + AR_AO) + (size_t)g * TG * D;
    const int sl = t.gw & 3, c0 = 512 * sl + 8 * t.lane, head = c0 >> 6;
    const float* lnw = a->in[I_LNW] + (size_t)jl * D + c0, *lnb = a->in[I_LNB] + (size_t)jl * D + c0;
    const f32x4 lw0 = *(const f32x4*)lnw, lw1 = *(const f32x4*)(lnw + 4), lb0 = *(const f32x4*)lnb, lb1 = *(const f32x4*)(lnb + 4);
    const float lw[8] = {lw0.x, lw0.y, lw0.z, lw0.w, lw1.x, lw1.y, lw1.z, lw1.w}, lb[8] = {lb0.x, lb0.y, lb0.z, lb0.w, lb1.x, lb1.y, lb1.z, lb1.w};
    const int rstep = t.ngw >> 2;
    for (int r0 = t.gw >> 2; r0 < TG; r0 += 2 * rstep) {
        u32x4 y0[2], y1[2], vv[2], gg[2]; float rk[2];
#pragma unroll
        for (int k = 0; k < 2; ++k) { const int r = r0 + k * rstep < TG ? r0 + k * rstep : r0; const size_t off = (size_t)r * D + c0;
            y0[k] = *(const u32x4*)(Y0 + off); y1[k] = *(const u32x4*)(Y1 + off); vv[k] = *(const u32x4*)(Vb + off); gg[k] = *(const u32x4*)(Gb + off);
            rk[k] = RK0[(size_t)r * 32 + head] + RK1[(size_t)r * 32 + head]; }
        asm volatile("" ::: "memory");
#pragma unroll
        for (int k = 0; k < 2; ++k) { const int r = r0 + k * rstep; if (r >= TG) break; const size_t off = (size_t)r * D + c0;
            const unsigned a0[4] = {y0[k].x, y0[k].y, y0[k].z, y0[k].w}, a1[4] = {y1[k].x, y1[k].y, y1[k].z, y1[k].w};
            const unsigned av[4] = {vv[k].x, vv[k].y, vv[k].z, vv[k].w}, ag[4] = {gg[k].x, gg[k].y, gg[k].z, gg[k].w};
            float y[8]; float s = 0.f;
#pragma unroll
            for (int i = 0; i < 4; ++i) { y[2 * i] = lo_bf(a0[i]) + lo_bf(a1[i]); y[2 * i + 1] = hi_bf(a0[i]) + hi_bf(a1[i]); s += y[2 * i] + y[2 * i + 1]; }
            s = sum8_(s);
            const float mean = s * (1.0f / 64.0f);
            float qq = 0.f;
#pragma unroll
            for (int i = 0; i < 8; ++i) { y[i] -= mean; qq += y[i] * y[i]; }
            qq = sum8_(qq);
            const float rstd = rsqrtf(qq * (1.0f / 64.0f) + 64e-5f);
            float o[8];
#pragma unroll
            for (int i = 0; i < 4; ++i) { o[2 * i] = (y[2 * i] * rstd * lw[2 * i] + lb[2 * i] + rk[k] * lo_bf(av[i])) * lo_bf(ag[i]);
                o[2 * i + 1] = (y[2 * i + 1] * rstd * lw[2 * i + 1] + lb[2 * i + 1] + rk[k] * hi_bf(av[i])) * hi_bf(ag[i]); }
            u32x4 w; w.x = pk2(o[0], o[1]); w.y = pk2(o[2], o[3]); w.z = pk2(o[4], o[5]); w.w = pk2(o[6], o[7]);
            *(u32x4*)(Ao + off) = w; }
        asm volatile("" ::: "memory");
    }
}

__device__ __forceinline__ void m3_conv(const Tc& t, CArgs a, int jl) {
    const bf16_t* U = (const bf16_t*)(a->ws + WS_ACT + AM_U);
    bf16_t* QK = (bf16_t*)(a->ws + WS_ACT + AM_QK);
    const int sl = t.gw & 7, c0 = 256 * sl + 4 * t.lane;
    const float* cw = a->in[I_CONVW] + (size_t)jl * 9 * D + c0;
    f32x4 wt[9];
#pragma unroll
    for (int k = 0; k < 9; ++k) wt[k] = *(const f32x4*)(cw + k * D);
    const f32x4 bias = *(const f32x4*)(a->in[I_CONVB] + (size_t)jl * D + c0);
    const float sc = c0 < 1024 ? 0.08838834764831845f : 1.0f;
    for (int row = t.gw >> 3; row < T; row += t.ngw >> 3) { const int s = row % SROW;
        f32x4 acc = bias;
        if (s < CTXL) {
#pragma unroll
            for (int dc = -1; dc <= 1; ++dc) if (s + dc >= 0 && s + dc < CTXL) { const u32x2 u = *(const u32x2*)(U + (size_t)(row + dc) * ULD + c0); const f32x4 w = wt[3 + dc + 1];
                acc.x += lo_bf(u.x) * w.x; acc.y += hi_bf(u.x) * w.y; acc.z += lo_bf(u.y) * w.z; acc.w += hi_bf(u.y) * w.w; }
        } else { const int i = s - CTXL, gr = i >> 6, gc = i & 63;
            u32x2 u[9];
#pragma unroll
            for (int dr = -1; dr <= 1; ++dr)
#pragma unroll
                for (int dc = -1; dc <= 1; ++dc) { const bool ok = (gr + dr >= 0) && (gr + dr < 32) && (gc + dc >= 0) && (gc + dc < 64);
                    u[(dr + 1) * 3 + dc + 1] = ok ? *(const u32x2*)(U + (size_t)(row + dr * 64 + dc) * ULD + c0) : (u32x2){0u, 0u}; }
#pragma unroll
            for (int k = 0; k < 9; ++k) { acc.x += lo_bf(u[k].x) * wt[k].x; acc.y += hi_bf(u[k].x) * wt[k].y; acc.z += lo_bf(u[k].y) * wt[k].z; acc.w += hi_bf(u[k].y) * wt[k].w; }
        }
        u32x2 w; w.x = pk2(siluf_(acc.x) * sc, siluf_(acc.y) * sc); w.y = pk2(siluf_(acc.z) * sc, siluf_(acc.w) * sc);
        *(u32x2*)(QK + (size_t)row * D + c0) = w;
    }
}

template <int CTRL> __device__ __forceinline__ float dppz_(float v) { return __int_as_float(__builtin_amdgcn_update_dpp(0, __float_as_int(v), CTRL, 0xF, 0xF, false)); }
template <int CTRL> __device__ __forceinline__ float dppm_(float v) { return __int_as_float(__builtin_amdgcn_update_dpp((int)0xff800000u, __float_as_int(v), CTRL, 0xF, 0xF, false)); }
constexpr int M4_QS = 136, M4_TS = 72;
constexpr int M4_SQ = 0, M4_SK = 17408, M4_SVT = 34816, M4_SWKT = 71680, M4_SP = 90112, M4_F = 99328;
__device__ __forceinline__ void m4_scan(const Tc& t, CArgs a, bool skip_ctx_out) {
    LAS bf16_t* sQ = (LAS bf16_t*)(t.lds + M4_SQ); LAS bf16_t* sK = (LAS bf16_t*)(t.lds + M4_SK); LAS bf16_t* sVT = (LAS bf16_t*)(t.lds + M4_SVT);
    LAS bf16_t* sWKT = (LAS bf16_t*)(t.lds + M4_SWKT); LAS bf16_t* sP = (LAS bf16_t*)(t.lds + M4_SP);
    LAS float* fI = (LAS float*)(t.lds + M4_F);
    LAS float* fF = fI + 64;
    LAS float* fU = fI + 128;
    LAS float* fG = fI + 192;
    LAS float* fWI = fI + 256;
    LAS float* fEN = fI + 320;
    LAS float* fWS = fI + 384;
    LAS float* fRS = fI + 448;
    LAS float* fQN = fI + 576;
    LAS float* fN = fI + 640;
    LAS float* fSC = fI + 768;
    LAS float* fNP = fI + 832;
    const bf16_t* QK = (const bf16_t*)(a->ws + WS_ACT + AM_QK);
    const bf16_t* U = (const bf16_t*)(a->ws + WS_ACT + AM_U);
    const float* Gt = (const float*)(a->ws + WS_ACT + AM_G);
    const int tid = t.tid, lane = t.lane, w = t.wave, l15 = lane & 15, q4 = lane >> 4;
    for (int chain = t.bid; chain < 2 * NB * MH; chain += t.G) {
        const int z = chain / (NB * MH), b = (chain / MH) % NB, h = chain % MH;
        bf16_t* HZ = (bf16_t*)(a->ws + WS_ACT + (z == 0 ? AM_HB : AM_HZ1));
        f32x4 Cacc[8][2];
#pragma unroll
        for (int db = 0; db < 8; ++db)
#pragma unroll
            for (int e = 0; e < 2; ++e) Cacc[db][e] = (f32x4){0.f, 0.f, 0.f, 0.f};
        float m_old = 0.f;
        if (tid < 128) fN[tid] = 0.f;
        LDS_BARRIER();
        const size_t rowb = (size_t)b * SROW; const int sdir = z == 0 ? 1 : -1;
        u32x4 pq[2], pkk[2], pvv[4]; float pgi = 0.f, pgf = 0.f;
#define M4_LOAD(chn) do { const int t0_ = (chn) * 64; const int sb_ = z == 0 ? t0_ : (t0_ < CTXL ? CTXL - 1 - t0_ : SROW + CTXL - 1 - t0_); \
            _Pragma("unroll") for (int rep = 0; rep < 2; ++rep) { const int cid = tid + 512 * rep, i = cid >> 4, cc = cid & 15; const size_t row = rowb + sb_ + sdir * i; \
                pq[rep] = *(const u32x4*)(QK + row * D + h * MDK + 8 * cc); pkk[rep] = *(const u32x4*)(QK + row * D + 1024 + h * MDK + 8 * cc); } \
            _Pragma("unroll") for (int rep = 0; rep < 4; ++rep) { const int cid = tid + 512 * rep, i = cid & 63, cc = cid >> 6; const size_t row = rowb + sb_ + sdir * i; \
                pvv[rep] = *(const u32x4*)(U + row * ULD + 2048 + h * MDV + 8 * cc); } \
            if (tid < 64) { const size_t row = rowb + sb_ + sdir * tid; pgi = Gt[row * 32 + z * 16 + h]; pgf = Gt[row * 32 + z * 16 + 8 + h]; } } while (0)
        M4_LOAD(0);
        asm volatile("s_waitcnt vmcnt(0)" ::: "memory");
        asm volatile("" : "+v"(pq[0]), "+v"(pq[1]), "+v"(pkk[0]), "+v"(pkk[1]));
        asm volatile("" : "+v"(pvv[0]), "+v"(pvv[1]), "+v"(pvv[2]), "+v"(pvv[3]), "+v"(pgi), "+v"(pgf));
        for (int ch = 0; ch < SROW / 64; ++ch) {
            const int t0 = ch * 64;
            const int sbase = z == 0 ? t0 : (t0 < CTXL ? CTXL - 1 - t0 : SROW + CTXL - 1 - t0);
#pragma unroll
            for (int rep = 0; rep < 2; ++rep) { const int cid = tid + 512 * rep, i = cid >> 4, cc = cid & 15;
                *(LAS u32x4*)(sQ + i * M4_QS + 8 * cc) = pq[rep]; *(LAS u32x4*)(sK + i * M4_QS + 8 * cc) = pkk[rep]; }
#pragma unroll
            for (int rep = 0; rep < 4; ++rep) { const int cid = tid + 512 * rep, i = cid & 63, cc = cid >> 6;
                const unsigned wv[4] = {pvv[rep].x, pvv[rep].y, pvv[rep].z, pvv[rep].w};
#pragma unroll
                for (int jj = 0; jj < 4; ++jj) { sVT[(8 * cc + 2 * jj) * M4_TS + i] = (bf16_t)(wv[jj] & 0xffffu); sVT[(8 * cc + 2 * jj + 1) * M4_TS + i] = (bf16_t)(wv[jj] >> 16); } }
            if (ch > 0 && tid < 128) fN[tid] = fSC[0] * fN[tid] + ((fNP[tid] + fNP[128 + tid]) + (fNP[256 + tid] + fNP[384 + tid]));
            if (tid < 64) { fI[tid] = pgi; fF[tid] = pgf; }
            if (ch + 1 < SROW / 64) M4_LOAD(ch + 1);
            LDS_BARRIER();
            if (w == 0) {
                const float ig = fI[lane], lf = fF[lane];
                float bc = lf;
                bc += dppz_<0x111>(bc); bc += dppz_<0x112>(bc); bc += dppz_<0x114>(bc); bc += dppz_<0x118>(bc);
                { const float t0 = rl_(bc, 15), t1 = rl_(bc, 31), t2 = rl_(bc, 47); bc += (lane >= 16 ? t0 : 0.f) + (lane >= 32 ? t1 : 0.f) + (lane >= 48 ? t2 : 0.f); }
                const float g = ig - bc;
                float pm = g;
                pm = fmaxf(pm, dppm_<0x111>(pm)); pm = fmaxf(pm, dppm_<0x112>(pm)); pm = fmaxf(pm, dppm_<0x114>(pm)); pm = fmaxf(pm, dppm_<0x118>(pm));
                { const float t0 = rl_(pm, 15), t1 = rl_(pm, 31), t2 = rl_(pm, 47); const float ninf = -__builtin_inff();
                  pm = fmaxf(pm, fmaxf(fmaxf(lane >= 16 ? t0 : ninf, lane >= 32 ? t1 : ninf), lane >= 48 ? t2 : ninf)); }
                const float b_end = rl_(bc, 63), pm_all = rl_(pm, 63);
                const float m_new = fmaxf(b_end + m_old, b_end + pm_all);
                const float mx = fmaxf(m_old, pm);
                fU[lane] = -mx; fG[lane] = g; fWI[lane] = __expf(m_old - mx); fEN[lane] = __expf(-mx - bc); fWS[lane] = __expf(b_end + g - m_new);
                if (lane == 0) { fSC[0] = __expf(b_end + m_old - m_new); fSC[1] = m_new; }
            }
            const int tb = w >> 1, jb0 = 2 * (w & 1);
            f32x4 St[2];
#pragma unroll
            for (int jj = 0; jj < 2; ++jj) { St[jj] = (f32x4){0.f, 0.f, 0.f, 0.f};
                if (jb0 + jj <= tb) {
#pragma unroll
                    for (int ks = 0; ks < 4; ++ks) { const bf16x8 av = *(const LAS bf16x8*)(sQ + (16 * tb + l15) * M4_QS + 32 * ks + 8 * q4);
                        const bf16x8 bv = *(const LAS bf16x8*)(sK + (16 * (jb0 + jj) + l15) * M4_QS + 32 * ks + 8 * q4);
                        St[jj] = __builtin_amdgcn_mfma_f32_16x16x32_bf16(av, bv, St[jj], 0, 0, 0); } } }
            LDS_BARRIER();
            { float rs[4] = {0.f, 0.f, 0.f, 0.f};
#pragma unroll
              for (int jj = 0; jj < 2; ++jj) { const int j = 16 * (jb0 + jj) + l15; const float gj = fG[j];
#pragma unroll
                  for (int i = 0; i < 4; ++i) { const int tt = 16 * tb + 4 * q4 + i; const float val = (j <= tt) ? St[jj][i] * __expf(fU[tt] + gj) : 0.f;
                      rs[i] += val; sP[tt * M4_TS + j] = (bf16_t)f2bfa(val); } }
#pragma unroll
              for (int i = 0; i < 4; ++i) { float v = rs[i]; v = sum16_(v);
                  if (l15 == 0) fRS[(w & 1) * 64 + 16 * tb + 4 * q4 + i] = v; } }
            { const int d = tid & 127, jg = tid >> 7; unsigned pk[8]; float nn = 0.f;
#pragma unroll
              for (int jj = 0; jj < 8; ++jj) { const int j0 = 16 * jg + 2 * jj; const float w0 = fWS[j0] * bf2f(sK[j0 * M4_QS + d]), w1 = fWS[j0 + 1] * bf2f(sK[(j0 + 1) * M4_QS + d]);
                  nn += w0 + w1; pk[jj] = pk2a(w0, w1); }
              fNP[jg * 128 + d] = nn;
              *(LAS u32x4*)(sWKT + d * M4_TS + 16 * jg) = (u32x4){pk[0], pk[1], pk[2], pk[3]};
              *(LAS u32x4*)(sWKT + d * M4_TS + 16 * jg + 8) = (u32x4){pk[4], pk[5], pk[6], pk[7]}; }
            { const int tt = tid >> 3, dp = tid & 7; float s = 0.f;
#pragma unroll
              for (int dd = 0; dd < 16; ++dd) s += bf2f(sQ[tt * M4_QS + 16 * dp + dd]) * fN[16 * dp + dd];
              s = sum8_(s);
              if (dp == 0) fQN[tt] = s; }
            LDS_BARRIER();
            asm volatile("s_waitcnt vmcnt(0)" ::: "memory");
            asm volatile("" : "+v"(pq[0]), "+v"(pq[1]), "+v"(pkk[0]), "+v"(pkk[1]));
            asm volatile("" : "+v"(pvv[0]), "+v"(pvv[1]), "+v"(pvv[2]), "+v"(pvv[3]), "+v"(pgi), "+v"(pgf));
#pragma unroll 1
            for (int x = (skip_ctx_out && t0 < CTXL) ? 4 : 0; x < 4; ++x) {
                f32x4 acc[2];
                acc[0] = (f32x4){0.f, 0.f, 0.f, 0.f}; acc[1] = (f32x4){0.f, 0.f, 0.f, 0.f};
#pragma unroll
                for (int kb = 0; kb < 4; ++kb) {
                    const LAS bf16_t* qr = sQ + (16 * x + l15) * M4_QS + 32 * kb + 4 * q4;
                    const u32x2 lo = *(const LAS u32x2*)qr, hi = *(const LAS u32x2*)(qr + 16);
                    const bf16x8 aop = __builtin_bit_cast(bf16x8, (u32x4){lo.x, lo.y, hi.x, hi.y});
#pragma unroll
                    for (int e = 0; e < 2; ++e) { const f32x4 c0 = Cacc[2 * kb][e], c1 = Cacc[2 * kb + 1][e];
                        u32x4 p; p.x = pk2a(c0[0], c0[1]); p.y = pk2a(c0[2], c0[3]); p.z = pk2a(c1[0], c1[1]); p.w = pk2a(c1[2], c1[3]);
                        acc[e] = __builtin_amdgcn_mfma_f32_16x16x32_bf16(aop, __builtin_bit_cast(bf16x8, p), acc[e], 0, 0, 0); } }
                { const f32x4 wi = *(const LAS f32x4*)(fWI + 16 * x + 4 * q4); acc[0] = acc[0] * wi; acc[1] = acc[1] * wi; }
#pragma unroll
                for (int ks = 0; ks < 2; ++ks) { const bf16x8 aop = *(const LAS bf16x8*)(sP + (16 * x + l15) * M4_TS + 32 * ks + 8 * q4);
#pragma unroll
                    for (int e = 0; e < 2; ++e) { const bf16x8 bop = *(const LAS bf16x8*)(sVT + (16 * (2 * w + e) + l15) * M4_TS + 32 * ks + 8 * q4);
                        acc[e] = __builtin_amdgcn_mfma_f32_16x16x32_bf16(aop, bop, acc[e], 0, 0, 0); } }
#pragma unroll
                for (int i = 0; i < 4; ++i) { const int tt = 16 * x + 4 * q4 + i;
                    const float den = fWI[tt] * fQN[tt] + fRS[tt] + fRS[64 + tt]; const float dv = __builtin_amdgcn_rcpf(fmaxf(fabsf(den), fEN[tt]));
                    const size_t row = rowb + sbase + sdir * tt;
#pragma unroll
                    for (int e = 0; e < 2; ++e) HZ[row * D + h * MDV + 16 * (2 * w + e) + l15] = (bf16_t)f2bfa(acc[e][i] * dv); }
            }
            { const float dec = fSC[0];
#pragma unroll
              for (int db = 0; db < 8; ++db)
#pragma unroll
                  for (int e = 0; e < 2; ++e) Cacc[db][e] = Cacc[db][e] * dec;
#pragma unroll
              for (int ks = 0; ks < 2; ++ks) {
                  bf16x8 bop[2];
#pragma unroll
                  for (int e = 0; e < 2; ++e) bop[e] = *(const LAS bf16x8*)(sVT + (16 * (2 * w + e) + l15) * M4_TS + 32 * ks + 8 * q4);
#pragma unroll
                  for (int db = 0; db < 8; ++db) { const bf16x8 aop = *(const LAS bf16x8*)(sWKT + (16 * db + l15) * M4_TS + 32 * ks + 8 * q4);
#pragma unroll
                      for (int e = 0; e < 2; ++e) Cacc[db][e] = __builtin_amdgcn_mfma_f32_16x16x32_bf16(aop, bop[e], Cacc[db][e], 0, 0, 0); } }
 }
            m_old = fSC[1];
            LDS_BARRIER();
        }
#undef M4_LOAD
    }
}

__device__ __forceinline__ void m5_readout(const Tc& t, CArgs a, int jl) {
    const bf16_t* H0 = (const bf16_t*)(a->ws + WS_ACT + AM_HB), *H1 = (const bf16_t*)(a->ws + WS_ACT + AM_HZ1);
    const bf16_t* U = (const bf16_t*)(a->ws + WS_ACT + AM_U);
    bf16_t* Ao = (bf16_t*)(a->ws + WS_ACT + AM_QK);
    const int sl = t.gw & 3, c0 = 512 * sl + 8 * t.lane;
    const float* nw = a->in[I_MNORMW] + (size_t)jl * D + c0;
    const f32x4 w0 = *(const f32x4*)nw, w1 = *(const f32x4*)(nw + 4);
    const float w8[8] = {w0.x, w0.y, w0.z, w0.w, w1.x, w1.y, w1.z, w1.w};
    const int rstep = t.ngw >> 2;
    for (int r0 = t.gw >> 2; r0 < T; r0 += 4 * rstep) {
        u32x4 h0[4], h1[4], ov[4];
#pragma unroll
        for (int k = 0; k < 4; ++k) { const int row = r0 + k * rstep < T ? r0 + k * rstep : r0; const size_t off = (size_t)row * D + c0;
            h0[k] = *(const u32x4*)(H0 + off); h1[k] = *(const u32x4*)(H1 + off); ov[k] = *(const u32x4*)(U + (size_t)row * ULD + 4096 + c0); }
        asm volatile("" ::: "memory");
#pragma unroll
        for (int k = 0; k < 4; ++k) { const int row = r0 + k * rstep; if (row >= T) break; const size_t off = (size_t)row * D + c0;
            const unsigned a0[4] = {h0[k].x, h0[k].y, h0[k].z, h0[k].w}, a1[4] = {h1[k].x, h1[k].y, h1[k].z, h1[k].w}, ao[4] = {ov[k].x, ov[k].y, ov[k].z, ov[k].w};
            float y[8]; float s = 0.f;
#pragma unroll
            for (int i = 0; i < 4; ++i) { y[2 * i] = lo_bf(a0[i]) + lo_bf(a1[i]); y[2 * i + 1] = hi_bf(a0[i]) + hi_bf(a1[i]); s += y[2 * i] + y[2 * i + 1]; }
            s = sum16_(s); s += shfl_xor_(s, 16, t.lane);
            const float mean = s * (1.0f / 256.0f);
            float qq = 0.f;
#pragma unroll
            for (int i = 0; i < 8; ++i) { y[i] -= mean; qq += y[i] * y[i]; }
            qq = sum16_(qq); qq += shfl_xor_(qq, 16, t.lane);
            const float rstd = rsqrtf(qq * (1.0f / 256.0f) + 1e-6f);
            float o[8];
#pragma unroll
            for (int i = 0; i < 4; ++i) { o[2 * i] = y[2 * i] * rstd * w8[2 * i] * sigmoidf_(lo_bf(ao[i])); o[2 * i + 1] = y[2 * i + 1] * rstd * w8[2 * i + 1] * sigmoidf_(hi_bf(ao[i])); }
            u32x4 wv; wv.x = pk2(o[0], o[1]); wv.y = pk2(o[2], o[3]); wv.z = pk2(o[4], o[5]); wv.w = pk2(o[6], o[7]);
            *(u32x4*)(Ao + off) = wv; }
        asm volatile("" ::: "memory");
    }
}

__device__ __forceinline__ void final_norm(const Tc& t, CArgs a) {
    const float* xres = (const float*)(a->ws + WS_XRES);
    f32x4 gg[8];
    { const f32x4* gp = (const f32x4*)a->in[I_FINALG] + t.lane;
#pragma unroll
      for (int j = 0; j < 8; ++j) gg[j] = gp[64 * j]; }
    for (int r0 = t.gw; r0 < NB * SEQ; r0 += 2 * t.ngw) {
        f32x4 v[2][8];
#pragma unroll
        for (int k = 0; k < 2; ++k) { const int r = r0 + k * t.ngw < NB * SEQ ? r0 + k * t.ngw : r0; const size_t row = (size_t)(r / SEQ) * SROW + CTXL + (r % SEQ);
            const f32x4* xr = (const f32x4*)(xres + row * D) + t.lane;
#pragma unroll
            for (int j = 0; j < 8; ++j) v[k][j] = xr[64 * j]; }
        asm volatile("" ::: "memory");
#pragma unroll
        for (int k = 0; k < 2; ++k) { const int r = r0 + k * t.ngw; if (r >= NB * SEQ) break;
            float ss = 0.f;
#pragma unroll
            for (int j = 0; j < 8; ++j) ss += (v[k][j].x * v[k][j].x + v[k][j].y * v[k][j].y) + (v[k][j].z * v[k][j].z + v[k][j].w * v[k][j].w);
            const float rstd = rsqrtf(wave_sum_dpp(ss) * (1.0f / D) + 1e-6f);
            f32x4* o = (f32x4*)(a->out + (size_t)r * D) + t.lane;
#pragma unroll
            for (int j = 0; j < 8; ++j) o[64 * j] = v[k][j] * rstd * gg[j]; }
        asm volatile("" ::: "memory");
    }
}
constexpr int NU_FULL = (T / 256) * (D / 256), NU_SKIP = (T / 9 * 8 / 256) * (D / 256);
constexpr int NSEG = 1 + 2 * (12 + 1 + 3) + 2 * (6 + 3) + 1;

__global__ void __launch_bounds__(512, 2) hybrid_fwd(Args args) {
    extern __shared__ __attribute__((aligned(16))) unsigned char lds_raw[];
    LAS unsigned char* const lds = (LAS unsigned char*)lds_raw;
    volatile LAS unsigned* MISC = (volatile LAS unsigned*)(lds + LDSCTL_OFF);
    if (threadIdx.x < 64) MISC[threadIdx.x] = 0u;
    __syncthreads();
    const int lo = args.ph_lo, hi = args.ph_hi;
    const bool fused = (hi - lo) > 1;
    unsigned* barw = (unsigned*)(args.ws + WS_CTL) + 4096;
    XcdBarrier bar; bar.bar = barw; bar.x = 0; bar.st = MISC + 8;
    if (fused) bar = xcd_barrier_post(barw, MISC + 8);
    int seg = 0;
    int urot = 0;
#define ACTIVE (seg >= lo && seg < hi)
#define PH_BEGIN const Tc t = mk_tc(lds); const CArgs a = opaque_args(); unsigned char* const act = a->ws + WS_ACT; (void)act; (void)t;
#define SEAM() do { if (fused && seg >= lo && seg + 1 < hi) xcd_barrier(bar); ++seg; } while (0)

    if (ACTIVE) { PH_BEGIN ph_prologue(t, a); }
    SEAM();
    for (int layer = 0; layer < 4; ++layer) {
        const int jl = layer >> 1;
        if ((layer & 1) == 0) {
            for (int g = 0; g < NGRP; ++g) {
                if (ACTIVE) { PH_BEGIN if (g == 0 && layer == 0) convert_rwkv(t, a, 0);
                    norm_rows<true>(t, a, layer, 0, g * TG, TG, act + AR_H, layer == 0); }
                SEAM();
                if (ACTIVE) { PH_BEGIN r2_mix(t, a, jl); }
                SEAM();
                if (ACTIVE) {
                    PH_BEGIN const bf16_t* wm = (const bf16_t*)(a->ws + WS_WMIX);
                    bf16_t* vdst = (layer == 0) ? (bf16_t*)(a->ws + WS_VF) + (size_t)g * TG * D : (bf16_t*)(act + AR_V);
                    const bf16_t* mix[6];
#pragma unroll
                    for (int m = 0; m < 6; ++m) mix[m] = (const bf16_t*)(act + AR_MIX + (size_t)m * SLOT);
                    for (int q = 0; q < 7; ++q) {
                        if (q == 6 && jl == 0) break;
                        const bf16_t* A = q == 0 ? mix[0] : q == 1 ? mix[2] : q == 2 ? mix[3] : q == 3 ? mix[1] : q == 4 ? mix[4] : q == 5 ? mix[5] : mix[3];
                        const size_t wo = q == 0 ? WM_R : q == 1 ? WM_K : q == 2 ? WM_V : q == 3 ? WM_W1 : q == 4 ? WM_A1 : q == 5 ? WM_G1 : WM_V1;
                        bf16_t* O = q == 0 ? (bf16_t*)(act + AR_R) : q == 1 ? (bf16_t*)(act + AR_K) : q == 2 ? vdst : (bf16_t*)(act + AR_LORA + (size_t)(q - 3) * 9 * MiB);
                        const int N = q < 3 ? D : 256; const int actf = q == 3 ? 1 : q == 5 ? 2 : 0;
                        pg8::EpiStore E{O, N, actf, 0, 0, -1, nullptr, nullptr};
                        run_gemm(t.lds, A, (const bf16_t*)((const char*)wm + wo), TG, N, D, E, urot);
                    }
                }
                SEAM();
                if (ACTIVE) {
                    PH_BEGIN const bf16_t* wm = (const bf16_t*)(a->ws + WS_WMIX);
                    const bf16_t* lora = (const bf16_t*)(act + AR_LORA);
                    for (int q = 0; q < 2; ++q) {
                        pg8::EpiSigAff E{(bf16_t*)(act + AR_MIX + (size_t)(2 * q) * SLOT), (size_t)TG * D, a->in[q == 0 ? I_W0 : I_A0] + (size_t)jl * 2 * D, q == 0 ? -0.6065306597126334f : 1.0f};
                        run_gemm(t.lds, lora + (size_t)q * TG * 256, (const bf16_t*)((const char*)wm + (q == 0 ? WM_W2 : WM_A2)), TG, 2 * D, 256, E, urot);
                    }
                    { pg8::EpiStore E{(bf16_t*)(act + AR_MIX + 4 * SLOT), D, 0, 0, 0, -1, nullptr, nullptr};
                      run_gemm(t.lds, lora + (size_t)2 * TG * 256, (const bf16_t*)((const char*)wm + WM_G2), TG, D, 256, E, urot); }
                    if (jl > 0) { pg8::EpiVmix E{(bf16_t*)(act + AR_V), (const bf16_t*)(a->ws + WS_VF) + (size_t)g * TG * D, a->in[I_V0] + (size_t)(jl - 1) * D};
                      run_gemm(t.lds, lora + (size_t)3 * TG * 256, (const bf16_t*)((const char*)wm + WM_V2), TG, D, 256, E, urot); }
                }
                SEAM();
                if (ACTIVE) { PH_BEGIN r5_scan(t, a, jl, layer, g); }
                SEAM();
                if (ACTIVE) { PH_BEGIN r6_readout(t, a, jl, layer, g); }
                SEAM();
            }
            if (ACTIVE) { PH_BEGIN pg8::EpiResid E{(float*)(a->ws + WS_XRES), (const float*)(a->ws + WS_MOD) + (size_t)layer * 17 * MODLD + 2 * D, 0, layer == 0 ? a->in[I_X] : nullptr, a->in[I_CTX]};
                run_gemm(t.lds, (const bf16_t*)(act + AR_AO), (const bf16_t*)(a->ws + WS_WMIX + WM_O), T, D, D, E, urot);
                { const Tc t2 = mk_tc(lds); const CArgs a2 = opaque_args(); Tc ts; if (tail_crew(t2, urot - NU_FULL, NU_FULL, ts)) { __syncthreads(); convert_ffn_out(ts, a2, layer); if (layer == 0) convert_ffn_in(ts, a2, 0); } } }
            SEAM();
        } else {
            if (ACTIVE) { PH_BEGIN norm_rows<true>(t, a, layer, 0, 0, T, act + AM_HB); }
            SEAM();
            if (ACTIVE) { PH_BEGIN pg8::EpiStore E{(bf16_t*)(act + AM_U), ULD, 0, 0, 0, 24, (float*)(act + AM_G), a->in[I_BGATE] + (size_t)jl * 32};
                run_gemm(t.lds, (const bf16_t*)(act + AM_HB), (const bf16_t*)(a->ws + WS_WMIX + WM_MIN), T, 6400, D, E, urot); }
            SEAM();
            if (ACTIVE) { PH_BEGIN m3_conv(t, a, jl); }
            SEAM();
            if (ACTIVE) { PH_BEGIN m4_scan(t, a, layer == 3); }
            SEAM();
            if (ACTIVE) { PH_BEGIN m5_readout(t, a, jl); }
            SEAM();
            if (ACTIVE) { PH_BEGIN pg8::EpiResid E{(float*)(a->ws + WS_XRES), (const float*)(a->ws + WS_MOD) + (size_t)layer * 17 * MODLD + 2 * D, 0, nullptr, nullptr};
                if (layer == 3) run_gemm<pg8::EpiResid, true>(t.lds, (const bf16_t*)(act + AM_QK), (const bf16_t*)(a->ws + WS_WMIX + WM_MOUT), T, D, D, E, urot);
                else run_gemm(t.lds, (const bf16_t*)(act + AM_QK), (const bf16_t*)(a->ws + WS_WMIX + WM_MOUT), T, D, D, E, urot);
                { const Tc t2 = mk_tc(lds); const CArgs a2 = opaque_args(); Tc ts; const int nu = layer == 3 ? NU_SKIP : NU_FULL; if (tail_crew(t2, urot - nu, nu, ts)) { __syncthreads(); convert_ffn_out(ts, a2, layer); } } }
            SEAM();
        }
        if (ACTIVE) { PH_BEGIN norm_rows<true>(t, a, layer, 1, 0, T, act + AF_H2); }
        SEAM();
        if (ACTIVE) { PH_BEGIN pg8::EpiSwiglu E{(bf16_t*)(act + AF_U)};
            if (layer == 3) run_gemm<pg8::EpiSwiglu, true>(t.lds, (const bf16_t*)(act + AF_H2), (const bf16_t*)(a->ws + WS_WFFN + WF_IN), T, 2 * DFF, D, E, urot);
            else run_gemm(t.lds, (const bf16_t*)(act + AF_H2), (const bf16_t*)(a->ws + WS_WFFN + WF_IN), T, 2 * DFF, D, E, urot); }
        SEAM();
        if (ACTIVE) { PH_BEGIN pg8::EpiResid E{(float*)(a->ws + WS_XRES), (const float*)(a->ws + WS_MOD) + (size_t)layer * 17 * MODLD + 5 * D, 0, nullptr, nullptr};
            if (layer == 3) run_gemm<pg8::EpiResid, true>(t.lds, (const bf16_t*)(act + AF_U), (const bf16_t*)(a->ws + WS_WFFN + WF_OUT), T, D, DFF, E, urot);
            else run_gemm(t.lds, (const bf16_t*)(act + AF_U), (const bf16_t*)(a->ws + WS_WFFN + WF_OUT), T, D, DFF, E, urot);
            if (layer < 3) { const Tc t2 = mk_tc(lds); const CArgs a2 = opaque_args(); Tc ts; if (tail_crew(t2, urot - NU_FULL, NU_FULL, ts)) { __syncthreads();
                if (layer & 1) convert_rwkv(ts, a2, (layer + 1) >> 1); else convert_mlstm(ts, a2, (layer + 1) >> 1);
                convert_ffn_in(ts, a2, layer + 1); } } }
        SEAM();
    }
    if (ACTIVE) { PH_BEGIN final_norm(t, a); }
#undef ACTIVE
#undef SEAM
#undef PH_BEGIN
}

#ifndef MK_MULTI
#define MK_MULTI 0
#endif
extern "C" void kernel_launch(void* const* d_in, const int* in_sizes, int n_in, void* d_out, int out_size, void* d_ws, size_t ws_size, hipStream_t stream) {
    static int grid = 0;
    if (grid == 0) {
        if (n_in != NIN || ws_size < WS_END) { fprintf(stderr, "kernel_launch: unexpected n_in %d / ws %zu\n", n_in, ws_size); grid = -1; return; }
        int dev = 0, cus = 0, per_cu = 0;
        if (hipGetDevice(&dev) != hipSuccess || hipDeviceGetAttribute(&cus, hipDeviceAttributeMultiprocessorCount, dev) != hipSuccess) { grid = -1; return; }
        if (hipFuncSetAttribute((const void*)hybrid_fwd, hipFuncAttributeMaxDynamicSharedMemorySize, LDS_BYTES) != hipSuccess) { fprintf(stderr, "kernel_launch: hipFuncSetAttribute failed\n"); grid = -1; return; }
        if (hipOccupancyMaxActiveBlocksPerMultiprocessor(&per_cu, (const void*)hybrid_fwd, 512, LDS_BYTES) != hipSuccess || per_cu < 1)
            fprintf(stderr, "kernel_launch: occupancy query reports %d workgroups per CU\n", per_cu);
        (void)hipGetLastError();
        grid = cus;
    }
    if (grid < 0) return;
    if (hipMemsetAsync((char*)d_ws + WS_CTL, 0, CTL_ZERO_BYTES, stream) != hipSuccess) return;
    Args a{};
    for (int i = 0; i < NIN; ++i) a.in[i] = (const float*)d_in[i];
    a.out = (float*)d_out; a.ws = (unsigned char*)d_ws;
#if MK_MULTI
    for (int s = 0; s < NSEG; ++s) { a.ph_lo = s; a.ph_hi = s + 1; hipLaunchKernelGGL(hybrid_fwd, dim3(grid), dim3(512), LDS_BYTES, stream, a); }
#else
    a.ph_lo = 0; a.ph_hi = NSEG;
    hipLaunchKernelGGL(hybrid_fwd, dim3(grid), dim3(512), LDS_BYTES, stream, a);
#endif
}
```

```cpp
#include <hip/hip_runtime.h>
#include <cstdio>
#include <cstdint>

#define LAS __attribute__((address_space(3)))
#define GAS __attribute__((address_space(1)))
typedef unsigned short bf16_t;
typedef short bf16x8 __attribute__((ext_vector_type(8)));
typedef short bf16x4 __attribute__((ext_vector_type(4)));
typedef float f32x4 __attribute__((ext_vector_type(4)));
typedef float f32x2 __attribute__((ext_vector_type(2)));
typedef unsigned u32x4 __attribute__((ext_vector_type(4)));
typedef unsigned u32x2 __attribute__((ext_vector_type(2)));
#define LDS_WAIT() asm volatile("s_waitcnt lgkmcnt(0)" ::: "memory")
#define LDS_BARRIER() asm volatile("s_waitcnt lgkmcnt(0)\n\ts_barrier" ::: "memory")
#define VM_WAIT() asm volatile("s_waitcnt vmcnt(0)" ::: "memory")

constexpr int D = 2048, NB = 16, SEQ = 2048, CTXL = 256, SROW = 2304, T = NB * SROW;
constexpr int NGRP = 2, BG = 8, TG = BG * SROW;
constexpr int DFF = 5632;
constexpr int RH = 32;
constexpr int MH = 8, MDV = 256, MDK = 128, MPROJ = 6176, ULD = 6144;
constexpr int MODLD = 6 * D;
constexpr int NIN = 37;
enum { I_X = 0, I_C, I_CTX, I_CCTX, I_MODW, I_MODB, I_NORMG, I_FINALG, I_MU, I_WR, I_WK, I_WV, I_WO, I_W0, I_W1, I_W2, I_A0, I_A1, I_A2, I_G1, I_G2, I_KK, I_KA, I_RK, I_LNW, I_LNB,
       I_V0, I_V1, I_V2, I_MWIN, I_BGATE, I_CONVW, I_CONVB, I_MNORMW, I_MWOUT, I_FWIN, I_FWOUT };

constexpr size_t MiB = 1u << 20;
constexpr size_t WS_CTL = 0, CTL_ZERO_BYTES = 1 * MiB;
constexpr size_t WS_MOD = 1 * MiB;
constexpr size_t WS_XRES = 5 * MiB;
constexpr size_t WS_VF = 293 * MiB;
constexpr size_t WS_WMIX = 437 * MiB;
constexpr size_t WS_WFFN = 479 * MiB;
constexpr size_t WS_ACT = 545 * MiB;
constexpr size_t WS_END = WS_ACT + 977 * MiB;
static_assert(WS_END <= (size_t)1536 * MiB, "ws");
constexpr size_t WM_R = 0, WM_K = 8 * MiB, WM_V = 16 * MiB, WM_O = 24 * MiB, WM_W1 = 32 * MiB, WM_A1 = 33 * MiB, WM_G1 = 34 * MiB, WM_V1 = 35 * MiB,
                 WM_W2 = 36 * MiB, WM_A2 = 38 * MiB, WM_G2 = 40 * MiB, WM_V2 = 41 * MiB;
constexpr size_t WM_MIN = 0, WM_MOUT = 25 * MiB;
constexpr size_t WF_IN = 0, WF_OUT = 44 * MiB;
constexpr size_t SLOT = 72 * MiB;
constexpr size_t AR_MIX = 0;
constexpr size_t AR_H = 432 * MiB;
constexpr size_t AR_R = 432 * MiB, AR_K = 504 * MiB, AR_V = 576 * MiB;
constexpr size_t AR_LORA = 648 * MiB;
constexpr size_t AR_Y = 684 * MiB;
constexpr size_t AR_RK = 828 * MiB;
constexpr size_t AR_AO = 833 * MiB;
constexpr size_t AM_HB = 0, AM_U = 144 * MiB, AM_QK = 576 * MiB, AM_HZ1 = 720 * MiB, AM_G = 864 * MiB;
constexpr size_t AF_H2 = 0, AF_U = 144 * MiB;

constexpr int LDS_BYTES = 147456;
constexpr int LDSCTL_OFF = LDS_BYTES - 256;

__device__ __forceinline__ float bf2f(bf16_t b) { return __uint_as_float(((unsigned)b) << 16); }
typedef __bf16 bf16x2n_t __attribute__((ext_vector_type(2)));
__device__ __forceinline__ unsigned pk2(float lo, float hi) { const f32x2 v = {lo, hi}; return __builtin_bit_cast(unsigned, __builtin_convertvector(v, bf16x2n_t)); }
__device__ __forceinline__ unsigned f2bf(float f) { return pk2(f, f) & 0xffffu; }
__device__ __forceinline__ unsigned pk2a(float lo, float hi) { unsigned r; asm("v_cvt_pk_bf16_f32 %0, %1, %2" : "=v"(r) : "v"(lo), "v"(hi)); return r; }
__device__ __forceinline__ unsigned f2bfa(float f) { return pk2a(f, f) & 0xffffu; }
__device__ __forceinline__ float lo_bf(unsigned w) { return __uint_as_float(w << 16); }
__device__ __forceinline__ float hi_bf(unsigned w) { return __uint_as_float(w & 0xffff0000u); }
__device__ __forceinline__ float sigmoidf_(float x) { return __builtin_amdgcn_rcpf(1.0f + __expf(-x)); }
__device__ __forceinline__ float tanhf_(float x) { return 1.0f - 2.0f * __builtin_amdgcn_rcpf(1.0f + __expf(2.0f * x)); }
__device__ __forceinline__ float siluf_(float x) { return x * __builtin_amdgcn_rcpf(1.0f + __expf(-x)); }
template <int CTRL> __device__ __forceinline__ float dpp_(float v) { return __int_as_float(__builtin_amdgcn_update_dpp(0, __float_as_int(v), CTRL, 0xF, 0xF, true)); }
__device__ __forceinline__ float rl_(float v, int k) { return __int_as_float(__builtin_amdgcn_readlane(__float_as_int(v), k)); }
__device__ __forceinline__ float sum8_(float v) { v += dpp_<0xB1>(v); v += dpp_<0x4E>(v); v += dpp_<0x141>(v); return v; }
__device__ __forceinline__ float sum16_(float v) { v = sum8_(v); v += dpp_<0x140>(v); return v; }
__device__ __forceinline__ float wave_sum_dpp(float v) { v = sum16_(v); return (rl_(v, 0) + rl_(v, 16)) + (rl_(v, 32) + rl_(v, 48)); }
__device__ __forceinline__ float wave_sum(float v) { return wave_sum_dpp(v); }
__device__ __forceinline__ float shfl_xor_(float v, int mask, int lane) { return __int_as_float(__builtin_amdgcn_ds_bpermute((lane ^ mask) << 2, __float_as_int(v))); }

#define XB_TMO      128
#define XB_XCNT(j)  (256  + 64 * (j))
#define XB_XSUB(j)  (1280 + 64 * (j))
#define XB_XGEN(j)  (2304 + 64 * (j))
#define XB_TOP      3328
#define XB_TOPGEN   3392
#define XCD_BAR_WORDS 3456
#define XB_SPIN_CAP (1u << 24)

__device__ __forceinline__ unsigned xb_ld(unsigned* p)              { return __hip_atomic_load(p, __ATOMIC_RELAXED, __HIP_MEMORY_SCOPE_AGENT); }
__device__ __forceinline__ unsigned xb_add(unsigned* p, unsigned v) { return __hip_atomic_fetch_add(p, v, __ATOMIC_RELAXED, __HIP_MEMORY_SCOPE_AGENT); }
__device__ __forceinline__ unsigned xb_xcc_id() { return (unsigned)__builtin_amdgcn_s_getreg((3 << 11) | 20) & 0xFu; }
#define XB_SPIN(cond, bar) do { unsigned _sp = 0; while (cond) { __builtin_amdgcn_s_sleep(1); \
    if ((++_sp & 255u) == 0u) { if (xb_ld(&(bar)[XB_TMO])) break; if (_sp > XB_SPIN_CAP) { atomicAdd(&(bar)[XB_TMO], 1u); break; } } } } while (0)

struct XcdBarrier { unsigned* bar; unsigned x; volatile LAS unsigned* st; };

__device__ __forceinline__ XcdBarrier xcd_barrier_post(unsigned* bar, volatile LAS unsigned* st) {
    XcdBarrier b; b.bar = bar; b.x = xb_xcc_id(); b.st = st;
    if (threadIdx.x == 0) (void)xb_add(&bar[XB_XCNT(b.x)], 1u);
    return b;
}
__device__ __forceinline__ void xcd_barrier_complete(unsigned* bar, unsigned x, unsigned& nloc, unsigned& nx) {
    const unsigned G = gridDim.x * gridDim.y * gridDim.z;
    unsigned sum, cnt, mine, sp = 0u;
    for (;;) {
        sum = 0u; cnt = 0u; mine = 0u;
#pragma unroll
        for (unsigned j = 0; j < 16; ++j) { const unsigned c = xb_ld(&bar[XB_XCNT(j)]); sum += c; cnt += (c > 0u) ? 1u : 0u; mine = (j == x) ? c : mine; }
        if (sum == G) break;
        __builtin_amdgcn_s_sleep(1);
        if ((++sp & 255u) == 0u) { if (xb_ld(&bar[XB_TMO])) break; if (sp > XB_SPIN_CAP) { atomicAdd(&bar[XB_TMO], 1u); break; } }
    }
    nloc = mine > 0u ? mine : 1u; nx = cnt > 0u ? cnt : 1u;
}
__device__ __forceinline__ void xcd_barrier(const XcdBarrier& b) {
    asm volatile("s_waitcnt vmcnt(0)" ::: "memory");
    __syncthreads();
    if (threadIdx.x == 0) {
        unsigned* bar = b.bar;
        __builtin_amdgcn_s_waitcnt(0);
        unsigned nloc = b.st[0], nx = b.st[1];
        if (nloc == 0u) { xcd_barrier_complete(bar, b.x, nloc, nx); b.st[0] = nloc; b.st[1] = nx; }
        const unsigned old = xb_add(&bar[XB_XSUB(b.x)], 1u);
        const unsigned gen = old / nloc;
        if (old + 1u == (gen + 1u) * nloc) {
            __builtin_amdgcn_fence(__ATOMIC_RELEASE, "agent");
            asm volatile("s_waitcnt vmcnt(0)" ::: "memory");
            const unsigned og = xb_add(&bar[XB_TOP], 1u);
            const unsigned tg = og / nx;
            if (og + 1u == (tg + 1u) * nx) xb_add(&bar[XB_TOPGEN], 1u);
            else XB_SPIN(xb_ld(&bar[XB_TOPGEN]) == tg, bar);
            __builtin_amdgcn_fence(__ATOMIC_ACQUIRE, "agent");
            xb_add(&bar[XB_XGEN(b.x)], 1u);
            asm volatile("s_waitcnt vmcnt(0)" ::: "memory");
        } else {
            XB_SPIN(xb_ld(&bar[XB_XGEN(b.x)]) == gen, bar);
            __builtin_amdgcn_fence(__ATOMIC_ACQUIRE, "agent");
            asm volatile("s_waitcnt vmcnt(0)" ::: "memory");
        }
    }
    __syncthreads();
}
#ifndef GP_ALIGN
#define GP_ALIGN true
#endif
#ifndef GP_SP2
#define GP_SP2 true
#endif
namespace pg8 {
constexpr int BM = 256, BK = 64, HALF = 128, HTB = HALF * BK * 2  , STAGE_BYTES = 8 * HTB, NXCD = 8, WGM = 8;

__host__ __device__ __forceinline__ int lds_byte(int r, int c) { const int st = (r >> 4) * 2 + (c >> 5), rr = r & 15, cc = c & 31, ob = rr * 64 + cc * 2; return st * 1024 + (ob ^ (((ob >> 9) & 1) << 5)); }
__host__ __device__ __forceinline__ void stage_rc(int b, int& R, int& C) { const int st = b / 1024, sb = b % 1024, swz = sb ^ (((sb >> 9) & 1) << 5); R = (st >> 1) * 16 + swz / 64; C = (st & 1) * 32 + (swz % 64) / 2; }
__host__ __device__ __forceinline__ int perm32(int rho) { const int n = rho >> 4, i = rho & 15; return 8 * (i >> 2) + 4 * n + (i & 3); }

struct Unit { int pm, pn; };
struct Gemm { const bf16_t* A; const bf16_t* Bt; int M, N, K; };

struct StaticOrder {
    int nM, nN, nwg, G, c;
    __host__ __device__ void init(int M, int N, int G_, int c_) { nM = M / BM; nN = N / BM; nwg = nM * nN; G = G_; c = c_; }
    __host__ __device__ bool next(int i, Unit& u) const {
        const long L = (long)i * G + c; if (L >= nwg) return false;
        int wgid = (int)L; { const int q = nwg / NXCD, r = nwg % NXCD, xcd = wgid % NXCD, off = wgid / NXCD; wgid = (xcd < r ? xcd * (q + 1) : r * (q + 1) + (xcd - r) * q) + off; }
        const int nig = WGM * nN, gid = wgid / nig, fm = gid * WGM, gsz = (nM - fm) < WGM ? (nM - fm) : WGM;
        u.pm = fm + ((wgid % nig) % gsz); u.pn = (wgid % nig) / gsz; return true;
    }
    __device__ __forceinline__ void a_ready(const Unit&) const {}
    __device__ __forceinline__ void done(const Unit&) const {}
};
__device__ __forceinline__ unsigned cvt_pk_bf16(float lo, float hi) { unsigned r; asm volatile("v_cvt_pk_bf16_f32 %0, %1, %2" : "=v"(r) : "v"(lo), "v"(hi)); return r; }
template <class Epi, class Sched, bool ALIGN_EPI = false, bool SP2 = false>
__device__ __forceinline__ void gemm_phase(LAS unsigned char* lds, const Gemm g, const Sched& S, const Epi& E) {
    int tid_ = threadIdx.x; asm volatile("" : "+v"(tid_));
    const int tid = tid_, wid = __builtin_amdgcn_readfirstlane(tid >> 6), lane = tid & 63, wr = wid >> 2, wc = wid & 3, fr = lane & 15, fq = lane >> 4;
    const int K = g.K, nt = K / BK;
    unsigned voffA[2], voffB[2];
#pragma unroll
    for (int i = 0; i < 2; ++i) { int R, C; stage_rc(tid * 16 + i * 8192, R, C); const int Rb = Epi::PERM ? ((R & ~31) + perm32(R & 31)) : R;
        voffA[i] = (unsigned)(R * K + C) * 2u; voffB[i] = (unsigned)(Rb * K + C) * 2u; }
    const size_t kstep = (size_t)(BK * 2);
    const size_t hstep = (size_t)HALF * K * 2;
    const size_t tstep = 2 * hstep;
    const unsigned ldsw = (unsigned)wid * 1024u;
    const int aoff = lds_byte(wr * 64 + fr, fq * 8), boff = lds_byte(wc * 32 + fr, fq * 8);
#define PG8_SA(b, h) (((b) * 2 + (h)) * HTB)
#define PG8_SB(b, h) ((4 + (b) * 2 + (h)) * HTB)
#define PG8_STAGE(bufoff, gbase, voff) do { _Pragma("unroll") for (int _i = 0; _i < 2; ++_i) \
        __builtin_amdgcn_global_load_lds((const unsigned*)((const char*)(gbase) + (voff)[_i]), (LAS unsigned*)(lds + (bufoff) + ldsw + _i * 8192), 16, 0, 0); } while (0)
#define PG8_LDA(dst, b, h) do { _Pragma("unroll") for (int m = 0; m < 4; ++m) _Pragma("unroll") for (int k = 0; k < 2; ++k) dst[m][k] = *(const LAS bf16x8*)(lds + PG8_SA(b, h) + aoff + m * 2048 + k * 1024); } while (0)
#define PG8_LDB(dst, b, h) do { _Pragma("unroll") for (int n = 0; n < 2; ++n) _Pragma("unroll") for (int k = 0; k < 2; ++k) dst[n][k] = *(const LAS bf16x8*)(lds + PG8_SB(b, h) + boff + n * 2048 + k * 1024); } while (0)
#define PG8_MMA(ai, bj, At, Bt) do { __builtin_amdgcn_s_setprio(1); _Pragma("unroll") for (int m = 0; m < 4; ++m) _Pragma("unroll") for (int n = 0; n < 2; ++n) _Pragma("unroll") for (int k = 0; k < 2; ++k) \
        acc[ai][bj][m][n] = __builtin_amdgcn_mfma_f32_16x16x32_bf16(Bt[n][k], At[m][k], acc[ai][bj][m][n], 0, 0, 0); __builtin_amdgcn_s_setprio(0); } while (0)
#define PG8_WAIT_V(n) asm volatile("s_waitcnt vmcnt(" #n ")" ::: "memory")
#define PG8_WAIT_L(n) asm volatile("s_waitcnt lgkmcnt(" #n ")" ::: "memory")
#define PG8_BAR __builtin_amdgcn_s_barrier()
#define PG8_SCHED __builtin_amdgcn_sched_barrier(0)
    Unit cur, nxt; int ui = 0;
    if (!S.next(0, cur)) return;
    f32x4 acc[2][2][4][2];
#pragma unroll
    for (int a = 0; a < 2; ++a)
#pragma unroll
        for (int b = 0; b < 2; ++b)
#pragma unroll
            for (int m = 0; m < 4; ++m)
#pragma unroll
                for (int n = 0; n < 2; ++n) acc[a][b][m][n] = (f32x4){0.f, 0.f, 0.f, 0.f};
    bf16x8 At[4][2], B0[2][2], B1[2][2];
    const char* cA = (const char*)g.A + (size_t)cur.pm * tstep; const char* cB = (const char*)g.Bt + (size_t)cur.pn * tstep;
    S.a_ready(cur);
    if constexpr (SP2) {
        PG8_STAGE(PG8_SB(0, 0), cB, voffB); PG8_STAGE(PG8_SB(0, 1), cB + hstep, voffB); PG8_STAGE(PG8_SA(0, 0), cA, voffA); PG8_STAGE(PG8_SA(0, 1), cA + hstep, voffA);
        if (wr == 1) PG8_BAR;
        PG8_WAIT_V(2); PG8_BAR;
        PG8_STAGE(PG8_SB(1, 0), cB + kstep, voffB); PG8_STAGE(PG8_SA(1, 0), cA + kstep, voffA); PG8_STAGE(PG8_SB(1, 1), cB + hstep + kstep, voffB);
        PG8_WAIT_V(6); PG8_BAR;
    } else {
        PG8_STAGE(PG8_SB(0, 0), cB, voffB); PG8_STAGE(PG8_SA(0, 0), cA, voffA); PG8_STAGE(PG8_SB(0, 1), cB + hstep, voffB); PG8_STAGE(PG8_SA(0, 1), cA + hstep, voffA);
        if (wr == 1) PG8_BAR;
        PG8_WAIT_V(4); PG8_BAR;
        PG8_STAGE(PG8_SB(1, 0), cB + kstep, voffB); PG8_STAGE(PG8_SA(1, 0), cA + kstep, voffA); PG8_STAGE(PG8_SB(1, 1), cB + hstep + kstep, voffB);
        PG8_WAIT_V(6); PG8_BAR;
    }
    for (;;) {
        const bool has_next = S.next(ui + 1, nxt);
        const char* nA = has_next ? (const char*)g.A + (size_t)nxt.pm * tstep : cA; const char* nB = has_next ? (const char*)g.Bt + (size_t)nxt.pn * tstep : cB;
#pragma unroll 1
        for (int t = 0; t < nt; t += 2) {
            const bool last = (t == nt - 2);
            const char* a1 = cA + (size_t)(t + 1) * kstep;
            const char* a2 = last ? nA : cA + (size_t)(t + 2) * kstep; const char* b2 = last ? nB : cB + (size_t)(t + 2) * kstep;
            const char* a3 = a2 + kstep; const char* b3 = b2 + kstep;
            if (last && has_next) S.a_ready(nxt);
            if constexpr (SP2) {
            PG8_LDB(B0, 0, 0); PG8_LDB(B1, 0, 1); PG8_SCHED; PG8_LDA(At, 0, 0); PG8_STAGE(PG8_SA(1, 1), a1 + hstep, voffA);
            PG8_WAIT_V(8); PG8_WAIT_L(0); PG8_BAR; PG8_MMA(0, 0, At, B0); PG8_MMA(0, 1, At, B1); PG8_BAR; PG8_SCHED;
            PG8_LDA(At, 0, 1); PG8_STAGE(PG8_SB(0, 0), b2, voffB); PG8_STAGE(PG8_SB(0, 1), b2 + hstep, voffB); PG8_STAGE(PG8_SA(0, 0), a2, voffA);
            PG8_WAIT_V(8); PG8_WAIT_L(0); PG8_BAR; PG8_MMA(1, 0, At, B0); PG8_MMA(1, 1, At, B1); PG8_BAR; PG8_SCHED;
            PG8_LDB(B0, 1, 0); PG8_LDB(B1, 1, 1); PG8_SCHED; PG8_LDA(At, 1, 0); PG8_STAGE(PG8_SA(0, 1), a2 + hstep, voffA);
            PG8_WAIT_V(8); PG8_WAIT_L(0); PG8_BAR; PG8_MMA(0, 0, At, B0); PG8_MMA(0, 1, At, B1); PG8_BAR; PG8_SCHED;
            PG8_LDA(At, 1, 1); PG8_STAGE(PG8_SB(1, 0), b3, voffB); PG8_STAGE(PG8_SB(1, 1), b3 + hstep, voffB); PG8_STAGE(PG8_SA(1, 0), a3, voffA);
            PG8_WAIT_V(8); PG8_WAIT_L(0); PG8_BAR; PG8_MMA(1, 0, At, B0); PG8_MMA(1, 1, At, B1); PG8_BAR; PG8_SCHED;
            } else {
            PG8_LDB(B0, 0, 0); PG8_SCHED; PG8_LDA(At, 0, 0); PG8_STAGE(PG8_SA(1, 1), a1 + hstep, voffA);
            PG8_WAIT_L(8); PG8_BAR; PG8_WAIT_L(0); PG8_MMA(0, 0, At, B0); PG8_BAR; PG8_SCHED;
            PG8_LDB(B1, 0, 1); PG8_STAGE(PG8_SB(0, 0), b2, voffB);
            PG8_BAR; PG8_WAIT_L(0); PG8_MMA(0, 1, At, B1); PG8_BAR;
            PG8_LDA(At, 0, 1); PG8_STAGE(PG8_SA(0, 0), a2, voffA);
            PG8_BAR; PG8_WAIT_L(0); PG8_MMA(1, 0, At, B0); PG8_BAR; PG8_SCHED;
            PG8_STAGE(PG8_SB(0, 1), b2 + hstep, voffB);
            PG8_WAIT_V(6); PG8_BAR; PG8_MMA(1, 1, At, B1); PG8_BAR;
            PG8_LDB(B0, 1, 0); PG8_SCHED; PG8_LDA(At, 1, 0); PG8_STAGE(PG8_SA(0, 1), a2 + hstep, voffA);
            PG8_WAIT_L(8); PG8_BAR; PG8_WAIT_L(0); PG8_MMA(0, 0, At, B0); PG8_BAR; PG8_SCHED;
            PG8_LDB(B1, 1, 1); PG8_STAGE(PG8_SB(1, 0), b3, voffB);
            PG8_BAR; PG8_WAIT_L(0); PG8_MMA(0, 1, At, B1); PG8_BAR;
            PG8_LDA(At, 1, 1); PG8_STAGE(PG8_SA(1, 0), a3, voffA);
            PG8_BAR; PG8_WAIT_L(0); PG8_MMA(1, 0, At, B0); PG8_BAR; PG8_SCHED;
            PG8_STAGE(PG8_SB(1, 1), b3 + hstep, voffB);
            PG8_WAIT_V(6); PG8_BAR; PG8_MMA(1, 1, At, B1); PG8_BAR;
            }
        }
        if constexpr (ALIGN_EPI) { if (wr == 0) PG8_BAR; }
        if constexpr (!Epi::AFTER_DRAIN) { E(acc, cur, wr, wc, fr, fq); S.done(cur); }
        if (!has_next) break;
#pragma unroll
        for (int a = 0; a < 2; ++a)
#pragma unroll
            for (int b = 0; b < 2; ++b)
#pragma unroll
                for (int m = 0; m < 4; ++m)
#pragma unroll
                    for (int n = 0; n < 2; ++n) acc[a][b][m][n] = (f32x4){0.f, 0.f, 0.f, 0.f};
        cur = nxt; cA = nA; cB = nB; ++ui;
        if constexpr (ALIGN_EPI) { if (wr == 1) PG8_BAR; }
    }
    PG8_WAIT_V(0);
    if constexpr (!ALIGN_EPI) { if (wr == 0) PG8_BAR; }
    PG8_BAR;
    if constexpr (Epi::AFTER_DRAIN) { E.fused(acc, cur, wr, wc, fr, fq, lds, wid, lane); S.done(cur); }
#undef PG8_SA
#undef PG8_SB
#undef PG8_STAGE
#undef PG8_LDA
#undef PG8_LDB
#undef PG8_MMA
#undef PG8_WAIT_V
#undef PG8_WAIT_L
#undef PG8_BAR
#undef PG8_SCHED
}
}
namespace pg8 {
typedef const f32x4 (&AccRef)[2][2][4][2];

struct EpiStore {
    static constexpr bool PERM = true, AFTER_DRAIN = false;
    bf16_t* O; int ldc; int act; int split_cols; size_t split_stride; int gate_pn; float* G; const float* bgate;
    __device__ __forceinline__ void operator()(AccRef acc, const Unit& u, int wr, int wc, int fr, int fq) const {
        const int row0 = u.pm * BM + wr * 64 + fr;
        if (u.pn == gate_pn) {
            if (wc == 0) {
#pragma unroll
                for (int n = 0; n < 2; ++n) {
                    const int c0 = 8 * fq + 4 * n;
                    const f32x4 bg = *(const f32x4*)(bgate + c0);
                    const bool isf = (c0 & 8) != 0;
#pragma unroll
                    for (int ai = 0; ai < 2; ++ai)
#pragma unroll
                        for (int m = 0; m < 4; ++m) {
                            f32x4 v = acc[ai][0][m][n] + bg, o;
#pragma unroll
                            for (int j = 0; j < 4; ++j) { const float cpd = 15.0f * tanhf_(v[j] * (1.0f / 15.0f)); const float eu = __expf(-cpd); o[j] = isf ? -(eu < 9.765625e-4f ? eu - 0.5f * eu * eu : __logf(1.0f + eu)) : cpd; }
                            *(f32x4*)(G + (size_t)(row0 + ai * HALF + m * 16) * 32 + c0) = o;
                        }
                }
            }
            return;
        }
        int colt = u.pn * BM; bf16_t* base = O;
        if (split_cols) { const int t = colt / split_cols; base += (size_t)t * split_stride; colt -= t * split_cols; }
        const int col0 = colt + wc * 32 + 8 * fq;
#pragma unroll
        for (int ai = 0; ai < 2; ++ai)
#pragma unroll
            for (int m = 0; m < 4; ++m) { bf16_t* rowp = base + (size_t)(row0 + ai * HALF + m * 16) * ldc + col0;
#pragma unroll
                for (int bj = 0; bj < 2; ++bj) { f32x4 v0 = acc[ai][bj][m][0], v1 = acc[ai][bj][m][1];
                    if (act == 1) {
#pragma unroll
                        for (int j = 0; j < 4; ++j) { v0[j] = tanhf_(v0[j]); v1[j] = tanhf_(v1[j]); } }
                    else if (act == 2) {
#pragma unroll
                        for (int j = 0; j < 4; ++j) { v0[j] = sigmoidf_(v0[j]); v1[j] = sigmoidf_(v1[j]); } }
                    u32x4 w; w.x = cvt_pk_bf16(v0[0], v0[1]); w.y = cvt_pk_bf16(v0[2], v0[3]); w.z = cvt_pk_bf16(v1[0], v1[1]); w.w = cvt_pk_bf16(v1[2], v1[3]);
                    *(u32x4*)(rowp + bj * HALF) = w; } }
    }
};

struct EpiSigAff {
    static constexpr bool PERM = true, AFTER_DRAIN = false;
    bf16_t* O; size_t split_stride; const float* bias; float scale;
    __device__ __forceinline__ void operator()(AccRef acc, const Unit& u, int wr, int wc, int fr, int fq) const {
        const int row0 = u.pm * BM + wr * 64 + fr;
        int colt = u.pn * BM; const int t = colt / D; bf16_t* base = O + (size_t)t * split_stride; colt -= t * D;
        const int col0 = colt + wc * 32 + 8 * fq, bcol0 = u.pn * BM + wc * 32 + 8 * fq;
        f32x4 bv[2][2];
#pragma unroll
        for (int bj = 0; bj < 2; ++bj)
#pragma unroll
            for (int n = 0; n < 2; ++n) bv[bj][n] = *(const f32x4*)(bias + bcol0 + bj * HALF + 4 * n);
#pragma unroll
        for (int ai = 0; ai < 2; ++ai)
#pragma unroll
            for (int m = 0; m < 4; ++m) { bf16_t* rowp = base + (size_t)(row0 + ai * HALF + m * 16) * D + col0;
#pragma unroll
                for (int bj = 0; bj < 2; ++bj) { f32x4 v0 = acc[ai][bj][m][0] + bv[bj][0], v1 = acc[ai][bj][m][1] + bv[bj][1];
#pragma unroll
                    for (int j = 0; j < 4; ++j) { v0[j] = scale * sigmoidf_(v0[j]); v1[j] = scale * sigmoidf_(v1[j]); }
                    u32x4 w; w.x = cvt_pk_bf16(v0[0], v0[1]); w.y = cvt_pk_bf16(v0[2], v0[3]); w.z = cvt_pk_bf16(v1[0], v1[1]); w.w = cvt_pk_bf16(v1[2], v1[3]);
                    *(u32x4*)(rowp + bj * HALF) = w; } }
    }
};

struct EpiVmix {
    static constexpr bool PERM = true, AFTER_DRAIN = false;
    bf16_t* V; const bf16_t* VF; const float* v0;
    __device__ __forceinline__ void operator()(AccRef acc, const Unit& u, int wr, int wc, int fr, int fq) const {
        const int row0 = u.pm * BM + wr * 64 + fr; const int col0 = u.pn * BM + wc * 32 + 8 * fq;
        f32x4 bv[2][2];
#pragma unroll
        for (int bj = 0; bj < 2; ++bj)
#pragma unroll
            for (int n = 0; n < 2; ++n) bv[bj][n] = *(const f32x4*)(v0 + col0 + bj * HALF + 4 * n);
#pragma unroll
        for (int ai = 0; ai < 2; ++ai) {
            u32x4 vvs[4][2], ffs[4][2];
#pragma unroll
            for (int m = 0; m < 4; ++m) { const size_t off = (size_t)(row0 + ai * HALF + m * 16) * D + col0;
#pragma unroll
                for (int bj = 0; bj < 2; ++bj) { vvs[m][bj] = *(const u32x4*)(V + off + bj * HALF); ffs[m][bj] = *(const u32x4*)(VF + off + bj * HALF); } }
            asm volatile("" ::: "memory");
#pragma unroll
            for (int m = 0; m < 4; ++m) { const size_t off = (size_t)(row0 + ai * HALF + m * 16) * D + col0;
#pragma unroll
                for (int bj = 0; bj < 2; ++bj) {
                    const u32x4 vv = vvs[m][bj], ff = ffs[m][bj];
                    const f32x4 a0 = acc[ai][bj][m][0] + bv[bj][0], a1 = acc[ai][bj][m][1] + bv[bj][1];
                    float o[8];
#pragma unroll
                    for (int j = 0; j < 4; ++j) {
                        const unsigned vw = j == 0 ? vv.x : j == 1 ? vv.y : j == 2 ? vv.z : vv.w, fw = j == 0 ? ff.x : j == 1 ? ff.y : j == 2 ? ff.z : ff.w;
                        const float s0 = sigmoidf_(j < 2 ? a0[2 * j] : a1[2 * j - 4]), s1 = sigmoidf_(j < 2 ? a0[2 * j + 1] : a1[2 * j - 3]);
                        const float x0 = lo_bf(vw), x1 = hi_bf(vw), f0 = lo_bf(fw), f1 = hi_bf(fw);
                        o[2 * j] = x0 + (f0 - x0) * s0; o[2 * j + 1] = x1 + (f1 - x1) * s1; }
                    u32x4 w; w.x = cvt_pk_bf16(o[0], o[1]); w.y = cvt_pk_bf16(o[2], o[3]); w.z = cvt_pk_bf16(o[4], o[5]); w.w = cvt_pk_bf16(o[6], o[7]);
                    *(u32x4*)(V + off + bj * HALF) = w; } }
            asm volatile("" ::: "memory"); }
    }
};

struct EpiResid {
    static constexpr bool PERM = false, AFTER_DRAIN = false;
    float* X; const float* gate; int tile0; const float* srcx; const float* srcc;
    __device__ __forceinline__ void operator()(AccRef acc, const Unit& u, int wr, int wc, int fr, int fq) const {
        const int gpm = tile0 + u.pm; const int b = gpm / 9, tix = gpm % 9; const int idx = (tix == 0) ? 16 : b;
        const int rloc = wr * 64 + fr, col0 = u.pn * BM + wc * 32 + 4 * fq;
        const float* src = srcx ? (tix == 0 ? srcc + (size_t)b * CTXL * D : srcx + ((size_t)b * SEQ + (size_t)(tix - 1) * BM) * D) : X + (size_t)gpm * BM * D;
        float* dst = X + (size_t)gpm * BM * D;
        f32x4 gv[2][2];
#pragma unroll
        for (int bj = 0; bj < 2; ++bj)
#pragma unroll
            for (int n = 0; n < 2; ++n) gv[bj][n] = *(const f32x4*)(gate + (size_t)idx * MODLD + col0 + bj * HALF + n * 16);
        f32x4 (&ac)[2][2][4][2] = const_cast<f32x4 (&)[2][2][4][2]>(acc);
        f32x4 xa[2][2], xb[2][2];
#define RES_LD(dstv, ai_, m_) do { const size_t off_ = (size_t)(rloc + (ai_) * HALF + (m_) * 16) * D + col0; _Pragma("unroll") for (int bj = 0; bj < 2; ++bj) _Pragma("unroll") for (int n = 0; n < 2; ++n) \
            dstv[bj][n] = *(const f32x4*)(src + off_ + bj * HALF + n * 16); } while (0)
#define RES_FMA(srcv, ai_, m_) do { _Pragma("unroll") for (int bj = 0; bj < 2; ++bj) _Pragma("unroll") for (int n = 0; n < 2; ++n) ac[ai_][bj][m_][n] = srcv[bj][n] + gv[bj][n] * ac[ai_][bj][m_][n]; } while (0)
        RES_LD(xa, 0, 0); RES_LD(xb, 0, 1);
        RES_FMA(xa, 0, 0); RES_LD(xa, 0, 2); RES_FMA(xb, 0, 1); RES_LD(xb, 0, 3);
        RES_FMA(xa, 0, 2); RES_LD(xa, 1, 0); RES_FMA(xb, 0, 3); RES_LD(xb, 1, 1);
        RES_FMA(xa, 1, 0); RES_LD(xa, 1, 2); RES_FMA(xb, 1, 1); RES_LD(xb, 1, 3);
        RES_FMA(xa, 1, 2); RES_FMA(xb, 1, 3);
#undef RES_LD
#undef RES_FMA
        asm volatile("" ::: "memory");
#pragma unroll
        for (int ai = 0; ai < 2; ++ai)
#pragma unroll
            for (int m = 0; m < 4; ++m) { const size_t off = (size_t)(rloc + ai * HALF + m * 16) * D + col0;
#pragma unroll
                for (int bj = 0; bj < 2; ++bj)
#pragma unroll
                    for (int n = 0; n < 2; ++n) *(f32x4*)(dst + off + bj * HALF + n * 16) = ac[ai][bj][m][n]; }
    }
};

struct EpiSwiglu {
    static constexpr bool PERM = true, AFTER_DRAIN = false;
    bf16_t* O;
    __device__ __forceinline__ void operator()(AccRef acc, const Unit& u, int wr, int wc, int fr, int fq) const {
        const int row0 = u.pm * BM + wr * 64 + fr; const int col0 = u.pn * HALF + wc * 32 + 8 * fq;
#pragma unroll
        for (int ai = 0; ai < 2; ++ai)
#pragma unroll
            for (int m = 0; m < 4; ++m) { bf16_t* rowp = O + (size_t)(row0 + ai * HALF + m * 16) * DFF + col0;
                f32x4 v0, v1;
#pragma unroll
                for (int j = 0; j < 4; ++j) { v0[j] = siluf_(acc[ai][0][m][0][j]) * acc[ai][1][m][0][j]; v1[j] = siluf_(acc[ai][0][m][1][j]) * acc[ai][1][m][1][j]; }
                u32x4 w; w.x = cvt_pk_bf16(v0[0], v0[1]); w.y = cvt_pk_bf16(v0[2], v0[3]); w.z = cvt_pk_bf16(v1[0], v1[1]); w.w = cvt_pk_bf16(v1[2], v1[3]);
                *(u32x4*)rowp = w; }
    }
};
}

namespace pg8 {
struct SkipCtxOrder : StaticOrder {
    __device__ __forceinline__ bool next(int i, Unit& u) const { if (!StaticOrder::next(i, u)) return false; u.pm = u.pm + (u.pm >> 3) + 1; return true; }
};
}
namespace pg8 {
struct CtxOnlyOrder : StaticOrder {
    __device__ __forceinline__ bool next(int i, Unit& u) const { if (!StaticOrder::next(i, u)) return false; u.pm = u.pm * 9; return true; }
};
}
template <class Epi>
__device__ __forceinline__ void run_gemm_ctx(LAS unsigned char* lds, const bf16_t* A, const bf16_t* Bt, int M, int N, int K, const Epi& E, int& urot) {
    pg8::Gemm g{A, Bt, M, N, K};
    const int G = (int)gridDim.x; const int Meff = M / 9; const int nwg = (Meff / 256) * (N / 256);
    const int c = ((int)blockIdx.x + G - (urot % G)) % G;
    pg8::CtxOnlyOrder S; S.init(Meff, N, G, c); pg8::gemm_phase<Epi, pg8::CtxOnlyOrder, GP_ALIGN, GP_SP2>(lds, g, S, E);
    urot += nwg;
}
template <class Epi, bool SKIPCTX = false>
__device__ __forceinline__ void run_gemm(LAS unsigned char* lds, const bf16_t* A, const bf16_t* Bt, int M, int N, int K, const Epi& E, int& urot) {
    pg8::Gemm g{A, Bt, M, N, K};
    const int G = (int)gridDim.x; const int Meff = SKIPCTX ? (M / 9) * 8 : M; const int nwg = (Meff / 256) * (N / 256);
    const int c = ((int)blockIdx.x + G - (urot % G)) % G;
    if constexpr (SKIPCTX) { pg8::SkipCtxOrder S; S.init(Meff, N, G, c); pg8::gemm_phase<Epi, pg8::SkipCtxOrder, GP_ALIGN, GP_SP2>(lds, g, S, E); }
    else { pg8::StaticOrder S; S.init(M, N, G, c); pg8::gemm_phase<Epi, pg8::StaticOrder, GP_ALIGN, GP_SP2>(lds, g, S, E); }
    urot += nwg;
}
struct Args { const float* in[NIN]; float* out; unsigned char* ws; int ph_lo, ph_hi; };
static_assert(sizeof(Args) == NIN * 8 + 8 + 8 + 8, "Args has no padding");

typedef const __attribute__((address_space(4))) Args* CArgs;
__device__ __forceinline__ CArgs opaque_args() { CArgs p = (CArgs)__builtin_amdgcn_kernarg_segment_ptr(); asm volatile("" : "+s"(p)); return p; }
struct Tc { LAS unsigned char* lds; int tid, lane, wave, bid, G, gw, ngw; };
__device__ __forceinline__ Tc mk_tc(LAS unsigned char* lds) { Tc t; int tid = threadIdx.x; asm volatile("" : "+v"(tid)); t.lds = lds; t.tid = tid; t.lane = tid & 63; t.wave = __builtin_amdgcn_readfirstlane(tid >> 6);
    t.bid = blockIdx.x; t.G = gridDim.x; t.gw = t.bid * 8 + t.wave; t.ngw = t.G * 8; return t; }

template <class RM>
__device__ __forceinline__ void tr_item(const float* W, int ldw, bf16_t* WT, int ldk, const RM& rm, LAS float* scr, int kb, int nb, int lane) {
    const int k0 = 64 * kb, n0 = 32 * nb;
    float tmp[32];
#pragma unroll
    for (int i = 0; i < 32; ++i) { const int kk = 2 * i + (lane >> 5); tmp[i] = W[(size_t)(k0 + kk) * ldw + n0 + (lane & 31)]; }
    asm volatile("" ::: "memory");
#pragma unroll
    for (int i = 0; i < 32; ++i) { const int kk = 2 * i + (lane >> 5); scr[kk * 33 + (lane & 31)] = tmp[i]; }
    LDS_WAIT();
    const int c = lane & 7;
#pragma unroll
    for (int j = 0; j < 4; ++j) { const int n = (lane >> 3) + 8 * j; const LAS float* s = scr + (8 * c) * 33 + n;
        u32x4 o; o.x = pk2(s[0 * 33], s[1 * 33]); o.y = pk2(s[2 * 33], s[3 * 33]); o.z = pk2(s[4 * 33], s[5 * 33]); o.w = pk2(s[6 * 33], s[7 * 33]);
        *(u32x4*)(WT + (size_t)rm(n0 + n) * ldk + k0 + 8 * c) = o; }
    LDS_WAIT();
}
struct RmId { __device__ __forceinline__ int operator()(int n) const { return n; } };
struct RmSwiglu { __device__ __forceinline__ int operator()(int n) const { const int up = n >= DFF ? 1 : 0; const int m = n - up * DFF; return 256 * (m >> 7) + 128 * up + (m & 127); } };

template <class RM>
__device__ __forceinline__ void tr_matrix(const Tc& t, const float* W, int K, int N, int ldw, bf16_t* WT, int ldk, const RM& rm) {
    LAS float* scr = (LAS float*)(t.lds + t.wave * 16384);
    const int nkb = K / 64, nnb = N / 32, items = nkb * nnb;
    for (int it = t.gw; it < items; it += t.ngw) tr_item(W, ldw, WT, ldk, rm, scr, it / nnb, it % nnb, t.lane);
}
template <class SRC>
__device__ __forceinline__ void build_small(const Tc& t, bf16_t* dst, int NR, int KC, const SRC& src) {
    const int total = NR * (KC / 8);
    for (int i = t.gw * 64 + t.lane; i < total; i += t.ngw * 64) { const int n = i % NR, ko = i / NR;
        float v[8];
#pragma unroll
        for (int j = 0; j < 8; ++j) v[j] = src(n, 8 * ko + j);
        u32x4 o; o.x = pk2(v[0], v[1]); o.y = pk2(v[2], v[3]); o.z = pk2(v[4], v[5]); o.w = pk2(v[6], v[7]);
        *(u32x4*)(dst + (size_t)n * KC + 8 * ko) = o; }
}

__device__ __forceinline__ void convert_rwkv(const Tc& t, CArgs a, int jl) {
    bf16_t* wm = (bf16_t*)(a->ws + WS_WMIX);
    const size_t dd = (size_t)D * D;
    tr_matrix(t, a->in[I_WR] + jl * dd, D, D, D, (bf16_t*)((char*)wm + WM_R), D, RmId());
    tr_matrix(t, a->in[I_WK] + jl * dd, D, D, D, (bf16_t*)((char*)wm + WM_K), D, RmId());
    tr_matrix(t, a->in[I_WV] + jl * dd, D, D, D, (bf16_t*)((char*)wm + WM_V), D, RmId());
    tr_matrix(t, a->in[I_WO] + jl * dd, D, D, D, (bf16_t*)((char*)wm + WM_O), D, RmId());
    { const float* w1 = a->in[I_W1] + (size_t)jl * 2 * D * 96;
      build_small(t, (bf16_t*)((char*)wm + WM_W1), 256, D, [=](int n, int k) -> float { if (n >= 192) return 0.f; const int z = n >= 96 ? 1 : 0, r = n - 96 * z; return w1[((size_t)z * D + k) * 96 + r]; }); }
    { const float* a1 = a->in[I_A1] + (size_t)jl * 2 * D * 96;
      build_small(t, (bf16_t*)((char*)wm + WM_A1), 256, D, [=](int n, int k) -> float { if (n >= 192) return 0.f; const int z = n >= 96 ? 1 : 0, r = n - 96 * z; return a1[((size_t)z * D + k) * 96 + r]; }); }
    { const float* g1 = a->in[I_G1] + (size_t)jl * D * 256;
      build_small(t, (bf16_t*)((char*)wm + WM_G1), 256, D, [=](int n, int k) -> float { return g1[(size_t)k * 256 + n]; }); }
    if (jl > 0) { const float* v1 = a->in[I_V1] + (size_t)(jl - 1) * D * 64;
      build_small(t, (bf16_t*)((char*)wm + WM_V1), 256, D, [=](int n, int k) -> float { return n < 64 ? v1[(size_t)k * 64 + n] : 0.f; }); }
    { const float* w2 = a->in[I_W2] + (size_t)jl * 2 * 96 * D;
      build_small(t, (bf16_t*)((char*)wm + WM_W2), 2 * D, 256, [=](int n, int k) -> float { const int z = n >= D ? 1 : 0, ch = n - z * D, kk = k - 96 * z; return (kk >= 0 && kk < 96) ? w2[((size_t)z * 96 + kk) * D + ch] : 0.f; }); }
    { const float* a2 = a->in[I_A2] + (size_t)jl * 2 * 96 * D;
      build_small(t, (bf16_t*)((char*)wm + WM_A2), 2 * D, 256, [=](int n, int k) -> float { const int z = n >= D ? 1 : 0, ch = n - z * D, kk = k - 96 * z; return (kk >= 0 && kk < 96) ? a2[((size_t)z * 96 + kk) * D + ch] : 0.f; }); }
    { const float* g2 = a->in[I_G2] + (size_t)jl * 256 * D;
      build_small(t, (bf16_t*)((char*)wm + WM_G2), D, 256, [=](int n, int k) -> float { return g2[(size_t)k * D + n]; }); }
    if (jl > 0) { const float* v2 = a->in[I_V2] + (size_t)(jl - 1) * 64 * D;
      build_small(t, (bf16_t*)((char*)wm + WM_V2), D, 256, [=](int n, int k) -> float { return k < 64 ? v2[(size_t)k * D + n] : 0.f; }); }
}
__device__ __forceinline__ void convert_mlstm(const Tc& t, CArgs a, int jl) {
    bf16_t* win = (bf16_t*)(a->ws + WS_WMIX + WM_MIN); bf16_t* wout = (bf16_t*)(a->ws + WS_WMIX + WM_MOUT);
    tr_matrix(t, a->in[I_MWIN] + (size_t)jl * D * MPROJ, D, MPROJ, MPROJ, win, D, RmId());
    { u32x4* z = (u32x4*)(win + (size_t)MPROJ * D); const int total = (6400 - MPROJ) * D / 8; unsigned zz = 0u; asm volatile("" : "+v"(zz)); const u32x4 zero = {zz, zz, zz, zz};
      for (int i = t.gw * 64 + t.lane; i < total; i += t.ngw * 64) z[i] = zero; }
    tr_matrix(t, a->in[I_MWOUT] + (size_t)jl * D * D, D, D, D, wout, D, RmId());
}
__device__ __forceinline__ void convert_ffn_in(const Tc& t, CArgs a, int layer) {
    tr_matrix(t, a->in[I_FWIN] + (size_t)layer * D * 2 * DFF, D, 2 * DFF, 2 * DFF, (bf16_t*)(a->ws + WS_WFFN + WF_IN), D, RmSwiglu());
}
__device__ __forceinline__ void convert_ffn_out(const Tc& t, CArgs a, int layer) {
    tr_matrix(t, a->in[I_FWOUT] + (size_t)layer * DFF * D, DFF, D, D, (bf16_t*)(a->ws + WS_WFFN + WF_OUT), DFF, RmId());
}
__device__ __forceinline__ bool tail_crew(const Tc& t, int urot0, int nwg, Tc& ts) {
    const int G = t.G, r = nwg % G, c = (t.bid + G - (urot0 % G)) % G;
    ts = t;
    if (r == 0) return true;
    if (c < r) return false;
    ts.bid = c - r; ts.G = G - r; ts.gw = ts.bid * 8 + t.wave; ts.ngw = ts.G * 8; return true;
}

__device__ __forceinline__ void ph_prologue(const Tc& t, CArgs a) {
    LAS float* S = (LAS float*)t.lds;
    { f32x4 cv[17];
#pragma unroll
      for (int b = 0; b < 17; ++b) cv[b] = *(const f32x4*)((b < 16 ? a->in[I_C] + (size_t)b * D : a->in[I_CCTX]) + 4 * t.tid);
      const int k = 4 * t.tid;
#pragma unroll
      for (int b = 0; b < 17; ++b) { const f32x4 s = {siluf_(cv[b][0]), siluf_(cv[b][1]), siluf_(cv[b][2]), siluf_(cv[b][3])};
          *(LAS f32x4*)(S + b * 2056 + (k >> 10) * 1028 + (k & 1023)) = s; } }
    __syncthreads();
    float* mod = (float*)(a->ws + WS_MOD);
    const int col = t.lane & 31, kh = t.lane >> 5;
    for (int it = t.wave * t.G + t.bid; it < 4 * 384; it += t.ngw) { const int layer = it / 384, n0 = 32 * (it % 384);
        const auto wrs = __builtin_amdgcn_make_buffer_rsrc((void*)(a->in[I_MODW] + (size_t)layer * D * MODLD), (short)0, (int)((size_t)D * MODLD * 4), 0x00020000);
        const unsigned voff = (unsigned)(kh * 1024 * MODLD + n0 + col) * 4u;
        const LAS float* Sk = S + kh * 1028;
        f32x2 acc[17];
#pragma unroll
        for (int b = 0; b < 17; ++b) acc[b] = (f32x2){0.f, 0.f};
        float wa[8], wb[8];
#define MOD_LD(dst, k0_) do { _Pragma("unroll") for (int j = 0; j < 8; ++j) dst[j] = __builtin_bit_cast(float, __builtin_amdgcn_raw_buffer_load_b32(wrs, voff, (unsigned)(((k0_) + j) * MODLD * 4), 0)); } while (0)
#define MOD_FMA(src, k0_) do { _Pragma("unroll") for (int j4 = 0; j4 < 2; ++j4) { _Pragma("unroll") for (int b = 0; b < 17; ++b) { const f32x4 s = *(const LAS f32x4*)(Sk + b * 2056 + (k0_) + 4 * j4); \
            acc[b] = acc[b] + (f32x2){s[0], s[1]} * (f32x2){src[4 * j4], src[4 * j4 + 1]} + (f32x2){s[2], s[3]} * (f32x2){src[4 * j4 + 2], src[4 * j4 + 3]}; } asm volatile("" ::: "memory"); } } while (0)
        MOD_LD(wa, 0);
#pragma unroll 1
        for (int k0 = 0; k0 < 1024; k0 += 16) {
            MOD_LD(wb, k0 + 8);
            MOD_FMA(wa, k0);
            if (k0 + 16 < 1024) MOD_LD(wa, k0 + 16);
            MOD_FMA(wb, k0 + 8); }
#undef MOD_LD
#undef MOD_FMA
#pragma unroll
        for (int b = 0; b < 17; ++b) { float v = acc[b].x + acc[b].y; v += shfl_xor_(v, 32, t.lane);
            if (kh == 0) mod[((size_t)layer * 17 + b) * MODLD + n0 + col] = v + a->in[I_MODB][layer * MODLD + n0 + col]; } }
    __syncthreads();
}

template <bool OUT_BF16>
__device__ __forceinline__ void norm_rows(const Tc& t, CArgs a, int layer, int which, int row_begin, int nrows, void* out, bool from_inputs = false, bool latent_only = false) {
    const float* xres = (const float*)(a->ws + WS_XRES);
    const float* mod = (const float*)(a->ws + WS_MOD) + (size_t)layer * 17 * MODLD;
    const int npw = (nrows + t.ngw - 1) / t.ngw;
    f32x4 gg[8], gm[8], sh[8];
    { const f32x4* gp = (const f32x4*)(a->in[I_NORMG] + (size_t)(layer * 2 + which) * D) + t.lane;
#pragma unroll
      for (int j = 0; j < 8; ++j) gg[j] = gp[64 * j]; }
    int cur_idx = -1;
    auto gmap = [&](int r) -> int { return latent_only ? (r / SEQ) * SROW + CTXL + r % SEQ : row_begin + r; };
    auto rowptr = [&](int r) -> const f32x4* { const int grow = gmap(r); const int gb = grow / SROW, gs = grow % SROW;
        const float* rp = from_inputs ? (gs < CTXL ? a->in[I_CTX] + ((size_t)gb * CTXL + gs) * D : a->in[I_X] + ((size_t)gb * SEQ + (gs - CTXL)) * D) : xres + (size_t)grow * D;
        return (const f32x4*)rp + t.lane; };
    const int rfirst = t.gw * npw;
    if (rfirst >= nrows) return;
    const int nmine = (nrows - rfirst) < npw ? (nrows - rfirst) : npw;
    f32x4 xn[8];
    { const f32x4* xr = rowptr(rfirst);
#pragma unroll
      for (int j = 0; j < 8; ++j) xn[j] = xr[64 * j]; }
    for (int i = 0; i < nmine; ++i) { const int r = rfirst + i; const int grow = gmap(r); const int orow = grow - row_begin; const int idx = (grow % SROW) < CTXL ? 16 : grow / SROW;
        f32x4 v[8];
#pragma unroll
        for (int j = 0; j < 8; ++j) v[j] = xn[j];
        if (idx != cur_idx) { cur_idx = idx;
            const f32x4* shp = (const f32x4*)(mod + (size_t)idx * MODLD + (3 * which) * D) + t.lane; const f32x4* scp = (const f32x4*)(mod + (size_t)idx * MODLD + (3 * which + 1) * D) + t.lane;
#pragma unroll
            for (int j = 0; j < 8; ++j) { sh[j] = shp[64 * j]; gm[j] = gg[j] * (scp[64 * j] + 1.0f); } }
        if (i + 1 < nmine) { const f32x4* xr = rowptr(r + 1);
#pragma unroll
            for (int j = 0; j < 8; ++j) xn[j] = xr[64 * j]; }
        asm volatile("" ::: "memory");
        float ss = 0.f;
#pragma unroll
        for (int j = 0; j < 8; ++j) ss += (v[j].x * v[j].x + v[j].y * v[j].y) + (v[j].z * v[j].z + v[j].w * v[j].w);
        const float rstd = rsqrtf(wave_sum_dpp(ss) * (1.0f / D) + 1e-6f);
#pragma unroll
        for (int j = 0; j < 8; ++j) { const f32x4 o = v[j] * rstd * gm[j] + sh[j];
            if (OUT_BF16) { u32x2 w; w.x = pk2(o.x, o.y); w.y = pk2(o.z, o.w); ((u32x2*)((bf16_t*)out + (size_t)orow * D))[64 * j + t.lane] = w; }
            else ((f32x4*)((float*)out + (size_t)orow * D))[64 * j + t.lane] = o; }
        asm volatile("" ::: "memory");
    }
}

__device__ __forceinline__ void r2_mix(const Tc& t, CArgs a, int jl) {
    const bf16_t* H = (const bf16_t*)(a->ws + WS_ACT + AR_H);
    const int sl = t.gw & 3, c0 = 512 * sl + 8 * t.lane;
    const float* mu = a->in[I_MU] + (size_t)jl * 6 * D + c0;
    f32x4 m0[6], m1[6];
#pragma unroll
    for (int m = 0; m < 6; ++m) { m0[m] = *(const f32x4*)(mu + m * D); m1[m] = *(const f32x4*)(mu + m * D + 4); }
    const int rstep = t.ngw >> 2;
    for (int r0 = t.gw >> 2; r0 < TG; r0 += 4 * rstep) {
        u32x4 hw[4], nw[4];
#pragma unroll
        for (int k = 0; k < 4; ++k) { const int r = r0 + k * rstep; hw[k] = (u32x4){0u, 0u, 0u, 0u}; nw[k] = hw[k];
            if (r < TG) { const int s = r % SROW; int nr;
                if (s < CTXL) nr = sl < 2 ? (s > 0 ? r - 1 : -1) : (s < CTXL - 1 ? r + 1 : -1);
                else { const int i = s - CTXL, gr = i >> 6, gc = i & 63; nr = sl == 0 ? (gc > 0 ? r - 1 : -1) : sl == 1 ? (gc < 63 ? r + 1 : -1) : sl == 2 ? (gr > 0 ? r - 64 : -1) : (gr < 31 ? r + 64 : -1); }
                hw[k] = *(const u32x4*)(H + (size_t)r * D + c0);
                if (nr >= 0) nw[k] = *(const u32x4*)(H + (size_t)nr * D + c0); } }
        asm volatile("" ::: "memory");
#pragma unroll
        for (int k = 0; k < 4; ++k) { const int r = r0 + k * rstep;
            if (r < TG) {
                const f32x4 h0 = {lo_bf(hw[k].x), hi_bf(hw[k].x), lo_bf(hw[k].y), hi_bf(hw[k].y)}, h1 = {lo_bf(hw[k].z), hi_bf(hw[k].z), lo_bf(hw[k].w), hi_bf(hw[k].w)};
                const f32x4 n0 = {lo_bf(nw[k].x), hi_bf(nw[k].x), lo_bf(nw[k].y), hi_bf(nw[k].y)}, n1 = {lo_bf(nw[k].z), hi_bf(nw[k].z), lo_bf(nw[k].w), hi_bf(nw[k].w)};
                const f32x4 x0 = n0 - h0, x1 = n1 - h1;
#pragma unroll
                for (int m = 0; m < 6; ++m) { const f32x4 o0 = h0 + x0 * m0[m], o1 = h1 + x1 * m1[m];
                    u32x4 w; w.x = pk2(o0.x, o0.y); w.y = pk2(o0.z, o0.w); w.z = pk2(o1.x, o1.y); w.w = pk2(o1.z, o1.w);
                    *(u32x4*)(a->ws + WS_ACT + AR_MIX + (size_t)m * SLOT + ((size_t)r * D + c0) * 2) = w; } } }
        asm volatile("" ::: "memory");
    }
}

constexpr int R5_L = 16;
constexpr int R5_ZR = 0, R5_BK = 4608, R5_BKT = 9216, R5_V = 14336, R5_GL = 18432, R5_CH = 18688;
constexpr int R5_BUF = 2 * R5_CH;
constexpr int R5_GR = 2 * R5_BUF;
constexpr int R5_GRCH = 3072;
constexpr int R5_DS = R5_GR + 2 * R5_GRCH;
constexpr int R5_YS = R5_DS + 8 * 1024;
constexpr int R5_PW = R5_YS + 2 * 2 * 4096;
constexpr int R5_END = R5_PW + 4 * 8192 + 512;
static_assert(R5_END <= LDSCTL_OFF, "scan LDS");
__device__ __forceinline__ int r5_seq(int z, int tt) { return z == 0 ? tt : (tt < CTXL ? CTXL - 1 - tt : SROW + CTXL - 1 - tt); }

__device__ __forceinline__ void r5_scan(const Tc& t, CArgs a, int jl, int layer, int g) {
    const bf16_t* R = (const bf16_t*)(a->ws + WS_ACT + AR_R);
    const bf16_t* Kb = (const bf16_t*)(a->ws + WS_ACT + AR_K);
    const bf16_t* Vb = (layer == 0) ? (const bf16_t*)(a->ws + WS_VF) + (size_t)g * TG * D : (const bf16_t*)(a->ws + WS_ACT + AR_V);
    const int w = t.wave, lane = t.lane, c2 = w >> 2, q = w & 3, l15 = lane & 15, q4 = lane >> 4;
    for (int pair = t.bid; pair < BG * RH; pair += t.G) {
        const int z = pair / (BG * RH / 2), bl = (pair / (RH / 2)) % BG, h = 2 * (pair % (RH / 2)) + c2;
        const bf16_t* E = (const bf16_t*)(a->ws + WS_ACT + AR_MIX + (size_t)z * SLOT);
        const bf16_t* Aa = (const bf16_t*)(a->ws + WS_ACT + AR_MIX + (size_t)(2 + z) * SLOT);
        bf16_t* Y = (bf16_t*)(a->ws + WS_ACT + AR_Y + (size_t)z * SLOT);
        float* RKo = (float*)(a->ws + WS_ACT + AR_RK) + (size_t)z * TG * 32;
        const size_t colb = (size_t)h * 64 + lane;
        f32x4 ST[4];
#pragma unroll
        for (int cb = 0; cb < 4; ++cb) ST[cb] = (f32x4){0.f, 0.f, 0.f, 0.f};
        const int pst = q == 0 ? 0 : 6 * (q - 1), npass = q == 0 ? 0 : (q == 3 ? 2 : 3);
        const int hf = lane >> 5, pi = lane & 31;
        unsigned ce[8], pr[3], pk[3], pv[3], pa[3];
        const int sd = z == 0 ? 1 : -1;
        const bf16_t* Eh = E + (size_t)bl * SROW * D + (size_t)h * 64; const bf16_t* Rh = R + (size_t)bl * SROW * D + (size_t)h * 64; const bf16_t* Kh = Kb + (size_t)bl * SROW * D + (size_t)h * 64;
        const bf16_t* Vh = Vb + (size_t)bl * SROW * D + (size_t)h * 64; const bf16_t* Ah = Aa + (size_t)bl * SROW * D + (size_t)h * 64;
        f32x2 kkc2, kac2, rkc2;
        { const size_t c0 = (size_t)jl * D + (size_t)h * 64 + 2 * pi; kkc2 = *(const f32x2*)(a->in[I_KK] + c0); kac2 = *(const f32x2*)(a->in[I_KA] + c0); rkc2 = *(const f32x2*)(a->in[I_RK] + c0); }
        auto prep_load = [&](int n) {
            if (q == 0) return;
            const int s0 = r5_seq(z, n * R5_L); const unsigned rlo = (unsigned)(sd > 0 ? s0 : s0 - 15) * (unsigned)D;
#pragma unroll
            for (int ps = 0; ps < 3; ++ps) if (ps < npass) { const int st = pst + 2 * ps + hf; const unsigned off = rlo + (unsigned)((sd > 0 ? st : 15 - st) * D) + 2u * (unsigned)pi;
                pr[ps] = *(const unsigned*)(Rh + off); pk[ps] = *(const unsigned*)(Kh + off); pv[ps] = *(const unsigned*)(Vh + off); pa[ps] = *(const unsigned*)(Ah + off); }
        };
        auto halfsum = [&](float v) -> float { v = sum16_(v); const float h0 = rl_(v, 0) + rl_(v, 16), h1 = rl_(v, 32) + rl_(v, 48); return hf ? h1 : h0; };
        auto prep_finish = [&](int n) {
            if (q == 0) return;
            LAS unsigned char* cbuf = t.lds + (n & 1) * R5_BUF + c2 * R5_CH;
            LAS bf16_t* ZR = (LAS bf16_t*)(cbuf + R5_ZR); LAS bf16_t* BK = (LAS bf16_t*)(cbuf + R5_BK); LAS bf16_t* BKT = (LAS bf16_t*)(cbuf + R5_BKT);
            LAS float* Vs = (LAS float*)(cbuf + R5_V); LAS float* GL = (LAS float*)(cbuf + R5_GL);
            const LAS f32x2* GT = (const LAS f32x2*)(t.lds + R5_PW + ((n & 1) * 2 + c2) * 8192);
            const LAS f32x2* GI = GT + 512;
            if (q == 3 && hf == 0) *(LAS f32x2*)(GL + 2 * pi) = GT[15 * 32 + pi];
            const int s0 = r5_seq(z, n * R5_L); float rkv[3] = {0.f, 0.f, 0.f};
#pragma unroll
            for (int ps = 0; ps < 3; ++ps) if (ps < npass) { const int st = pst + 2 * ps + hf;
                const f32x2 gt = GT[st * 32 + pi]; const f32x2 gi = {__builtin_amdgcn_rcpf(gt.x), __builtin_amdgcn_rcpf(gt.y)}; f32x2 gp = {1.f, 1.f}; if (st > 0) gp = GT[(st - 1) * 32 + pi];
                const f32x2 r2 = {lo_bf(pr[ps]), hi_bf(pr[ps])}, k2 = {lo_bf(pk[ps]), hi_bf(pk[ps])}, v2 = {lo_bf(pv[ps]), hi_bf(pv[ps])}, a2 = {lo_bf(pa[ps]), hi_bf(pa[ps])};
                f32x2 kk2 = k2 * kkc2; const float n2 = halfsum(kk2.x * kk2.x + kk2.y * kk2.y); kk2 = kk2 * __builtin_amdgcn_rsqf(fmaxf(n2, 1e-24f));
                const f32x2 km2 = k2 * ((a2 - 1.0f) * kac2 + 1.0f);
                const f32x2 rkm = r2 * km2 * rkc2; const float rk = halfsum(rkm.x + rkm.y);
                rkv[ps] = rk;
                const f32x2 zt = kk2 * gp * -1.0f, rt = r2 * gt, bt = kk2 * a2 * gi, kt = km2 * gi;
                const unsigned zw = pk2(zt.x, zt.y), rw = pk2(rt.x, rt.y), bw = pk2(bt.x, bt.y), kw = pk2(kt.x, kt.y);
                *(LAS unsigned*)(ZR + st * 72 + 2 * pi) = zw; *(LAS unsigned*)(ZR + (16 + st) * 72 + 2 * pi) = rw; *(LAS unsigned*)(BK + st * 72 + 2 * pi) = bw; *(LAS unsigned*)(BK + (16 + st) * 72 + 2 * pi) = kw;
                BKT[(2 * pi) * 40 + st] = (bf16_t)(bw & 0xffffu); BKT[(2 * pi + 1) * 40 + st] = (bf16_t)(bw >> 16);
                BKT[(2 * pi) * 40 + 16 + st] = (bf16_t)(kw & 0xffffu); BKT[(2 * pi + 1) * 40 + 16 + st] = (bf16_t)(kw >> 16);
                *(LAS f32x2*)(Vs + st * 64 + 2 * pi) = v2; }
            if (pi == 0) {
#pragma unroll
                for (int ps = 0; ps < 3; ++ps) if (ps < npass) RKo[((size_t)bl * SROW + s0 + sd * (pst + 2 * ps + hf)) * 32 + h] = rkv[ps]; }
        };
        auto cum_load = [&](int m) {
            const int s0 = r5_seq(z, m * R5_L); const unsigned rlo = (unsigned)(sd > 0 ? s0 : s0 - 15) * (unsigned)D;
#pragma unroll
            for (int j = 0; j < 8; ++j) { const int i = 8 * hf + j; ce[j] = *(const unsigned*)(Eh + rlo + (unsigned)((sd > 0 ? i : 15 - i) * D) + 2u * (unsigned)pi); }
        };
        auto cum_finish = [&](int m) {
            LAS f32x2* GT = (LAS f32x2*)(t.lds + R5_PW + ((m & 1) * 2 + c2) * 8192); LAS f32x2* GI = GT + 512;
            LAS f32x2* HB = (LAS f32x2*)(t.lds + R5_PW + 4 * 8192 + c2 * 256);
            f32x2 cs[8]; f32x2 lg = {0.f, 0.f};
#pragma unroll
            for (int j = 0; j < 8; ++j) { lg = lg + (f32x2){lo_bf(ce[j]), hi_bf(ce[j])}; cs[j] = lg; }
            if (hf == 0) HB[pi] = lg;
            asm volatile("s_waitcnt lgkmcnt(0)" ::: "memory");
            f32x2 base = HB[pi]; if (hf == 0) base = (f32x2){0.f, 0.f};
#pragma unroll
            for (int j = 0; j < 8; ++j) { const f32x2 c = cs[j] + base;
                GT[(8 * hf + j) * 32 + pi] = (f32x2){__expf(c.x), __expf(c.y)}; }
        };
        constexpr int NCH = SROW / R5_L;
        if (q == 0) { cum_load(0); cum_finish(0); cum_load(1); cum_finish(1); cum_load(2); } else prep_load(0);
        LDS_BARRIER();
        prep_finish(0); prep_load(1);
        LDS_BARRIER();
        for (int n = 0; n < NCH; ++n) {
            LAS unsigned char* cbuf = t.lds + (n & 1) * R5_BUF + c2 * R5_CH;
            const LAS bf16_t* ZR = (const LAS bf16_t*)(cbuf + R5_ZR); const LAS bf16_t* BK = (const LAS bf16_t*)(cbuf + R5_BK); const LAS bf16_t* BKT = (const LAS bf16_t*)(cbuf + R5_BKT);
            const LAS float* Vs = (const LAS float*)(cbuf + R5_V); const LAS float* GL = (const LAS float*)(cbuf + R5_GL);
            LAS float* Nm = (LAS float*)(t.lds + R5_GR + c2 * R5_GRCH); LAS bf16_t* MKZ = (LAS bf16_t*)(t.lds + R5_GR + c2 * R5_GRCH + 1024); LAS bf16_t* MBK = (LAS bf16_t*)(t.lds + R5_GR + c2 * R5_GRCH + 1536);
            LAS bf16_t* MT = (LAS bf16_t*)(t.lds + R5_GR + c2 * R5_GRCH + 2560);
            { f32x4 gacc = (f32x4){0.f, 0.f, 0.f, 0.f};
#pragma unroll
              for (int ks = 0; ks < 2; ++ks) { const bf16x8 av = *(const LAS bf16x8*)(ZR + ((q & 2) ? 16 + l15 : l15) * 72 + 32 * ks + 8 * q4);
                  const bf16x8 bv = *(const LAS bf16x8*)(BK + ((q & 1) ? 16 + l15 : l15) * 72 + 32 * ks + 8 * q4);
                  gacc = __builtin_amdgcn_mfma_f32_16x16x32_bf16(av, bv, gacc, 0, 0, 0); }
#pragma unroll
              for (int i = 0; i < 4; ++i) { const int tt = 4 * q4 + i, j = l15; const bool keep = (q & 2) ? (j <= tt) : (j < tt); const float val = keep ? gacc[i] : 0.f;
                  if (q == 0) Nm[tt * 16 + j] = val; else if (q == 1) MKZ[tt * 16 + j] = (bf16_t)f2bf(val); else MBK[tt * 32 + (q == 3 ? 16 : 0) + j] = (bf16_t)f2bf(val); }
              if (q == 0) {
                  asm volatile("s_waitcnt lgkmcnt(0)" ::: "memory");
                  float tc[16];
                  tc[0] = (l15 == 0) ? 1.0f : 0.0f;
                  f32x4 nA[12], nB[12];
#define R5_SLOT_A(i, jb) ((i) <= 4 ? (i) - 1 : 4 + 2 * ((i) - 5) + (jb))
#pragma unroll
                  for (int i = 1; i <= 8; ++i)
#pragma unroll
                      for (int jb = 0; 4 * jb < i; ++jb) nA[R5_SLOT_A(i, jb)] = *(const LAS f32x4*)(Nm + i * 16 + 4 * jb);
#pragma unroll
                  for (int i = 9; i <= 12; ++i)
#pragma unroll
                      for (int jb = 0; jb < 3; ++jb) nB[(i - 9) * 3 + jb] = *(const LAS f32x4*)(Nm + i * 16 + 4 * jb);
                  asm volatile("" ::: "memory");
#pragma unroll
                  for (int i = 1; i <= 8; ++i) { float s = (l15 == i) ? 1.0f : 0.0f;
#pragma unroll
                      for (int jb = 0; 4 * jb < i; ++jb) { const f32x4 nv = nA[R5_SLOT_A(i, jb)];
#pragma unroll
                          for (int j = 0; j < 4; ++j) if (4 * jb + j < i) s += nv[j] * tc[4 * jb + j]; }
                      tc[i] = s; }
#pragma unroll
                  for (int i = 13; i <= 15; ++i)
#pragma unroll
                      for (int jb = 0; jb < 4; ++jb) nA[(i - 13) * 4 + jb] = *(const LAS f32x4*)(Nm + i * 16 + 4 * jb);
                  asm volatile("" ::: "memory");
#pragma unroll
                  for (int i = 9; i <= 12; ++i) { float s = (l15 == i) ? 1.0f : 0.0f;
#pragma unroll
                      for (int jb = 0; jb < 3; ++jb) { const f32x4 nv = nB[(i - 9) * 3 + jb];
#pragma unroll
                          for (int j = 0; j < 4; ++j) if (4 * jb + j < i) s += nv[j] * tc[4 * jb + j]; }
                      tc[i] = s; }
#pragma unroll
                  for (int i = 13; i <= 15; ++i) { float s = (l15 == i) ? 1.0f : 0.0f;
#pragma unroll
                      for (int jb = 0; jb < 4; ++jb) { const f32x4 nv = nA[(i - 13) * 4 + jb];
#pragma unroll
                          for (int j = 0; j < 4; ++j) if (4 * jb + j < i) s += nv[j] * tc[4 * jb + j]; }
                      tc[i] = s; }
#undef R5_SLOT_A
#pragma unroll
                  for (int i = 0; i < 4; ++i) { const float v = q4 == 0 ? tc[i] : q4 == 1 ? tc[4 + i] : q4 == 2 ? tc[8 + i] : tc[12 + i];
                      MT[(4 * q4 + i) * 16 + l15] = (bf16_t)f2bf(v); } } }
            if (n + 1 < NCH) prep_finish(n + 1);
            if (n + 2 < NCH) prep_load(n + 2);
            if (q == 0) {
                if (n + 2 < NCH) cum_finish(n + 2);
                if (n + 3 < NCH) cum_load(n + 3); }
            if (q == 3) {
                if (n > 0) { const LAS float* ys = (const LAS float*)(t.lds + R5_YS + ((n - 1) & 1) * 8192 + c2 * 4096);
#pragma unroll
                    for (int tt = 0; tt < 16; ++tt) Y[((size_t)bl * SROW + r5_seq(z, (n - 1) * R5_L) + sd * tt) * D + colb] = (bf16_t)f2bf(ys[tt * 64 + lane]); } }
            LDS_BARRIER();
            {
              f32x4 Pz = (f32x4){0.f, 0.f, 0.f, 0.f}, Pr = Pz;
#pragma unroll
              for (int ks = 0; ks < 2; ++ks) { const f32x4 s0 = ST[2 * ks], s1 = ST[2 * ks + 1];
                  u32x4 p; p.x = pk2(s0[0], s0[1]); p.y = pk2(s0[2], s0[3]); p.z = pk2(s1[0], s1[1]); p.w = pk2(s1[2], s1[3]);
                  const bf16x8 bop = __builtin_bit_cast(bf16x8, p);
                  const LAS bf16_t* zr = ZR + l15 * 72 + 32 * ks + 4 * q4; const LAS bf16_t* rr = ZR + (16 + l15) * 72 + 32 * ks + 4 * q4;
                  const u32x2 z0 = *(const LAS u32x2*)zr, z1 = *(const LAS u32x2*)(zr + 16), r0 = *(const LAS u32x2*)rr, r1 = *(const LAS u32x2*)(rr + 16);
                  Pz = __builtin_amdgcn_mfma_f32_16x16x32_bf16(__builtin_bit_cast(bf16x8, (u32x4){z0.x, z0.y, z1.x, z1.y}), bop, Pz, 0, 0, 0);
                  Pr = __builtin_amdgcn_mfma_f32_16x16x32_bf16(__builtin_bit_cast(bf16x8, (u32x4){r0.x, r0.y, r1.x, r1.y}), bop, Pr, 0, 0, 0); }
              float vd[4];
#pragma unroll
              for (int i = 0; i < 4; ++i) vd[i] = Vs[(4 * q4 + i) * 64 + 16 * q + l15];
              const unsigned vp0 = pk2(vd[0], vd[1]), vp1 = pk2(vd[2], vd[3]);
              { const u32x2 m = *(const LAS u32x2*)(MKZ + l15 * 16 + 4 * q4);
                Pz = __builtin_amdgcn_mfma_f32_16x16x32_bf16(__builtin_bit_cast(bf16x8, (u32x4){m.x, m.y, 0u, 0u}), __builtin_bit_cast(bf16x8, (u32x4){vp0, vp1, 0u, 0u}), Pz, 0, 0, 0); }
              { float x[4];
                { const u32x2 mt = *(const LAS u32x2*)(MT + l15 * 16 + 4 * q4);
                  const f32x4 dv = __builtin_amdgcn_mfma_f32_16x16x32_bf16(__builtin_bit_cast(bf16x8, (u32x4){mt.x, mt.y, 0u, 0u}), __builtin_bit_cast(bf16x8, (u32x4){pk2(Pz[0], Pz[1]), pk2(Pz[2], Pz[3]), 0u, 0u}), (f32x4){0.f, 0.f, 0.f, 0.f}, 0, 0, 0);
                  x[0] = dv[0]; x[1] = dv[1]; x[2] = dv[2]; x[3] = dv[3]; }
                const unsigned dp0 = pk2(x[0], x[1]), dp1 = pk2(x[2], x[3]);
                const bf16x8 bdv = __builtin_bit_cast(bf16x8, (u32x4){dp0, dp1, vp0, vp1});
                { const u32x2 m0 = *(const LAS u32x2*)(MBK + l15 * 32 + 4 * q4), m1 = *(const LAS u32x2*)(MBK + l15 * 32 + 16 + 4 * q4);
                  Pr = __builtin_amdgcn_mfma_f32_16x16x32_bf16(__builtin_bit_cast(bf16x8, (u32x4){m0.x, m0.y, m1.x, m1.y}), bdv, Pr, 0, 0, 0); }
                { LAS float* ys = (LAS float*)(t.lds + R5_YS + (n & 1) * 8192 + c2 * 4096);
#pragma unroll
                  for (int i = 0; i < 4; ++i) ys[(4 * q4 + i) * 64 + 16 * q + l15] = Pr[i]; }
#pragma unroll
                for (int cb = 0; cb < 4; ++cb) { const LAS bf16_t* bt = BKT + (16 * cb + l15) * 40 + 4 * q4;
                    const u32x2 b0 = *(const LAS u32x2*)bt, k0 = *(const LAS u32x2*)(bt + 16);
                    ST[cb] = __builtin_amdgcn_mfma_f32_16x16x32_bf16(__builtin_bit_cast(bf16x8, (u32x4){b0.x, b0.y, k0.x, k0.y}), bdv, ST[cb], 0, 0, 0);
                    const f32x4 gl = *(const LAS f32x4*)(GL + 16 * cb + 4 * q4);
                    ST[cb] = ST[cb] * gl; } } }
            LDS_BARRIER();
        }
        if (q == 3) { const LAS float* ys = (const LAS float*)(t.lds + R5_YS + ((NCH - 1) & 1) * 8192 + c2 * 4096);
#pragma unroll
          for (int tt = 0; tt < 16; ++tt) Y[((size_t)bl * SROW + r5_seq(z, (NCH - 1) * R5_L) + sd * tt) * D + colb] = (bf16_t)f2bf(ys[tt * 64 + lane]); }
        LDS_BARRIER();
    }
}
__device__ __forceinline__ void r6_readout(const Tc& t, CArgs a, int jl, int layer, int g) {
    const bf16_t* Y0 = (const bf16_t*)(a->ws + WS_ACT + AR_Y), *Y1 = (const bf16_t*)(a->ws + WS_ACT + AR_Y + SLOT);
    const float* RK0 = (const float*)(a->ws + WS_ACT + AR_RK), *RK1 = RK0 + (size_t)TG * 32;
    const bf16_t* Vb = (layer == 0) ? (const bf16_t*)(a->ws + WS_VF) + (size_t)g * TG * D : (const bf16_t*)(a->ws + WS_ACT + AR_V);
    const bf16_t* Gb = (const bf16_t*)(a->ws + WS_ACT + AR_MIX + 4 * SLOT);
    bf16_t* Ao = (bf16_t*)(a->ws + WS_ACT + AR_AO) + (size_t)g * TG * D;
    const int sl = t.gw & 3, c0 = 512 * sl + 8 * t.lane, head = c0 >> 6;
    const float* lnw = a->in[I_LNW] + (size_t)jl * D + c0, *lnb = a->in[I_LNB] + (size_t)jl * D + c0;
    const f32x4 lw0 = *(const f32x4*)lnw, lw1 = *(const f32x4*)(lnw + 4), lb0 = *(const f32x4*)lnb, lb1 = *(const f32x4*)(lnb + 4);
    const float lw[8] = {lw0.x, lw0.y, lw0.z, lw0.w, lw1.x, lw1.y, lw1.z, lw1.w}, lb[8] = {lb0.x, lb0.y, lb0.z, lb0.w, lb1.x, lb1.y, lb1.z, lb1.w};
    const int rstep = t.ngw >> 2;
    for (int r0 = t.gw >> 2; r0 < TG; r0 += 2 * rstep) {
        u32x4 y0[2], y1[2], vv[2], gg[2]; float rk[2];
#pragma unroll
        for (int k = 0; k < 2; ++k) { const int r = r0 + k * rstep < TG ? r0 + k * rstep : r0; const size_t off = (size_t)r * D + c0;
            y0[k] = *(const u32x4*)(Y0 + off); y1[k] = *(const u32x4*)(Y1 + off); vv[k] = *(const u32x4*)(Vb + off); gg[k] = *(const u32x4*)(Gb + off);
            rk[k] = RK0[(size_t)r * 32 + head] + RK1[(size_t)r * 32 + head]; }
        asm volatile("" ::: "memory");
#pragma unroll
        for (int k = 0; k < 2; ++k) { const int r = r0 + k * rstep; if (r >= TG) break; const size_t off = (size_t)r * D + c0;
            const unsigned a0[4] = {y0[k].x, y0[k].y, y0[k].z, y0[k].w}, a1[4] = {y1[k].x, y1[k].y, y1[k].z, y1[k].w};
            const unsigned av[4] = {vv[k].x, vv[k].y, vv[k].z, vv[k].w}, ag[4] = {gg[k].x, gg[k].y, gg[k].z, gg[k].w};
            float y[8]; float s = 0.f;
#pragma unroll
            for (int i = 0; i < 4; ++i) { y[2 * i] = lo_bf(a0[i]) + lo_bf(a1[i]); y[2 * i + 1] = hi_bf(a0[i]) + hi_bf(a1[i]); s += y[2 * i] + y[2 * i + 1]; }
            s = sum8_(s);
            const float mean = s * (1.0f / 64.0f);
            float qq = 0.f;
#pragma unroll
            for (int i = 0; i < 8; ++i) { y[i] -= mean; qq += y[i] * y[i]; }
            qq = sum8_(qq);
            const float rstd = rsqrtf(qq * (1.0f / 64.0f) + 64e-5f);
            float o[8];
#pragma unroll
            for (int i = 0; i < 4; ++i) { o[2 * i] = (y[2 * i] * rstd * lw[2 * i] + lb[2 * i] + rk[k] * lo_bf(av[i])) * lo_bf(ag[i]);
                o[2 * i + 1] = (y[2 * i + 1] * rstd * lw[2 * i + 1] + lb[2 * i + 1] + rk[k] * hi_bf(av[i])) * hi_bf(ag[i]); }
            u32x4 w; w.x = pk2(o[0], o[1]); w.y = pk2(o[2], o[3]); w.z = pk2(o[4], o[5]); w.w = pk2(o[6], o[7]);
            *(u32x4*)(Ao + off) = w; }
        asm volatile("" ::: "memory");
    }
}

__device__ __forceinline__ void m3_conv(const Tc& t, CArgs a, int jl) {
    const bf16_t* U = (const bf16_t*)(a->ws + WS_ACT + AM_U);
    bf16_t* QK = (bf16_t*)(a->ws + WS_ACT + AM_QK);
    const int sl = t.gw & 7, c0 = 256 * sl + 4 * t.lane;
    const float* cw = a->in[I_CONVW] + (size_t)jl * 9 * D + c0;
    f32x4 wt[9];
#pragma unroll
    for (int k = 0; k < 9; ++k) wt[k] = *(const f32x4*)(cw + k * D);
    const f32x4 bias = *(const f32x4*)(a->in[I_CONVB] + (size_t)jl * D + c0);
    const float sc = c0 < 1024 ? 0.08838834764831845f : 1.0f;
    for (int row = t.gw >> 3; row < T; row += t.ngw >> 3) { const int s = row % SROW;
        f32x4 acc = bias;
        if (s < CTXL) {
#pragma unroll
            for (int dc = -1; dc <= 1; ++dc) if (s + dc >= 0 && s + dc < CTXL) { const u32x2 u = *(const u32x2*)(U + (size_t)(row + dc) * ULD + c0); const f32x4 w = wt[3 + dc + 1];
                acc.x += lo_bf(u.x) * w.x; acc.y += hi_bf(u.x) * w.y; acc.z += lo_bf(u.y) * w.z; acc.w += hi_bf(u.y) * w.w; }
        } else { const int i = s - CTXL, gr = i >> 6, gc = i & 63;
            u32x2 u[9];
#pragma unroll
            for (int dr = -1; dr <= 1; ++dr)
#pragma unroll
                for (int dc = -1; dc <= 1; ++dc) { const bool ok = (gr + dr >= 0) && (gr + dr < 32) && (gc + dc >= 0) && (gc + dc < 64);
                    u[(dr + 1) * 3 + dc + 1] = ok ? *(const u32x2*)(U + (size_t)(row + dr * 64 + dc) * ULD + c0) : (u32x2){0u, 0u}; }
#pragma unroll
            for (int k = 0; k < 9; ++k) { acc.x += lo_bf(u[k].x) * wt[k].x; acc.y += hi_bf(u[k].x) * wt[k].y; acc.z += lo_bf(u[k].y) * wt[k].z; acc.w += hi_bf(u[k].y) * wt[k].w; }
        }
        u32x2 w; w.x = pk2(siluf_(acc.x) * sc, siluf_(acc.y) * sc); w.y = pk2(siluf_(acc.z) * sc, siluf_(acc.w) * sc);
        *(u32x2*)(QK + (size_t)row * D + c0) = w;
    }
}

template <int CTRL> __device__ __forceinline__ float dppz_(float v) { return __int_as_float(__builtin_amdgcn_update_dpp(0, __float_as_int(v), CTRL, 0xF, 0xF, false)); }
template <int CTRL> __device__ __forceinline__ float dppm_(float v) { return __int_as_float(__builtin_amdgcn_update_dpp((int)0xff800000u, __float_as_int(v), CTRL, 0xF, 0xF, false)); }
constexpr int M4_QS = 136, M4_TS = 72;
constexpr int M4_SQ = 0, M4_SK = 17408, M4_SVT = 34816, M4_SWKT = 71680, M4_SP = 90112, M4_F = 99328;
__device__ __forceinline__ void m4_scan(const Tc& t, CArgs a, bool skip_ctx_out) {
    LAS bf16_t* sQ = (LAS bf16_t*)(t.lds + M4_SQ); LAS bf16_t* sK = (LAS bf16_t*)(t.lds + M4_SK); LAS bf16_t* sVT = (LAS bf16_t*)(t.lds + M4_SVT);
    LAS bf16_t* sWKT = (LAS bf16_t*)(t.lds + M4_SWKT); LAS bf16_t* sP = (LAS bf16_t*)(t.lds + M4_SP);
    LAS float* fI = (LAS float*)(t.lds + M4_F);
    LAS float* fF = fI + 64;
    LAS float* fU = fI + 128;
    LAS float* fG = fI + 192;
    LAS float* fWI = fI + 256;
    LAS float* fEN = fI + 320;
    LAS float* fWS = fI + 384;
    LAS float* fRS = fI + 448;
    LAS float* fQN = fI + 576;
    LAS float* fN = fI + 640;
    LAS float* fSC = fI + 768;
    LAS float* fNP = fI + 832;
    const bf16_t* QK = (const bf16_t*)(a->ws + WS_ACT + AM_QK);
    const bf16_t* U = (const bf16_t*)(a->ws + WS_ACT + AM_U);
    const float* Gt = (const float*)(a->ws + WS_ACT + AM_G);
    const int tid = t.tid, lane = t.lane, w = t.wave, l15 = lane & 15, q4 = lane >> 4;
    for (int chain = t.bid; chain < 2 * NB * MH; chain += t.G) {
        const int z = chain / (NB * MH), b = (chain / MH) % NB, h = chain % MH;
        bf16_t* HZ = (bf16_t*)(a->ws + WS_ACT + (z == 0 ? AM_HB : AM_HZ1));
        f32x4 Cacc[8][2];
#pragma unroll
        for (int db = 0; db < 8; ++db)
#pragma unroll
            for (int e = 0; e < 2; ++e) Cacc[db][e] = (f32x4){0.f, 0.f, 0.f, 0.f};
        float m_old = 0.f;
        if (tid < 128) fN[tid] = 0.f;
        LDS_BARRIER();
        const size_t rowb = (size_t)b * SROW; const int sdir = z == 0 ? 1 : -1;
        u32x4 pq[2], pkk[2], pvv[4]; float pgi = 0.f, pgf = 0.f;
#define M4_LOAD(chn) do { const int t0_ = (chn) * 64; const int sb_ = z == 0 ? t0_ : (t0_ < CTXL ? CTXL - 1 - t0_ : SROW + CTXL - 1 - t0_); \
            _Pragma("unroll") for (int rep = 0; rep < 2; ++rep) { const int cid = tid + 512 * rep, i = cid >> 4, cc = cid & 15; const size_t row = rowb + sb_ + sdir * i; \
                pq[rep] = *(const u32x4*)(QK + row * D + h * MDK + 8 * cc); pkk[rep] = *(const u32x4*)(QK + row * D + 1024 + h * MDK + 8 * cc); } \
            _Pragma("unroll") for (int rep = 0; rep < 4; ++rep) { const int cid = tid + 512 * rep, i = cid & 63, cc = cid >> 6; const size_t row = rowb + sb_ + sdir * i; \
                pvv[rep] = *(const u32x4*)(U + row * ULD + 2048 + h * MDV + 8 * cc); } \
            if (tid < 64) { const size_t row = rowb + sb_ + sdir * tid; pgi = Gt[row * 32 + z * 16 + h]; pgf = Gt[row * 32 + z * 16 + 8 + h]; } } while (0)
        M4_LOAD(0);
        asm volatile("s_waitcnt vmcnt(0)" ::: "memory");
        asm volatile("" : "+v"(pq[0]), "+v"(pq[1]), "+v"(pkk[0]), "+v"(pkk[1]));
        asm volatile("" : "+v"(pvv[0]), "+v"(pvv[1]), "+v"(pvv[2]), "+v"(pvv[3]), "+v"(pgi), "+v"(pgf));
        for (int ch = 0; ch < SROW / 64; ++ch) {
            const int t0 = ch * 64;
            const int sbase = z == 0 ? t0 : (t0 < CTXL ? CTXL - 1 - t0 : SROW + CTXL - 1 - t0);
#pragma unroll
            for (int rep = 0; rep < 2; ++rep) { const int cid = tid + 512 * rep, i = cid >> 4, cc = cid & 15;
                *(LAS u32x4*)(sQ + i * M4_QS + 8 * cc) = pq[rep]; *(LAS u32x4*)(sK + i * M4_QS + 8 * cc) = pkk[rep]; }
#pragma unroll
            for (int rep = 0; rep < 4; ++rep) { const int cid = tid + 512 * rep, i = cid & 63, cc = cid >> 6;
                const unsigned wv[4] = {pvv[rep].x, pvv[rep].y, pvv[rep].z, pvv[rep].w};
#pragma unroll
                for (int jj = 0; jj < 4; ++jj) { sVT[(8 * cc + 2 * jj) * M4_TS + i] = (bf16_t)(wv[jj] & 0xffffu); sVT[(8 * cc + 2 * jj + 1) * M4_TS + i] = (bf16_t)(wv[jj] >> 16); } }
            if (ch > 0 && tid < 128) fN[tid] = fSC[0] * fN[tid] + ((fNP[tid] + fNP[128 + tid]) + (fNP[256 + tid] + fNP[384 + tid]));
            if (tid < 64) { fI[tid] = pgi; fF[tid] = pgf; }
            if (ch + 1 < SROW / 64) M4_LOAD(ch + 1);
            LDS_BARRIER();
            if (w == 0) {
                const float ig = fI[lane], lf = fF[lane];
                float bc = lf;
                bc += dppz_<0x111>(bc); bc += dppz_<0x112>(bc); bc += dppz_<0x114>(bc); bc += dppz_<0x118>(bc);
                { const float t0 = rl_(bc, 15), t1 = rl_(bc, 31), t2 = rl_(bc, 47); bc += (lane >= 16 ? t0 : 0.f) + (lane >= 32 ? t1 : 0.f) + (lane >= 48 ? t2 : 0.f); }
                const float g = ig - bc;
                float pm = g;
                pm = fmaxf(pm, dppm_<0x111>(pm)); pm = fmaxf(pm, dppm_<0x112>(pm)); pm = fmaxf(pm, dppm_<0x114>(pm)); pm = fmaxf(pm, dppm_<0x118>(pm));
                { const float t0 = rl_(pm, 15), t1 = rl_(pm, 31), t2 = rl_(pm, 47); const float ninf = -__builtin_inff();
                  pm = fmaxf(pm, fmaxf(fmaxf(lane >= 16 ? t0 : ninf, lane >= 32 ? t1 : ninf), lane >= 48 ? t2 : ninf)); }
                const float b_end = rl_(bc, 63), pm_all = rl_(pm, 63);
                const float m_new = fmaxf(b_end + m_old, b_end + pm_all);
                const float mx = fmaxf(m_old, pm);
                fU[lane] = -mx; fG[lane] = g; fWI[lane] = __expf(m_old - mx); fEN[lane] = __expf(-mx - bc); fWS[lane] = __expf(b_end + g - m_new);
                if (lane == 0) { fSC[0] = __expf(b_end + m_old - m_new); fSC[1] = m_new; }
            }
            const int tb = w >> 1, jb0 = 2 * (w & 1);
            f32x4 St[2];
#pragma unroll
            for (int jj = 0; jj < 2; ++jj) { St[jj] = (f32x4){0.f, 0.f, 0.f, 0.f};
                if (jb0 + jj <= tb) {
#pragma unroll
                    for (int ks = 0; ks < 4; ++ks) { const bf16x8 av = *(const LAS bf16x8*)(sQ + (16 * tb + l15) * M4_QS + 32 * ks + 8 * q4);
                        const bf16x8 bv = *(const LAS bf16x8*)(sK + (16 * (jb0 + jj) + l15) * M4_QS + 32 * ks + 8 * q4);
                        St[jj] = __builtin_amdgcn_mfma_f32_16x16x32_bf16(av, bv, St[jj], 0, 0, 0); } } }
            LDS_BARRIER();
            { float rs[4] = {0.f, 0.f, 0.f, 0.f};
#pragma unroll
              for (int jj = 0; jj < 2; ++jj) { const int j = 16 * (jb0 + jj) + l15; const float gj = fG[j];
#pragma unroll
                  for (int i = 0; i < 4; ++i) { const int tt = 16 * tb + 4 * q4 + i; const float val = (j <= tt) ? St[jj][i] * __expf(fU[tt] + gj) : 0.f;
                      rs[i] += val; sP[tt * M4_TS + j] = (bf16_t)f2bfa(val); } }
#pragma unroll
              for (int i = 0; i < 4; ++i) { float v = rs[i]; v = sum16_(v);
                  if (l15 == 0) fRS[(w & 1) * 64 + 16 * tb + 4 * q4 + i] = v; } }
            { const int d = tid & 127, jg = tid >> 7; unsigned pk[8]; float nn = 0.f;
#pragma unroll
              for (int jj = 0; jj < 8; ++jj) { const int j0 = 16 * jg + 2 * jj; const float w0 = fWS[j0] * bf2f(sK[j0 * M4_QS + d]), w1 = fWS[j0 + 1] * bf2f(sK[(j0 + 1) * M4_QS + d]);
                  nn += w0 + w1; pk[jj] = pk2a(w0, w1); }
              fNP[jg * 128 + d] = nn;
              *(LAS u32x4*)(sWKT + d * M4_TS + 16 * jg) = (u32x4){pk[0], pk[1], pk[2], pk[3]};
              *(LAS u32x4*)(sWKT + d * M4_TS + 16 * jg + 8) = (u32x4){pk[4], pk[5], pk[6], pk[7]}; }
            { const int tt = tid >> 3, dp = tid & 7; float s = 0.f;
#pragma unroll
              for (int dd = 0; dd < 16; ++dd) s += bf2f(sQ[tt * M4_QS + 16 * dp + dd]) * fN[16 * dp + dd];
              s = sum8_(s);
              if (dp == 0) fQN[tt] = s; }
            LDS_BARRIER();
            asm volatile("s_waitcnt vmcnt(0)" ::: "memory");
            asm volatile("" : "+v"(pq[0]), "+v"(pq[1]), "+v"(pkk[0]), "+v"(pkk[1]));
            asm volatile("" : "+v"(pvv[0]), "+v"(pvv[1]), "+v"(pvv[2]), "+v"(pvv[3]), "+v"(pgi), "+v"(pgf));
#pragma unroll 1
            for (int x = (skip_ctx_out && t0 < CTXL) ? 4 : 0; x < 4; ++x) {
                f32x4 acc[2];
                acc[0] = (f32x4){0.f, 0.f, 0.f, 0.f}; acc[1] = (f32x4){0.f, 0.f, 0.f, 0.f};
#pragma unroll
                for (int kb = 0; kb < 4; ++kb) {
                    const LAS bf16_t* qr = sQ + (16 * x + l15) * M4_QS + 32 * kb + 4 * q4;
                    const u32x2 lo = *(const LAS u32x2*)qr, hi = *(const LAS u32x2*)(qr + 16);
                    const bf16x8 aop = __builtin_bit_cast(bf16x8, (u32x4){lo.x, lo.y, hi.x, hi.y});
#pragma unroll
                    for (int e = 0; e < 2; ++e) { const f32x4 c0 = Cacc[2 * kb][e], c1 = Cacc[2 * kb + 1][e];
                        u32x4 p; p.x = pk2a(c0[0], c0[1]); p.y = pk2a(c0[2], c0[3]); p.z = pk2a(c1[0], c1[1]); p.w = pk2a(c1[2], c1[3]);
                        acc[e] = __builtin_amdgcn_mfma_f32_16x16x32_bf16(aop, __builtin_bit_cast(bf16x8, p), acc[e], 0, 0, 0); } }
                { const f32x4 wi = *(const LAS f32x4*)(fWI + 16 * x + 4 * q4); acc[0] = acc[0] * wi; acc[1] = acc[1] * wi; }
#pragma unroll
                for (int ks = 0; ks < 2; ++ks) { const bf16x8 aop = *(const LAS bf16x8*)(sP + (16 * x + l15) * M4_TS + 32 * ks + 8 * q4);
#pragma unroll
                    for (int e = 0; e < 2; ++e) { const bf16x8 bop = *(const LAS bf16x8*)(sVT + (16 * (2 * w + e) + l15) * M4_TS + 32 * ks + 8 * q4);
                        acc[e] = __builtin_amdgcn_mfma_f32_16x16x32_bf16(aop, bop, acc[e], 0, 0, 0); } }
#pragma unroll
                for (int i = 0; i < 4; ++i) { const int tt = 16 * x + 4 * q4 + i;
                    const float den = fWI[tt] * fQN[tt] + fRS[tt] + fRS[64 + tt]; const float dv = __builtin_amdgcn_rcpf(fmaxf(fabsf(den), fEN[tt]));
                    const size_t row = rowb + sbase + sdir * tt;
#pragma unroll
                    for (int e = 0; e < 2; ++e) HZ[row * D + h * MDV + 16 * (2 * w + e) + l15] = (bf16_t)f2bfa(acc[e][i] * dv); }
            }
            { const float dec = fSC[0];
#pragma unroll
              for (int db = 0; db < 8; ++db)
#pragma unroll
                  for (int e = 0; e < 2; ++e) Cacc[db][e] = Cacc[db][e] * dec;
#pragma unroll
              for (int ks = 0; ks < 2; ++ks) {
                  bf16x8 bop[2];
#pragma unroll
                  for (int e = 0; e < 2; ++e) bop[e] = *(const LAS bf16x8*)(sVT + (16 * (2 * w + e) + l15) * M4_TS + 32 * ks + 8 * q4);
#pragma unroll
                  for (int db = 0; db < 8; ++db) { const bf16x8 aop = *(const LAS bf16x8*)(sWKT + (16 * db + l15) * M4_TS + 32 * ks + 8 * q4);
#pragma unroll
                      for (int e = 0; e < 2; ++e) Cacc[db][e] = __builtin_amdgcn_mfma_f32_16x16x32_bf16(aop, bop[e], Cacc[db][e], 0, 0, 0); } }
 }
            m_old = fSC[1];
            LDS_BARRIER();
        }
#undef M4_LOAD
    }
}

__device__ __forceinline__ void m5_readout(const Tc& t, CArgs a, int jl, bool latent_only) {
    const bf16_t* H0 = (const bf16_t*)(a->ws + WS_ACT + AM_HB), *H1 = (const bf16_t*)(a->ws + WS_ACT + AM_HZ1);
    const bf16_t* U = (const bf16_t*)(a->ws + WS_ACT + AM_U);
    bf16_t* Ao = (bf16_t*)(a->ws + WS_ACT + AM_QK);
    const int sl = t.gw & 3, c0 = 512 * sl + 8 * t.lane;
    const float* nw = a->in[I_MNORMW] + (size_t)jl * D + c0;
    const f32x4 w0 = *(const f32x4*)nw, w1 = *(const f32x4*)(nw + 4);
    const float w8[8] = {w0.x, w0.y, w0.z, w0.w, w1.x, w1.y, w1.z, w1.w};
    const int rstep = t.ngw >> 2;
    const int NR = latent_only ? NB * SEQ : T;
    auto rmap = [&](int rr) -> int { return latent_only ? (rr / SEQ) * SROW + CTXL + rr % SEQ : rr; };
    for (int r0 = t.gw >> 2; r0 < NR; r0 += 4 * rstep) {
        u32x4 h0[4], h1[4], ov[4];
#pragma unroll
        for (int k = 0; k < 4; ++k) { const int row = rmap(r0 + k * rstep < NR ? r0 + k * rstep : r0); const size_t off = (size_t)row * D + c0;
            h0[k] = *(const u32x4*)(H0 + off); h1[k] = *(const u32x4*)(H1 + off); ov[k] = *(const u32x4*)(U + (size_t)row * ULD + 4096 + c0); }
        asm volatile("" ::: "memory");
#pragma unroll
        for (int k = 0; k < 4; ++k) { if (r0 + k * rstep >= NR) break; const int row = rmap(r0 + k * rstep); const size_t off = (size_t)row * D + c0;
            const unsigned a0[4] = {h0[k].x, h0[k].y, h0[k].z, h0[k].w}, a1[4] = {h1[k].x, h1[k].y, h1[k].z, h1[k].w}, ao[4] = {ov[k].x, ov[k].y, ov[k].z, ov[k].w};
            float y[8]; float s = 0.f;
#pragma unroll
            for (int i = 0; i < 4; ++i) { y[2 * i] = lo_bf(a0[i]) + lo_bf(a1[i]); y[2 * i + 1] = hi_bf(a0[i]) + hi_bf(a1[i]); s += y[2 * i] + y[2 * i + 1]; }
            s = sum16_(s); s += shfl_xor_(s, 16, t.lane);
            const float mean = s * (1.0f / 256.0f);
            float qq = 0.f;
#pragma unroll
            for (int i = 0; i < 8; ++i) { y[i] -= mean; qq += y[i] * y[i]; }
            qq = sum16_(qq); qq += shfl_xor_(qq, 16, t.lane);
            const float rstd = rsqrtf(qq * (1.0f / 256.0f) + 1e-6f);
            float o[8];
#pragma unroll
            for (int i = 0; i < 4; ++i) { o[2 * i] = y[2 * i] * rstd * w8[2 * i] * sigmoidf_(lo_bf(ao[i])); o[2 * i + 1] = y[2 * i + 1] * rstd * w8[2 * i + 1] * sigmoidf_(hi_bf(ao[i])); }
            u32x4 wv; wv.x = pk2(o[0], o[1]); wv.y = pk2(o[2], o[3]); wv.z = pk2(o[4], o[5]); wv.w = pk2(o[6], o[7]);
            *(u32x4*)(Ao + off) = wv; }
        asm volatile("" ::: "memory");
    }
}

__device__ __forceinline__ void final_norm(const Tc& t, CArgs a) {
    const float* xres = (const float*)(a->ws + WS_XRES);
    f32x4 gg[8];
    { const f32x4* gp = (const f32x4*)a->in[I_FINALG] + t.lane;
#pragma unroll
      for (int j = 0; j < 8; ++j) gg[j] = gp[64 * j]; }
    for (int r0 = t.gw; r0 < NB * SEQ; r0 += 2 * t.ngw) {
        f32x4 v[2][8];
#pragma unroll
        for (int k = 0; k < 2; ++k) { const int r = r0 + k * t.ngw < NB * SEQ ? r0 + k * t.ngw : r0; const size_t row = (size_t)(r / SEQ) * SROW + CTXL + (r % SEQ);
            const f32x4* xr = (const f32x4*)(xres + row * D) + t.lane;
#pragma unroll
            for (int j = 0; j < 8; ++j) v[k][j] = xr[64 * j]; }
        asm volatile("" ::: "memory");
#pragma unroll
        for (int k = 0; k < 2; ++k) { const int r = r0 + k * t.ngw; if (r >= NB * SEQ) break;
            float ss = 0.f;
#pragma unroll
            for (int j = 0; j < 8; ++j) ss += (v[k][j].x * v[k][j].x + v[k][j].y * v[k][j].y) + (v[k][j].z * v[k][j].z + v[k][j].w * v[k][j].w);
            const float rstd = rsqrtf(wave_sum_dpp(ss) * (1.0f / D) + 1e-6f);
            f32x4* o = (f32x4*)(a->out + (size_t)r * D) + t.lane;
#pragma unroll
            for (int j = 0; j < 8; ++j) o[64 * j] = v[k][j] * rstd * gg[j]; }
        asm volatile("" ::: "memory");
    }
}
constexpr int NU_FULL = (T / 256) * (D / 256), NU_SKIP = (T / 9 * 8 / 256) * (D / 256);
constexpr int NSEG = 1 + 2 * (12 + 1 + 3) + 2 * (6 + 3) + 1;

__global__ void __launch_bounds__(512, 2) hybrid_fwd(Args args) {
    extern __shared__ __attribute__((aligned(16))) unsigned char lds_raw[];
    LAS unsigned char* const lds = (LAS unsigned char*)lds_raw;
    volatile LAS unsigned* MISC = (volatile LAS unsigned*)(lds + LDSCTL_OFF);
    if (threadIdx.x < 64) MISC[threadIdx.x] = 0u;
    __syncthreads();
    const int lo = args.ph_lo, hi = args.ph_hi;
    const bool fused = (hi - lo) > 1;
    unsigned* barw = (unsigned*)(args.ws + WS_CTL) + 4096;
    XcdBarrier bar; bar.bar = barw; bar.x = 0; bar.st = MISC + 8;
    if (fused) bar = xcd_barrier_post(barw, MISC + 8);
    int seg = 0;
    int urot = 0;
#define ACTIVE (seg >= lo && seg < hi)
#define PH_BEGIN const Tc t = mk_tc(lds); const CArgs a = opaque_args(); unsigned char* const act = a->ws + WS_ACT; (void)act; (void)t;
#define SEAM() do { if (fused && seg >= lo && seg + 1 < hi) xcd_barrier(bar); ++seg; } while (0)

    if (ACTIVE) { PH_BEGIN ph_prologue(t, a); }
    SEAM();
    for (int layer = 0; layer < 4; ++layer) {
        const int jl = layer >> 1;
        if ((layer & 1) == 0) {
            for (int g = 0; g < NGRP; ++g) {
                if (ACTIVE) { PH_BEGIN if (g == 0 && layer == 0) convert_rwkv(t, a, 0);
                    norm_rows<true>(t, a, layer, 0, g * TG, TG, act + AR_H, layer == 0); }
                SEAM();
                if (ACTIVE) { PH_BEGIN r2_mix(t, a, jl); }
                SEAM();
                if (ACTIVE) {
                    PH_BEGIN const bf16_t* wm = (const bf16_t*)(a->ws + WS_WMIX);
                    bf16_t* vdst = (layer == 0) ? (bf16_t*)(a->ws + WS_VF) + (size_t)g * TG * D : (bf16_t*)(act + AR_V);
                    const bf16_t* mix[6];
#pragma unroll
                    for (int m = 0; m < 6; ++m) mix[m] = (const bf16_t*)(act + AR_MIX + (size_t)m * SLOT);
                    for (int q = 0; q < 7; ++q) {
                        if (q == 6 && jl == 0) break;
                        const bf16_t* A = q == 0 ? mix[0] : q == 1 ? mix[2] : q == 2 ? mix[3] : q == 3 ? mix[1] : q == 4 ? mix[4] : q == 5 ? mix[5] : mix[3];
                        const size_t wo = q == 0 ? WM_R : q == 1 ? WM_K : q == 2 ? WM_V : q == 3 ? WM_W1 : q == 4 ? WM_A1 : q == 5 ? WM_G1 : WM_V1;
                        bf16_t* O = q == 0 ? (bf16_t*)(act + AR_R) : q == 1 ? (bf16_t*)(act + AR_K) : q == 2 ? vdst : (bf16_t*)(act + AR_LORA + (size_t)(q - 3) * 9 * MiB);
                        const int N = q < 3 ? D : 256; const int actf = q == 3 ? 1 : q == 5 ? 2 : 0;
                        pg8::EpiStore E{O, N, actf, 0, 0, -1, nullptr, nullptr};
                        run_gemm(t.lds, A, (const bf16_t*)((const char*)wm + wo), TG, N, D, E, urot);
                    }
                }
                SEAM();
                if (ACTIVE) {
                    PH_BEGIN const bf16_t* wm = (const bf16_t*)(a->ws + WS_WMIX);
                    const bf16_t* lora = (const bf16_t*)(act + AR_LORA);
                    for (int q = 0; q < 2; ++q) {
                        pg8::EpiSigAff E{(bf16_t*)(act + AR_MIX + (size_t)(2 * q) * SLOT), (size_t)TG * D, a->in[q == 0 ? I_W0 : I_A0] + (size_t)jl * 2 * D, q == 0 ? -0.6065306597126334f : 1.0f};
                        run_gemm(t.lds, lora + (size_t)q * TG * 256, (const bf16_t*)((const char*)wm + (q == 0 ? WM_W2 : WM_A2)), TG, 2 * D, 256, E, urot);
                    }
                    { pg8::EpiStore E{(bf16_t*)(act + AR_MIX + 4 * SLOT), D, 0, 0, 0, -1, nullptr, nullptr};
                      run_gemm(t.lds, lora + (size_t)2 * TG * 256, (const bf16_t*)((const char*)wm + WM_G2), TG, D, 256, E, urot); }
                    if (jl > 0) { pg8::EpiVmix E{(bf16_t*)(act + AR_V), (const bf16_t*)(a->ws + WS_VF) + (size_t)g * TG * D, a->in[I_V0] + (size_t)(jl - 1) * D};
                      run_gemm(t.lds, lora + (size_t)3 * TG * 256, (const bf16_t*)((const char*)wm + WM_V2), TG, D, 256, E, urot); }
                }
                SEAM();
                if (ACTIVE) { PH_BEGIN r5_scan(t, a, jl, layer, g); }
                SEAM();
                if (ACTIVE) { PH_BEGIN r6_readout(t, a, jl, layer, g); }
                SEAM();
            }
            if (ACTIVE) { PH_BEGIN pg8::EpiResid E{(float*)(a->ws + WS_XRES), (const float*)(a->ws + WS_MOD) + (size_t)layer * 17 * MODLD + 2 * D, 0, layer == 0 ? a->in[I_X] : nullptr, a->in[I_CTX]};
                run_gemm(t.lds, (const bf16_t*)(act + AR_AO), (const bf16_t*)(a->ws + WS_WMIX + WM_O), T, D, D, E, urot);
                { const Tc t2 = mk_tc(lds); const CArgs a2 = opaque_args(); Tc ts; if (tail_crew(t2, urot - NU_FULL, NU_FULL, ts)) { __syncthreads(); convert_ffn_out(ts, a2, layer); if (layer == 0) convert_ffn_in(ts, a2, 0); } } }
            SEAM();
        } else {
            if (ACTIVE) { PH_BEGIN norm_rows<true>(t, a, layer, 0, 0, T, act + AM_HB); }
            SEAM();
            if (ACTIVE) { PH_BEGIN const bf16_t* win = (const bf16_t*)(a->ws + WS_WMIX + WM_MIN); float* Gp = (float*)(act + AM_G); const float* bg = a->in[I_BGATE] + (size_t)jl * 32;
                if (layer == 3) {
                    { pg8::EpiStore E{(bf16_t*)(act + AM_U), ULD, 0, 0, 0, -1, nullptr, nullptr};
                      run_gemm(t.lds, (const bf16_t*)(act + AM_HB), win, T, 4096, D, E, urot); }
                    { pg8::EpiStore E{(bf16_t*)(act + AM_U) + 4096, ULD, 0, 0, 0, 8, Gp, bg};
                      run_gemm<pg8::EpiStore, true>(t.lds, (const bf16_t*)(act + AM_HB), win + (size_t)4096 * D, T, 2304, D, E, urot); }
                    { pg8::EpiStore E{(bf16_t*)(act + AM_U), ULD, 0, 0, 0, 0, Gp, bg};
                      run_gemm_ctx(t.lds, (const bf16_t*)(act + AM_HB), win + (size_t)6144 * D, T, 256, D, E, urot); }
                } else { pg8::EpiStore E{(bf16_t*)(act + AM_U), ULD, 0, 0, 0, 24, Gp, bg};
                    run_gemm(t.lds, (const bf16_t*)(act + AM_HB), win, T, 6400, D, E, urot); } }
            SEAM();
            if (ACTIVE) { PH_BEGIN m3_conv(t, a, jl); }
            SEAM();
            if (ACTIVE) { PH_BEGIN m4_scan(t, a, layer == 3); }
            SEAM();
            if (ACTIVE) { PH_BEGIN m5_readout(t, a, jl, layer == 3); }
            SEAM();
            if (ACTIVE) { PH_BEGIN pg8::EpiResid E{(float*)(a->ws + WS_XRES), (const float*)(a->ws + WS_MOD) + (size_t)layer * 17 * MODLD + 2 * D, 0, nullptr, nullptr};
                if (layer == 3) run_gemm<pg8::EpiResid, true>(t.lds, (const bf16_t*)(act + AM_QK), (const bf16_t*)(a->ws + WS_WMIX + WM_MOUT), T, D, D, E, urot);
                else run_gemm(t.lds, (const bf16_t*)(act + AM_QK), (const bf16_t*)(a->ws + WS_WMIX + WM_MOUT), T, D, D, E, urot);
                { const Tc t2 = mk_tc(lds); const CArgs a2 = opaque_args(); Tc ts; const int nu = layer == 3 ? NU_SKIP : NU_FULL; if (tail_crew(t2, urot - nu, nu, ts)) { __syncthreads(); convert_ffn_out(ts, a2, layer); } } }
            SEAM();
        }
        if (ACTIVE) { PH_BEGIN if (layer == 3) norm_rows<true>(t, a, layer, 1, 0, NB * SEQ, act + AF_H2, false, true); else norm_rows<true>(t, a, layer, 1, 0, T, act + AF_H2); }
        SEAM();
        if (ACTIVE) { PH_BEGIN pg8::EpiSwiglu E{(bf16_t*)(act + AF_U)};
            if (layer == 3) run_gemm<pg8::EpiSwiglu, true>(t.lds, (const bf16_t*)(act + AF_H2), (const bf16_t*)(a->ws + WS_WFFN + WF_IN), T, 2 * DFF, D, E, urot);
            else run_gemm(t.lds, (const bf16_t*)(act + AF_H2), (const bf16_t*)(a->ws + WS_WFFN + WF_IN), T, 2 * DFF, D, E, urot); }
        SEAM();
        if (ACTIVE) { PH_BEGIN pg8::EpiResid E{(float*)(a->ws + WS_XRES), (const float*)(a->ws + WS_MOD) + (size_t)layer * 17 * MODLD + 5 * D, 0, nullptr, nullptr};
            if (layer == 3) run_gemm<pg8::EpiResid, true>(t.lds, (const bf16_t*)(act + AF_U), (const bf16_t*)(a->ws + WS_WFFN + WF_OUT), T, D, DFF, E, urot);
            else run_gemm(t.lds, (const bf16_t*)(act + AF_U), (const bf16_t*)(a->ws + WS_WFFN + WF_OUT), T, D, DFF, E, urot);
            if (layer < 3) { const Tc t2 = mk_tc(lds); const CArgs a2 = opaque_args(); Tc ts; if (tail_crew(t2, urot - NU_FULL, NU_FULL, ts)) { __syncthreads();
                if (layer & 1) convert_rwkv(ts, a2, (layer + 1) >> 1); else convert_mlstm(ts, a2, (layer + 1) >> 1);
                convert_ffn_in(ts, a2, layer + 1); } } }
        SEAM();
    }
    if (ACTIVE) { PH_BEGIN final_norm(t, a); }
#undef ACTIVE
#undef SEAM
#undef PH_BEGIN
}

#ifndef MK_MULTI
#define MK_MULTI 0
#endif
extern "C" void kernel_launch(void* const* d_in, const int* in_sizes, int n_in, void* d_out, int out_size, void* d_ws, size_t ws_size, hipStream_t stream) {
    static int grid = 0;
    if (grid == 0) {
        if (n_in != NIN || ws_size < WS_END) { fprintf(stderr, "kernel_launch: unexpected n_in %d / ws %zu\n", n_in, ws_size); grid = -1; return; }
        int dev = 0, cus = 0, per_cu = 0;
        if (hipGetDevice(&dev) != hipSuccess || hipDeviceGetAttribute(&cus, hipDeviceAttributeMultiprocessorCount, dev) != hipSuccess) { grid = -1; return; }
        if (hipFuncSetAttribute((const void*)hybrid_fwd, hipFuncAttributeMaxDynamicSharedMemorySize, LDS_BYTES) != hipSuccess) { fprintf(stderr, "kernel_launch: hipFuncSetAttribute failed\n"); grid = -1; return; }
        if (hipOccupancyMaxActiveBlocksPerMultiprocessor(&per_cu, (const void*)hybrid_fwd, 512, LDS_BYTES) != hipSuccess || per_cu < 1)
            fprintf(stderr, "kernel_launch: occupancy query reports %d workgroups per CU\n", per_cu);
        (void)hipGetLastError();
        grid = cus;
    }
    if (grid < 0) return;
    if (hipMemsetAsync((char*)d_ws + WS_CTL, 0, CTL_ZERO_BYTES, stream) != hipSuccess) return;
    Args a{};
    for (int i = 0; i < NIN; ++i) a.in[i] = (const float*)d_in[i];
    a.out = (float*)d_out; a.ws = (unsigned char*)d_ws;
#if MK_MULTI
    for (int s = 0; s < NSEG; ++s) { a.ph_lo = s; a.ph_hi = s + 1; hipLaunchKernelGGL(hybrid_fwd, dim3(grid), dim3(512), LDS_BYTES, stream, a); }
#else
    a.ph_lo = 0; a.ph_hi = NSEG;
    hipLaunchKernelGGL(hybrid_fwd, dim3(grid), dim3(512), LDS_BYTES, stream, a);
#endif
}
```

```cpp
#include <hip/hip_runtime.h>
#include <cstdio>
#include <cstdint>

#define LAS __attribute__((address_space(3)))
#define GAS __attribute__((address_space(1)))
typedef unsigned short bf16_t;
typedef short bf16x8 __attribute__((ext_vector_type(8)));
typedef short bf16x4 __attribute__((ext_vector_type(4)));
typedef float f32x4 __attribute__((ext_vector_type(4)));
typedef float f32x2 __attribute__((ext_vector_type(2)));
typedef unsigned u32x4 __attribute__((ext_vector_type(4)));
typedef unsigned u32x2 __attribute__((ext_vector_type(2)));
#define LDS_WAIT() asm volatile("s_waitcnt lgkmcnt(0)" ::: "memory")
#define LDS_BARRIER() asm volatile("s_waitcnt lgkmcnt(0)\n\ts_barrier" ::: "memory")
#define VM_WAIT() asm volatile("s_waitcnt vmcnt(0)" ::: "memory")

constexpr int D = 2048, NB = 16, SEQ = 2048, CTXL = 256, SROW = 2304, T = NB * SROW;
constexpr int NGRP = 2, BG = 8, TG = BG * SROW;
constexpr int DFF = 5632;
constexpr int RH = 32;
constexpr int MH = 8, MDV = 256, MDK = 128, MPROJ = 6176, ULD = 6144;
constexpr int MODLD = 6 * D;
constexpr int NIN = 37;
enum { I_X = 0, I_C, I_CTX, I_CCTX, I_MODW, I_MODB, I_NORMG, I_FINALG, I_MU, I_WR, I_WK, I_WV, I_WO, I_W0, I_W1, I_W2, I_A0, I_A1, I_A2, I_G1, I_G2, I_KK, I_KA, I_RK, I_LNW, I_LNB,
       I_V0, I_V1, I_V2, I_MWIN, I_BGATE, I_CONVW, I_CONVB, I_MNORMW, I_MWOUT, I_FWIN, I_FWOUT };

constexpr size_t MiB = 1u << 20;
constexpr size_t WS_CTL = 0, CTL_ZERO_BYTES = 1 * MiB;
constexpr size_t WS_MOD = 1 * MiB;
constexpr size_t WS_XRES = 5 * MiB;
constexpr size_t WS_VF = 293 * MiB;
constexpr size_t WS_WMIX = 437 * MiB;
constexpr size_t WS_WFFN = 479 * MiB;
constexpr size_t WS_ACT = 545 * MiB;
constexpr size_t WS_END = WS_ACT + 977 * MiB;
static_assert(WS_END <= (size_t)1536 * MiB, "ws");
constexpr size_t WM_R = 0, WM_K = 8 * MiB, WM_V = 16 * MiB, WM_O = 24 * MiB, WM_W1 = 32 * MiB, WM_A1 = 33 * MiB, WM_G1 = 34 * MiB, WM_V1 = 35 * MiB,
                 WM_W2 = 36 * MiB, WM_A2 = 38 * MiB, WM_G2 = 40 * MiB, WM_V2 = 41 * MiB;
constexpr size_t WM_MIN = 0, WM_MOUT = 25 * MiB;
constexpr size_t WF_IN = 0, WF_OUT = 44 * MiB;
constexpr size_t SLOT = 72 * MiB;
constexpr size_t AR_MIX = 0;
constexpr size_t AR_H = 432 * MiB;
constexpr size_t AR_R = 432 * MiB, AR_K = 504 * MiB, AR_V = 576 * MiB;
constexpr size_t AR_LORA = 648 * MiB;
constexpr size_t AR_Y = 684 * MiB;
constexpr size_t AR_RK = 828 * MiB;
constexpr size_t AR_AO = 833 * MiB;
constexpr size_t AM_HB = 0, AM_U = 144 * MiB, AM_QK = 576 * MiB, AM_HZ1 = 720 * MiB, AM_G = 864 * MiB;
constexpr size_t AF_H2 = 0, AF_U = 144 * MiB;

constexpr int LDS_BYTES = 147456;
constexpr int LDSCTL_OFF = LDS_BYTES - 256;

__device__ __forceinline__ float bf2f(bf16_t b) { return __uint_as_float(((unsigned)b) << 16); }
typedef __bf16 bf16x2n_t __attribute__((ext_vector_type(2)));
__device__ __forceinline__ unsigned pk2(float lo, float hi) { const f32x2 v = {lo, hi}; return __builtin_bit_cast(unsigned, __builtin_convertvector(v, bf16x2n_t)); }
__device__ __forceinline__ unsigned f2bf(float f) { return pk2(f, f) & 0xffffu; }
__device__ __forceinline__ unsigned pk2a(float lo, float hi) { unsigned r; asm("v_cvt_pk_bf16_f32 %0, %1, %2" : "=v"(r) : "v"(lo), "v"(hi)); return r; }
__device__ __forceinline__ unsigned f2bfa(float f) { return pk2a(f, f) & 0xffffu; }
__device__ __forceinline__ float lo_bf(unsigned w) { return __uint_as_float(w << 16); }
__device__ __forceinline__ float hi_bf(unsigned w) { return __uint_as_float(w & 0xffff0000u); }
__device__ __forceinline__ float sigmoidf_(float x) { return __builtin_amdgcn_rcpf(1.0f + __expf(-x)); }
__device__ __forceinline__ float tanhf_(float x) { return 1.0f - 2.0f * __builtin_amdgcn_rcpf(1.0f + __expf(2.0f * x)); }
__device__ __forceinline__ float siluf_(float x) { return x * __builtin_amdgcn_rcpf(1.0f + __expf(-x)); }
template <int CTRL> __device__ __forceinline__ float dpp_(float v) { return __int_as_float(__builtin_amdgcn_update_dpp(0, __float_as_int(v), CTRL, 0xF, 0xF, true)); }
__device__ __forceinline__ float rl_(float v, int k) { return __int_as_float(__builtin_amdgcn_readlane(__float_as_int(v), k)); }
__device__ __forceinline__ float sum8_(float v) { v += dpp_<0xB1>(v); v += dpp_<0x4E>(v); v += dpp_<0x141>(v); return v; }
__device__ __forceinline__ float sum16_(float v) { v = sum8_(v); v += dpp_<0x140>(v); return v; }
__device__ __forceinline__ float wave_sum_dpp(float v) { v = sum16_(v); return (rl_(v, 0) + rl_(v, 16)) + (rl_(v, 32) + rl_(v, 48)); }
__device__ __forceinline__ float wave_sum(float v) { return wave_sum_dpp(v); }
__device__ __forceinline__ float shfl_xor_(float v, int mask, int lane) { return __int_as_float(__builtin_amdgcn_ds_bpermute((lane ^ mask) << 2, __float_as_int(v))); }

#define XB_TMO      128
#define XB_XCNT(j)  (256  + 64 * (j))
#define XB_XSUB(j)  (1280 + 64 * (j))
#define XB_XGEN(j)  (2304 + 64 * (j))
#define XB_TOP      3328
#define XB_TOPGEN   3392
#define XCD_BAR_WORDS 3456
#define XB_SPIN_CAP (1u << 24)

__device__ __forceinline__ unsigned xb_ld(unsigned* p)              { return __hip_atomic_load(p, __ATOMIC_RELAXED, __HIP_MEMORY_SCOPE_AGENT); }
__device__ __forceinline__ unsigned xb_add(unsigned* p, unsigned v) { return __hip_atomic_fetch_add(p, v, __ATOMIC_RELAXED, __HIP_MEMORY_SCOPE_AGENT); }
__device__ __forceinline__ unsigned xb_xcc_id() { return (unsigned)__builtin_amdgcn_s_getreg((3 << 11) | 20) & 0xFu; }
#define XB_SPIN(cond, bar) do { unsigned _sp = 0; while (cond) { __builtin_amdgcn_s_sleep(1); \
    if ((++_sp & 255u) == 0u) { if (xb_ld(&(bar)[XB_TMO])) break; if (_sp > XB_SPIN_CAP) { atomicAdd(&(bar)[XB_TMO], 1u); break; } } } } while (0)

struct XcdBarrier { unsigned* bar; unsigned x; volatile LAS unsigned* st; };

__device__ __forceinline__ XcdBarrier xcd_barrier_post(unsigned* bar, volatile LAS unsigned* st) {
    XcdBarrier b; b.bar = bar; b.x = xb_xcc_id(); b.st = st;
    if (threadIdx.x == 0) (void)xb_add(&bar[XB_XCNT(b.x)], 1u);
    return b;
}
__device__ __forceinline__ void xcd_barrier_complete(unsigned* bar, unsigned x, unsigned& nloc, unsigned& nx) {
    const unsigned G = gridDim.x * gridDim.y * gridDim.z;
    unsigned sum, cnt, mine, sp = 0u;
    for (;;) {
        sum = 0u; cnt = 0u; mine = 0u;
#pragma unroll
        for (unsigned j = 0; j < 16; ++j) { const unsigned c = xb_ld(&bar[XB_XCNT(j)]); sum += c; cnt += (c > 0u) ? 1u : 0u; mine = (j == x) ? c : mine; }
        if (sum == G) break;
        __builtin_amdgcn_s_sleep(1);
        if ((++sp & 255u) == 0u) { if (xb_ld(&bar[XB_TMO])) break; if (sp > XB_SPIN_CAP) { atomicAdd(&bar[XB_TMO], 1u); break; } }
    }
    nloc = mine > 0u ? mine : 1u; nx = cnt > 0u ? cnt : 1u;
}
__device__ __forceinline__ void xcd_barrier(const XcdBarrier& b) {
    asm volatile("s_waitcnt vmcnt(0)" ::: "memory");
    __syncthreads();
    if (threadIdx.x == 0) {
        unsigned* bar = b.bar;
        __builtin_amdgcn_s_waitcnt(0);
        unsigned nloc = b.st[0], nx = b.st[1];
        if (nloc == 0u) { xcd_barrier_complete(bar, b.x, nloc, nx); b.st[0] = nloc; b.st[1] = nx; }
        const unsigned old = xb_add(&bar[XB_XSUB(b.x)], 1u);
        const unsigned gen = old / nloc;
        if (old + 1u == (gen + 1u) * nloc) {
            __builtin_amdgcn_fence(__ATOMIC_RELEASE, "agent");
            asm volatile("s_waitcnt vmcnt(0)" ::: "memory");
            const unsigned og = xb_add(&bar[XB_TOP], 1u);
            const unsigned tg = og / nx;
            if (og + 1u == (tg + 1u) * nx) xb_add(&bar[XB_TOPGEN], 1u);
            else XB_SPIN(xb_ld(&bar[XB_TOPGEN]) == tg, bar);
            __builtin_amdgcn_fence(__ATOMIC_ACQUIRE, "agent");
            xb_add(&bar[XB_XGEN(b.x)], 1u);
            asm volatile("s_waitcnt vmcnt(0)" ::: "memory");
        } else {
            XB_SPIN(xb_ld(&bar[XB_XGEN(b.x)]) == gen, bar);
            __builtin_amdgcn_fence(__ATOMIC_ACQUIRE, "agent");
            asm volatile("s_waitcnt vmcnt(0)" ::: "memory");
        }
    }
    __syncthreads();
}
#ifndef GP_ALIGN
#define GP_ALIGN true
#endif
#ifndef GP_SP2
#define GP_SP2 true
#endif
namespace pg8 {
constexpr int BM = 256, BK = 64, HALF = 128, HTB = HALF * BK * 2  , STAGE_BYTES = 8 * HTB, NXCD = 8, WGM = 8;

__host__ __device__ __forceinline__ int lds_byte(int r, int c) { const int st = (r >> 4) * 2 + (c >> 5), rr = r & 15, cc = c & 31, ob = rr * 64 + cc * 2; return st * 1024 + (ob ^ (((ob >> 9) & 1) << 5)); }
__host__ __device__ __forceinline__ void stage_rc(int b, int& R, int& C) { const int st = b / 1024, sb = b % 1024, swz = sb ^ (((sb >> 9) & 1) << 5); R = (st >> 1) * 16 + swz / 64; C = (st & 1) * 32 + (swz % 64) / 2; }
__host__ __device__ __forceinline__ int perm32(int rho) { const int n = rho >> 4, i = rho & 15; return 8 * (i >> 2) + 4 * n + (i & 3); }

struct Unit { int pm, pn; };
struct Gemm { const bf16_t* A; const bf16_t* Bt; int M, N, K; };

struct StaticOrder {
    int nM, nN, nwg, G, c;
    __host__ __device__ void init(int M, int N, int G_, int c_) { nM = M / BM; nN = N / BM; nwg = nM * nN; G = G_; c = c_; }
    __host__ __device__ bool next(int i, Unit& u) const {
        const long L = (long)i * G + c; if (L >= nwg) return false;
        int wgid = (int)L; { const int q = nwg / NXCD, r = nwg % NXCD, xcd = wgid % NXCD, off = wgid / NXCD; wgid = (xcd < r ? xcd * (q + 1) : r * (q + 1) + (xcd - r) * q) + off; }
        const int nig = WGM * nN, gid = wgid / nig, fm = gid * WGM, gsz = (nM - fm) < WGM ? (nM - fm) : WGM;
        u.pm = fm + ((wgid % nig) % gsz); u.pn = (wgid % nig) / gsz; return true;
    }
    __device__ __forceinline__ void a_ready(const Unit&) const {}
    __device__ __forceinline__ void done(const Unit&) const {}
};
__device__ __forceinline__ unsigned cvt_pk_bf16(float lo, float hi) { unsigned r; asm volatile("v_cvt_pk_bf16_f32 %0, %1, %2" : "=v"(r) : "v"(lo), "v"(hi)); return r; }
template <class Epi, class Sched, bool ALIGN_EPI = false, bool SP2 = false>
__device__ __forceinline__ void gemm_phase(LAS unsigned char* lds, const Gemm g, const Sched& S, const Epi& E) {
    int tid_ = threadIdx.x; asm volatile("" : "+v"(tid_));
    const int tid = tid_, wid = __builtin_amdgcn_readfirstlane(tid >> 6), lane = tid & 63, wr = wid >> 2, wc = wid & 3, fr = lane & 15, fq = lane >> 4;
    const int K = g.K, nt = K / BK;
    unsigned voffA[2], voffB[2];
#pragma unroll
    for (int i = 0; i < 2; ++i) { int R, C; stage_rc(tid * 16 + i * 8192, R, C); const int Rb = Epi::PERM ? ((R & ~31) + perm32(R & 31)) : R;
        voffA[i] = (unsigned)(R * K + C) * 2u; voffB[i] = (unsigned)(Rb * K + C) * 2u; }
    const size_t kstep = (size_t)(BK * 2);
    const size_t hstep = (size_t)HALF * K * 2;
    const size_t tstep = 2 * hstep;
    const unsigned ldsw = (unsigned)wid * 1024u;
    const int aoff = lds_byte(wr * 64 + fr, fq * 8), boff = lds_byte(wc * 32 + fr, fq * 8);
#define PG8_SA(b, h) (((b) * 2 + (h)) * HTB)
#define PG8_SB(b, h) ((4 + (b) * 2 + (h)) * HTB)
#define PG8_STAGE(bufoff, gbase, voff) do { _Pragma("unroll") for (int _i = 0; _i < 2; ++_i) \
        __builtin_amdgcn_global_load_lds((const unsigned*)((const char*)(gbase) + (voff)[_i]), (LAS unsigned*)(lds + (bufoff) + ldsw + _i * 8192), 16, 0, 0); } while (0)
#define PG8_LDA(dst, b, h) do { _Pragma("unroll") for (int m = 0; m < 4; ++m) _Pragma("unroll") for (int k = 0; k < 2; ++k) dst[m][k] = *(const LAS bf16x8*)(lds + PG8_SA(b, h) + aoff + m * 2048 + k * 1024); } while (0)
#define PG8_LDB(dst, b, h) do { _Pragma("unroll") for (int n = 0; n < 2; ++n) _Pragma("unroll") for (int k = 0; k < 2; ++k) dst[n][k] = *(const LAS bf16x8*)(lds + PG8_SB(b, h) + boff + n * 2048 + k * 1024); } while (0)
#define PG8_MMA(ai, bj, At, Bt) do { __builtin_amdgcn_s_setprio(1); _Pragma("unroll") for (int m = 0; m < 4; ++m) _Pragma("unroll") for (int n = 0; n < 2; ++n) _Pragma("unroll") for (int k = 0; k < 2; ++k) \
        acc[ai][bj][m][n] = __builtin_amdgcn_mfma_f32_16x16x32_bf16(Bt[n][k], At[m][k], acc[ai][bj][m][n], 0, 0, 0); __builtin_amdgcn_s_setprio(0); } while (0)
#define PG8_WAIT_V(n) asm volatile("s_waitcnt vmcnt(" #n ")" ::: "memory")
#define PG8_WAIT_L(n) asm volatile("s_waitcnt lgkmcnt(" #n ")" ::: "memory")
#define PG8_BAR __builtin_amdgcn_s_barrier()
#define PG8_SCHED __builtin_amdgcn_sched_barrier(0)
    Unit cur, nxt; int ui = 0;
    if (!S.next(0, cur)) return;
    f32x4 acc[2][2][4][2];
    float zf_ = 0.f; asm volatile("" : "+v"(zf_));
#pragma unroll
    for (int a = 0; a < 2; ++a)
#pragma unroll
        for (int b = 0; b < 2; ++b)
#pragma unroll
            for (int m = 0; m < 4; ++m)
#pragma unroll
                for (int n = 0; n < 2; ++n) acc[a][b][m][n] = (f32x4){zf_, zf_, zf_, zf_};
    bf16x8 At[4][2], B0[2][2], B1[2][2];
    const char* cA = (const char*)g.A + (size_t)cur.pm * tstep; const char* cB = (const char*)g.Bt + (size_t)cur.pn * tstep;
    S.a_ready(cur);
    if constexpr (SP2) {
        PG8_STAGE(PG8_SB(0, 0), cB, voffB); PG8_STAGE(PG8_SB(0, 1), cB + hstep, voffB); PG8_STAGE(PG8_SA(0, 0), cA, voffA); PG8_STAGE(PG8_SA(0, 1), cA + hstep, voffA);
        if (wr == 1) PG8_BAR;
        PG8_WAIT_V(2); PG8_BAR;
        PG8_STAGE(PG8_SB(1, 0), cB + kstep, voffB); PG8_STAGE(PG8_SA(1, 0), cA + kstep, voffA); PG8_STAGE(PG8_SB(1, 1), cB + hstep + kstep, voffB);
        PG8_WAIT_V(6); PG8_BAR;
    } else {
        PG8_STAGE(PG8_SB(0, 0), cB, voffB); PG8_STAGE(PG8_SA(0, 0), cA, voffA); PG8_STAGE(PG8_SB(0, 1), cB + hstep, voffB); PG8_STAGE(PG8_SA(0, 1), cA + hstep, voffA);
        if (wr == 1) PG8_BAR;
        PG8_WAIT_V(4); PG8_BAR;
        PG8_STAGE(PG8_SB(1, 0), cB + kstep, voffB); PG8_STAGE(PG8_SA(1, 0), cA + kstep, voffA); PG8_STAGE(PG8_SB(1, 1), cB + hstep + kstep, voffB);
        PG8_WAIT_V(6); PG8_BAR;
    }
    for (;;) {
        const bool has_next = S.next(ui + 1, nxt);
        const char* nA = has_next ? (const char*)g.A + (size_t)nxt.pm * tstep : cA; const char* nB = has_next ? (const char*)g.Bt + (size_t)nxt.pn * tstep : cB;
#pragma unroll 1
        for (int t = 0; t < nt; t += 2) {
            const bool last = (t == nt - 2);
            const char* a1 = cA + (size_t)(t + 1) * kstep;
            const char* a2 = last ? nA : cA + (size_t)(t + 2) * kstep; const char* b2 = last ? nB : cB + (size_t)(t + 2) * kstep;
            const char* a3 = a2 + kstep; const char* b3 = b2 + kstep;
            if (last && has_next) S.a_ready(nxt);
            if constexpr (SP2) {
            PG8_LDB(B0, 0, 0); PG8_LDB(B1, 0, 1); PG8_SCHED; PG8_LDA(At, 0, 0); PG8_STAGE(PG8_SA(1, 1), a1 + hstep, voffA);
            PG8_WAIT_V(8); PG8_WAIT_L(0); PG8_BAR; PG8_MMA(0, 0, At, B0); PG8_MMA(0, 1, At, B1); PG8_BAR; PG8_SCHED;
            PG8_LDA(At, 0, 1); PG8_STAGE(PG8_SB(0, 0), b2, voffB); PG8_STAGE(PG8_SB(0, 1), b2 + hstep, voffB); PG8_STAGE(PG8_SA(0, 0), a2, voffA);
            PG8_WAIT_V(8); PG8_WAIT_L(0); PG8_BAR; PG8_MMA(1, 0, At, B0); PG8_MMA(1, 1, At, B1); PG8_BAR; PG8_SCHED;
            PG8_LDB(B0, 1, 0); PG8_LDB(B1, 1, 1); PG8_SCHED; PG8_LDA(At, 1, 0); PG8_STAGE(PG8_SA(0, 1), a2 + hstep, voffA);
            PG8_WAIT_V(8); PG8_WAIT_L(0); PG8_BAR; PG8_MMA(0, 0, At, B0); PG8_MMA(0, 1, At, B1); PG8_BAR; PG8_SCHED;
            PG8_LDA(At, 1, 1); PG8_STAGE(PG8_SB(1, 0), b3, voffB); PG8_STAGE(PG8_SB(1, 1), b3 + hstep, voffB); PG8_STAGE(PG8_SA(1, 0), a3, voffA);
            PG8_WAIT_V(8); PG8_WAIT_L(0); PG8_BAR; PG8_MMA(1, 0, At, B0); PG8_MMA(1, 1, At, B1); PG8_BAR; PG8_SCHED;
            } else {
            PG8_LDB(B0, 0, 0); PG8_SCHED; PG8_LDA(At, 0, 0); PG8_STAGE(PG8_SA(1, 1), a1 + hstep, voffA);
            PG8_WAIT_L(8); PG8_BAR; PG8_WAIT_L(0); PG8_MMA(0, 0, At, B0); PG8_BAR; PG8_SCHED;
            PG8_LDB(B1, 0, 1); PG8_STAGE(PG8_SB(0, 0), b2, voffB);
            PG8_BAR; PG8_WAIT_L(0); PG8_MMA(0, 1, At, B1); PG8_BAR;
            PG8_LDA(At, 0, 1); PG8_STAGE(PG8_SA(0, 0), a2, voffA);
            PG8_BAR; PG8_WAIT_L(0); PG8_MMA(1, 0, At, B0); PG8_BAR; PG8_SCHED;
            PG8_STAGE(PG8_SB(0, 1), b2 + hstep, voffB);
            PG8_WAIT_V(6); PG8_BAR; PG8_MMA(1, 1, At, B1); PG8_BAR;
            PG8_LDB(B0, 1, 0); PG8_SCHED; PG8_LDA(At, 1, 0); PG8_STAGE(PG8_SA(0, 1), a2 + hstep, voffA);
            PG8_WAIT_L(8); PG8_BAR; PG8_WAIT_L(0); PG8_MMA(0, 0, At, B0); PG8_BAR; PG8_SCHED;
            PG8_LDB(B1, 1, 1); PG8_STAGE(PG8_SB(1, 0), b3, voffB);
            PG8_BAR; PG8_WAIT_L(0); PG8_MMA(0, 1, At, B1); PG8_BAR;
            PG8_LDA(At, 1, 1); PG8_STAGE(PG8_SA(1, 0), a3, voffA);
            PG8_BAR; PG8_WAIT_L(0); PG8_MMA(1, 0, At, B0); PG8_BAR; PG8_SCHED;
            PG8_STAGE(PG8_SB(1, 1), b3 + hstep, voffB);
            PG8_WAIT_V(6); PG8_BAR; PG8_MMA(1, 1, At, B1); PG8_BAR;
            }
        }
        if constexpr (ALIGN_EPI) { if (wr == 0) PG8_BAR; }
        if constexpr (!Epi::AFTER_DRAIN) { E(acc, cur, wr, wc, fr, fq); S.done(cur); }
        if (!has_next) break;
        zf_ = 0.f; asm volatile("" : "+v"(zf_));
#pragma unroll
        for (int a = 0; a < 2; ++a)
#pragma unroll
            for (int b = 0; b < 2; ++b)
#pragma unroll
                for (int m = 0; m < 4; ++m)
#pragma unroll
                    for (int n = 0; n < 2; ++n) acc[a][b][m][n] = (f32x4){zf_, zf_, zf_, zf_};
        cur = nxt; cA = nA; cB = nB; ++ui;
        if constexpr (ALIGN_EPI) { if (wr == 1) PG8_BAR; }
    }
    PG8_WAIT_V(0);
    if constexpr (!ALIGN_EPI) { if (wr == 0) PG8_BAR; }
    PG8_BAR;
    if constexpr (Epi::AFTER_DRAIN) { E.fused(acc, cur, wr, wc, fr, fq, lds, wid, lane); S.done(cur); }
#undef PG8_SA
#undef PG8_SB
#undef PG8_STAGE
#undef PG8_LDA
#undef PG8_LDB
#undef PG8_MMA
#undef PG8_WAIT_V
#undef PG8_WAIT_L
#undef PG8_BAR
#undef PG8_SCHED
}
}
namespace pg8 {
typedef const f32x4 (&AccRef)[2][2][4][2];

struct EpiStore {
    static constexpr bool PERM = true, AFTER_DRAIN = false;
    bf16_t* O; int ldc; int act; int split_cols; size_t split_stride; int gate_pn; float* G; const float* bgate;
    __device__ __forceinline__ void operator()(AccRef acc, const Unit& u, int wr, int wc, int fr, int fq) const {
        const int row0 = u.pm * BM + wr * 64 + fr;
        if (u.pn == gate_pn) {
            if (wc == 0) {
#pragma unroll
                for (int n = 0; n < 2; ++n) {
                    const int c0 = 8 * fq + 4 * n;
                    const f32x4 bg = *(const f32x4*)(bgate + c0);
                    const bool isf = (c0 & 8) != 0;
#pragma unroll
                    for (int ai = 0; ai < 2; ++ai)
#pragma unroll
                        for (int m = 0; m < 4; ++m) {
                            f32x4 v = acc[ai][0][m][n] + bg, o;
#pragma unroll
                            for (int j = 0; j < 4; ++j) { const float cpd = 15.0f * tanhf_(v[j] * (1.0f / 15.0f)); const float eu = __expf(-cpd); o[j] = isf ? -(eu < 9.765625e-4f ? eu - 0.5f * eu * eu : __logf(1.0f + eu)) : cpd; }
                            *(f32x4*)(G + (size_t)(row0 + ai * HALF + m * 16) * 32 + c0) = o;
                        }
                }
            }
            return;
        }
        int colt = u.pn * BM; bf16_t* base = O;
        const size_t hs = split_cols < 0 ? split_stride : (size_t)HALF;
        if (split_cols > 0) { const int t = colt / split_cols; base += (size_t)t * split_stride; colt -= t * split_cols; }
        const int col0 = colt + wc * 32 + 8 * fq;
#pragma unroll
        for (int ai = 0; ai < 2; ++ai)
#pragma unroll
            for (int m = 0; m < 4; ++m) { bf16_t* rowp = base + (size_t)(row0 + ai * HALF + m * 16) * ldc + col0;
#pragma unroll
                for (int bj = 0; bj < 2; ++bj) { f32x4 v0 = acc[ai][bj][m][0], v1 = acc[ai][bj][m][1];
                    if (act == 1) {
#pragma unroll
                        for (int j = 0; j < 4; ++j) { v0[j] = tanhf_(v0[j]); v1[j] = tanhf_(v1[j]); } }
                    else if (act == 2) {
#pragma unroll
                        for (int j = 0; j < 4; ++j) { v0[j] = sigmoidf_(v0[j]); v1[j] = sigmoidf_(v1[j]); } }
                    u32x4 w; w.x = cvt_pk_bf16(v0[0], v0[1]); w.y = cvt_pk_bf16(v0[2], v0[3]); w.z = cvt_pk_bf16(v1[0], v1[1]); w.w = cvt_pk_bf16(v1[2], v1[3]);
                    *(u32x4*)(rowp + bj * hs) = w; } }
    }
};

struct EpiSigAff {
    static constexpr bool PERM = true, AFTER_DRAIN = false;
    bf16_t* O; size_t split_stride; const float* bias; float scale;
    __device__ __forceinline__ void operator()(AccRef acc, const Unit& u, int wr, int wc, int fr, int fq) const {
        const int row0 = u.pm * BM + wr * 64 + fr;
        int colt = u.pn * BM; const int t = colt / D; bf16_t* base = O + (size_t)t * split_stride; colt -= t * D;
        const int col0 = colt + wc * 32 + 8 * fq, bcol0 = u.pn * BM + wc * 32 + 8 * fq;
        f32x4 bv[2][2];
#pragma unroll
        for (int bj = 0; bj < 2; ++bj)
#pragma unroll
            for (int n = 0; n < 2; ++n) bv[bj][n] = *(const f32x4*)(bias + bcol0 + bj * HALF + 4 * n);
#pragma unroll
        for (int ai = 0; ai < 2; ++ai)
#pragma unroll
            for (int m = 0; m < 4; ++m) { bf16_t* rowp = base + (size_t)(row0 + ai * HALF + m * 16) * D + col0;
#pragma unroll
                for (int bj = 0; bj < 2; ++bj) { f32x4 v0 = acc[ai][bj][m][0] + bv[bj][0], v1 = acc[ai][bj][m][1] + bv[bj][1];
#pragma unroll
                    for (int j = 0; j < 4; ++j) { v0[j] = scale * sigmoidf_(v0[j]); v1[j] = scale * sigmoidf_(v1[j]); }
                    u32x4 w; w.x = cvt_pk_bf16(v0[0], v0[1]); w.y = cvt_pk_bf16(v0[2], v0[3]); w.z = cvt_pk_bf16(v1[0], v1[1]); w.w = cvt_pk_bf16(v1[2], v1[3]);
                    *(u32x4*)(rowp + bj * HALF) = w; } }
    }
};

struct EpiVmix {
    static constexpr bool PERM = true, AFTER_DRAIN = false;
    bf16_t* V; const bf16_t* VF; const float* v0;
    __device__ __forceinline__ void operator()(AccRef acc, const Unit& u, int wr, int wc, int fr, int fq) const {
        const int row0 = u.pm * BM + wr * 64 + fr; const int col0 = u.pn * BM + wc * 32 + 8 * fq;
        f32x4 bv[2][2];
#pragma unroll
        for (int bj = 0; bj < 2; ++bj)
#pragma unroll
            for (int n = 0; n < 2; ++n) bv[bj][n] = *(const f32x4*)(v0 + col0 + bj * HALF + 4 * n);
#pragma unroll
        for (int ai = 0; ai < 2; ++ai) {
            u32x4 vvs[4][2], ffs[4][2];
#pragma unroll
            for (int m = 0; m < 4; ++m) { const size_t off = (size_t)(row0 + ai * HALF + m * 16) * D + col0;
#pragma unroll
                for (int bj = 0; bj < 2; ++bj) { vvs[m][bj] = *(const u32x4*)(V + off + bj * HALF); ffs[m][bj] = *(const u32x4*)(VF + off + bj * HALF); } }
            asm volatile("" ::: "memory");
#pragma unroll
            for (int m = 0; m < 4; ++m) { const size_t off = (size_t)(row0 + ai * HALF + m * 16) * D + col0;
#pragma unroll
                for (int bj = 0; bj < 2; ++bj) {
                    const u32x4 vv = vvs[m][bj], ff = ffs[m][bj];
                    const f32x4 a0 = acc[ai][bj][m][0] + bv[bj][0], a1 = acc[ai][bj][m][1] + bv[bj][1];
                    float o[8];
#pragma unroll
                    for (int j = 0; j < 4; ++j) {
                        const unsigned vw = j == 0 ? vv.x : j == 1 ? vv.y : j == 2 ? vv.z : vv.w, fw = j == 0 ? ff.x : j == 1 ? ff.y : j == 2 ? ff.z : ff.w;
                        const float s0 = sigmoidf_(j < 2 ? a0[2 * j] : a1[2 * j - 4]), s1 = sigmoidf_(j < 2 ? a0[2 * j + 1] : a1[2 * j - 3]);
                        const float x0 = lo_bf(vw), x1 = hi_bf(vw), f0 = lo_bf(fw), f1 = hi_bf(fw);
                        o[2 * j] = x0 + (f0 - x0) * s0; o[2 * j + 1] = x1 + (f1 - x1) * s1; }
                    u32x4 w; w.x = cvt_pk_bf16(o[0], o[1]); w.y = cvt_pk_bf16(o[2], o[3]); w.z = cvt_pk_bf16(o[4], o[5]); w.w = cvt_pk_bf16(o[6], o[7]);
                    *(u32x4*)(V + off + bj * HALF) = w; } }
            asm volatile("" ::: "memory"); }
    }
};

struct EpiResid {
    static constexpr bool PERM = false, AFTER_DRAIN = false;
    float* X; const float* gate; int tile0; const float* srcx; const float* srcc;
    __device__ __forceinline__ void operator()(AccRef acc, const Unit& u, int wr, int wc, int fr, int fq) const {
        const int gpm = tile0 + u.pm; const int b = gpm / 9, tix = gpm % 9; const int idx = (tix == 0) ? 16 : b;
        const int rloc = wr * 64 + fr, col0 = u.pn * BM + wc * 32 + 4 * fq;
        const float* src = srcx ? (tix == 0 ? srcc + (size_t)b * CTXL * D : srcx + ((size_t)b * SEQ + (size_t)(tix - 1) * BM) * D) : X + (size_t)gpm * BM * D;
        float* dst = X + (size_t)gpm * BM * D;
        f32x4 gv[2][2];
#pragma unroll
        for (int bj = 0; bj < 2; ++bj)
#pragma unroll
            for (int n = 0; n < 2; ++n) gv[bj][n] = *(const f32x4*)(gate + (size_t)idx * MODLD + col0 + bj * HALF + n * 16);
        f32x4 (&ac)[2][2][4][2] = const_cast<f32x4 (&)[2][2][4][2]>(acc);
        f32x4 xa[2][2], xb[2][2];
#define RES_LD(dstv, ai_, m_) do { const size_t off_ = (size_t)(rloc + (ai_) * HALF + (m_) * 16) * D + col0; _Pragma("unroll") for (int bj = 0; bj < 2; ++bj) _Pragma("unroll") for (int n = 0; n < 2; ++n) \
            dstv[bj][n] = *(const f32x4*)(src + off_ + bj * HALF + n * 16); } while (0)
#define RES_FMA(srcv, ai_, m_) do { _Pragma("unroll") for (int bj = 0; bj < 2; ++bj) _Pragma("unroll") for (int n = 0; n < 2; ++n) ac[ai_][bj][m_][n] = srcv[bj][n] + gv[bj][n] * ac[ai_][bj][m_][n]; } while (0)
        RES_LD(xa, 0, 0); RES_LD(xb, 0, 1);
        RES_FMA(xa, 0, 0); RES_LD(xa, 0, 2); RES_FMA(xb, 0, 1); RES_LD(xb, 0, 3);
        RES_FMA(xa, 0, 2); RES_LD(xa, 1, 0); RES_FMA(xb, 0, 3); RES_LD(xb, 1, 1);
        RES_FMA(xa, 1, 0); RES_LD(xa, 1, 2); RES_FMA(xb, 1, 1); RES_LD(xb, 1, 3);
        RES_FMA(xa, 1, 2); RES_FMA(xb, 1, 3);
#undef RES_LD
#undef RES_FMA
        asm volatile("" ::: "memory");
#pragma unroll
        for (int ai = 0; ai < 2; ++ai)
#pragma unroll
            for (int m = 0; m < 4; ++m) { const size_t off = (size_t)(rloc + ai * HALF + m * 16) * D + col0;
#pragma unroll
                for (int bj = 0; bj < 2; ++bj)
#pragma unroll
                    for (int n = 0; n < 2; ++n) *(f32x4*)(dst + off + bj * HALF + n * 16) = ac[ai][bj][m][n]; }
    }
};

struct EpiSwiglu {
    static constexpr bool PERM = true, AFTER_DRAIN = false;
    bf16_t* O;
    __device__ __forceinline__ void operator()(AccRef acc, const Unit& u, int wr, int wc, int fr, int fq) const {
        const int row0 = u.pm * BM + wr * 64 + fr; const int col0 = u.pn * HALF + wc * 32 + 8 * fq;
#pragma unroll
        for (int ai = 0; ai < 2; ++ai)
#pragma unroll
            for (int m = 0; m < 4; ++m) { bf16_t* rowp = O + (size_t)(row0 + ai * HALF + m * 16) * DFF + col0;
                f32x4 v0, v1;
#pragma unroll
                for (int j = 0; j < 4; ++j) { v0[j] = siluf_(acc[ai][0][m][0][j]) * acc[ai][1][m][0][j]; v1[j] = siluf_(acc[ai][0][m][1][j]) * acc[ai][1][m][1][j]; }
                u32x4 w; w.x = cvt_pk_bf16(v0[0], v0[1]); w.y = cvt_pk_bf16(v0[2], v0[3]); w.z = cvt_pk_bf16(v1[0], v1[1]); w.w = cvt_pk_bf16(v1[2], v1[3]);
                *(u32x4*)rowp = w; }
    }
};
}

namespace pg8 {
struct SkipCtxOrder : StaticOrder {
    __device__ __forceinline__ bool next(int i, Unit& u) const { if (!StaticOrder::next(i, u)) return false; u.pm = u.pm + (u.pm >> 3) + 1; return true; }
};
}
namespace pg8 {
struct CtxOnlyOrder : StaticOrder {
    __device__ __forceinline__ bool next(int i, Unit& u) const { if (!StaticOrder::next(i, u)) return false; u.pm = u.pm * 9; return true; }
};
}
template <class Epi>
__device__ __forceinline__ void run_gemm_ctx(LAS unsigned char* lds, const bf16_t* A, const bf16_t* Bt, int M, int N, int K, const Epi& E, int& urot) {
    pg8::Gemm g{A, Bt, M, N, K};
    const int G = (int)gridDim.x; const int Meff = M / 9; const int nwg = (Meff / 256) * (N / 256);
    const int c = ((int)blockIdx.x + G - (urot % G)) % G;
    pg8::CtxOnlyOrder S; S.init(Meff, N, G, c); pg8::gemm_phase<Epi, pg8::CtxOnlyOrder, GP_ALIGN, GP_SP2>(lds, g, S, E);
    urot += nwg;
}
template <class Epi, bool SKIPCTX = false>
__device__ __forceinline__ void run_gemm(LAS unsigned char* lds, const bf16_t* A, const bf16_t* Bt, int M, int N, int K, const Epi& E, int& urot) {
    pg8::Gemm g{A, Bt, M, N, K};
    const int G = (int)gridDim.x; const int Meff = SKIPCTX ? (M / 9) * 8 : M; const int nwg = (Meff / 256) * (N / 256);
    const int c = ((int)blockIdx.x + G - (urot % G)) % G;
    if constexpr (SKIPCTX) { pg8::SkipCtxOrder S; S.init(Meff, N, G, c); pg8::gemm_phase<Epi, pg8::SkipCtxOrder, GP_ALIGN, GP_SP2>(lds, g, S, E); }
    else { pg8::StaticOrder S; S.init(M, N, G, c); pg8::gemm_phase<Epi, pg8::StaticOrder, GP_ALIGN, GP_SP2>(lds, g, S, E); }
    urot += nwg;
}
struct Args { const float* in[NIN]; float* out; unsigned char* ws; int ph_lo, ph_hi; };
static_assert(sizeof(Args) == NIN * 8 + 8 + 8 + 8, "Args has no padding");

typedef const __attribute__((address_space(4))) Args* CArgs;
__device__ __forceinline__ CArgs opaque_args() { CArgs p = (CArgs)__builtin_amdgcn_kernarg_segment_ptr(); asm volatile("" : "+s"(p)); return p; }
struct Tc { LAS unsigned char* lds; int tid, lane, wave, bid, G, gw, ngw; };
__device__ __forceinline__ Tc mk_tc(LAS unsigned char* lds) { Tc t; int tid = threadIdx.x; asm volatile("" : "+v"(tid)); t.lds = lds; t.tid = tid; t.lane = tid & 63; t.wave = __builtin_amdgcn_readfirstlane(tid >> 6);
    t.bid = blockIdx.x; t.G = gridDim.x; t.gw = t.bid * 8 + t.wave; t.ngw = t.G * 8; return t; }

template <class RM>
__device__ __forceinline__ void tr_item(const float* W, int ldw, bf16_t* WT, int ldk, const RM& rm, LAS float* scr, int kb, int nb, int lane) {
    const int k0 = 64 * kb, n0 = 32 * nb;
    float tmp[32];
#pragma unroll
    for (int i = 0; i < 32; ++i) { const int kk = 2 * i + (lane >> 5); tmp[i] = W[(size_t)(k0 + kk) * ldw + n0 + (lane & 31)]; }
    asm volatile("" ::: "memory");
#pragma unroll
    for (int i = 0; i < 32; ++i) { const int kk = 2 * i + (lane >> 5); scr[kk * 33 + (lane & 31)] = tmp[i]; }
    LDS_WAIT();
    const int c = lane & 7;
#pragma unroll
    for (int j = 0; j < 4; ++j) { const int n = (lane >> 3) + 8 * j; const LAS float* s = scr + (8 * c) * 33 + n;
        u32x4 o; o.x = pk2(s[0 * 33], s[1 * 33]); o.y = pk2(s[2 * 33], s[3 * 33]); o.z = pk2(s[4 * 33], s[5 * 33]); o.w = pk2(s[6 * 33], s[7 * 33]);
        *(u32x4*)(WT + (size_t)rm(n0 + n) * ldk + k0 + 8 * c) = o; }
    LDS_WAIT();
}
struct RmId { __device__ __forceinline__ int operator()(int n) const { return n; } };
struct RmSwiglu { __device__ __forceinline__ int operator()(int n) const { const int up = n >= DFF ? 1 : 0; const int m = n - up * DFF; return 256 * (m >> 7) + 128 * up + (m & 127); } };

template <class RM>
__device__ __forceinline__ void tr_matrix(const Tc& t, const float* W, int K, int N, int ldw, bf16_t* WT, int ldk, const RM& rm) {
    LAS float* scr = (LAS float*)(t.lds + t.wave * 16384);
    const int nkb = K / 64, nnb = N / 32, items = nkb * nnb;
    for (int it = t.gw; it < items; it += t.ngw) tr_item(W, ldw, WT, ldk, rm, scr, it / nnb, it % nnb, t.lane);
}
template <class SRC>
__device__ __forceinline__ void build_small(const Tc& t, bf16_t* dst, int NR, int KC, const SRC& src) {
    const int total = NR * (KC / 8);
    for (int i = t.gw * 64 + t.lane; i < total; i += t.ngw * 64) { const int n = i % NR, ko = i / NR;
        float v[8];
#pragma unroll
        for (int j = 0; j < 8; ++j) v[j] = src(n, 8 * ko + j);
        u32x4 o; o.x = pk2(v[0], v[1]); o.y = pk2(v[2], v[3]); o.z = pk2(v[4], v[5]); o.w = pk2(v[6], v[7]);
        *(u32x4*)(dst + (size_t)n * KC + 8 * ko) = o; }
}

__device__ __forceinline__ void convert_rwkv(const Tc& t, CArgs a, int jl) {
    bf16_t* wm = (bf16_t*)(a->ws + WS_WMIX);
    const size_t dd = (size_t)D * D;
    tr_matrix(t, a->in[I_WR] + jl * dd, D, D, D, (bf16_t*)((char*)wm + WM_R), D, RmId());
    tr_matrix(t, a->in[I_WK] + jl * dd, D, D, D, (bf16_t*)((char*)wm + WM_K), D, RmId());
    tr_matrix(t, a->in[I_WV] + jl * dd, D, D, D, (bf16_t*)((char*)wm + WM_V), D, RmId());
    tr_matrix(t, a->in[I_WO] + jl * dd, D, D, D, (bf16_t*)((char*)wm + WM_O), D, RmId());
    { const float* w1 = a->in[I_W1] + (size_t)jl * 2 * D * 96;
      build_small(t, (bf16_t*)((char*)wm + WM_W1), 256, D, [=](int n, int k) -> float { const int z = n >> 7, r = n & 127; if (r >= 96) return 0.f; return w1[((size_t)z * D + k) * 96 + r]; }); }
    { const float* a1 = a->in[I_A1] + (size_t)jl * 2 * D * 96;
      build_small(t, (bf16_t*)((char*)wm + WM_A1), 256, D, [=](int n, int k) -> float { const int z = n >> 7, r = n & 127; if (r >= 96) return 0.f; return a1[((size_t)z * D + k) * 96 + r]; }); }
    { const float* g1 = a->in[I_G1] + (size_t)jl * D * 256;
      build_small(t, (bf16_t*)((char*)wm + WM_G1), 256, D, [=](int n, int k) -> float { return g1[(size_t)k * 256 + n]; }); }
    if (jl > 0) { const float* v1 = a->in[I_V1] + (size_t)(jl - 1) * D * 64;
      build_small(t, (bf16_t*)((char*)wm + WM_V1), 256, D, [=](int n, int k) -> float { return n < 64 ? v1[(size_t)k * 64 + n] : 0.f; }); }
    { const float* w2 = a->in[I_W2] + (size_t)jl * 2 * 96 * D;
      build_small(t, (bf16_t*)((char*)wm + WM_W2), 2 * D, 128, [=](int n, int k) -> float { const int z = n >= D ? 1 : 0, ch = n - z * D; return k < 96 ? w2[((size_t)z * 96 + k) * D + ch] : 0.f; }); }
    { const float* a2 = a->in[I_A2] + (size_t)jl * 2 * 96 * D;
      build_small(t, (bf16_t*)((char*)wm + WM_A2), 2 * D, 128, [=](int n, int k) -> float { const int z = n >= D ? 1 : 0, ch = n - z * D; return k < 96 ? a2[((size_t)z * 96 + k) * D + ch] : 0.f; }); }
    { const float* g2 = a->in[I_G2] + (size_t)jl * 256 * D;
      build_small(t, (bf16_t*)((char*)wm + WM_G2), D, 256, [=](int n, int k) -> float { return g2[(size_t)k * D + n]; }); }
    if (jl > 0) { const float* v2 = a->in[I_V2] + (size_t)(jl - 1) * 64 * D;
      build_small(t, (bf16_t*)((char*)wm + WM_V2), D, 128, [=](int n, int k) -> float { return k < 64 ? v2[(size_t)k * D + n] : 0.f; }); }
}
__device__ __forceinline__ void convert_mlstm(const Tc& t, CArgs a, int jl) {
    bf16_t* win = (bf16_t*)(a->ws + WS_WMIX + WM_MIN); bf16_t* wout = (bf16_t*)(a->ws + WS_WMIX + WM_MOUT);
    tr_matrix(t, a->in[I_MWIN] + (size_t)jl * D * MPROJ, D, MPROJ, MPROJ, win, D, RmId());
    { u32x4* z = (u32x4*)(win + (size_t)MPROJ * D); const int total = (6400 - MPROJ) * D / 8; unsigned zz = 0u; asm volatile("" : "+v"(zz)); const u32x4 zero = {zz, zz, zz, zz};
      for (int i = t.gw * 64 + t.lane; i < total; i += t.ngw * 64) z[i] = zero; }
    tr_matrix(t, a->in[I_MWOUT] + (size_t)jl * D * D, D, D, D, wout, D, RmId());
}
__device__ __forceinline__ void convert_ffn_in(const Tc& t, CArgs a, int layer) {
    tr_matrix(t, a->in[I_FWIN] + (size_t)layer * D * 2 * DFF, D, 2 * DFF, 2 * DFF, (bf16_t*)(a->ws + WS_WFFN + WF_IN), D, RmSwiglu());
}
__device__ __forceinline__ void convert_ffn_out(const Tc& t, CArgs a, int layer) {
    tr_matrix(t, a->in[I_FWOUT] + (size_t)layer * DFF * D, DFF, D, D, (bf16_t*)(a->ws + WS_WFFN + WF_OUT), DFF, RmId());
}
__device__ __forceinline__ bool tail_crew(const Tc& t, int urot0, int nwg, Tc& ts) {
    const int G = t.G, r = nwg % G, c = (t.bid + G - (urot0 % G)) % G;
    ts = t;
    if (r == 0) return true;
    if (c < r) return false;
    ts.bid = c - r; ts.G = G - r; ts.gw = ts.bid * 8 + t.wave; ts.ngw = ts.G * 8; return true;
}

__device__ __forceinline__ void ph_prologue(const Tc& t, CArgs a) {
    LAS float* S = (LAS float*)t.lds;
    { f32x4 cv[17];
#pragma unroll
      for (int b = 0; b < 17; ++b) cv[b] = *(const f32x4*)((b < 16 ? a->in[I_C] + (size_t)b * D : a->in[I_CCTX]) + 4 * t.tid);
      const int k = 4 * t.tid;
#pragma unroll
      for (int b = 0; b < 17; ++b) { const f32x4 s = {siluf_(cv[b][0]), siluf_(cv[b][1]), siluf_(cv[b][2]), siluf_(cv[b][3])};
          *(LAS f32x4*)(S + b * 2056 + (k >> 10) * 1028 + (k & 1023)) = s; } }
    __syncthreads();
    float* mod = (float*)(a->ws + WS_MOD);
    const int col = t.lane & 31, kh = t.lane >> 5;
    for (int it = t.wave * t.G + t.bid; it < 4 * 384; it += t.ngw) { const int layer = it / 384, n0 = 32 * (it % 384);
        const auto wrs = __builtin_amdgcn_make_buffer_rsrc((void*)(a->in[I_MODW] + (size_t)layer * D * MODLD), (short)0, (int)((size_t)D * MODLD * 4), 0x00020000);
        const unsigned voff = (unsigned)(kh * 1024 * MODLD + n0 + col) * 4u;
        const LAS float* Sk = S + kh * 1028;
        f32x2 acc[17];
#pragma unroll
        for (int b = 0; b < 17; ++b) acc[b] = (f32x2){0.f, 0.f};
        float wa[8], wb[8];
#define MOD_LD(dst, k0_) do { _Pragma("unroll") for (int j = 0; j < 8; ++j) dst[j] = __builtin_bit_cast(float, __builtin_amdgcn_raw_buffer_load_b32(wrs, voff, (unsigned)(((k0_) + j) * MODLD * 4), 0)); } while (0)
#define MOD_FMA(src, k0_) do { _Pragma("unroll") for (int j4 = 0; j4 < 2; ++j4) { _Pragma("unroll") for (int b = 0; b < 17; ++b) { const f32x4 s = *(const LAS f32x4*)(Sk + b * 2056 + (k0_) + 4 * j4); \
            acc[b] = acc[b] + (f32x2){s[0], s[1]} * (f32x2){src[4 * j4], src[4 * j4 + 1]} + (f32x2){s[2], s[3]} * (f32x2){src[4 * j4 + 2], src[4 * j4 + 3]}; } asm volatile("" ::: "memory"); } } while (0)
        MOD_LD(wa, 0);
#pragma unroll 1
        for (int k0 = 0; k0 < 1024; k0 += 16) {
            MOD_LD(wb, k0 + 8);
            MOD_FMA(wa, k0);
            if (k0 + 16 < 1024) MOD_LD(wa, k0 + 16);
            MOD_FMA(wb, k0 + 8); }
#undef MOD_LD
#undef MOD_FMA
#pragma unroll
        for (int b = 0; b < 17; ++b) { float v = acc[b].x + acc[b].y; v += shfl_xor_(v, 32, t.lane);
            if (kh == 0) mod[((size_t)layer * 17 + b) * MODLD + n0 + col] = v + a->in[I_MODB][layer * MODLD + n0 + col]; } }
    __syncthreads();
}

template <bool OUT_BF16>
__device__ __forceinline__ void norm_rows(const Tc& t, CArgs a, int layer, int which, int row_begin, int nrows, void* out, bool from_inputs = false, bool latent_only = false) {
    const float* xres = (const float*)(a->ws + WS_XRES);
    const float* mod = (const float*)(a->ws + WS_MOD) + (size_t)layer * 17 * MODLD;
    const int npw = (nrows + t.ngw - 1) / t.ngw;
    f32x4 gg[8], gm[8], sh[8];
    { const f32x4* gp = (const f32x4*)(a->in[I_NORMG] + (size_t)(layer * 2 + which) * D) + t.lane;
#pragma unroll
      for (int j = 0; j < 8; ++j) gg[j] = gp[64 * j]; }
    int cur_idx = -1;
    auto gmap = [&](int r) -> int { return latent_only ? (r / SEQ) * SROW + CTXL + r % SEQ : row_begin + r; };
    auto rowptr = [&](int r) -> const f32x4* { const int grow = gmap(r); const int gb = grow / SROW, gs = grow % SROW;
        const float* rp = from_inputs ? (gs < CTXL ? a->in[I_CTX] + ((size_t)gb * CTXL + gs) * D : a->in[I_X] + ((size_t)gb * SEQ + (gs - CTXL)) * D) : xres + (size_t)grow * D;
        return (const f32x4*)rp + t.lane; };
    const int rfirst = t.gw * npw;
    if (rfirst >= nrows) return;
    const int nmine = (nrows - rfirst) < npw ? (nrows - rfirst) : npw;
    f32x4 xn[8];
    { const f32x4* xr = rowptr(rfirst);
#pragma unroll
      for (int j = 0; j < 8; ++j) xn[j] = xr[64 * j]; }
    for (int i = 0; i < nmine; ++i) { const int r = rfirst + i; const int grow = gmap(r); const int orow = grow - row_begin; const int idx = (grow % SROW) < CTXL ? 16 : grow / SROW;
        f32x4 v[8];
#pragma unroll
        for (int j = 0; j < 8; ++j) v[j] = xn[j];
        if (idx != cur_idx) { cur_idx = idx;
            const f32x4* shp = (const f32x4*)(mod + (size_t)idx * MODLD + (3 * which) * D) + t.lane; const f32x4* scp = (const f32x4*)(mod + (size_t)idx * MODLD + (3 * which + 1) * D) + t.lane;
#pragma unroll
            for (int j = 0; j < 8; ++j) { sh[j] = shp[64 * j]; gm[j] = gg[j] * (scp[64 * j] + 1.0f); } }
        if (i + 1 < nmine) { const f32x4* xr = rowptr(r + 1);
#pragma unroll
            for (int j = 0; j < 8; ++j) xn[j] = xr[64 * j]; }
        asm volatile("" ::: "memory");
        float ss = 0.f;
#pragma unroll
        for (int j = 0; j < 8; ++j) ss += (v[j].x * v[j].x + v[j].y * v[j].y) + (v[j].z * v[j].z + v[j].w * v[j].w);
        const float rstd = rsqrtf(wave_sum_dpp(ss) * (1.0f / D) + 1e-6f);
#pragma unroll
        for (int j = 0; j < 8; ++j) { const f32x4 o = v[j] * rstd * gm[j] + sh[j];
            if (OUT_BF16) { u32x2 w; w.x = pk2(o.x, o.y); w.y = pk2(o.z, o.w); ((u32x2*)((bf16_t*)out + (size_t)orow * D))[64 * j + t.lane] = w; }
            else ((f32x4*)((float*)out + (size_t)orow * D))[64 * j + t.lane] = o; }
        asm volatile("" ::: "memory");
    }
}

__device__ __forceinline__ void r2_mix(const Tc& t, CArgs a, int jl) {
    const bf16_t* H = (const bf16_t*)(a->ws + WS_ACT + AR_H);
    const int sl = t.gw & 3, c0 = 512 * sl + 8 * t.lane;
    const float* mu = a->in[I_MU] + (size_t)jl * 6 * D + c0;
    f32x4 m0[6], m1[6];
#pragma unroll
    for (int m = 0; m < 6; ++m) { m0[m] = *(const f32x4*)(mu + m * D); m1[m] = *(const f32x4*)(mu + m * D + 4); }
    const int rstep = t.ngw >> 2;
    for (int r0 = t.gw >> 2; r0 < TG; r0 += 4 * rstep) {
        u32x4 hw[4], nw[4];
#pragma unroll
        for (int k = 0; k < 4; ++k) { const int r = r0 + k * rstep; hw[k] = (u32x4){0u, 0u, 0u, 0u}; nw[k] = hw[k];
            if (r < TG) { const int s = r % SROW; int nr;
                if (s < CTXL) nr = sl < 2 ? (s > 0 ? r - 1 : -1) : (s < CTXL - 1 ? r + 1 : -1);
                else { const int i = s - CTXL, gr = i >> 6, gc = i & 63; nr = sl == 0 ? (gc > 0 ? r - 1 : -1) : sl == 1 ? (gc < 63 ? r + 1 : -1) : sl == 2 ? (gr > 0 ? r - 64 : -1) : (gr < 31 ? r + 64 : -1); }
                hw[k] = *(const u32x4*)(H + (size_t)r * D + c0);
                if (nr >= 0) nw[k] = *(const u32x4*)(H + (size_t)nr * D + c0); } }
        asm volatile("" ::: "memory");
#pragma unroll
        for (int k = 0; k < 4; ++k) { const int r = r0 + k * rstep;
            if (r < TG) {
                const f32x4 h0 = {lo_bf(hw[k].x), hi_bf(hw[k].x), lo_bf(hw[k].y), hi_bf(hw[k].y)}, h1 = {lo_bf(hw[k].z), hi_bf(hw[k].z), lo_bf(hw[k].w), hi_bf(hw[k].w)};
                const f32x4 n0 = {lo_bf(nw[k].x), hi_bf(nw[k].x), lo_bf(nw[k].y), hi_bf(nw[k].y)}, n1 = {lo_bf(nw[k].z), hi_bf(nw[k].z), lo_bf(nw[k].w), hi_bf(nw[k].w)};
                const f32x4 x0 = n0 - h0, x1 = n1 - h1;
#pragma unroll
                for (int m = 0; m < 6; ++m) { const f32x4 o0 = h0 + x0 * m0[m], o1 = h1 + x1 * m1[m];
                    u32x4 w; w.x = pk2(o0.x, o0.y); w.y = pk2(o0.z, o0.w); w.z = pk2(o1.x, o1.y); w.w = pk2(o1.z, o1.w);
                    *(u32x4*)(a->ws + WS_ACT + AR_MIX + (size_t)m * SLOT + ((size_t)r * D + c0) * 2) = w; } } }
        asm volatile("" ::: "memory");
    }
}

constexpr int R5_L = 16;
constexpr int R5_ZR = 0, R5_BK = 4608, R5_BKT = 9216, R5_V = 14336, R5_GL = 18432, R5_CH = 18688;
constexpr int R5_BUF = 2 * R5_CH;
constexpr int R5_GR = 2 * R5_BUF;
constexpr int R5_GRCH = 3072;
constexpr int R5_DS = R5_GR + 2 * R5_GRCH;
constexpr int R5_YS = R5_DS + 8 * 1024;
constexpr int R5_PW = R5_YS + 2 * 2 * 4096;
constexpr int R5_END = R5_PW + 4 * 8192 + 512;
static_assert(R5_END <= LDSCTL_OFF, "scan LDS");
__device__ __forceinline__ int r5_seq(int z, int tt) { return z == 0 ? tt : (tt < CTXL ? CTXL - 1 - tt : SROW + CTXL - 1 - tt); }

__device__ __forceinline__ void r5_scan(const Tc& t, CArgs a, int jl, int layer, int g) {
    const bf16_t* R = (const bf16_t*)(a->ws + WS_ACT + AR_R);
    const bf16_t* Kb = (const bf16_t*)(a->ws + WS_ACT + AR_K);
    const bf16_t* Vb = (layer == 0) ? (const bf16_t*)(a->ws + WS_VF) + (size_t)g * TG * D : (const bf16_t*)(a->ws + WS_ACT + AR_V);
    const int w = t.wave, lane = t.lane, c2 = w >> 2, q = w & 3, l15 = lane & 15, q4 = lane >> 4;
    for (int pair = t.bid; pair < BG * RH; pair += t.G) {
        const int z = pair / (BG * RH / 2), bl = (pair / (RH / 2)) % BG, h = 2 * (pair % (RH / 2)) + c2;
        const bf16_t* E = (const bf16_t*)(a->ws + WS_ACT + AR_MIX + (size_t)z * SLOT);
        const bf16_t* Aa = (const bf16_t*)(a->ws + WS_ACT + AR_MIX + (size_t)(2 + z) * SLOT);
        bf16_t* Y = (bf16_t*)(a->ws + WS_ACT + AR_Y + (size_t)z * SLOT);
        float* RKo = (float*)(a->ws + WS_ACT + AR_RK) + (size_t)z * TG * 32;
        const size_t colb = (size_t)h * 64 + lane;
        f32x4 ST[4];
#pragma unroll
        for (int cb = 0; cb < 4; ++cb) ST[cb] = (f32x4){0.f, 0.f, 0.f, 0.f};
        const int pst = q == 0 ? 0 : 6 * (q - 1), npass = q == 0 ? 0 : (q == 3 ? 2 : 3);
        const int hf = lane >> 5, pi = lane & 31;
        unsigned ce[8], pr[3], pk[3], pv[3], pa[3];
        const int sd = z == 0 ? 1 : -1;
        const bf16_t* Eh = E + (size_t)bl * SROW * D + (size_t)h * 64; const bf16_t* Rh = R + (size_t)bl * SROW * D + (size_t)h * 64; const bf16_t* Kh = Kb + (size_t)bl * SROW * D + (size_t)h * 64;
        const bf16_t* Vh = Vb + (size_t)bl * SROW * D + (size_t)h * 64; const bf16_t* Ah = Aa + (size_t)bl * SROW * D + (size_t)h * 64;
        f32x2 kkc2, kac2, rkc2;
        { const size_t c0 = (size_t)jl * D + (size_t)h * 64 + 2 * pi; kkc2 = *(const f32x2*)(a->in[I_KK] + c0); kac2 = *(const f32x2*)(a->in[I_KA] + c0); rkc2 = *(const f32x2*)(a->in[I_RK] + c0); }
        auto prep_load = [&](int n) {
            if (q == 0) return;
            const int s0 = r5_seq(z, n * R5_L); const unsigned rlo = (unsigned)(sd > 0 ? s0 : s0 - 15) * (unsigned)D;
#pragma unroll
            for (int ps = 0; ps < 3; ++ps) if (ps < npass) { const int st = pst + 2 * ps + hf; const unsigned off = rlo + (unsigned)((sd > 0 ? st : 15 - st) * D) + 2u * (unsigned)pi;
                pr[ps] = *(const unsigned*)(Rh + off); pk[ps] = *(const unsigned*)(Kh + off); pv[ps] = *(const unsigned*)(Vh + off); pa[ps] = *(const unsigned*)(Ah + off); }
        };
        auto halfsum = [&](float v) -> float { v = sum16_(v); const float h0 = rl_(v, 0) + rl_(v, 16), h1 = rl_(v, 32) + rl_(v, 48); return hf ? h1 : h0; };
        auto prep_finish = [&](int n) {
            if (q == 0) return;
            LAS unsigned char* cbuf = t.lds + (n & 1) * R5_BUF + c2 * R5_CH;
            LAS bf16_t* ZR = (LAS bf16_t*)(cbuf + R5_ZR); LAS bf16_t* BK = (LAS bf16_t*)(cbuf + R5_BK); LAS bf16_t* BKT = (LAS bf16_t*)(cbuf + R5_BKT);
            LAS float* Vs = (LAS float*)(cbuf + R5_V); LAS float* GL = (LAS float*)(cbuf + R5_GL);
            const LAS f32x2* GT = (const LAS f32x2*)(t.lds + R5_PW + ((n & 1) * 2 + c2) * 8192);
            const LAS f32x2* GI = GT + 512;
            if (q == 3 && hf == 0) *(LAS f32x2*)(GL + 2 * pi) = GT[15 * 32 + pi];
            const int s0 = r5_seq(z, n * R5_L); float rkv[3] = {0.f, 0.f, 0.f};
#pragma unroll
            for (int ps = 0; ps < 3; ++ps) if (ps < npass) { const int st = pst + 2 * ps + hf;
                const f32x2 gt = GT[st * 32 + pi]; const f32x2 gi = {__builtin_amdgcn_rcpf(gt.x), __builtin_amdgcn_rcpf(gt.y)}; f32x2 gp = {1.f, 1.f}; if (st > 0) gp = GT[(st - 1) * 32 + pi];
                const f32x2 r2 = {lo_bf(pr[ps]), hi_bf(pr[ps])}, k2 = {lo_bf(pk[ps]), hi_bf(pk[ps])}, v2 = {lo_bf(pv[ps]), hi_bf(pv[ps])}, a2 = {lo_bf(pa[ps]), hi_bf(pa[ps])};
                f32x2 kk2 = k2 * kkc2; const float n2 = halfsum(kk2.x * kk2.x + kk2.y * kk2.y); kk2 = kk2 * __builtin_amdgcn_rsqf(fmaxf(n2, 1e-24f));
                const f32x2 km2 = k2 * ((a2 - 1.0f) * kac2 + 1.0f);
                const f32x2 rkm = r2 * km2 * rkc2; const float rk = halfsum(rkm.x + rkm.y);
                rkv[ps] = rk;
                const f32x2 zt = kk2 * gp * -1.0f, rt = r2 * gt, bt = kk2 * a2 * gi, kt = km2 * gi;
                const unsigned zw = pk2(zt.x, zt.y), rw = pk2(rt.x, rt.y), bw = pk2(bt.x, bt.y), kw = pk2(kt.x, kt.y);
                *(LAS unsigned*)(ZR + st * 72 + 2 * pi) = zw; *(LAS unsigned*)(ZR + (16 + st) * 72 + 2 * pi) = rw; *(LAS unsigned*)(BK + st * 72 + 2 * pi) = bw; *(LAS unsigned*)(BK + (16 + st) * 72 + 2 * pi) = kw;
                BKT[(2 * pi) * 40 + st] = (bf16_t)(bw & 0xffffu); BKT[(2 * pi + 1) * 40 + st] = (bf16_t)(bw >> 16);
                BKT[(2 * pi) * 40 + 16 + st] = (bf16_t)(kw & 0xffffu); BKT[(2 * pi + 1) * 40 + 16 + st] = (bf16_t)(kw >> 16);
                *(LAS f32x2*)(Vs + st * 64 + 2 * pi) = v2; }
            if (pi == 0) {
#pragma unroll
                for (int ps = 0; ps < 3; ++ps) if (ps < npass) RKo[((size_t)bl * SROW + s0 + sd * (pst + 2 * ps + hf)) * 32 + h] = rkv[ps]; }
        };
        auto cum_load = [&](int m) {
            const int s0 = r5_seq(z, m * R5_L); const unsigned rlo = (unsigned)(sd > 0 ? s0 : s0 - 15) * (unsigned)D;
#pragma unroll
            for (int j = 0; j < 8; ++j) { const int i = 8 * hf + j; ce[j] = *(const unsigned*)(Eh + rlo + (unsigned)((sd > 0 ? i : 15 - i) * D) + 2u * (unsigned)pi); }
        };
        auto cum_finish = [&](int m) {
            LAS f32x2* GT = (LAS f32x2*)(t.lds + R5_PW + ((m & 1) * 2 + c2) * 8192); LAS f32x2* GI = GT + 512;
            LAS f32x2* HB = (LAS f32x2*)(t.lds + R5_PW + 4 * 8192 + c2 * 256);
            f32x2 cs[8]; f32x2 lg = {0.f, 0.f};
#pragma unroll
            for (int j = 0; j < 8; ++j) { lg = lg + (f32x2){lo_bf(ce[j]), hi_bf(ce[j])}; cs[j] = lg; }
            if (hf == 0) HB[pi] = lg;
            asm volatile("s_waitcnt lgkmcnt(0)" ::: "memory");
            f32x2 base = HB[pi]; if (hf == 0) base = (f32x2){0.f, 0.f};
#pragma unroll
            for (int j = 0; j < 8; ++j) { const f32x2 c = cs[j] + base;
                GT[(8 * hf + j) * 32 + pi] = (f32x2){__expf(c.x), __expf(c.y)}; }
        };
        constexpr int NCH = SROW / R5_L;
        if (q == 0) { cum_load(0); cum_finish(0); cum_load(1); cum_finish(1); cum_load(2); } else prep_load(0);
        LDS_BARRIER();
        prep_finish(0); prep_load(1);
        LDS_BARRIER();
        for (int n = 0; n < NCH; ++n) {
            LAS unsigned char* cbuf = t.lds + (n & 1) * R5_BUF + c2 * R5_CH;
            const LAS bf16_t* ZR = (const LAS bf16_t*)(cbuf + R5_ZR); const LAS bf16_t* BK = (const LAS bf16_t*)(cbuf + R5_BK); const LAS bf16_t* BKT = (const LAS bf16_t*)(cbuf + R5_BKT);
            const LAS float* Vs = (const LAS float*)(cbuf + R5_V); const LAS float* GL = (const LAS float*)(cbuf + R5_GL);
            LAS float* Nm = (LAS float*)(t.lds + R5_GR + c2 * R5_GRCH); LAS bf16_t* MKZ = (LAS bf16_t*)(t.lds + R5_GR + c2 * R5_GRCH + 1024); LAS bf16_t* MBK = (LAS bf16_t*)(t.lds + R5_GR + c2 * R5_GRCH + 1536);
            LAS bf16_t* MT = (LAS bf16_t*)(t.lds + R5_GR + c2 * R5_GRCH + 2560);
            { f32x4 gacc = (f32x4){0.f, 0.f, 0.f, 0.f};
#pragma unroll
              for (int ks = 0; ks < 2; ++ks) { const bf16x8 av = *(const LAS bf16x8*)(ZR + ((q & 2) ? 16 + l15 : l15) * 72 + 32 * ks + 8 * q4);
                  const bf16x8 bv = *(const LAS bf16x8*)(BK + ((q & 1) ? 16 + l15 : l15) * 72 + 32 * ks + 8 * q4);
                  gacc = __builtin_amdgcn_mfma_f32_16x16x32_bf16(av, bv, gacc, 0, 0, 0); }
#pragma unroll
              for (int i = 0; i < 4; ++i) { const int tt = 4 * q4 + i, j = l15; const bool keep = (q & 2) ? (j <= tt) : (j < tt); const float val = keep ? gacc[i] : 0.f;
                  if (q == 0) Nm[tt * 16 + j] = val; else if (q == 1) MKZ[tt * 16 + j] = (bf16_t)f2bf(val); else MBK[tt * 32 + (q == 3 ? 16 : 0) + j] = (bf16_t)f2bf(val); }
              if (q == 0) {
                  asm volatile("s_waitcnt lgkmcnt(0)" ::: "memory");
                  float tc[16];
                  tc[0] = (l15 == 0) ? 1.0f : 0.0f;
                  f32x4 nA[12], nB[12];
#define R5_SLOT_A(i, jb) ((i) <= 4 ? (i) - 1 : 4 + 2 * ((i) - 5) + (jb))
#pragma unroll
                  for (int i = 1; i <= 8; ++i)
#pragma unroll
                      for (int jb = 0; 4 * jb < i; ++jb) nA[R5_SLOT_A(i, jb)] = *(const LAS f32x4*)(Nm + i * 16 + 4 * jb);
#pragma unroll
                  for (int i = 9; i <= 12; ++i)
#pragma unroll
                      for (int jb = 0; jb < 3; ++jb) nB[(i - 9) * 3 + jb] = *(const LAS f32x4*)(Nm + i * 16 + 4 * jb);
                  asm volatile("" ::: "memory");
#pragma unroll
                  for (int i = 1; i <= 8; ++i) { float s = (l15 == i) ? 1.0f : 0.0f;
#pragma unroll
                      for (int jb = 0; 4 * jb < i; ++jb) { const f32x4 nv = nA[R5_SLOT_A(i, jb)];
#pragma unroll
                          for (int j = 0; j < 4; ++j) if (4 * jb + j < i) s += nv[j] * tc[4 * jb + j]; }
                      tc[i] = s; }
#pragma unroll
                  for (int i = 13; i <= 15; ++i)
#pragma unroll
                      for (int jb = 0; jb < 4; ++jb) nA[(i - 13) * 4 + jb] = *(const LAS f32x4*)(Nm + i * 16 + 4 * jb);
                  asm volatile("" ::: "memory");
#pragma unroll
                  for (int i = 9; i <= 12; ++i) { float s = (l15 == i) ? 1.0f : 0.0f;
#pragma unroll
                      for (int jb = 0; jb < 3; ++jb) { const f32x4 nv = nB[(i - 9) * 3 + jb];
#pragma unroll
                          for (int j = 0; j < 4; ++j) if (4 * jb + j < i) s += nv[j] * tc[4 * jb + j]; }
                      tc[i] = s; }
#pragma unroll
                  for (int i = 13; i <= 15; ++i) { float s = (l15 == i) ? 1.0f : 0.0f;
#pragma unroll
                      for (int jb = 0; jb < 4; ++jb) { const f32x4 nv = nA[(i - 13) * 4 + jb];
#pragma unroll
                          for (int j = 0; j < 4; ++j) if (4 * jb + j < i) s += nv[j] * tc[4 * jb + j]; }
                      tc[i] = s; }
#undef R5_SLOT_A
#pragma unroll
                  for (int i = 0; i < 4; ++i) { const float v = q4 == 0 ? tc[i] : q4 == 1 ? tc[4 + i] : q4 == 2 ? tc[8 + i] : tc[12 + i];
                      MT[(4 * q4 + i) * 16 + l15] = (bf16_t)f2bf(v); } } }
            if (n + 1 < NCH) prep_finish(n + 1);
            if (n + 2 < NCH) prep_load(n + 2);
            if (q == 0) {
                if (n + 2 < NCH) cum_finish(n + 2);
                if (n + 3 < NCH) cum_load(n + 3); }
            if (q == 3) {
                if (n > 0) { const LAS float* ys = (const LAS float*)(t.lds + R5_YS + ((n - 1) & 1) * 8192 + c2 * 4096);
#pragma unroll
                    for (int tt = 0; tt < 16; ++tt) Y[((size_t)bl * SROW + r5_seq(z, (n - 1) * R5_L) + sd * tt) * D + colb] = (bf16_t)f2bf(ys[tt * 64 + lane]); } }
            LDS_BARRIER();
            {
              f32x4 Pz = (f32x4){0.f, 0.f, 0.f, 0.f}, Pr = Pz;
#pragma unroll
              for (int ks = 0; ks < 2; ++ks) { const f32x4 s0 = ST[2 * ks], s1 = ST[2 * ks + 1];
                  u32x4 p; p.x = pk2(s0[0], s0[1]); p.y = pk2(s0[2], s0[3]); p.z = pk2(s1[0], s1[1]); p.w = pk2(s1[2], s1[3]);
                  const bf16x8 bop = __builtin_bit_cast(bf16x8, p);
                  const LAS bf16_t* zr = ZR + l15 * 72 + 32 * ks + 4 * q4; const LAS bf16_t* rr = ZR + (16 + l15) * 72 + 32 * ks + 4 * q4;
                  const u32x2 z0 = *(const LAS u32x2*)zr, z1 = *(const LAS u32x2*)(zr + 16), r0 = *(const LAS u32x2*)rr, r1 = *(const LAS u32x2*)(rr + 16);
                  Pz = __builtin_amdgcn_mfma_f32_16x16x32_bf16(__builtin_bit_cast(bf16x8, (u32x4){z0.x, z0.y, z1.x, z1.y}), bop, Pz, 0, 0, 0);
                  Pr = __builtin_amdgcn_mfma_f32_16x16x32_bf16(__builtin_bit_cast(bf16x8, (u32x4){r0.x, r0.y, r1.x, r1.y}), bop, Pr, 0, 0, 0); }
              float vd[4];
#pragma unroll
              for (int i = 0; i < 4; ++i) vd[i] = Vs[(4 * q4 + i) * 64 + 16 * q + l15];
              const unsigned vp0 = pk2(vd[0], vd[1]), vp1 = pk2(vd[2], vd[3]);
              { const u32x2 m = *(const LAS u32x2*)(MKZ + l15 * 16 + 4 * q4);
                Pz = __builtin_amdgcn_mfma_f32_16x16x32_bf16(__builtin_bit_cast(bf16x8, (u32x4){m.x, m.y, 0u, 0u}), __builtin_bit_cast(bf16x8, (u32x4){vp0, vp1, 0u, 0u}), Pz, 0, 0, 0); }
              { float x[4];
                { const u32x2 mt = *(const LAS u32x2*)(MT + l15 * 16 + 4 * q4);
                  const f32x4 dv = __builtin_amdgcn_mfma_f32_16x16x32_bf16(__builtin_bit_cast(bf16x8, (u32x4){mt.x, mt.y, 0u, 0u}), __builtin_bit_cast(bf16x8, (u32x4){pk2(Pz[0], Pz[1]), pk2(Pz[2], Pz[3]), 0u, 0u}), (f32x4){0.f, 0.f, 0.f, 0.f}, 0, 0, 0);
                  x[0] = dv[0]; x[1] = dv[1]; x[2] = dv[2]; x[3] = dv[3]; }
                const unsigned dp0 = pk2(x[0], x[1]), dp1 = pk2(x[2], x[3]);
                const bf16x8 bdv = __builtin_bit_cast(bf16x8, (u32x4){dp0, dp1, vp0, vp1});
                { const u32x2 m0 = *(const LAS u32x2*)(MBK + l15 * 32 + 4 * q4), m1 = *(const LAS u32x2*)(MBK + l15 * 32 + 16 + 4 * q4);
                  Pr = __builtin_amdgcn_mfma_f32_16x16x32_bf16(__builtin_bit_cast(bf16x8, (u32x4){m0.x, m0.y, m1.x, m1.y}), bdv, Pr, 0, 0, 0); }
                { LAS float* ys = (LAS float*)(t.lds + R5_YS + (n & 1) * 8192 + c2 * 4096);
#pragma unroll
                  for (int i = 0; i < 4; ++i) ys[(4 * q4 + i) * 64 + 16 * q + l15] = Pr[i]; }
#pragma unroll
                for (int cb = 0; cb < 4; ++cb) { const LAS bf16_t* bt = BKT + (16 * cb + l15) * 40 + 4 * q4;
                    const u32x2 b0 = *(const LAS u32x2*)bt, k0 = *(const LAS u32x2*)(bt + 16);
                    ST[cb] = __builtin_amdgcn_mfma_f32_16x16x32_bf16(__builtin_bit_cast(bf16x8, (u32x4){b0.x, b0.y, k0.x, k0.y}), bdv, ST[cb], 0, 0, 0);
                    const f32x4 gl = *(const LAS f32x4*)(GL + 16 * cb + 4 * q4);
                    ST[cb] = ST[cb] * gl; } } }
            LDS_BARRIER();
        }
        if (q == 3) { const LAS float* ys = (const LAS float*)(t.lds + R5_YS + ((NCH - 1) & 1) * 8192 + c2 * 4096);
#pragma unroll
          for (int tt = 0; tt < 16; ++tt) Y[((size_t)bl * SROW + r5_seq(z, (NCH - 1) * R5_L) + sd * tt) * D + colb] = (bf16_t)f2bf(ys[tt * 64 + lane]); }
        LDS_BARRIER();
    }
}
__device__ __forceinline__ void r6_readout(const Tc& t, CArgs a, int jl, int layer, int g) {
    const bf16_t* Y0 = (const bf16_t*)(a->ws + WS_ACT + AR_Y), *Y1 = (const bf16_t*)(a->ws + WS_ACT + AR_Y + SLOT);
    const float* RK0 = (const float*)(a->ws + WS_ACT + AR_RK), *RK1 = RK0 + (size_t)TG * 32;
    const bf16_t* Vb = (layer == 0) ? (const bf16_t*)(a->ws + WS_VF) + (size_t)g * TG * D : (const bf16_t*)(a->ws + WS_ACT + AR_V);
    const bf16_t* Gb = (const bf16_t*)(a->ws + WS_ACT + AR_MIX + 4 * SLOT);
    bf16_t* Ao = (bf16_t*)(a->ws + WS_ACT + AR_AO) + (size_t)g * TG * D;
    const int sl = t.gw & 3, c0 = 512 * sl + 8 * t.lane, head = c0 >> 6;
    const float* lnw = a->in[I_LNW] + (size_t)jl * D + c0, *lnb = a->in[I_LNB] + (size_t)jl * D + c0;
    const f32x4 lw0 = *(const f32x4*)lnw, lw1 = *(const f32x4*)(lnw + 4), lb0 = *(const f32x4*)lnb, lb1 = *(const f32x4*)(lnb + 4);
    const float lw[8] = {lw0.x, lw0.y, lw0.z, lw0.w, lw1.x, lw1.y, lw1.z, lw1.w}, lb[8] = {lb0.x, lb0.y, lb0.z, lb0.w, lb1.x, lb1.y, lb1.z, lb1.w};
    const int rstep = t.ngw >> 2;
    for (int r0 = t.gw >> 2; r0 < TG; r0 += 2 * rstep) {
        u32x4 y0[2], y1[2], vv[2], gg[2]; float rk[2];
#pragma unroll
        for (int k = 0; k < 2; ++k) { const int r = r0 + k * rstep < TG ? r0 + k * rstep : r0; const size_t off = (size_t)r * D + c0;
            y0[k] = *(const u32x4*)(Y0 + off); y1[k] = *(const u32x4*)(Y1 + off); vv[k] = *(const u32x4*)(Vb + off); gg[k] = *(const u32x4*)(Gb + off);
            rk[k] = RK0[(size_t)r * 32 + head] + RK1[(size_t)r * 32 + head]; }
        asm volatile("" ::: "memory");
#pragma unroll
        for (int k = 0; k < 2; ++k) { const int r = r0 + k * rstep; if (r >= TG) break; const size_t off = (size_t)r * D + c0;
            const unsigned a0[4] = {y0[k].x, y0[k].y, y0[k].z, y0[k].w}, a1[4] = {y1[k].x, y1[k].y, y1[k].z, y1[k].w};
            const unsigned av[4] = {vv[k].x, vv[k].y, vv[k].z, vv[k].w}, ag[4] = {gg[k].x, gg[k].y, gg[k].z, gg[k].w};
            float y[8]; float s = 0.f;
#pragma unroll
            for (int i = 0; i < 4; ++i) { y[2 * i] = lo_bf(a0[i]) + lo_bf(a1[i]); y[2 * i + 1] = hi_bf(a0[i]) + hi_bf(a1[i]); s += y[2 * i] + y[2 * i + 1]; }
            s = sum8_(s);
            const float mean = s * (1.0f / 64.0f);
            float qq = 0.f;
#pragma unroll
            for (int i = 0; i < 8; ++i) { y[i] -= mean; qq += y[i] * y[i]; }
            qq = sum8_(qq);
            const float rstd = rsqrtf(qq * (1.0f / 64.0f) + 64e-5f);
            float o[8];
#pragma unroll
            for (int i = 0; i < 4; ++i) { o[2 * i] = (y[2 * i] * rstd * lw[2 * i] + lb[2 * i] + rk[k] * lo_bf(av[i])) * lo_bf(ag[i]);
                o[2 * i + 1] = (y[2 * i + 1] * rstd * lw[2 * i + 1] + lb[2 * i + 1] + rk[k] * hi_bf(av[i])) * hi_bf(ag[i]); }
            u32x4 w; w.x = pk2(o[0], o[1]); w.y = pk2(o[2], o[3]); w.z = pk2(o[4], o[5]); w.w = pk2(o[6], o[7]);
            *(u32x4*)(Ao + off) = w; }
        asm volatile("" ::: "memory");
    }
}

__device__ __forceinline__ void m3_conv(const Tc& t, CArgs a, int jl) {
    const bf16_t* U = (const bf16_t*)(a->ws + WS_ACT + AM_U);
    bf16_t* QK = (bf16_t*)(a->ws + WS_ACT + AM_QK);
    const int sl = t.gw & 7, c0 = 256 * sl + 4 * t.lane;
    const float* cw = a->in[I_CONVW] + (size_t)jl * 9 * D + c0;
    f32x4 wt[9];
#pragma unroll
    for (int k = 0; k < 9; ++k) wt[k] = *(const f32x4*)(cw + k * D);
    const f32x4 bias = *(const f32x4*)(a->in[I_CONVB] + (size_t)jl * D + c0);
    const float sc = c0 < 1024 ? 0.08838834764831845f : 1.0f;
    for (int row = t.gw >> 3; row < T; row += t.ngw >> 3) { const int s = row % SROW;
        f32x4 acc = bias;
        if (s < CTXL) {
#pragma unroll
            for (int dc = -1; dc <= 1; ++dc) if (s + dc >= 0 && s + dc < CTXL) { const u32x2 u = *(const u32x2*)(U + (size_t)(row + dc) * ULD + c0); const f32x4 w = wt[3 + dc + 1];
                acc.x += lo_bf(u.x) * w.x; acc.y += hi_bf(u.x) * w.y; acc.z += lo_bf(u.y) * w.z; acc.w += hi_bf(u.y) * w.w; }
        } else { const int i = s - CTXL, gr = i >> 6, gc = i & 63;
            u32x2 u[9];
#pragma unroll
            for (int dr = -1; dr <= 1; ++dr)
#pragma unroll
                for (int dc = -1; dc <= 1; ++dc) { const bool ok = (gr + dr >= 0) && (gr + dr < 32) && (gc + dc >= 0) && (gc + dc < 64);
                    u[(dr + 1) * 3 + dc + 1] = ok ? *(const u32x2*)(U + (size_t)(row + dr * 64 + dc) * ULD + c0) : (u32x2){0u, 0u}; }
#pragma unroll
            for (int k = 0; k < 9; ++k) { acc.x += lo_bf(u[k].x) * wt[k].x; acc.y += hi_bf(u[k].x) * wt[k].y; acc.z += lo_bf(u[k].y) * wt[k].z; acc.w += hi_bf(u[k].y) * wt[k].w; }
        }
        u32x2 w; w.x = pk2(siluf_(acc.x) * sc, siluf_(acc.y) * sc); w.y = pk2(siluf_(acc.z) * sc, siluf_(acc.w) * sc);
        *(u32x2*)(QK + (size_t)row * D + c0) = w;
    }
}

template <int CTRL> __device__ __forceinline__ float dppz_(float v) { return __int_as_float(__builtin_amdgcn_update_dpp(0, __float_as_int(v), CTRL, 0xF, 0xF, false)); }
template <int CTRL> __device__ __forceinline__ float dppm_(float v) { return __int_as_float(__builtin_amdgcn_update_dpp((int)0xff800000u, __float_as_int(v), CTRL, 0xF, 0xF, false)); }
constexpr int M4_QS = 136, M4_TS = 72;
constexpr int M4_SQ = 0, M4_SK = 17408, M4_SVT = 34816, M4_SWKT = 71680, M4_SP = 90112, M4_F = 99328;
__device__ __forceinline__ void m4_scan(const Tc& t, CArgs a, bool skip_ctx_out) {
    LAS bf16_t* sQ = (LAS bf16_t*)(t.lds + M4_SQ); LAS bf16_t* sK = (LAS bf16_t*)(t.lds + M4_SK); LAS bf16_t* sVT = (LAS bf16_t*)(t.lds + M4_SVT);
    LAS bf16_t* sWKT = (LAS bf16_t*)(t.lds + M4_SWKT); LAS bf16_t* sP = (LAS bf16_t*)(t.lds + M4_SP);
    LAS float* fI = (LAS float*)(t.lds + M4_F);
    LAS float* fF = fI + 64;
    LAS float* fU = fI + 128;
    LAS float* fG = fI + 192;
    LAS float* fWI = fI + 256;
    LAS float* fEN = fI + 320;
    LAS float* fWS = fI + 384;
    LAS float* fRS = fI + 448;
    LAS float* fQN = fI + 576;
    LAS float* fN = fI + 640;
    LAS float* fSC = fI + 768;
    LAS float* fNP = fI + 832;
    const bf16_t* QK = (const bf16_t*)(a->ws + WS_ACT + AM_QK);
    const bf16_t* U = (const bf16_t*)(a->ws + WS_ACT + AM_U);
    const float* Gt = (const float*)(a->ws + WS_ACT + AM_G);
    const int tid = t.tid, lane = t.lane, w = t.wave, l15 = lane & 15, q4 = lane >> 4;
    for (int chain = t.bid; chain < 2 * NB * MH; chain += t.G) {
        const int z = chain / (NB * MH), b = (chain / MH) % NB, h = chain % MH;
        bf16_t* HZ = (bf16_t*)(a->ws + WS_ACT + (z == 0 ? AM_HB : AM_HZ1));
        f32x4 Cacc[8][2];
#pragma unroll
        for (int db = 0; db < 8; ++db)
#pragma unroll
            for (int e = 0; e < 2; ++e) Cacc[db][e] = (f32x4){0.f, 0.f, 0.f, 0.f};
        float m_old = 0.f;
        if (tid < 128) fN[tid] = 0.f;
        LDS_BARRIER();
        const size_t rowb = (size_t)b * SROW; const int sdir = z == 0 ? 1 : -1;
        u32x4 pq[2], pkk[2], pvv[4]; float pgi = 0.f, pgf = 0.f;
#define M4_LOAD(chn) do { const int t0_ = (chn) * 64; const int sb_ = z == 0 ? t0_ : (t0_ < CTXL ? CTXL - 1 - t0_ : SROW + CTXL - 1 - t0_); \
            _Pragma("unroll") for (int rep = 0; rep < 2; ++rep) { const int cid = tid + 512 * rep, i = cid >> 4, cc = cid & 15; const size_t row = rowb + sb_ + sdir * i; \
                pq[rep] = *(const u32x4*)(QK + row * D + h * MDK + 8 * cc); pkk[rep] = *(const u32x4*)(QK + row * D + 1024 + h * MDK + 8 * cc); } \
            _Pragma("unroll") for (int rep = 0; rep < 4; ++rep) { const int cid = tid + 512 * rep, i = cid & 63, cc = cid >> 6; const size_t row = rowb + sb_ + sdir * i; \
                pvv[rep] = *(const u32x4*)(U + row * ULD + 2048 + h * MDV + 8 * cc); } \
            if (tid < 64) { const size_t row = rowb + sb_ + sdir * tid; pgi = Gt[row * 32 + z * 16 + h]; pgf = Gt[row * 32 + z * 16 + 8 + h]; } } while (0)
        M4_LOAD(0);
        asm volatile("s_waitcnt vmcnt(0)" ::: "memory");
        asm volatile("" : "+v"(pq[0]), "+v"(pq[1]), "+v"(pkk[0]), "+v"(pkk[1]));
        asm volatile("" : "+v"(pvv[0]), "+v"(pvv[1]), "+v"(pvv[2]), "+v"(pvv[3]), "+v"(pgi), "+v"(pgf));
        for (int ch = 0; ch < SROW / 64; ++ch) {
            const int t0 = ch * 64;
            const int sbase = z == 0 ? t0 : (t0 < CTXL ? CTXL - 1 - t0 : SROW + CTXL - 1 - t0);
#pragma unroll
            for (int rep = 0; rep < 2; ++rep) { const int cid = tid + 512 * rep, i = cid >> 4, cc = cid & 15;
                *(LAS u32x4*)(sQ + i * M4_QS + 8 * cc) = pq[rep]; *(LAS u32x4*)(sK + i * M4_QS + 8 * cc) = pkk[rep]; }
#pragma unroll
            for (int rep = 0; rep < 4; ++rep) { const int cid = tid + 512 * rep, i = cid & 63, cc = cid >> 6;
                const unsigned wv[4] = {pvv[rep].x, pvv[rep].y, pvv[rep].z, pvv[rep].w};
#pragma unroll
                for (int jj = 0; jj < 4; ++jj) { sVT[(8 * cc + 2 * jj) * M4_TS + i] = (bf16_t)(wv[jj] & 0xffffu); sVT[(8 * cc + 2 * jj + 1) * M4_TS + i] = (bf16_t)(wv[jj] >> 16); } }
            if (ch > 0 && tid < 128) fN[tid] = fSC[0] * fN[tid] + ((fNP[tid] + fNP[128 + tid]) + (fNP[256 + tid] + fNP[384 + tid]));
            if (tid < 64) { fI[tid] = pgi; fF[tid] = pgf; }
            if (ch + 1 < SROW / 64) M4_LOAD(ch + 1);
            LDS_BARRIER();
            if (w == 0) {
                const float ig = fI[lane], lf = fF[lane];
                float bc = lf;
                bc += dppz_<0x111>(bc); bc += dppz_<0x112>(bc); bc += dppz_<0x114>(bc); bc += dppz_<0x118>(bc);
                { const float t0 = rl_(bc, 15), t1 = rl_(bc, 31), t2 = rl_(bc, 47); bc += (lane >= 16 ? t0 : 0.f) + (lane >= 32 ? t1 : 0.f) + (lane >= 48 ? t2 : 0.f); }
                const float g = ig - bc;
                float pm = g;
                pm = fmaxf(pm, dppm_<0x111>(pm)); pm = fmaxf(pm, dppm_<0x112>(pm)); pm = fmaxf(pm, dppm_<0x114>(pm)); pm = fmaxf(pm, dppm_<0x118>(pm));
                { const float t0 = rl_(pm, 15), t1 = rl_(pm, 31), t2 = rl_(pm, 47); const float ninf = -__builtin_inff();
                  pm = fmaxf(pm, fmaxf(fmaxf(lane >= 16 ? t0 : ninf, lane >= 32 ? t1 : ninf), lane >= 48 ? t2 : ninf)); }
                const float b_end = rl_(bc, 63), pm_all = rl_(pm, 63);
                const float m_new = fmaxf(b_end + m_old, b_end + pm_all);
                const float mx = fmaxf(m_old, pm);
                fU[lane] = -mx; fG[lane] = g; fWI[lane] = __expf(m_old - mx); fEN[lane] = __expf(-mx - bc); fWS[lane] = __expf(b_end + g - m_new);
                if (lane == 0) { fSC[0] = __expf(b_end + m_old - m_new); fSC[1] = m_new; }
            }
            const int tb = w >> 1, jb0 = 2 * (w & 1);
            f32x4 St[2];
#pragma unroll
            for (int jj = 0; jj < 2; ++jj) { St[jj] = (f32x4){0.f, 0.f, 0.f, 0.f};
                if (jb0 + jj <= tb) {
#pragma unroll
                    for (int ks = 0; ks < 4; ++ks) { const bf16x8 av = *(const LAS bf16x8*)(sQ + (16 * tb + l15) * M4_QS + 32 * ks + 8 * q4);
                        const bf16x8 bv = *(const LAS bf16x8*)(sK + (16 * (jb0 + jj) + l15) * M4_QS + 32 * ks + 8 * q4);
                        St[jj] = __builtin_amdgcn_mfma_f32_16x16x32_bf16(av, bv, St[jj], 0, 0, 0); } } }
            LDS_BARRIER();
            { float rs[4] = {0.f, 0.f, 0.f, 0.f};
#pragma unroll
              for (int jj = 0; jj < 2; ++jj) { const int j = 16 * (jb0 + jj) + l15; const float gj = fG[j];
#pragma unroll
                  for (int i = 0; i < 4; ++i) { const int tt = 16 * tb + 4 * q4 + i; const float val = (j <= tt) ? St[jj][i] * __expf(fU[tt] + gj) : 0.f;
                      rs[i] += val; sP[tt * M4_TS + j] = (bf16_t)f2bfa(val); } }
#pragma unroll
              for (int i = 0; i < 4; ++i) { float v = rs[i]; v = sum16_(v);
                  if (l15 == 0) fRS[(w & 1) * 64 + 16 * tb + 4 * q4 + i] = v; } }
            { const int d = tid & 127, jg = tid >> 7; unsigned pk[8]; float nn = 0.f;
#pragma unroll
              for (int jj = 0; jj < 8; ++jj) { const int j0 = 16 * jg + 2 * jj; const float w0 = fWS[j0] * bf2f(sK[j0 * M4_QS + d]), w1 = fWS[j0 + 1] * bf2f(sK[(j0 + 1) * M4_QS + d]);
                  nn += w0 + w1; pk[jj] = pk2a(w0, w1); }
              fNP[jg * 128 + d] = nn;
              *(LAS u32x4*)(sWKT + d * M4_TS + 16 * jg) = (u32x4){pk[0], pk[1], pk[2], pk[3]};
              *(LAS u32x4*)(sWKT + d * M4_TS + 16 * jg + 8) = (u32x4){pk[4], pk[5], pk[6], pk[7]}; }
            { const int tt = tid >> 3, dp = tid & 7; float s = 0.f;
#pragma unroll
              for (int dd = 0; dd < 16; ++dd) s += bf2f(sQ[tt * M4_QS + 16 * dp + dd]) * fN[16 * dp + dd];
              s = sum8_(s);
              if (dp == 0) fQN[tt] = s; }
            LDS_BARRIER();
            asm volatile("s_waitcnt vmcnt(0)" ::: "memory");
            asm volatile("" : "+v"(pq[0]), "+v"(pq[1]), "+v"(pkk[0]), "+v"(pkk[1]));
            asm volatile("" : "+v"(pvv[0]), "+v"(pvv[1]), "+v"(pvv[2]), "+v"(pvv[3]), "+v"(pgi), "+v"(pgf));
#pragma unroll 1
            for (int x = (skip_ctx_out && t0 < CTXL) ? 4 : 0; x < 4; ++x) {
                f32x4 acc[2];
                acc[0] = (f32x4){0.f, 0.f, 0.f, 0.f}; acc[1] = (f32x4){0.f, 0.f, 0.f, 0.f};
#pragma unroll
                for (int kb = 0; kb < 4; ++kb) {
                    const LAS bf16_t* qr = sQ + (16 * x + l15) * M4_QS + 32 * kb + 4 * q4;
                    const u32x2 lo = *(const LAS u32x2*)qr, hi = *(const LAS u32x2*)(qr + 16);
                    const bf16x8 aop = __builtin_bit_cast(bf16x8, (u32x4){lo.x, lo.y, hi.x, hi.y});
#pragma unroll
                    for (int e = 0; e < 2; ++e) { const f32x4 c0 = Cacc[2 * kb][e], c1 = Cacc[2 * kb + 1][e];
                        u32x4 p; p.x = pk2a(c0[0], c0[1]); p.y = pk2a(c0[2], c0[3]); p.z = pk2a(c1[0], c1[1]); p.w = pk2a(c1[2], c1[3]);
                        acc[e] = __builtin_amdgcn_mfma_f32_16x16x32_bf16(aop, __builtin_bit_cast(bf16x8, p), acc[e], 0, 0, 0); } }
                { const f32x4 wi = *(const LAS f32x4*)(fWI + 16 * x + 4 * q4); acc[0] = acc[0] * wi; acc[1] = acc[1] * wi; }
#pragma unroll
                for (int ks = 0; ks < 2; ++ks) { const bf16x8 aop = *(const LAS bf16x8*)(sP + (16 * x + l15) * M4_TS + 32 * ks + 8 * q4);
#pragma unroll
                    for (int e = 0; e < 2; ++e) { const bf16x8 bop = *(const LAS bf16x8*)(sVT + (16 * (2 * w + e) + l15) * M4_TS + 32 * ks + 8 * q4);
                        acc[e] = __builtin_amdgcn_mfma_f32_16x16x32_bf16(aop, bop, acc[e], 0, 0, 0); } }
#pragma unroll
                for (int i = 0; i < 4; ++i) { const int tt = 16 * x + 4 * q4 + i;
                    const float den = fWI[tt] * fQN[tt] + fRS[tt] + fRS[64 + tt]; const float dv = __builtin_amdgcn_rcpf(fmaxf(fabsf(den), fEN[tt]));
                    const size_t row = rowb + sbase + sdir * tt;
#pragma unroll
                    for (int e = 0; e < 2; ++e) HZ[row * D + h * MDV + 16 * (2 * w + e) + l15] = (bf16_t)f2bfa(acc[e][i] * dv); }
            }
            { const float dec = fSC[0];
#pragma unroll
              for (int db = 0; db < 8; ++db)
#pragma unroll
                  for (int e = 0; e < 2; ++e) Cacc[db][e] = Cacc[db][e] * dec;
#pragma unroll
              for (int ks = 0; ks < 2; ++ks) {
                  bf16x8 bop[2];
#pragma unroll
                  for (int e = 0; e < 2; ++e) bop[e] = *(const LAS bf16x8*)(sVT + (16 * (2 * w + e) + l15) * M4_TS + 32 * ks + 8 * q4);
#pragma unroll
                  for (int db = 0; db < 8; ++db) { const bf16x8 aop = *(const LAS bf16x8*)(sWKT + (16 * db + l15) * M4_TS + 32 * ks + 8 * q4);
#pragma unroll
                      for (int e = 0; e < 2; ++e) Cacc[db][e] = __builtin_amdgcn_mfma_f32_16x16x32_bf16(aop, bop[e], Cacc[db][e], 0, 0, 0); } }
 }
            m_old = fSC[1];
            LDS_BARRIER();
        }
#undef M4_LOAD
    }
}

__device__ __forceinline__ void m5_readout(const Tc& t, CArgs a, int jl, bool latent_only) {
    const bf16_t* H0 = (const bf16_t*)(a->ws + WS_ACT + AM_HB), *H1 = (const bf16_t*)(a->ws + WS_ACT + AM_HZ1);
    const bf16_t* U = (const bf16_t*)(a->ws + WS_ACT + AM_U);
    bf16_t* Ao = (bf16_t*)(a->ws + WS_ACT + AM_QK);
    const int sl = t.gw & 3, c0 = 512 * sl + 8 * t.lane;
    const float* nw = a->in[I_MNORMW] + (size_t)jl * D + c0;
    const f32x4 w0 = *(const f32x4*)nw, w1 = *(const f32x4*)(nw + 4);
    const float w8[8] = {w0.x, w0.y, w0.z, w0.w, w1.x, w1.y, w1.z, w1.w};
    const int rstep = t.ngw >> 2;
    const int NR = latent_only ? NB * SEQ : T;
    auto rmap = [&](int rr) -> int { return latent_only ? (rr / SEQ) * SROW + CTXL + rr % SEQ : rr; };
    for (int r0 = t.gw >> 2; r0 < NR; r0 += 4 * rstep) {
        u32x4 h0[4], h1[4], ov[4];
#pragma unroll
        for (int k = 0; k < 4; ++k) { const int row = rmap(r0 + k * rstep < NR ? r0 + k * rstep : r0); const size_t off = (size_t)row * D + c0;
            h0[k] = *(const u32x4*)(H0 + off); h1[k] = *(const u32x4*)(H1 + off); ov[k] = *(const u32x4*)(U + (size_t)row * ULD + 4096 + c0); }
        asm volatile("" ::: "memory");
#pragma unroll
        for (int k = 0; k < 4; ++k) { if (r0 + k * rstep >= NR) break; const int row = rmap(r0 + k * rstep); const size_t off = (size_t)row * D + c0;
            const unsigned a0[4] = {h0[k].x, h0[k].y, h0[k].z, h0[k].w}, a1[4] = {h1[k].x, h1[k].y, h1[k].z, h1[k].w}, ao[4] = {ov[k].x, ov[k].y, ov[k].z, ov[k].w};
            float y[8]; float s = 0.f;
#pragma unroll
            for (int i = 0; i < 4; ++i) { y[2 * i] = lo_bf(a0[i]) + lo_bf(a1[i]); y[2 * i + 1] = hi_bf(a0[i]) + hi_bf(a1[i]); s += y[2 * i] + y[2 * i + 1]; }
            s = sum16_(s); s += shfl_xor_(s, 16, t.lane);
            const float mean = s * (1.0f / 256.0f);
            float qq = 0.f;
#pragma unroll
            for (int i = 0; i < 8; ++i) { y[i] -= mean; qq += y[i] * y[i]; }
            qq = sum16_(qq); qq += shfl_xor_(qq, 16, t.lane);
            const float rstd = rsqrtf(qq * (1.0f / 256.0f) + 1e-6f);
            float o[8];
#pragma unroll
            for (int i = 0; i < 4; ++i) { o[2 * i] = y[2 * i] * rstd * w8[2 * i] * sigmoidf_(lo_bf(ao[i])); o[2 * i + 1] = y[2 * i + 1] * rstd * w8[2 * i + 1] * sigmoidf_(hi_bf(ao[i])); }
            u32x4 wv; wv.x = pk2(o[0], o[1]); wv.y = pk2(o[2], o[3]); wv.z = pk2(o[4], o[5]); wv.w = pk2(o[6], o[7]);
            *(u32x4*)(Ao + off) = wv; }
        asm volatile("" ::: "memory");
    }
}

__device__ __forceinline__ void final_norm(const Tc& t, CArgs a) {
    const float* xres = (const float*)(a->ws + WS_XRES);
    f32x4 gg[8];
    { const f32x4* gp = (const f32x4*)a->in[I_FINALG] + t.lane;
#pragma unroll
      for (int j = 0; j < 8; ++j) gg[j] = gp[64 * j]; }
    for (int r0 = t.gw; r0 < NB * SEQ; r0 += 2 * t.ngw) {
        f32x4 v[2][8];
#pragma unroll
        for (int k = 0; k < 2; ++k) { const int r = r0 + k * t.ngw < NB * SEQ ? r0 + k * t.ngw : r0; const size_t row = (size_t)(r / SEQ) * SROW + CTXL + (r % SEQ);
            const f32x4* xr = (const f32x4*)(xres + row * D) + t.lane;
#pragma unroll
            for (int j = 0; j < 8; ++j) v[k][j] = xr[64 * j]; }
        asm volatile("" ::: "memory");
#pragma unroll
        for (int k = 0; k < 2; ++k) { const int r = r0 + k * t.ngw; if (r >= NB * SEQ) break;
            float ss = 0.f;
#pragma unroll
            for (int j = 0; j < 8; ++j) ss += (v[k][j].x * v[k][j].x + v[k][j].y * v[k][j].y) + (v[k][j].z * v[k][j].z + v[k][j].w * v[k][j].w);
            const float rstd = rsqrtf(wave_sum_dpp(ss) * (1.0f / D) + 1e-6f);
            f32x4* o = (f32x4*)(a->out + (size_t)r * D) + t.lane;
#pragma unroll
            for (int j = 0; j < 8; ++j) o[64 * j] = v[k][j] * rstd * gg[j]; }
        asm volatile("" ::: "memory");
    }
}
constexpr int NU_FULL = (T / 256) * (D / 256), NU_SKIP = (T / 9 * 8 / 256) * (D / 256);
constexpr int NSEG = 1 + 2 * (12 + 1 + 3) + 2 * (6 + 3) + 1;

__global__ void __launch_bounds__(512, 2) hybrid_fwd(Args args) {
    extern __shared__ __attribute__((aligned(16))) unsigned char lds_raw[];
    LAS unsigned char* const lds = (LAS unsigned char*)lds_raw;
    volatile LAS unsigned* MISC = (volatile LAS unsigned*)(lds + LDSCTL_OFF);
    if (threadIdx.x < 64) MISC[threadIdx.x] = 0u;
    __syncthreads();
    const int lo = args.ph_lo, hi = args.ph_hi;
    const bool fused = (hi - lo) > 1;
    unsigned* barw = (unsigned*)(args.ws + WS_CTL) + 4096;
    XcdBarrier bar; bar.bar = barw; bar.x = 0; bar.st = MISC + 8;
    if (fused) bar = xcd_barrier_post(barw, MISC + 8);
    int seg = 0;
    int urot = 0;
#define ACTIVE (seg >= lo && seg < hi)
#define PH_BEGIN const Tc t = mk_tc(lds); const CArgs a = opaque_args(); unsigned char* const act = a->ws + WS_ACT; (void)act; (void)t;
#define SEAM() do { if (fused && seg >= lo && seg + 1 < hi) xcd_barrier(bar); ++seg; } while (0)

    if (ACTIVE) { PH_BEGIN ph_prologue(t, a); }
    SEAM();
    for (int layer = 0; layer < 4; ++layer) {
        const int jl = layer >> 1;
        if ((layer & 1) == 0) {
            for (int g = 0; g < NGRP; ++g) {
                if (g == 0) {
                if (ACTIVE) { PH_BEGIN if (layer == 0) convert_rwkv(t, a, 0);
                    norm_rows<true>(t, a, layer, 0, 0, TG, act + AR_H, layer == 0); }
                SEAM(); }
                if (ACTIVE) { PH_BEGIN r2_mix(t, a, jl); }
                SEAM();
                if (ACTIVE) {
                    PH_BEGIN const bf16_t* wm = (const bf16_t*)(a->ws + WS_WMIX);
                    bf16_t* vdst = (layer == 0) ? (bf16_t*)(a->ws + WS_VF) + (size_t)g * TG * D : (bf16_t*)(act + AR_V);
                    const bf16_t* mix[6];
#pragma unroll
                    for (int m = 0; m < 6; ++m) mix[m] = (const bf16_t*)(act + AR_MIX + (size_t)m * SLOT);
                    for (int q = 0; q < 7; ++q) {
                        if (q == 6 && jl == 0) break;
                        const bf16_t* A = q == 0 ? mix[0] : q == 1 ? mix[2] : q == 2 ? mix[3] : q == 3 ? mix[1] : q == 4 ? mix[4] : q == 5 ? mix[5] : mix[3];
                        const size_t wo = q == 0 ? WM_R : q == 1 ? WM_K : q == 2 ? WM_V : q == 3 ? WM_W1 : q == 4 ? WM_A1 : q == 5 ? WM_G1 : WM_V1;
                        bf16_t* O = q == 0 ? (bf16_t*)(act + AR_R) : q == 1 ? (bf16_t*)(act + AR_K) : q == 2 ? vdst : (bf16_t*)(act + AR_LORA + (size_t)(q - 3) * 9 * MiB);
                        const int N = q < 3 ? D : 256; const int actf = q == 3 ? 1 : q == 5 ? 2 : 0;
                        pg8::EpiStore E{O, (q == 3 || q == 4 || q == 6) ? 128 : N, actf, (q == 3 || q == 4 || q == 6) ? -1 : 0, (size_t)TG * 128, -1, nullptr, nullptr};
                        run_gemm(t.lds, A, (const bf16_t*)((const char*)wm + wo), TG, N, D, E, urot);
                    }
                }
                SEAM();
                if (ACTIVE) {
                    PH_BEGIN const bf16_t* wm = (const bf16_t*)(a->ws + WS_WMIX);
                    const bf16_t* lora = (const bf16_t*)(act + AR_LORA);
                    int k128 = 128; asm volatile("" : "+s"(k128));
#pragma unroll 1
                    for (int qz = 0; qz < 4; ++qz) { const int q = qz >> 1, z = qz & 1;
                        pg8::EpiSigAff E{(bf16_t*)(act + AR_MIX + (size_t)(2 * q) * SLOT) + (size_t)z * TG * D, (size_t)TG * D, a->in[q == 0 ? I_W0 : I_A0] + (size_t)jl * 2 * D + (size_t)z * D, q == 0 ? -0.6065306597126334f : 1.0f};
                        run_gemm(t.lds, lora + (size_t)q * TG * 256 + (size_t)z * TG * 128, (const bf16_t*)((const char*)wm + (q == 0 ? WM_W2 : WM_A2)) + (size_t)z * D * 128, TG, D, k128, E, urot);
                    }
                    { pg8::EpiStore E{(bf16_t*)(act + AR_MIX + 4 * SLOT), D, 0, 0, 0, -1, nullptr, nullptr};
                      run_gemm(t.lds, lora + (size_t)2 * TG * 256, (const bf16_t*)((const char*)wm + WM_G2), TG, D, 256, E, urot); }
                    if (jl > 0) { pg8::EpiVmix E{(bf16_t*)(act + AR_V), (const bf16_t*)(a->ws + WS_VF) + (size_t)g * TG * D, a->in[I_V0] + (size_t)(jl - 1) * D};
                      run_gemm(t.lds, lora + (size_t)3 * TG * 256, (const bf16_t*)((const char*)wm + WM_V2), TG, D, k128, E, urot); }
                }
                SEAM();
                if (ACTIVE) { PH_BEGIN r5_scan(t, a, jl, layer, g); }
                SEAM();
                if (ACTIVE) { PH_BEGIN r6_readout(t, a, jl, layer, g);
                    if (g == 0) { const Tc t2 = mk_tc(lds); const CArgs a2 = opaque_args(); norm_rows<true>(t2, a2, layer, 0, TG, TG, a2->ws + WS_ACT + AR_H, layer == 0); } }
                SEAM();
            }
            if (ACTIVE) { PH_BEGIN pg8::EpiResid E{(float*)(a->ws + WS_XRES), (const float*)(a->ws + WS_MOD) + (size_t)layer * 17 * MODLD + 2 * D, 0, layer == 0 ? a->in[I_X] : nullptr, a->in[I_CTX]};
                run_gemm(t.lds, (const bf16_t*)(act + AR_AO), (const bf16_t*)(a->ws + WS_WMIX + WM_O), T, D, D, E, urot);
                { const Tc t2 = mk_tc(lds); const CArgs a2 = opaque_args(); Tc ts; if (tail_crew(t2, urot - NU_FULL, NU_FULL, ts)) { __syncthreads(); convert_ffn_out(ts, a2, layer); if (layer == 0) convert_ffn_in(ts, a2, 0); } } }
            SEAM();
        } else {
            if (ACTIVE) { PH_BEGIN norm_rows<true>(t, a, layer, 0, 0, T, act + AM_HB); }
            SEAM();
            if (ACTIVE) { PH_BEGIN const bf16_t* win = (const bf16_t*)(a->ws + WS_WMIX + WM_MIN); float* Gp = (float*)(act + AM_G); const float* bg = a->in[I_BGATE] + (size_t)jl * 32;
                if (layer == 3) {
                    { pg8::EpiStore E{(bf16_t*)(act + AM_U), ULD, 0, 0, 0, -1, nullptr, nullptr};
                      run_gemm(t.lds, (const bf16_t*)(act + AM_HB), win, T, 4096, D, E, urot); }
                    { pg8::EpiStore E{(bf16_t*)(act + AM_U) + 4096, ULD, 0, 0, 0, 8, Gp, bg};
                      run_gemm<pg8::EpiStore, true>(t.lds, (const bf16_t*)(act + AM_HB), win + (size_t)4096 * D, T, 2304, D, E, urot); }
                    { pg8::EpiStore E{(bf16_t*)(act + AM_U), ULD, 0, 0, 0, 0, Gp, bg};
                      run_gemm_ctx(t.lds, (const bf16_t*)(act + AM_HB), win + (size_t)6144 * D, T, 256, D, E, urot); }
                } else { pg8::EpiStore E{(bf16_t*)(act + AM_U), ULD, 0, 0, 0, 24, Gp, bg};
                    run_gemm(t.lds, (const bf16_t*)(act + AM_HB), win, T, 6400, D, E, urot); } }
            SEAM();
            if (ACTIVE) { PH_BEGIN m3_conv(t, a, jl); }
            SEAM();
            if (ACTIVE) { PH_BEGIN m4_scan(t, a, layer == 3); }
            SEAM();
            if (ACTIVE) { PH_BEGIN m5_readout(t, a, jl, layer == 3); }
            SEAM();
            if (ACTIVE) { PH_BEGIN pg8::EpiResid E{(float*)(a->ws + WS_XRES), (const float*)(a->ws + WS_MOD) + (size_t)layer * 17 * MODLD + 2 * D, 0, nullptr, nullptr};
                if (layer == 3) run_gemm<pg8::EpiResid, true>(t.lds, (const bf16_t*)(act + AM_QK), (const bf16_t*)(a->ws + WS_WMIX + WM_MOUT), T, D, D, E, urot);
                else run_gemm(t.lds, (const bf16_t*)(act + AM_QK), (const bf16_t*)(a->ws + WS_WMIX + WM_MOUT), T, D, D, E, urot);
                { const Tc t2 = mk_tc(lds); const CArgs a2 = opaque_args(); Tc ts; const int nu = layer == 3 ? NU_SKIP : NU_FULL; if (tail_crew(t2, urot - nu, nu, ts)) { __syncthreads(); convert_ffn_out(ts, a2, layer); } } }
            SEAM();
        }
        if (ACTIVE) { PH_BEGIN if (layer == 3) norm_rows<true>(t, a, layer, 1, 0, NB * SEQ, act + AF_H2, false, true); else norm_rows<true>(t, a, layer, 1, 0, T, act + AF_H2); }
        SEAM();
        if (ACTIVE) { PH_BEGIN pg8::EpiSwiglu E{(bf16_t*)(act + AF_U)};
            if (layer == 3) run_gemm<pg8::EpiSwiglu, true>(t.lds, (const bf16_t*)(act + AF_H2), (const bf16_t*)(a->ws + WS_WFFN + WF_IN), T, 2 * DFF, D, E, urot);
            else run_gemm(t.lds, (const bf16_t*)(act + AF_H2), (const bf16_t*)(a->ws + WS_WFFN + WF_IN), T, 2 * DFF, D, E, urot); }
        SEAM();
        if (ACTIVE) { PH_BEGIN pg8::EpiResid E{(float*)(a->ws + WS_XRES), (const float*)(a->ws + WS_MOD) + (size_t)layer * 17 * MODLD + 5 * D, 0, nullptr, nullptr};
            if (layer == 3) run_gemm<pg8::EpiResid, true>(t.lds, (const bf16_t*)(act + AF_U), (const bf16_t*)(a->ws + WS_WFFN + WF_OUT), T, D, DFF, E, urot);
            else run_gemm(t.lds, (const bf16_t*)(act + AF_U), (const bf16_t*)(a->ws + WS_WFFN + WF_OUT), T, D, DFF, E, urot);
            if (layer < 3) { const Tc t2 = mk_tc(lds); const CArgs a2 = opaque_args(); Tc ts; if (tail_crew(t2, urot - NU_FULL, NU_FULL, ts)) { __syncthreads();
                if (layer & 1) convert_rwkv(ts, a2, (layer + 1) >> 1); else convert_mlstm(ts, a2, (layer + 1) >> 1);
                convert_ffn_in(ts, a2, layer + 1); } } }
        SEAM();
    }
    if (ACTIVE) { PH_BEGIN final_norm(t, a); }
#undef ACTIVE
#undef SEAM
#undef PH_BEGIN
}

#ifndef MK_MULTI
#define MK_MULTI 0
#endif
extern "C" void kernel_launch(void* const* d_in, const int* in_sizes, int n_in, void* d_out, int out_size, void* d_ws, size_t ws_size, hipStream_t stream) {
    static int grid = 0;
    if (grid == 0) {
        if (n_in != NIN || ws_size < WS_END) { fprintf(stderr, "kernel_launch: unexpected n_in %d / ws %zu\n", n_in, ws_size); grid = -1; return; }
        int dev = 0, cus = 0, per_cu = 0;
        if (hipGetDevice(&dev) != hipSuccess || hipDeviceGetAttribute(&cus, hipDeviceAttributeMultiprocessorCount, dev) != hipSuccess) { grid = -1; return; }
        if (hipFuncSetAttribute((const void*)hybrid_fwd, hipFuncAttributeMaxDynamicSharedMemorySize, LDS_BYTES) != hipSuccess) { fprintf(stderr, "kernel_launch: hipFuncSetAttribute failed\n"); grid = -1; return; }
        if (hipOccupancyMaxActiveBlocksPerMultiprocessor(&per_cu, (const void*)hybrid_fwd, 512, LDS_BYTES) != hipSuccess || per_cu < 1)
            fprintf(stderr, "kernel_launch: occupancy query reports %d workgroups per CU\n", per_cu);
        (void)hipGetLastError();
        grid = cus;
    }
    if (grid < 0) return;
    if (hipMemsetAsync((char*)d_ws + WS_CTL, 0, CTL_ZERO_BYTES, stream) != hipSuccess) return;
    Args a{};
    for (int i = 0; i < NIN; ++i) a.in[i] = (const float*)d_in[i];
    a.out = (float*)d_out; a.ws = (unsigned char*)d_ws;
#if MK_MULTI
    for (int s = 0; s < NSEG; ++s) { a.ph_lo = s; a.ph_hi = s + 1; hipLaunchKernelGGL(hybrid_fwd, dim3(grid), dim3(512), LDS_BYTES, stream, a); }
#else
    a.ph_lo = 0; a.ph_hi = NSEG;
    hipLaunchKernelGGL(hybrid_fwd, dim3(grid), dim3(512), LDS_BYTES, stream, a);
#endif
}
```
